# Optimizing an MI355X kernel written in HIP

```python
import math
import jax, jax.numpy as jnp
from jax import lax
import numpy as np

D_MODEL = 1024
BATCH = 8
SEQ = 4096
DEPTH = 1

HEAD_DIM = 64
N_HEADS_A = 8
DILATED_PATTERNS = ((128, 1), (512, 4), (2048, 16))
N_HEADS_B = 4
DIFF_V_DIM = 2 * HEAD_DIM
WIDTH_A = N_HEADS_A * HEAD_DIM
WIDTH_B = N_HEADS_B * DIFF_V_DIM
N_ALIBI_HEADS = N_HEADS_A + N_HEADS_B
ALIBI_IDX_A = (0, 1, 3, 4, 6, 7, 9, 10)
ALIBI_IDX_B = (2, 5, 8, 11)
IN_SIZES = (WIDTH_A, WIDTH_A, WIDTH_A,
            N_HEADS_B * 2 * HEAD_DIM, N_HEADS_B * 2 * HEAD_DIM, WIDTH_B,
            D_MODEL, D_MODEL)
IN_TOTAL = sum(IN_SIZES)
Q_BLOCK = 128
MASK_VALUE = -1e30
N_EXPERTS = 32
TOP_K = 4
D_EXPERT = D_MODEL
SWIGLU_ALPHA = 1.702
SWIGLU_LIMIT = 7.0
MOE_BLOCK = 256
LN_EPS = 1e-5
SUBLN_EPS = 1e-5
DEEPNORM_ALPHA = (2.0 * DEPTH) ** 0.25
DEEPNORM_BETA = (8.0 * DEPTH) ** -0.25

kernel_name = "hybrid_dilated_diffattn_moe_encoder"


def alibi_slopes(n):
    return jnp.asarray(2.0 ** (-8.0 * np.arange(1, n + 1) / n), jnp.float32)


def layer_norm(x, g, b):
    xf = x.astype(jnp.float32)
    mu = jnp.mean(xf, axis=-1, keepdims=True)
    var = jnp.mean(jnp.square(xf - mu), axis=-1, keepdims=True)
    y = (xf - mu) * lax.rsqrt(var + LN_EPS) * g.astype(jnp.float32) + b.astype(jnp.float32)
    return y.astype(x.dtype)


def dilated_window_attention(q, k, v, slopes, window, dilation):
    b, h, s, dh = q.shape
    half = window // (2 * dilation)
    L = s // dilation
    nb = -(-L // Q_BLOCK)
    Lp = nb * Q_BLOCK
    band = Q_BLOCK + 2 * half

    def to_residue(t):
        return t.reshape(b, h, L, dilation, dh).transpose(0, 1, 3, 2, 4)

    qr, kr, vr = to_residue(q), to_residue(k), to_residue(v)
    qb = jnp.pad(qr, ((0, 0), (0, 0), (0, 0), (0, Lp - L), (0, 0))).reshape(b, h, dilation, nb, Q_BLOCK, dh)
    kv_pad = ((0, 0), (0, 0), (0, 0), (half, Lp - L + half), (0, 0))
    kp, vp = jnp.pad(kr, kv_pad), jnp.pad(vr, kv_pad)
    idx = jnp.arange(nb)[:, None] * Q_BLOCK + jnp.arange(band)[None, :]
    kb = kp[:, :, :, idx]
    vb = vp[:, :, :, idx]

    scores = jnp.einsum('bhrnqe,bhrnke->bhrnqk', qb, kb).astype(jnp.float32) * (dh ** -0.5)
    rel = jnp.arange(Q_BLOCK)[:, None] - jnp.arange(band)[None, :] + half
    key_pos = idx - half
    valid = ((jnp.abs(rel) <= half)[None]
             & (key_pos[:, None, :] >= 0) & (key_pos[:, None, :] < L))
    bias = -slopes[:, None, None] * (dilation * jnp.abs(rel)).astype(jnp.float32)
    scores = jnp.where(valid, scores + bias[None, :, None, None], MASK_VALUE)
    m = jnp.max(scores, axis=-1, keepdims=True)
    p = jnp.exp(scores - m)
    z = jnp.sum(p, axis=-1, keepdims=True)
    o = jnp.einsum('bhrnqk,bhrnke->bhrnqe', (p / z).astype(v.dtype), vb)
    lse = (m + jnp.log(z))[..., 0]
    o = o.reshape(b, h, dilation, Lp, dh)[:, :, :, :L].transpose(0, 1, 3, 2, 4).reshape(b, h, s, dh)
    lse = lse.reshape(b, h, dilation, Lp)[..., :L].transpose(0, 1, 3, 2).reshape(b, h, s)
    return o, lse


def differential_attention(q1, q2, k1, k2, v, slopes, lam):
    b, h, s, dh = q1.shape
    nb = s // Q_BLOCK
    scale = dh ** -0.5
    key_pos = jnp.arange(s)

    def blocks(t):
        return t.reshape(b, h, nb, Q_BLOCK, dh).transpose(2, 0, 1, 3, 4)

    def one_block(args):
        q1b, q2b, start = args
        qpos = start + jnp.arange(Q_BLOCK)
        bias = -slopes[:, None, None] * jnp.abs(qpos[:, None] - key_pos[None, :]).astype(jnp.float32)
        a1 = jax.nn.softmax(jnp.einsum('bhqe,bhke->bhqk', q1b, k1).astype(jnp.float32) * scale + bias, axis=-1)
        a2 = jax.nn.softmax(jnp.einsum('bhqe,bhke->bhqk', q2b, k2).astype(jnp.float32) * scale + bias, axis=-1)
        return jnp.einsum('bhqk,bhkv->bhqv', (a1 - lam * a2).astype(v.dtype), v)

    starts = jnp.arange(nb, dtype=jnp.int32) * Q_BLOCK
    o = lax.map(one_block, (blocks(q1), blocks(q2), starts))
    return o.transpose(1, 2, 0, 3, 4).reshape(b, h, s, v.shape[-1])


def token_mixer(x, w_in, b_in, lambda_q1, lambda_k1, lambda_q2, lambda_k2, subln_g,
                w_proj_a, w_proj_b, w_out, b_out, lambda_init):
    bsz, seq, _ = x.shape
    proj = x @ w_in + b_in
    splits = [int(c) for c in np.cumsum(IN_SIZES)[:-1]]
    q_a, k_a, v_a, q_b, k_b, v_b, g_a, g_b = jnp.split(proj, splits, axis=-1)
    slopes = alibi_slopes(N_ALIBI_HEADS)

    def split_heads(t, n, dh):
        return t.reshape(bsz, seq, n, dh).transpose(0, 2, 1, 3)

    qa = split_heads(q_a, N_HEADS_A, HEAD_DIM)
    ka = split_heads(k_a, N_HEADS_A, HEAD_DIM)
    va = split_heads(v_a, N_HEADS_A, HEAD_DIM)
    slopes_a = slopes[np.array(ALIBI_IDX_A)]
    outs, lses = [], []
    for window, dilation in DILATED_PATTERNS:
        o, l = dilated_window_attention(qa, ka, va, slopes_a, window, dilation)
        outs.append(o)
        lses.append(l)
    mix_w = jax.nn.softmax(jnp.stack(lses), axis=0)
    o_a = jnp.sum(mix_w[..., None] * jnp.stack(outs).astype(jnp.float32), axis=0).astype(x.dtype)
    o_a = o_a.transpose(0, 2, 1, 3).reshape(bsz, seq, WIDTH_A)

    def split_pair(t):
        t = t.reshape(bsz, seq, N_HEADS_B, 2, HEAD_DIM).transpose(0, 2, 3, 1, 4)
        return t[:, :, 0], t[:, :, 1]

    q1, q2 = split_pair(q_b)
    k1, k2 = split_pair(k_b)
    vb = split_heads(v_b, N_HEADS_B, DIFF_V_DIM)
    lam = (jnp.exp(jnp.sum(lambda_q1.astype(jnp.float32) * lambda_k1.astype(jnp.float32)))
           - jnp.exp(jnp.sum(lambda_q2.astype(jnp.float32) * lambda_k2.astype(jnp.float32)))
           + lambda_init)
    o_b = differential_attention(q1, q2, k1, k2, vb, slopes[np.array(ALIBI_IDX_B)], lam)
    of = o_b.astype(jnp.float32)
    of = of * lax.rsqrt(jnp.mean(jnp.square(of), axis=-1, keepdims=True) + SUBLN_EPS)
    of = of * subln_g.astype(jnp.float32) * (1.0 - lambda_init)
    o_b = of.astype(x.dtype).transpose(0, 2, 1, 3).reshape(bsz, seq, WIDTH_B)

    merged = jax.nn.sigmoid(g_a) * (o_a @ w_proj_a) + jax.nn.sigmoid(g_b) * (o_b @ w_proj_b)
    return merged @ w_out + b_out


def moe_ffn(x, w_router, b_router, w_up, b_up, w_down, b_down):
    bsz, seq, d = x.shape
    xt = x.reshape(bsz * seq, d)
    n_tok = xt.shape[0]
    logits = (xt @ w_router + b_router).astype(jnp.float32)
    top_vals, top_idx = lax.top_k(logits, TOP_K)
    gates = jax.nn.softmax(top_vals, axis=-1).astype(x.dtype)

    n_assign = n_tok * TOP_K
    flat_e = top_idx.reshape(n_assign)
    flat_tok = jnp.arange(n_assign, dtype=jnp.int32) // TOP_K
    flat_w = gates.reshape(n_assign)
    order = jnp.argsort(flat_e)
    sorted_e = flat_e[order]
    counts = jnp.bincount(flat_e, length=N_EXPERTS)
    start = jnp.cumsum(counts) - counts
    padded_counts = (counts + MOE_BLOCK - 1) // MOE_BLOCK * MOE_BLOCK
    padded_end = jnp.cumsum(padded_counts)
    padded_start = padded_end - padded_counts
    dest = padded_start[sorted_e] + (jnp.arange(n_assign) - start[sorted_e])

    n_blocks = -(-n_assign // MOE_BLOCK) + N_EXPERTS
    n_rows = n_blocks * MOE_BLOCK
    buf_tok = jnp.zeros((n_rows,), jnp.int32).at[dest].set(flat_tok[order])
    buf_w = jnp.zeros((n_rows,), x.dtype).at[dest].set(flat_w[order])
    block_start = jnp.arange(n_blocks) * MOE_BLOCK
    block_e = jnp.minimum(jnp.searchsorted(padded_end, block_start, side='right'), N_EXPERTS - 1)

    def expert_block(args):
        tok, e = args
        xb = xt[tok]
        hcat = xb @ w_up[e] + b_up[e]
        gate = jnp.minimum(hcat[:, :D_EXPERT], SWIGLU_LIMIT)
        up = jnp.clip(hcat[:, D_EXPERT:], -SWIGLU_LIMIT, SWIGLU_LIMIT)
        act = gate * jax.nn.sigmoid(SWIGLU_ALPHA * gate) * (up + 1.0)
        return act @ w_down[e] + b_down[e]

    ys = lax.map(expert_block, (buf_tok.reshape(n_blocks, MOE_BLOCK), block_e))
    ys = ys.reshape(n_rows, d) * buf_w[:, None]
    out = jnp.zeros((n_tok, d), x.dtype).at[buf_tok].add(ys)
    return out.reshape(bsz, seq, d)


def setup_inputs(seed: int = 0) -> dict:
    key = jax.random.key(seed)
    ks = jax.random.split(key, 24)
    f32 = jnp.float32

    def nrm(k, shape, scale):
        return jax.random.normal(k, shape, f32) * scale

    col_scale = np.ones((IN_TOTAL,), np.float32)
    offs = np.concatenate([[0], np.cumsum(IN_SIZES)])
    col_scale[offs[2]:offs[3]] = DEEPNORM_BETA
    col_scale[offs[5]:offs[6]] = DEEPNORM_BETA

    return {
        "x": jax.random.normal(ks[0], (BATCH, SEQ, D_MODEL), f32),
        "w_in": nrm(ks[1], (DEPTH, D_MODEL, IN_TOTAL), D_MODEL ** -0.5) * jnp.asarray(col_scale),
        "b_in": nrm(ks[2], (DEPTH, IN_TOTAL), 0.01),
        "lambda_q1": nrm(ks[3], (DEPTH, HEAD_DIM), 0.1),
        "lambda_k1": nrm(ks[4], (DEPTH, HEAD_DIM), 0.1),
        "lambda_q2": nrm(ks[5], (DEPTH, HEAD_DIM), 0.1),
        "lambda_k2": nrm(ks[6], (DEPTH, HEAD_DIM), 0.1),
        "subln_g": 1.0 + nrm(ks[7], (DEPTH, DIFF_V_DIM), 0.02),
        "w_proj_a": nrm(ks[8], (DEPTH, WIDTH_A, D_MODEL), WIDTH_A ** -0.5),
        "w_proj_b": nrm(ks[9], (DEPTH, WIDTH_B, D_MODEL), WIDTH_B ** -0.5),
        "w_out": nrm(ks[10], (DEPTH, D_MODEL, D_MODEL), D_MODEL ** -0.5 * DEEPNORM_BETA),
        "b_out": nrm(ks[11], (DEPTH, D_MODEL), 0.01),
        "ln1_g": 1.0 + nrm(ks[12], (DEPTH, D_MODEL), 0.02),
        "ln1_b": nrm(ks[13], (DEPTH, D_MODEL), 0.02),
        "w_router": nrm(ks[14], (DEPTH, D_MODEL, N_EXPERTS), D_MODEL ** -0.5),
        "b_router": nrm(ks[15], (DEPTH, N_EXPERTS), 0.01),
        "w_up": nrm(ks[16], (DEPTH, N_EXPERTS, D_MODEL, 2 * D_EXPERT), D_MODEL ** -0.5),
        "b_up": nrm(ks[17], (DEPTH, N_EXPERTS, 2 * D_EXPERT), 0.01),
        "w_down": nrm(ks[18], (DEPTH, N_EXPERTS, D_EXPERT, D_MODEL), D_EXPERT ** -0.5 * DEEPNORM_BETA),
        "b_down": nrm(ks[19], (DEPTH, N_EXPERTS, D_MODEL), 0.01),
        "ln2_g": 1.0 + nrm(ks[20], (DEPTH, D_MODEL), 0.02),
        "ln2_b": nrm(ks[21], (DEPTH, D_MODEL), 0.02),
    }


def reference(x, w_in, b_in, lambda_q1, lambda_k1, lambda_q2, lambda_k2, subln_g,
              w_proj_a, w_proj_b, w_out, b_out, ln1_g, ln1_b,
              w_router, b_router, w_up, b_up, w_down, b_down, ln2_g, ln2_b):
    for layer in range(DEPTH):
        lambda_init = 0.8 - 0.6 * math.exp(-0.3 * layer)
        y = token_mixer(x, w_in[layer], b_in[layer], lambda_q1[layer], lambda_k1[layer],
                        lambda_q2[layer], lambda_k2[layer], subln_g[layer],
                        w_proj_a[layer], w_proj_b[layer], w_out[layer], b_out[layer], lambda_init)
        x = layer_norm(DEEPNORM_ALPHA * x + y, ln1_g[layer], ln1_b[layer])
        y = moe_ffn(x, w_router[layer], b_router[layer], w_up[layer], b_up[layer],
                    w_down[layer], b_down[layer])
        x = layer_norm(DEEPNORM_ALPHA * x + y, ln2_g[layer], ln2_b[layer])
    return x
```

```cpp
#include <hip/hip_runtime.h>
#include <stdint.h>

namespace {
constexpr int NB = 8, SEQ = 4096, DM = 1024, TOK = NB * SEQ;
constexpr int INW = 5120;
constexpr int C_QA = 0, C_KA = 512, C_VA = 1024, C_QB = 1536, C_KB = 2048, C_VB = 2560, C_GA = 3072, C_GB = 4096;
constexpr int NEXP = 32, TOPK = 4, NASG = TOK * TOPK;
constexpr int PADM = 64;
constexpr int MAXROWS = NASG + 8192;
constexpr int MAXTILES = MAXROWS / PADM;
constexpr float ALPHA = 1.189207115002721f;
constexpr float LAMBDA_INIT = 0.2f;
constexpr size_t MiB = 1048576;

__device__ __forceinline__ float sigmoidf_(float x) { return 1.0f / (1.0f + __expf(-x)); }
__device__ __forceinline__ float slope_of(int idx) { return exp2f(-8.0f * (float)(idx + 1) / 12.0f); }

template <bool GATHER>
__device__ __forceinline__ void sgemm_core(const float* __restrict__ A, int lda, const int* __restrict__ rows, int row0,
                                           const float* __restrict__ B, int ldb, int col0, int N, int K,
                                           float (&acc)[4][4], float (*As)[68], float (*Bs)[68]) {
    const int tid = threadIdx.x, tx = tid & 15, ty = tid >> 4;
    const int lr = tid >> 2, lk = (tid & 3) * 4;
    const int bk = tid >> 4, bn = (tid & 15) * 4;
    long arow;
    if (GATHER) { int rr = rows[row0 + lr]; arow = rr < 0 ? 0 : rr; } else arow = row0 + lr;
    const float* ap = A + arow * (long)lda + lk;
    const float* bp = B + (long)bk * ldb + col0 + bn;
    const bool bok = (col0 + bn) < N;
    for (int k0 = 0; k0 < K; k0 += 16) {
        float4 av = *(const float4*)(ap + k0);
        float4 bv = bok ? *(const float4*)(bp + (long)k0 * ldb) : make_float4(0.f, 0.f, 0.f, 0.f);
        __syncthreads();
        As[lk + 0][lr] = av.x; As[lk + 1][lr] = av.y; As[lk + 2][lr] = av.z; As[lk + 3][lr] = av.w;
        Bs[bk][bn + 0] = bv.x; Bs[bk][bn + 1] = bv.y; Bs[bk][bn + 2] = bv.z; Bs[bk][bn + 3] = bv.w;
        __syncthreads();
#pragma unroll
        for (int kk = 0; kk < 16; ++kk) {
            float a[4], b[4];
#pragma unroll
            for (int i = 0; i < 4; ++i) { a[i] = As[kk][ty * 4 + i]; b[i] = Bs[kk][tx * 4 + i]; }
#pragma unroll
            for (int i = 0; i < 4; ++i)
#pragma unroll
                for (int j = 0; j < 4; ++j) acc[i][j] = fmaf(a[i], b[j], acc[i][j]);
        }
    }
}

template <int MODE>
__global__ void __launch_bounds__(256) k_sgemm(const float* A, int lda, const float* B, int ldb, float* C, int ldc, int N, int K,
                                               const float* bias, const float* G, int ldg, const float* X, int ldx) {
    __shared__ float As[16][68], Bs[16][68];
    float acc[4][4] = {};
    const int row0 = blockIdx.y * 64, col0 = blockIdx.x * 64;
    sgemm_core<false>(A, lda, nullptr, row0, B, ldb, col0, N, K, acc, As, Bs);
    const int tx = threadIdx.x & 15, ty = threadIdx.x >> 4;
#pragma unroll
    for (int i = 0; i < 4; ++i)
#pragma unroll
        for (int j = 0; j < 4; ++j) {
            const int r = row0 + ty * 4 + i, c = col0 + tx * 4 + j;
            if (c >= N) continue;
            float v = acc[i][j];
            if (MODE == 0) v += bias[c];
            if (MODE == 1) v = sigmoidf_(G[(long)r * ldg + c]) * v;
            if (MODE == 2) v = C[(long)r * ldc + c] + sigmoidf_(G[(long)r * ldg + c]) * v;
            if (MODE == 3) v = ALPHA * X[(long)r * ldx + c] + v + bias[c];
            C[(long)r * ldc + c] = v;
        }
}

__global__ void __launch_bounds__(256) k_mixA(const float* __restrict__ proj, float* __restrict__ oa) {
    const int t = blockIdx.x * 256 + threadIdx.x, h = blockIdx.y, b = blockIdx.z;
    const float slope = slope_of(h + (h >> 1));
    const float* base = proj + (long)b * SEQ * INW;
    float q[64];
#pragma unroll
    for (int d = 0; d < 64; ++d) q[d] = base[(long)t * INW + C_QA + h * 64 + d] * 0.125f;
    float m = -3.0e38f;
    for (int p = 0; p < 3; ++p) {
        const int dil = p == 0 ? 1 : (p == 1 ? 4 : 16);
        for (int j = -64; j <= 64; ++j) {
            const int kp = t + j * dil;
            if (kp < 0 || kp >= SEQ) continue;
            const float* kr = base + (long)kp * INW + C_KA + h * 64;
            float s = 0.f;
#pragma unroll
            for (int d = 0; d < 64; ++d) s = fmaf(q[d], kr[d], s);
            s -= slope * (float)(dil * (j < 0 ? -j : j));
            m = fmaxf(m, s);
        }
    }
    float l = 0.f, o[64];
#pragma unroll
    for (int d = 0; d < 64; ++d) o[d] = 0.f;
    for (int p = 0; p < 3; ++p) {
        const int dil = p == 0 ? 1 : (p == 1 ? 4 : 16);
        for (int j = -64; j <= 64; ++j) {
            const int kp = t + j * dil;
            if (kp < 0 || kp >= SEQ) continue;
            const float* kr = base + (long)kp * INW + C_KA + h * 64;
            const float* vr = base + (long)kp * INW + C_VA + h * 64;
            float s = 0.f;
#pragma unroll
            for (int d = 0; d < 64; ++d) s = fmaf(q[d], kr[d], s);
            s -= slope * (float)(dil * (j < 0 ? -j : j));
            const float pr = __expf(s - m);
            l += pr;
#pragma unroll
            for (int d = 0; d < 64; ++d) o[d] = fmaf(pr, vr[d], o[d]);
        }
    }
    const float il = 1.0f / l;
    float* op = oa + ((long)b * SEQ + t) * 512 + h * 64;
#pragma unroll
    for (int d = 0; d < 64; ++d) op[d] = o[d] * il;
}

__global__ void __launch_bounds__(256) k_mixB(const float* __restrict__ proj, float* __restrict__ obp) {
    const int t = blockIdx.x * 256 + threadIdx.x;
    const int h = blockIdx.y & 3, map = (blockIdx.y >> 2) & 1, vh = blockIdx.y >> 3, b = blockIdx.z;
    const float slope = slope_of(3 * h + 2);
    const float* base = proj + (long)b * SEQ * INW;
    float q[64], o[64];
#pragma unroll
    for (int d = 0; d < 64; ++d) { q[d] = base[(long)t * INW + C_QB + h * 128 + map * 64 + d] * 0.125f; o[d] = 0.f; }
    float m = -3.0e38f, l = 0.f;
    for (int kp = 0; kp < SEQ; ++kp) {
        const float* kr = base + (long)kp * INW + C_KB + h * 128 + map * 64;
        const float* vr = base + (long)kp * INW + C_VB + h * 128 + vh * 64;
        float s = 0.f;
#pragma unroll
        for (int d = 0; d < 64; ++d) s = fmaf(q[d], kr[d], s);
        const int dist = t > kp ? t - kp : kp - t;
        s -= slope * (float)dist;
        if (s > m) {
            const float sc = __expf(m - s);
            l *= sc;
#pragma unroll
            for (int d = 0; d < 64; ++d) o[d] *= sc;
            m = s;
        }
        const float pr = __expf(s - m);
        l += pr;
#pragma unroll
        for (int d = 0; d < 64; ++d) o[d] = fmaf(pr, vr[d], o[d]);
    }
    const float il = 1.0f / l;
    float* op = obp + (long)map * TOK * 512 + ((long)b * SEQ + t) * 512 + h * 128 + vh * 64;
#pragma unroll
    for (int d = 0; d < 64; ++d) op[d] = o[d] * il;
}

__global__ void __launch_bounds__(256) k_mixB_fin(const float* __restrict__ obp, float* __restrict__ ob, const float* lq1, const float* lk1,
                                                  const float* lq2, const float* lk2, const float* subg) {
    const int lane = threadIdx.x & 63, w = threadIdx.x >> 6;
    const long th = (long)blockIdx.x * 4 + w;
    float a = lq1[lane] * lk1[lane], c = lq2[lane] * lk2[lane];
    for (int o = 32; o >= 1; o >>= 1) { a += __shfl_xor(a, o); c += __shfl_xor(c, o); }
    const float lam = __expf(a) - __expf(c) + LAMBDA_INIT;
    const long off = th * 128;
    float v0 = obp[off + lane] - lam * obp[(long)TOK * 512 + off + lane];
    float v1 = obp[off + 64 + lane] - lam * obp[(long)TOK * 512 + off + 64 + lane];
    float ss = v0 * v0 + v1 * v1;
    for (int o = 32; o >= 1; o >>= 1) ss += __shfl_xor(ss, o);
    const float r = rsqrtf(ss * (1.0f / 128.0f) + 1e-5f) * (1.0f - LAMBDA_INIT);
    ob[off + lane] = v0 * r * subg[lane];
    ob[off + 64 + lane] = v1 * r * subg[64 + lane];
}

__global__ void __launch_bounds__(256) k_ln(const float* xin, const float* add, float* out,
                                            const float* __restrict__ g, const float* __restrict__ bta) {
    const int lane = threadIdx.x & 63, w = threadIdx.x >> 6;
    const long row = (long)blockIdx.x * 4 + w;
    float v[16]; float s = 0.f;
#pragma unroll
    for (int i = 0; i < 16; ++i) {
        const int c = i * 64 + lane;
        float x = xin[row * DM + c];
        if (add) x = ALPHA * x + add[row * DM + c];
        v[i] = x; s += x;
    }
    for (int o = 32; o >= 1; o >>= 1) s += __shfl_xor(s, o);
    const float mu = s * (1.0f / DM);
    float q = 0.f;
#pragma unroll
    for (int i = 0; i < 16; ++i) { const float d = v[i] - mu; q += d * d; }
    for (int o = 32; o >= 1; o >>= 1) q += __shfl_xor(q, o);
    const float rs = rsqrtf(q * (1.0f / DM) + 1e-5f);
#pragma unroll
    for (int i = 0; i < 16; ++i) { const int c = i * 64 + lane; out[row * DM + c] = (v[i] - mu) * rs * g[c] + bta[c]; }
}

__global__ void __launch_bounds__(256) k_router(const float* __restrict__ x1, const float* __restrict__ wr, const float* __restrict__ br,
                                                int* __restrict__ cnt, int* __restrict__ tk_e, float* __restrict__ tk_g, int* __restrict__ tk_slot) {
    const int lane = threadIdx.x & 63, w = threadIdx.x >> 6;
    const int t = blockIdx.x * 4 + w;
    const int e = lane & 31, half = lane >> 5;
    const float* xr = x1 + (long)t * DM + half * 512;
    const float* wp = wr + (long)half * 512 * NEXP + e;
    float s = 0.f;
    for (int i = 0; i < 512; ++i) s = fmaf(xr[i], wp[(long)i * NEXP], s);
    s += __shfl_xor(s, 32);
    s += br[e];
    float v = lane < 32 ? s : -3.0e38f;
    float tv[4]; int ti[4];
#pragma unroll
    for (int k = 0; k < 4; ++k) {
        float bv = v; int bi = lane;
        for (int o = 32; o >= 1; o >>= 1) {
            const float ov = __shfl_xor(bv, o); const int oi = __shfl_xor(bi, o);
            if (ov > bv || (ov == bv && oi < bi)) { bv = ov; bi = oi; }
        }
        tv[k] = bv; ti[k] = bi;
        if (lane == bi) v = -3.0e38f;
    }
    const float e0 = 1.0f, e1 = __expf(tv[1] - tv[0]), e2 = __expf(tv[2] - tv[0]), e3 = __expf(tv[3] - tv[0]);
    const float inv = 1.0f / (e0 + e1 + e2 + e3);
    if (lane < 4) {
        const int ee = lane == 0 ? ti[0] : lane == 1 ? ti[1] : lane == 2 ? ti[2] : ti[3];
        const float gg = (lane == 0 ? e0 : lane == 1 ? e1 : lane == 2 ? e2 : e3) * inv;
        const int slot = atomicAdd(&cnt[ee], 1);
        tk_e[t * 4 + lane] = ee; tk_g[t * 4 + lane] = gg; tk_slot[t * 4 + lane] = slot;
    }
}

__global__ void k_scan(const int* __restrict__ cnt, int* __restrict__ pstart, int* __restrict__ tile_e, int* __restrict__ ntiles) {
    if (threadIdx.x == 0) {
        int acc = 0;
        for (int e = 0; e < NEXP; ++e) {
            pstart[e] = acc;
            const int nt = (cnt[e] + PADM - 1) / PADM;
            for (int i = 0; i < nt; ++i) tile_e[acc / PADM + i] = e;
            acc += nt * PADM;
        }
        pstart[NEXP] = acc;
        *ntiles = acc / PADM;
    }
}
__global__ void __launch_bounds__(256) k_fill(const int* __restrict__ pstart, const int* __restrict__ tk_e, const float* __restrict__ tk_g,
                                              const int* __restrict__ tk_slot, int* __restrict__ rowtok, float* __restrict__ roww) {
    const int a = blockIdx.x * 256 + threadIdx.x;
    const int row = pstart[tk_e[a]] + tk_slot[a];
    rowtok[row] = a >> 2; roww[row] = tk_g[a];
}

__global__ void __launch_bounds__(256) k_up(const float* __restrict__ x1, const float* __restrict__ wup, const float* __restrict__ bup,
                                            const int* __restrict__ rowtok, const int* __restrict__ tile_e, const int* __restrict__ ntiles,
                                            float* __restrict__ act) {
    __shared__ float As[16][68], Bs[16][68];
    if ((int)blockIdx.y >= *ntiles) return;
    const int e = tile_e[blockIdx.y], row0 = blockIdx.y * 64, col0 = blockIdx.x * 64;
    const float* B = wup + (long)e * DM * 2048;
    float ag[4][4] = {}, au[4][4] = {};
    sgemm_core<true>(x1, DM, rowtok, row0, B, 2048, col0, 2048, DM, ag, As, Bs);
    sgemm_core<true>(x1, DM, rowtok, row0, B, 2048, 1024 + col0, 2048, DM, au, As, Bs);
    const int tx = threadIdx.x & 15, ty = threadIdx.x >> 4;
#pragma unroll
    for (int i = 0; i < 4; ++i)
#pragma unroll
        for (int j = 0; j < 4; ++j) {
            const int r = row0 + ty * 4 + i, c = col0 + tx * 4 + j;
            const float hg = ag[i][j] + bup[(long)e * 2048 + c], hu = au[i][j] + bup[(long)e * 2048 + 1024 + c];
            const float gate = fminf(hg, 7.0f), up = fminf(fmaxf(hu, -7.0f), 7.0f);
            act[(long)r * DM + c] = gate * sigmoidf_(1.702f * gate) * (up + 1.0f);
        }
}
__global__ void __launch_bounds__(256) k_down(const float* __restrict__ act, const float* __restrict__ wdn, const float* __restrict__ bdn,
                                              const int* __restrict__ rowtok, const float* __restrict__ roww, const int* __restrict__ tile_e,
                                              const int* __restrict__ ntiles, float* __restrict__ moe) {
    __shared__ float As[16][68], Bs[16][68];
    if ((int)blockIdx.y >= *ntiles) return;
    const int e = tile_e[blockIdx.y], row0 = blockIdx.y * 64, col0 = blockIdx.x * 64;
    const float* B = wdn + (long)e * DM * DM;
    float acc[4][4] = {};
    sgemm_core<false>(act, DM, nullptr, row0, B, DM, col0, DM, DM, acc, As, Bs);
    const int tx = threadIdx.x & 15, ty = threadIdx.x >> 4;
#pragma unroll
    for (int i = 0; i < 4; ++i) {
        const int r = row0 + ty * 4 + i; const int tok = rowtok[r];
        if (tok < 0) continue;
        const float wgt = roww[r];
#pragma unroll
        for (int j = 0; j < 4; ++j) { const int c = col0 + tx * 4 + j; atomicAdd(&moe[(long)tok * DM + c], wgt * (acc[i][j] + bdn[(long)e * DM + c])); }
    }
}
}

extern "C" void kernel_launch(void* const* d_in, const int* in_sizes, int n_in, void* d_out, int out_size, void* d_ws, size_t ws_size,
                              hipStream_t stream) {
    const float* x = (const float*)d_in[0];
    const float* w_in = (const float*)d_in[1];
    const float* b_in = (const float*)d_in[2];
    const float* lq1 = (const float*)d_in[3];
    const float* lk1 = (const float*)d_in[4];
    const float* lq2 = (const float*)d_in[5];
    const float* lk2 = (const float*)d_in[6];
    const float* subg = (const float*)d_in[7];
    const float* w_pa = (const float*)d_in[8];
    const float* w_pb = (const float*)d_in[9];
    const float* w_out = (const float*)d_in[10];
    const float* b_out = (const float*)d_in[11];
    const float* ln1g = (const float*)d_in[12];
    const float* ln1b = (const float*)d_in[13];
    const float* w_r = (const float*)d_in[14];
    const float* b_r = (const float*)d_in[15];
    const float* w_up = (const float*)d_in[16];
    const float* b_up = (const float*)d_in[17];
    const float* w_dn = (const float*)d_in[18];
    const float* b_dn = (const float*)d_in[19];
    const float* ln2g = (const float*)d_in[20];
    const float* ln2b = (const float*)d_in[21];
    float* out = (float*)d_out;
    char* ws = (char*)d_ws;

    float* proj = (float*)(ws);
    float* oa = (float*)(ws + 640 * MiB);
    float* ob = (float*)(ws + 704 * MiB);
    float* obp = (float*)(ws + 768 * MiB);
    float* merged = (float*)(ws + 896 * MiB);
    float* x1 = (float*)(ws + 768 * MiB);
    float* act = (float*)(ws);
    float* moe = (float*)(ws + 640 * MiB);
    char* sm = ws + 560 * MiB;
    int* cnt = (int*)(sm);
    int* pstart = (int*)(sm + 1024);
    int* ntiles = (int*)(sm + 2048);
    int* tile_e = (int*)(sm + 4096);
    int* tk_e = (int*)(sm + 1 * MiB);
    float* tk_g = (float*)(sm + 2 * MiB);
    int* tk_slot = (int*)(sm + 3 * MiB);
    int* rowtok = (int*)(sm + 4 * MiB);
    float* roww = (float*)(sm + 5 * MiB);

    k_sgemm<0><<<dim3(INW / 64, TOK / 64), 256, 0, stream>>>(x, DM, w_in, INW, proj, INW, INW, DM, b_in, nullptr, 0, nullptr, 0);
    k_mixA<<<dim3(SEQ / 256, 8, NB), 256, 0, stream>>>(proj, oa);
    k_mixB<<<dim3(SEQ / 256, 16, NB), 256, 0, stream>>>(proj, obp);
    k_mixB_fin<<<TOK, 256, 0, stream>>>(obp, ob, lq1, lk1, lq2, lk2, subg);
    k_sgemm<1><<<dim3(DM / 64, TOK / 64), 256, 0, stream>>>(oa, 512, w_pa, DM, merged, DM, DM, 512, nullptr, proj + C_GA, INW, nullptr, 0);
    k_sgemm<2><<<dim3(DM / 64, TOK / 64), 256, 0, stream>>>(ob, 512, w_pb, DM, merged, DM, DM, 512, nullptr, proj + C_GB, INW, nullptr, 0);
    k_sgemm<3><<<dim3(DM / 64, TOK / 64), 256, 0, stream>>>(merged, DM, w_out, DM, x1, DM, DM, DM, b_out, nullptr, 0, x, DM);
    k_ln<<<TOK / 4, 256, 0, stream>>>(x1, nullptr, x1, ln1g, ln1b);
    hipMemsetAsync(cnt, 0, 1024, stream);
    hipMemsetAsync(rowtok, 0xFF, (size_t)MAXROWS * 4, stream);
    hipMemsetAsync(moe, 0, (size_t)TOK * DM * 4, stream);
    k_router<<<TOK / 4, 256, 0, stream>>>(x1, w_r, b_r, cnt, tk_e, tk_g, tk_slot);
    k_scan<<<1, 64, 0, stream>>>(cnt, pstart, tile_e, ntiles);
    k_fill<<<NASG / 256, 256, 0, stream>>>(pstart, tk_e, tk_g, tk_slot, rowtok, roww);
    k_up<<<dim3(DM / 64, MAXTILES), 256, 0, stream>>>(x1, w_up, b_up, rowtok, tile_e, ntiles, act);
    k_down<<<dim3(DM / 64, MAXTILES), 256, 0, stream>>>(act, w_dn, b_dn, rowtok, roww, tile_e, ntiles, moe);
    k_ln<<<TOK / 4, 256, 0, stream>>>(x1, moe, out, ln2g, ln2b);
}
```

```cpp
#include <hip/hip_runtime.h>
#include <hip/hip_cooperative_groups.h>
#include <stdint.h>
#include <stdio.h>

namespace {
constexpr int NB = 8, SEQ = 4096, DM = 1024, TOK = NB * SEQ;
constexpr int INW = 5120;
constexpr int C_QA = 0, C_KA = 512, C_VA = 1024, C_QB = 1536, C_KB = 2048, C_VB = 2560, C_GA = 3072, C_GB = 4096;
constexpr int NEXP = 32, TOPK = 4, NASG = TOK * TOPK;
constexpr float ALPHA = 1.189207115002721f;
constexpr float LAMBDA_INIT = 0.2f;
constexpr float LOG2E = 1.4426950408889634f;
constexpr size_t MiB = 1048576;

__device__ __forceinline__ float sigmoidf_(float x) { return 1.0f / (1.0f + __expf(-x)); }
__device__ __forceinline__ float slope_of(int idx) { return exp2f(-8.0f * (float)(idx + 1) / 12.0f); }
#define LAS __attribute__((address_space(3)))
typedef _Float16 f16;
typedef _Float16 f16x8 __attribute__((ext_vector_type(8)));
typedef _Float16 f16x4 __attribute__((ext_vector_type(4)));
typedef _Float16 f16x2 __attribute__((ext_vector_type(2)));
typedef float f32x4 __attribute__((ext_vector_type(4)));
typedef float f32x16 __attribute__((ext_vector_type(16)));
typedef unsigned u32x4 __attribute__((ext_vector_type(4)));
typedef unsigned u32x2 __attribute__((ext_vector_type(2)));

constexpr int NTHR = 512, NWG = 256;
constexpr int BM = 256, BK = 64, HALF = 128, HTB = HALF * BK * 2, STAGE_BYTES = 8 * HTB;
constexpr int LDS_MISC = STAGE_BYTES;
constexpr int LDS_TOTAL = 155648;
constexpr float QSCALE = 0.125f * 1.4426950408889634f;
constexpr int ROWPAD = 256;
constexpr int MOE_ROWS = NASG + NEXP * ROWPAD;
constexpr int LISTCAP = TOK;

__device__ __forceinline__ unsigned pk2(float a, float b) { f16x2 v; v.x = (f16)a; v.y = (f16)b; return __builtin_bit_cast(unsigned, v); }
__device__ __forceinline__ int lds_byte(int r, int c) { const int st = (r >> 4) * 2 + (c >> 5), rr = r & 15, cc = c & 31, ob = rr * 64 + cc * 2; return st * 1024 + (ob ^ (((ob >> 9) & 1) << 5)); }
__device__ __forceinline__ void stage_rc(int b, int& R, int& C) { const int st = b / 1024, sb = b % 1024, swz = sb ^ (((sb >> 9) & 1) << 5); R = (st >> 1) * 16 + swz / 64; C = (st & 1) * 32 + (swz % 64) / 2; }
__device__ __forceinline__ int perm32(int rho) { const int n = rho >> 4, i = rho & 15; return 8 * (i >> 2) + 4 * n + (i & 3); }

struct Unit { int pm, pn, e, row0, nrows; };

template <int K_>
struct DenseSched {
    static constexpr int K = K_;
    const char* A; const char* Bt; int nM, nN, nwg, G, c;
    __device__ void init(const void* A_, const void* Bt_, int M, int N, int G_, int c_) { A = (const char*)A_; Bt = (const char*)Bt_; nM = M / BM; nN = N / BM; nwg = nM * nN; G = G_; c = c_; }
    __device__ __forceinline__ bool next(int i, Unit& u) const {
        const long L = (long)i * G + c; if (L >= nwg) return false;
        int wgid = (int)L; { const int q = nwg / 8, r = nwg % 8, xcd = wgid % 8, off = wgid / 8; wgid = (xcd < r ? xcd * (q + 1) : r * (q + 1) + (xcd - r) * q) + off; }
        const int nig = 8 * nN, gid = wgid / nig, fm = gid * 8, gsz = (nM - fm) < 8 ? (nM - fm) : 8;
        u.pm = fm + ((wgid % nig) % gsz); u.pn = (wgid % nig) / gsz; u.e = 0; u.row0 = u.pm * BM; u.nrows = BM; return true;
    }
    __device__ __forceinline__ void a_offsets(const Unit& u, const int (&R)[2], const int (&C)[2], unsigned (&ao)[2][2]) const {
#pragma unroll
        for (int h = 0; h < 2; ++h)
#pragma unroll
            for (int i = 0; i < 2; ++i) ao[h][i] = (unsigned)((u.pm * BM + h * HALF + R[i]) * K + C[i]) * 2u;
    }
    __device__ __forceinline__ const char* b_base(const Unit& u) const { return Bt + (size_t)u.pn * BM * K * 2; }
};

template <class Sched, class Epi>
__device__ __forceinline__ void gemm_phase(LAS unsigned char* lds, const Sched& S, const Epi& E) {
    constexpr int K = Sched::K, nt = K / BK;
    const int tid = threadIdx.x, wid = __builtin_amdgcn_readfirstlane(tid >> 6), lane = tid & 63, wr = wid >> 2, wc = wid & 3, fr = lane & 15, fq = lane >> 4;
    int R[2], C[2]; unsigned voffB[2];
#pragma unroll
    for (int i = 0; i < 2; ++i) { stage_rc(tid * 16 + i * 8192, R[i], C[i]); const int Rb = Epi::PERM ? ((R[i] & ~31) + perm32(R[i] & 31)) : R[i]; voffB[i] = (unsigned)(Rb * K + C[i]) * 2u; }
    constexpr unsigned kstep = BK * 2;
    constexpr unsigned hstepB = HALF * K * 2;
    const unsigned ldsw = (unsigned)wid * 1024u;
    const int aoff = lds_byte(wr * 64 + fr, fq * 8), boff = lds_byte(wc * 32 + fr, fq * 8);
#define G_SA(b, h) (((b) * 2 + (h)) * HTB)
#define G_SB(b, h) ((4 + (b) * 2 + (h)) * HTB)
#define G_STAGE_A(bufoff, o0, o1, kb) do { \
        __builtin_amdgcn_global_load_lds((const unsigned*)(Abase + (size_t)(o0) + (kb)), (LAS unsigned*)(lds + (bufoff) + ldsw), 16, 0, 0); \
        __builtin_amdgcn_global_load_lds((const unsigned*)(Abase + (size_t)(o1) + (kb)), (LAS unsigned*)(lds + (bufoff) + ldsw + 8192), 16, 0, 0); } while (0)
#define G_STAGE_B(bufoff, gbase) do { _Pragma("unroll") for (int _i = 0; _i < 2; ++_i) \
        __builtin_amdgcn_global_load_lds((const unsigned*)((const char*)(gbase) + voffB[_i]), (LAS unsigned*)(lds + (bufoff) + ldsw + _i * 8192), 16, 0, 0); } while (0)
#define G_LDA(dst, b, h) do { _Pragma("unroll") for (int m = 0; m < 4; ++m) _Pragma("unroll") for (int k = 0; k < 2; ++k) dst[m][k] = *(const LAS f16x8*)(lds + G_SA(b, h) + aoff + m * 2048 + k * 1024); } while (0)
#define G_LDB(dst, b, h) do { _Pragma("unroll") for (int n = 0; n < 2; ++n) _Pragma("unroll") for (int k = 0; k < 2; ++k) dst[n][k] = *(const LAS f16x8*)(lds + G_SB(b, h) + boff + n * 2048 + k * 1024); } while (0)
#define G_MMA(ai, bj, At, Bt) do { __builtin_amdgcn_s_setprio(1); _Pragma("unroll") for (int m = 0; m < 4; ++m) _Pragma("unroll") for (int n = 0; n < 2; ++n) _Pragma("unroll") for (int k = 0; k < 2; ++k) \
        acc[ai][bj][m][n] = __builtin_amdgcn_mfma_f32_16x16x32_f16(Bt[n][k], At[m][k], acc[ai][bj][m][n], 0, 0, 0); __builtin_amdgcn_s_setprio(0); } while (0)
#define G_WAIT_V(n) asm volatile("s_waitcnt vmcnt(" #n ")" ::: "memory")
#define G_WAIT_L(n) asm volatile("s_waitcnt lgkmcnt(" #n ")" ::: "memory")
#define G_BAR __builtin_amdgcn_s_barrier()
#define G_SCHED __builtin_amdgcn_sched_barrier(0)
    Unit cur, nxt; int ui = 0;
    if (!S.next(0, cur)) return;
    f32x4 acc[2][2][4][2];
#pragma unroll
    for (int a = 0; a < 2; ++a)
#pragma unroll
        for (int b = 0; b < 2; ++b)
#pragma unroll
            for (int m = 0; m < 4; ++m)
#pragma unroll
                for (int n = 0; n < 2; ++n) acc[a][b][m][n] = (f32x4){0.f, 0.f, 0.f, 0.f};
    f16x8 At[4][2], B0[2][2], B1[2][2];
    const char* const Abase = S.A;
    unsigned cao[2][2], nao[2][2];
    S.a_offsets(cur, R, C, cao);
    const char* cB = S.b_base(cur);
    G_STAGE_B(G_SB(0, 0), cB); G_STAGE_A(G_SA(0, 0), cao[0][0], cao[0][1], 0u); G_STAGE_B(G_SB(0, 1), cB + hstepB); G_STAGE_A(G_SA(0, 1), cao[1][0], cao[1][1], 0u);
    if (wr == 1) G_BAR;
    G_WAIT_V(4); G_BAR;
    G_STAGE_B(G_SB(1, 0), cB + kstep); G_STAGE_A(G_SA(1, 0), cao[0][0], cao[0][1], kstep); G_STAGE_B(G_SB(1, 1), cB + hstepB + kstep);
    G_WAIT_V(6); G_BAR;
    for (;;) {
        const bool has_next = S.next(ui + 1, nxt);
        const char* nB = cB;
        if (has_next) { S.a_offsets(nxt, R, C, nao); nB = S.b_base(nxt); }
        else {
#pragma unroll
            for (int h = 0; h < 2; ++h)
#pragma unroll
                for (int i = 0; i < 2; ++i) nao[h][i] = cao[h][i];
        }
        for (int t = 0; t < nt; t += 2) {
            const bool last = (t == nt - 2);
            const unsigned k1 = (unsigned)(t + 1) * kstep;
            const unsigned k2 = last ? 0u : (unsigned)(t + 2) * kstep, k3 = k2 + kstep;
            const unsigned a2_00 = last ? nao[0][0] : cao[0][0], a2_01 = last ? nao[0][1] : cao[0][1];
            const unsigned a2_10 = last ? nao[1][0] : cao[1][0], a2_11 = last ? nao[1][1] : cao[1][1];
            const char* b2 = (last ? nB : cB) + k2; const char* b3 = b2 + kstep;
            G_LDB(B0, 0, 0); G_SCHED; G_LDA(At, 0, 0); G_STAGE_A(G_SA(1, 1), cao[1][0], cao[1][1], k1);
            G_WAIT_L(8); G_BAR; G_WAIT_L(0); G_MMA(0, 0, At, B0); G_BAR; G_SCHED;
            G_LDB(B1, 0, 1); G_STAGE_B(G_SB(0, 0), b2);
            G_BAR; G_WAIT_L(0); G_MMA(0, 1, At, B1); G_BAR;
            G_LDA(At, 0, 1); G_STAGE_A(G_SA(0, 0), a2_00, a2_01, k2);
            G_BAR; G_WAIT_L(0); G_MMA(1, 0, At, B0); G_BAR; G_SCHED;
            G_STAGE_B(G_SB(0, 1), b2 + hstepB);
            G_WAIT_V(6); G_BAR; G_MMA(1, 1, At, B1); G_BAR;
            G_LDB(B0, 1, 0); G_SCHED; G_LDA(At, 1, 0); G_STAGE_A(G_SA(0, 1), a2_10, a2_11, k2);
            G_WAIT_L(8); G_BAR; G_WAIT_L(0); G_MMA(0, 0, At, B0); G_BAR; G_SCHED;
            G_LDB(B1, 1, 1); G_STAGE_B(G_SB(1, 0), b3);
            G_BAR; G_WAIT_L(0); G_MMA(0, 1, At, B1); G_BAR;
            G_LDA(At, 1, 1); G_STAGE_A(G_SA(1, 0), a2_00, a2_01, k3);
            G_BAR; G_WAIT_L(0); G_MMA(1, 0, At, B0); G_BAR; G_SCHED;
            G_STAGE_B(G_SB(1, 1), b3 + hstepB);
            G_WAIT_V(6); G_BAR; G_MMA(1, 1, At, B1); G_BAR;
        }
        E(acc, cur, wr, wc, fr, fq);
        if (!has_next) break;
#pragma unroll
        for (int a = 0; a < 2; ++a)
#pragma unroll
            for (int b = 0; b < 2; ++b)
#pragma unroll
                for (int m = 0; m < 4; ++m)
#pragma unroll
                    for (int n = 0; n < 2; ++n) acc[a][b][m][n] = (f32x4){0.f, 0.f, 0.f, 0.f};
        cur = nxt; cB = nB; ++ui;
#pragma unroll
        for (int h = 0; h < 2; ++h)
#pragma unroll
            for (int i = 0; i < 2; ++i) cao[h][i] = nao[h][i];
    }
    G_WAIT_V(0);
    if (wr == 0) G_BAR;
    G_BAR;
#undef G_SA
#undef G_SB
#undef G_STAGE_A
#undef G_STAGE_B
#undef G_LDA
#undef G_LDB
#undef G_MMA
#undef G_WAIT_V
#undef G_WAIT_L
#undef G_BAR
#undef G_SCHED
}
constexpr size_t WS_WIN = 0;
constexpr size_t WS_WPA = WS_WIN + (size_t)INW * DM * 2;
constexpr size_t WS_WPB = WS_WPA + (size_t)DM * 512 * 2;
constexpr size_t WS_WOUT = WS_WPB + (size_t)DM * 512 * 2;
constexpr size_t WS_WUP = WS_WOUT + (size_t)DM * DM * 2;
constexpr size_t WS_WDN = WS_WUP + (size_t)NEXP * 2048 * DM * 2;
constexpr size_t WS_XH = WS_WDN + (size_t)NEXP * DM * DM * 2;
constexpr size_t WS_PROJ = WS_XH + (size_t)TOK * DM * 2;
constexpr size_t WS_OAB = WS_PROJ + (size_t)TOK * INW * 2;
constexpr size_t WS_MERGED = WS_OAB + (size_t)TOK * DM * 2;
constexpr size_t WS_H1 = WS_MERGED + (size_t)TOK * DM * 2;
constexpr size_t WS_SMALL = WS_H1 + (size_t)TOK * DM * 4 + 16 * MiB;
constexpr size_t WS_YS = WS_OAB;
constexpr size_t SM_CNT = 0, SM_TK = 4096, SM_LIST = SM_TK + (size_t)NASG * 4;
constexpr size_t WS_END = WS_SMALL + SM_LIST + (size_t)NEXP * LISTCAP * 8;
static_assert(WS_YS + (size_t)MOE_ROWS * DM * 2 <= WS_SMALL, "ys overlaps bookkeeping");
static_assert((size_t)MOE_ROWS * DM * 2 <= (size_t)TOK * INW * 2, "act does not fit over proj");
static_assert(WS_END <= 1024 * MiB, "workspace");

struct Params {
    const float* in[22]; float* out; unsigned char* ws;
};

__device__ __forceinline__ void prep_tile(const float* __restrict__ src, int ldsrc, int srccol0, int k0, f16* __restrict__ dst, int K, int n0, LAS float* tile) {
    const int tid = threadIdx.x;
#pragma unroll
    for (int j = 0; j < 2; ++j) {
        const int idx = tid + j * NTHR, k = idx >> 4, n4 = (idx & 15) * 4;
        const float4 v = *(const float4*)(src + (size_t)(k0 + k) * ldsrc + srccol0 + n4);
        tile[k * 65 + n4 + 0] = v.x; tile[k * 65 + n4 + 1] = v.y; tile[k * 65 + n4 + 2] = v.z; tile[k * 65 + n4 + 3] = v.w;
    }
    __syncthreads();
    {
        const int n = tid >> 3, kc = (tid & 7) * 8;
        u32x4 w;
        w.x = pk2(tile[(kc + 0) * 65 + n], tile[(kc + 1) * 65 + n]); w.y = pk2(tile[(kc + 2) * 65 + n], tile[(kc + 3) * 65 + n]);
        w.z = pk2(tile[(kc + 4) * 65 + n], tile[(kc + 5) * 65 + n]); w.w = pk2(tile[(kc + 6) * 65 + n], tile[(kc + 7) * 65 + n]);
        *(u32x4*)(dst + (size_t)(n0 + n) * K + k0 + kc) = w;
    }
    __syncthreads();
}
__device__ __forceinline__ void phase_prep(const Params& p, LAS unsigned char* lds, int wg, int nwg) {
    unsigned char* ws = p.ws;
    {
        const float4* src = (const float4*)p.in[0]; u32x4* dst = (u32x4*)(ws + WS_XH);
        const size_t n8 = (size_t)TOK * DM / 8;
        for (size_t i = (size_t)wg * NTHR + threadIdx.x; i < n8; i += (size_t)nwg * NTHR) {
            const float4 a = src[2 * i], b = src[2 * i + 1];
            u32x4 w; w.x = pk2(a.x, a.y); w.y = pk2(a.z, a.w); w.z = pk2(b.x, b.y); w.w = pk2(b.z, b.w);
            dst[i] = w;
        }
    }
    if (wg == 0 && threadIdx.x < 64) ((int*)(ws + WS_SMALL + SM_CNT))[threadIdx.x] = 0;
    LAS float* tile = (LAS float*)lds;
    constexpr int T_IN = (INW / 64) * (DM / 64), T_PA = (DM / 64) * (512 / 64), T_OUT = (DM / 64) * (DM / 64);
    constexpr int T_UP1 = (2048 / 64) * (DM / 64), T_DN1 = (DM / 64) * (DM / 64);
    constexpr int T0 = T_IN, T1 = T0 + T_PA, T2 = T1 + T_PA, T3 = T2 + T_OUT, T4 = T3 + NEXP * T_UP1, T5 = T4 + NEXP * T_DN1;
    for (int t = wg; t < T5; t += nwg) {
        if (t < T0) { const int tn = t / 16, tk = t % 16; prep_tile(p.in[1], INW, tn * 64, tk * 64, (f16*)(ws + WS_WIN), DM, tn * 64, tile); }
        else if (t < T1) { const int q = t - T0, tn = q / 8, tk = q % 8; prep_tile(p.in[8], DM, tn * 64, tk * 64, (f16*)(ws + WS_WPA), 512, tn * 64, tile); }
        else if (t < T2) { const int q = t - T1, tn = q / 8, tk = q % 8; prep_tile(p.in[9], DM, tn * 64, tk * 64, (f16*)(ws + WS_WPB), 512, tn * 64, tile); }
        else if (t < T3) { const int q = t - T2, tn = q / 16, tk = q % 16; prep_tile(p.in[10], DM, tn * 64, tk * 64, (f16*)(ws + WS_WOUT), DM, tn * 64, tile); }
        else if (t < T4) { const int q = t - T3, e = q / T_UP1, r = q % T_UP1, tn = r / 16, tk = r % 16;
            const int np = tn * 64, pn = np >> 8, j = np & 255;
            const int sc = j < 128 ? pn * 128 + j : 1024 + pn * 128 + (j - 128);
            prep_tile(p.in[16] + (size_t)e * DM * 2048, 2048, sc, tk * 64, (f16*)(ws + WS_WUP) + (size_t)e * 2048 * DM, DM, np, tile); }
        else { const int q = t - T4, e = q / T_DN1, r = q % T_DN1, tn = r / 16, tk = r % 16;
            prep_tile(p.in[18] + (size_t)e * DM * DM, DM, tn * 64, tk * 64, (f16*)(ws + WS_WDN) + (size_t)e * DM * DM, DM, tn * 64, tile); }
    }
}

struct EpiInProj {
    static constexpr bool PERM = true;
    f16* O; const float* bias;
    __device__ __forceinline__ void operator()(const f32x4 (&acc)[2][2][4][2], const Unit& u, int wr, int wc, int fr, int fq) const {
        const int row0 = u.pm * BM + wr * 64 + fr, col0 = u.pn * BM + wc * 32 + 8 * fq;
        const int cls = u.pn;
        const float scl = (cls < 2 || cls == 6 || cls == 7) ? QSCALE : 1.0f;
        const bool sig = cls >= 12;
        f32x4 bv[2][2];
#pragma unroll
        for (int bj = 0; bj < 2; ++bj)
#pragma unroll
            for (int n = 0; n < 2; ++n) bv[bj][n] = *(const f32x4*)(bias + col0 + bj * HALF + 4 * n);
#pragma unroll
        for (int ai = 0; ai < 2; ++ai)
#pragma unroll
            for (int m = 0; m < 4; ++m) {
                f16* rowp = O + (size_t)(row0 + ai * HALF + m * 16) * INW + col0;
#pragma unroll
                for (int bj = 0; bj < 2; ++bj) {
                    f32x4 v0 = acc[ai][bj][m][0] + bv[bj][0], v1 = acc[ai][bj][m][1] + bv[bj][1];
                    if (sig) {
#pragma unroll
                        for (int j = 0; j < 4; ++j) { v0[j] = __builtin_amdgcn_rcpf(1.0f + __expf(-v0[j])); v1[j] = __builtin_amdgcn_rcpf(1.0f + __expf(-v1[j])); }
                    } else { v0 *= scl; v1 *= scl; }
                    u32x4 w; w.x = pk2(v0[0], v0[1]); w.y = pk2(v0[2], v0[3]); w.z = pk2(v1[0], v1[1]); w.w = pk2(v1[2], v1[3]);
                    *(u32x4*)(rowp + bj * HALF) = w;
                }
            }
    }
};
__device__ __forceinline__ void phase_inproj(const Params& p, LAS unsigned char* lds, int wg, int nwg) {
    DenseSched<DM> S; S.init(p.ws + WS_XH, p.ws + WS_WIN, TOK, INW, nwg, wg);
    EpiInProj E{(f16*)(p.ws + WS_PROJ), p.in[2]};
    gemm_phase(lds, S, E);
}
__device__ __forceinline__ float ldf(const float* p) { return *p; }
__device__ __forceinline__ float ldf(const f16* p) { return (float)*p; }
__device__ __forceinline__ void ld4(const float* p, float (&v)[4]) { const float4 t = *(const float4*)p; v[0] = t.x; v[1] = t.y; v[2] = t.z; v[3] = t.w; }
__device__ __forceinline__ void ld4(const f16* p, float (&v)[4]) { const f16x4 t = *(const f16x4*)p; v[0] = (float)t[0]; v[1] = (float)t[1]; v[2] = (float)t[2]; v[3] = (float)t[3]; }

template <class TA>
__device__ __forceinline__ void sgemm_core(const TA* __restrict__ ap, const float* __restrict__ B, int ldb, int col0, int N, int K,
                                           float (&acc)[4][4], float (*As)[68], float (*Bs)[68]) {
    const int tid = threadIdx.x, tx = tid & 15, ty = tid >> 4;
    const int lr = tid >> 2, lk = (tid & 3) * 4;
    const int bk = tid >> 4, bn = (tid & 15) * 4;
    const float* bp = B + (long)bk * ldb + col0 + bn;
    const bool bok = (col0 + bn) < N;
    for (int k0 = 0; k0 < K; k0 += 16) {
        float av[4]; ld4(ap + k0, av);
        float4 bv = bok ? *(const float4*)(bp + (long)k0 * ldb) : make_float4(0.f, 0.f, 0.f, 0.f);
        __syncthreads();
        As[lk + 0][lr] = av[0]; As[lk + 1][lr] = av[1]; As[lk + 2][lr] = av[2]; As[lk + 3][lr] = av[3];
        Bs[bk][bn + 0] = bv.x; Bs[bk][bn + 1] = bv.y; Bs[bk][bn + 2] = bv.z; Bs[bk][bn + 3] = bv.w;
        __syncthreads();
#pragma unroll
        for (int kk = 0; kk < 16; ++kk) {
            float a[4], b[4];
#pragma unroll
            for (int i = 0; i < 4; ++i) { a[i] = As[kk][ty * 4 + i]; b[i] = Bs[kk][tx * 4 + i]; }
#pragma unroll
            for (int i = 0; i < 4; ++i)
#pragma unroll
                for (int j = 0; j < 4; ++j) acc[i][j] = fmaf(a[i], b[j], acc[i][j]);
        }
    }
}

__global__ void __launch_bounds__(256) g_inproj(const float* x, const float* w_in, const float* b_in, f16* proj) {
    __shared__ float As[16][68], Bs[16][68];
    float acc[4][4] = {};
    const int row0 = blockIdx.y * 64, col0 = blockIdx.x * 64;
    sgemm_core<float>(x + (long)(row0 + (threadIdx.x >> 2)) * DM + (threadIdx.x & 3) * 4, w_in, INW, col0, INW, DM, acc, As, Bs);
    const int tx = threadIdx.x & 15, ty = threadIdx.x >> 4;
#pragma unroll
    for (int i = 0; i < 4; ++i)
#pragma unroll
        for (int j = 0; j < 4; ++j) {
            const int r = row0 + ty * 4 + i, c = col0 + tx * 4 + j;
            float v = acc[i][j] + b_in[c];
            if (c < 512 || (c >= C_QB && c < C_KB)) v *= QSCALE;
            if (c >= C_GA) v = sigmoidf_(v);
            proj[(long)r * INW + c] = (f16)v;
        }
}
__global__ void __launch_bounds__(256) g_mixA(const f16* __restrict__ proj, f16* __restrict__ oa) {
    const int t = blockIdx.x * 256 + threadIdx.x, h = blockIdx.y, b = blockIdx.z;
    const float slope2 = slope_of(h + (h >> 1)) * LOG2E;
    const f16* base = proj + (long)b * SEQ * INW;
    float q[64];
#pragma unroll
    for (int d = 0; d < 64; ++d) q[d] = (float)base[(long)t * INW + C_QA + h * 64 + d];
    float m = -3.0e38f;
    for (int p = 0; p < 3; ++p) {
        const int dil = p == 0 ? 1 : (p == 1 ? 4 : 16);
        for (int j = -64; j <= 64; ++j) {
            const int kp = t + j * dil;
            if (kp < 0 || kp >= SEQ) continue;
            const f16* kr = base + (long)kp * INW + C_KA + h * 64;
            float s = 0.f;
#pragma unroll
            for (int d = 0; d < 64; ++d) s = fmaf(q[d], (float)kr[d], s);
            s -= slope2 * (float)(dil * (j < 0 ? -j : j));
            m = fmaxf(m, s);
        }
    }
    float l = 0.f, o[64];
#pragma unroll
    for (int d = 0; d < 64; ++d) o[d] = 0.f;
    for (int p = 0; p < 3; ++p) {
        const int dil = p == 0 ? 1 : (p == 1 ? 4 : 16);
        for (int j = -64; j <= 64; ++j) {
            const int kp = t + j * dil;
            if (kp < 0 || kp >= SEQ) continue;
            const f16* kr = base + (long)kp * INW + C_KA + h * 64;
            const f16* vr = base + (long)kp * INW + C_VA + h * 64;
            float s = 0.f;
#pragma unroll
            for (int d = 0; d < 64; ++d) s = fmaf(q[d], (float)kr[d], s);
            s -= slope2 * (float)(dil * (j < 0 ? -j : j));
            const float pr = exp2f(s - m);
            l += pr;
#pragma unroll
            for (int d = 0; d < 64; ++d) o[d] = fmaf(pr, (float)vr[d], o[d]);
        }
    }
    const float il = 1.0f / l;
    f16* op = oa + ((long)b * SEQ + t) * 512 + h * 64;
#pragma unroll
    for (int d = 0; d < 64; ++d) op[d] = (f16)(o[d] * il);
}
__global__ void __launch_bounds__(256) g_mixB(const f16* __restrict__ proj, float* __restrict__ obp) {
    const int t = blockIdx.x * 256 + threadIdx.x;
    const int h = blockIdx.y & 3, map = (blockIdx.y >> 2) & 1, vh = blockIdx.y >> 3, b = blockIdx.z;
    const float slope2 = slope_of(3 * h + 2) * LOG2E;
    const f16* base = proj + (long)b * SEQ * INW;
    float q[64], o[64];
#pragma unroll
    for (int d = 0; d < 64; ++d) { q[d] = (float)base[(long)t * INW + C_QB + h * 128 + map * 64 + d]; o[d] = 0.f; }
    float m = -3.0e38f, l = 0.f;
    for (int kp = 0; kp < SEQ; ++kp) {
        const f16* kr = base + (long)kp * INW + C_KB + h * 128 + map * 64;
        const f16* vr = base + (long)kp * INW + C_VB + h * 128 + vh * 64;
        float s = 0.f;
#pragma unroll
        for (int d = 0; d < 64; ++d) s = fmaf(q[d], (float)kr[d], s);
        const int dist = t > kp ? t - kp : kp - t;
        s -= slope2 * (float)dist;
        if (s > m) {
            const float sc = exp2f(m - s);
            l *= sc;
#pragma unroll
            for (int d = 0; d < 64; ++d) o[d] *= sc;
            m = s;
        }
        const float pr = exp2f(s - m);
        l += pr;
#pragma unroll
        for (int d = 0; d < 64; ++d) o[d] = fmaf(pr, (float)vr[d], o[d]);
    }
    const float il = 1.0f / l;
    float* op = obp + (long)map * TOK * 512 + ((long)b * SEQ + t) * 512 + h * 128 + vh * 64;
#pragma unroll
    for (int d = 0; d < 64; ++d) op[d] = o[d] * il;
}
__device__ __forceinline__ float lambda_full(const float* lq1, const float* lk1, const float* lq2, const float* lk2, int lane) {
    float a = lq1[lane] * lk1[lane], c = lq2[lane] * lk2[lane];
    for (int o = 32; o >= 1; o >>= 1) { a += __shfl_xor(a, o); c += __shfl_xor(c, o); }
    return __expf(a) - __expf(c) + LAMBDA_INIT;
}
__global__ void __launch_bounds__(256) g_mixB_fin(const float* __restrict__ obp, f16* __restrict__ ob, const float* lq1, const float* lk1,
                                                  const float* lq2, const float* lk2, const float* subg) {
    const int lane = threadIdx.x & 63, w = threadIdx.x >> 6;
    const long th = (long)blockIdx.x * 4 + w;
    const float lam = lambda_full(lq1, lk1, lq2, lk2, lane);
    const long off = th * 128;
    float v0 = obp[off + lane] - lam * obp[(long)TOK * 512 + off + lane];
    float v1 = obp[off + 64 + lane] - lam * obp[(long)TOK * 512 + off + 64 + lane];
    float ss = v0 * v0 + v1 * v1;
    for (int o = 32; o >= 1; o >>= 1) ss += __shfl_xor(ss, o);
    const float r = rsqrtf(ss * (1.0f / 128.0f) + 1e-5f) * (1.0f - LAMBDA_INIT);
    ob[off + lane] = (f16)(v0 * r * subg[lane]);
    ob[off + 64 + lane] = (f16)(v1 * r * subg[64 + lane]);
}
template <int MODE>
__global__ void __launch_bounds__(256) g_merge(const f16* A, const float* W, const f16* proj, const f16* mpart, f16* outp) {
    __shared__ float As[16][68], Bs[16][68];
    float acc[4][4] = {};
    const int row0 = blockIdx.y * 64, col0 = blockIdx.x * 64;
    sgemm_core<f16>(A + (long)(row0 + (threadIdx.x >> 2)) * 512 + (threadIdx.x & 3) * 4, W, DM, col0, DM, 512, acc, As, Bs);
    const int tx = threadIdx.x & 15, ty = threadIdx.x >> 4;
#pragma unroll
    for (int i = 0; i < 4; ++i)
#pragma unroll
        for (int j = 0; j < 4; ++j) {
            const int r = row0 + ty * 4 + i, c = col0 + tx * 4 + j;
            const float g = (float)proj[(long)r * INW + (MODE == 0 ? C_GA : C_GB) + c];
            float v = g * acc[i][j];
            if (MODE == 1) v += (float)mpart[(long)r * DM + c];
            outp[(long)r * DM + c] = (f16)v;
        }
}
__global__ void __launch_bounds__(256) g_outproj(const f16* merged, const float* W, const float* bias, const float* x, float* h1) {
    __shared__ float As[16][68], Bs[16][68];
    float acc[4][4] = {};
    const int row0 = blockIdx.y * 64, col0 = blockIdx.x * 64;
    sgemm_core<f16>(merged + (long)(row0 + (threadIdx.x >> 2)) * DM + (threadIdx.x & 3) * 4, W, DM, col0, DM, DM, acc, As, Bs);
    const int tx = threadIdx.x & 15, ty = threadIdx.x >> 4;
#pragma unroll
    for (int i = 0; i < 4; ++i)
#pragma unroll
        for (int j = 0; j < 4; ++j) {
            const int r = row0 + ty * 4 + i, c = col0 + tx * 4 + j;
            h1[(long)r * DM + c] = ALPHA * x[(long)r * DM + c] + acc[i][j] + bias[c];
        }
}
__device__ __forceinline__ int pstart_of(const int* cnt, int e) { int a = 0; for (int i = 0; i < e; ++i) a += (cnt[i] + ROWPAD - 1) / ROWPAD * ROWPAD; return a; }
__global__ void __launch_bounds__(256) g_up(const f16* __restrict__ x1h, const float* __restrict__ wup, const float* __restrict__ bup,
                                            const int* __restrict__ cnt, const int2* __restrict__ list, f16* __restrict__ act) {
    __shared__ float As[16][68], Bs[16][68];
    __shared__ int s_e, s_ps;
    const int row0 = blockIdx.y * 64, col0 = blockIdx.x * 64;
    if (threadIdx.x == 0) { int a = 0, e = 0; for (; e < NEXP; ++e) { const int n = (cnt[e] + ROWPAD - 1) / ROWPAD * ROWPAD; if (row0 < a + n) break; a += n; } s_e = e; s_ps = a; }
    __syncthreads();
    const int e = s_e; if (e >= NEXP) return;
    const int slot0 = row0 - s_ps, ce = cnt[e];
    if (slot0 >= ce) return;
    const int myslot = slot0 + (threadIdx.x >> 2);
    const int tok = myslot < ce ? list[(long)e * LISTCAP + myslot].x : 0;
    const float* B = wup + (long)e * DM * 2048;
    float ag[4][4] = {}, au[4][4] = {};
    sgemm_core<f16>(x1h + (long)tok * DM + (threadIdx.x & 3) * 4, B, 2048, col0, 2048, DM, ag, As, Bs);
    sgemm_core<f16>(x1h + (long)tok * DM + (threadIdx.x & 3) * 4, B, 2048, 1024 + col0, 2048, DM, au, As, Bs);
    const int tx = threadIdx.x & 15, ty = threadIdx.x >> 4;
#pragma unroll
    for (int i = 0; i < 4; ++i)
#pragma unroll
        for (int j = 0; j < 4; ++j) {
            const int r = row0 + ty * 4 + i, c = col0 + tx * 4 + j;
            const float hg = ag[i][j] + bup[(long)e * 2048 + c], hu = au[i][j] + bup[(long)e * 2048 + 1024 + c];
            const float gate = fminf(hg, 7.0f), up = fminf(fmaxf(hu, -7.0f), 7.0f);
            act[(long)r * DM + c] = (f16)(gate * sigmoidf_(1.702f * gate) * (up + 1.0f));
        }
}
__global__ void __launch_bounds__(256) g_down(const f16* __restrict__ act, const float* __restrict__ wdn, const float* __restrict__ bdn,
                                              const int* __restrict__ cnt, const int2* __restrict__ list, f16* __restrict__ ys) {
    __shared__ float As[16][68], Bs[16][68];
    __shared__ int s_e, s_ps;
    const int row0 = blockIdx.y * 64, col0 = blockIdx.x * 64;
    if (threadIdx.x == 0) { int a = 0, e = 0; for (; e < NEXP; ++e) { const int n = (cnt[e] + ROWPAD - 1) / ROWPAD * ROWPAD; if (row0 < a + n) break; a += n; } s_e = e; s_ps = a; }
    __syncthreads();
    const int e = s_e; if (e >= NEXP) return;
    const int slot0 = row0 - s_ps, ce = cnt[e];
    if (slot0 >= ce) return;
    const float* B = wdn + (long)e * DM * DM;
    float acc[4][4] = {};
    const int lrow = (slot0 + (threadIdx.x >> 2)) < ce ? (threadIdx.x >> 2) : 0;
    sgemm_core<f16>(act + (long)(row0 + lrow) * DM + (threadIdx.x & 3) * 4, B, DM, col0, DM, DM, acc, As, Bs);
    const int tx = threadIdx.x & 15, ty = threadIdx.x >> 4;
#pragma unroll
    for (int i = 0; i < 4; ++i) {
        const int slot = slot0 + ty * 4 + i; if (slot >= ce) continue;
        const float wgt = __int_as_float(list[(long)e * LISTCAP + slot].y);
#pragma unroll
        for (int j = 0; j < 4; ++j) { const int c = col0 + tx * 4 + j; ys[(long)(row0 + ty * 4 + i) * DM + c] = (f16)(wgt * (acc[i][j] + bdn[(long)e * DM + c])); }
    }
}
constexpr int RT_LOG = 131072, RT_HIST = RT_LOG + 16384;
__device__ __forceinline__ void phase_router(const Params& p, LAS unsigned char* lds, int wg, int nwg) {
    const int tid = threadIdx.x, lane = tid & 63, wave = tid >> 6;
    const float* h1 = (const float*)(p.ws + WS_H1);
    f16* x1h = (f16*)(p.ws + WS_XH);
    const float* lng = p.in[12]; const float* lnb = p.in[13];
    const float* wr = p.in[14]; const float* br = p.in[15];
    int* cnt = (int*)(p.ws + WS_SMALL + SM_CNT);
    int* tk = (int*)(p.ws + WS_SMALL + SM_TK);
    int2* list = (int2*)(p.ws + WS_SMALL + SM_LIST);
    LAS float* wl = (LAS float*)lds;
    LAS float* slog = (LAS float*)(lds + RT_LOG);
    LAS int* hist = (LAS int*)(lds + RT_HIST);
    LAS int* hbase = hist + 32;
    for (int i = tid; i < DM * 8; i += NTHR) {
        const int col = i >> 3, k = i & 7;
        const float4 v = *(const float4*)(wr + (size_t)col * NEXP + k * 4);
        LAS float* d = wl + col * 32 + ((k ^ ((col >> 1) & 7)) << 2);
        d[0] = v.x; d[1] = v.y; d[2] = v.z; d[3] = v.w;
    }
    if (tid < 32) hist[tid] = 0;
    __syncthreads();
    const int tpw = TOK / (nwg * 8);
    const int tok0 = wg * (TOK / nwg) + wave * tpw;
    float gam[16], bet[16];
#pragma unroll
    for (int r = 0; r < 16; ++r) { gam[r] = lng[r * 64 + lane]; bet[r] = lnb[r * 64 + lane]; }
    for (int j = 0; j < tpw; ++j) {
        const int t = tok0 + j;
        float x[16]; float s = 0.f;
#pragma unroll
        for (int r = 0; r < 16; ++r) { x[r] = h1[(size_t)t * DM + r * 64 + lane]; s += x[r]; }
        for (int o = 32; o >= 1; o >>= 1) s += __shfl_xor(s, o);
        const float mu = s * (1.0f / DM);
        float q = 0.f;
#pragma unroll
        for (int r = 0; r < 16; ++r) { const float d = x[r] - mu; q += d * d; }
        for (int o = 32; o >= 1; o >>= 1) q += __shfl_xor(q, o);
        const float rs = rsqrtf(q * (1.0f / DM) + 1e-5f);
#pragma unroll
        for (int r = 0; r < 16; ++r) { x[r] = (x[r] - mu) * rs * gam[r] + bet[r]; x1h[(size_t)t * DM + r * 64 + lane] = (f16)x[r]; }
        float acc[32];
#pragma unroll
        for (int e = 0; e < 32; ++e) acc[e] = 0.f;
#pragma unroll
        for (int r = 0; r < 16; ++r) {
            const int col = r * 64 + lane;
            const LAS float* wrow = wl + col * 32;
            const int sw = (col >> 1) & 7;
#pragma unroll
            for (int k = 0; k < 8; ++k) {
                const f32x4 w4 = *(const LAS f32x4*)(wrow + ((k ^ sw) << 2));
#pragma unroll
                for (int c = 0; c < 4; ++c) acc[k * 4 + c] = fmaf(x[r], w4[c], acc[k * 4 + c]);
            }
        }
        float a16[16], a8[8], a4[4], a2[2], a1;
        { const bool hi = (lane & 32) != 0;
#pragma unroll
          for (int k = 0; k < 16; ++k) { const float snd = hi ? acc[k] : acc[16 + k]; const float rcv = __shfl_xor(snd, 32); a16[k] = (hi ? acc[16 + k] : acc[k]) + rcv; } }
        { const bool hi = (lane & 16) != 0;
#pragma unroll
          for (int k = 0; k < 8; ++k) { const float snd = hi ? a16[k] : a16[8 + k]; const float rcv = __shfl_xor(snd, 16); a8[k] = (hi ? a16[8 + k] : a16[k]) + rcv; } }
        { const bool hi = (lane & 8) != 0;
#pragma unroll
          for (int k = 0; k < 4; ++k) { const float snd = hi ? a8[k] : a8[4 + k]; const float rcv = __shfl_xor(snd, 8); a4[k] = (hi ? a8[4 + k] : a8[k]) + rcv; } }
        { const bool hi = (lane & 4) != 0;
#pragma unroll
          for (int k = 0; k < 2; ++k) { const float snd = hi ? a4[k] : a4[2 + k]; const float rcv = __shfl_xor(snd, 4); a2[k] = (hi ? a4[2 + k] : a4[k]) + rcv; } }
        { const bool hi = (lane & 2) != 0; const float snd = hi ? a2[0] : a2[1]; const float rcv = __shfl_xor(snd, 2); a1 = (hi ? a2[1] : a2[0]) + rcv; }
        a1 += __shfl_xor(a1, 1);
        if ((lane & 1) == 0) slog[(wave * tpw + j) * 32 + (lane >> 1)] = a1 + br[lane >> 1];
    }
    __syncthreads();
    int my_e[4]; float my_g[4]; int my_loc[4];
    const bool act = lane < tpw;
    const int tl = wave * tpw + lane;
    if (act) {
        float v[32];
#pragma unroll
        for (int k = 0; k < 8; ++k) { const f32x4 t4 = *(const LAS f32x4*)(slog + tl * 32 + k * 4); v[k * 4] = t4[0]; v[k * 4 + 1] = t4[1]; v[k * 4 + 2] = t4[2]; v[k * 4 + 3] = t4[3]; }
        float tv[4];
#pragma unroll
        for (int k = 0; k < 4; ++k) {
            float bv = -3.0e38f; int bi = 0;
#pragma unroll
            for (int e = 0; e < 32; ++e) { if (v[e] > bv) { bv = v[e]; bi = e; } }
            tv[k] = bv; my_e[k] = bi;
#pragma unroll
            for (int e = 0; e < 32; ++e) v[e] = (e == bi) ? -3.0e38f : v[e];
        }
        const float e1 = __expf(tv[1] - tv[0]), e2 = __expf(tv[2] - tv[0]), e3 = __expf(tv[3] - tv[0]);
        const float inv = 1.0f / (1.0f + e1 + e2 + e3);
        my_g[0] = inv; my_g[1] = e1 * inv; my_g[2] = e2 * inv; my_g[3] = e3 * inv;
#pragma unroll
        for (int k = 0; k < 4; ++k) my_loc[k] = __hip_atomic_fetch_add(hist + my_e[k], 1, __ATOMIC_RELAXED, __HIP_MEMORY_SCOPE_WORKGROUP);
    }
    __syncthreads();
    if (tid < 32) hbase[tid] = atomicAdd(&cnt[tid], hist[tid]);
    __syncthreads();
    if (act) {
        const int t = tok0 + lane;
#pragma unroll
        for (int k = 0; k < 4; ++k) {
            const int slot = hbase[my_e[k]] + my_loc[k];
            tk[t * 4 + k] = (my_e[k] << 20) | slot;
            list[(size_t)my_e[k] * LISTCAP + slot] = make_int2(t, __float_as_int(my_g[k]));
        }
    }
    __syncthreads();
}

__device__ __forceinline__ void phase_final(const Params& p, LAS unsigned char* lds, int wg, int nwg) {
    const int tid = threadIdx.x, lane = tid & 63, wave = tid >> 6;
    const f16* x1h = (const f16*)(p.ws + WS_XH);
    const f16* ys = (const f16*)(p.ws + WS_YS);
    const int* cnt = (const int*)(p.ws + WS_SMALL + SM_CNT);
    const int* tk = (const int*)(p.ws + WS_SMALL + SM_TK);
    const float* lng = p.in[20]; const float* lnb = p.in[21];
    LAS int* ps = (LAS int*)lds;
    if (tid == 0) { int a = 0; for (int e = 0; e < NEXP; ++e) { ps[e] = a; a += (cnt[e] + ROWPAD - 1) / ROWPAD * ROWPAD; } }
    __syncthreads();
    const int tpw = TOK / (nwg * 8);
    const int tok0 = wg * (TOK / nwg) + wave * tpw;
    for (int j = 0; j < tpw; ++j) {
        const int t = tok0 + j;
        float v[16];
        { const f16x8 a = *(const f16x8*)(x1h + (size_t)t * DM + 8 * lane), b = *(const f16x8*)(x1h + (size_t)t * DM + 512 + 8 * lane);
#pragma unroll
          for (int i = 0; i < 8; ++i) { v[i] = ALPHA * (float)a[i]; v[8 + i] = ALPHA * (float)b[i]; } }
#pragma unroll
        for (int k = 0; k < 4; ++k) {
            const int c = tk[t * 4 + k]; const int row = ps[c >> 20] + (c & 0xFFFFF);
            const f16x8 a = *(const f16x8*)(ys + (size_t)row * DM + 8 * lane), b = *(const f16x8*)(ys + (size_t)row * DM + 512 + 8 * lane);
#pragma unroll
            for (int i = 0; i < 8; ++i) { v[i] += (float)a[i]; v[8 + i] += (float)b[i]; }
        }
        float s = 0.f;
#pragma unroll
        for (int i = 0; i < 16; ++i) s += v[i];
        for (int o = 32; o >= 1; o >>= 1) s += __shfl_xor(s, o);
        const float mu = s * (1.0f / DM);
        float q = 0.f;
#pragma unroll
        for (int i = 0; i < 16; ++i) { const float d = v[i] - mu; q += d * d; }
        for (int o = 32; o >= 1; o >>= 1) q += __shfl_xor(q, o);
        const float rs = rsqrtf(q * (1.0f / DM) + 1e-5f);
        float* op = p.out + (size_t)t * DM;
#pragma unroll
        for (int hh = 0; hh < 2; ++hh) {
            const int c0 = hh * 512 + 8 * lane;
            const float4 g0 = *(const float4*)(lng + c0), g1 = *(const float4*)(lng + c0 + 4), b0 = *(const float4*)(lnb + c0), b1 = *(const float4*)(lnb + c0 + 4);
            float4 o0, o1;
            o0.x = (v[hh * 8 + 0] - mu) * rs * g0.x + b0.x; o0.y = (v[hh * 8 + 1] - mu) * rs * g0.y + b0.y; o0.z = (v[hh * 8 + 2] - mu) * rs * g0.z + b0.z; o0.w = (v[hh * 8 + 3] - mu) * rs * g0.w + b0.w;
            o1.x = (v[hh * 8 + 4] - mu) * rs * g1.x + b1.x; o1.y = (v[hh * 8 + 5] - mu) * rs * g1.y + b1.y; o1.z = (v[hh * 8 + 6] - mu) * rs * g1.z + b1.z; o1.w = (v[hh * 8 + 7] - mu) * rs * g1.w + b1.w;
            *(float4*)(op + c0) = o0; *(float4*)(op + c0 + 4) = o1;
        }
    }
    __syncthreads();
}
struct MergeSched {
    static constexpr int K = 512;
    const char* A; const char* Bt; DenseSched<512> D;
    __device__ void init(const void* oa, const void* wpa_t, int G, int c) { A = (const char*)oa; Bt = (const char*)wpa_t; D.init(oa, wpa_t, TOK, DM, G, c); }
    __device__ __forceinline__ bool next(int i, Unit& u) const { if (!D.next(i >> 1, u)) return false; u.e = i & 1; return true; }
    __device__ __forceinline__ void a_offsets(const Unit& u, const int (&R)[2], const int (&C)[2], unsigned (&ao)[2][2]) const {
#pragma unroll
        for (int h = 0; h < 2; ++h)
#pragma unroll
            for (int i = 0; i < 2; ++i) ao[h][i] = (unsigned)((u.pm * BM + h * HALF + R[i]) * K + C[i]) * 2u + (unsigned)u.e * (unsigned)(TOK * 512 * 2);
    }
    __device__ __forceinline__ const char* b_base(const Unit& u) const { return Bt + (size_t)u.e * DM * 512 * 2 + (size_t)u.pn * BM * K * 2; }
};
struct EpiMerge {
    static constexpr bool PERM = true;
    const f16* proj; f16* mpart; f16* merged;
    __device__ __forceinline__ void operator()(const f32x4 (&acc)[2][2][4][2], const Unit& u, int wr, int wc, int fr, int fq) const {
        const int row0 = u.pm * BM + wr * 64 + fr, col0 = u.pn * BM + wc * 32 + 8 * fq;
        const int gcol = (u.e == 0 ? C_GA : C_GB) + col0;
#pragma unroll
        for (int ai = 0; ai < 2; ++ai)
#pragma unroll
            for (int m = 0; m < 4; ++m) {
                const size_t row = (size_t)(row0 + ai * HALF + m * 16);
#pragma unroll
                for (int bj = 0; bj < 2; ++bj) {
                    const f16x8 g = *(const f16x8*)(proj + row * INW + gcol + bj * HALF);
                    float v[8];
#pragma unroll
                    for (int j = 0; j < 4; ++j) { v[j] = (float)g[j] * acc[ai][bj][m][0][j]; v[4 + j] = (float)g[4 + j] * acc[ai][bj][m][1][j]; }
                    if (u.e == 1) {
                        const f16x8 q = *(const f16x8*)(mpart + row * DM + col0 + bj * HALF);
#pragma unroll
                        for (int j = 0; j < 8; ++j) v[j] += (float)q[j];
                    }
                    u32x4 w; w.x = pk2(v[0], v[1]); w.y = pk2(v[2], v[3]); w.z = pk2(v[4], v[5]); w.w = pk2(v[6], v[7]);
                    *(u32x4*)((u.e == 0 ? mpart : merged) + row * DM + col0 + bj * HALF) = w;
                }
            }
    }
};
__device__ __forceinline__ void phase_merge(const Params& p, LAS unsigned char* lds, int wg, int nwg) {
    MergeSched S; S.init(p.ws + WS_OAB, p.ws + WS_WPA, nwg, wg);
    EpiMerge E{(const f16*)(p.ws + WS_PROJ), (f16*)(p.ws + WS_H1), (f16*)(p.ws + WS_MERGED)};
    gemm_phase(lds, S, E);
}
struct EpiOutProj {
    static constexpr bool PERM = false;
    const float* x; const float* bias; float* h1;
    __device__ __forceinline__ void operator()(const f32x4 (&acc)[2][2][4][2], const Unit& u, int wr, int wc, int fr, int fq) const {
        const int row0 = u.pm * BM + wr * 64 + fr, col0 = u.pn * BM + wc * 32 + 4 * fq;
        f32x4 bv[2][2];
#pragma unroll
        for (int bj = 0; bj < 2; ++bj)
#pragma unroll
            for (int n = 0; n < 2; ++n) bv[bj][n] = *(const f32x4*)(bias + col0 + bj * HALF + n * 16);
#pragma unroll
        for (int ai = 0; ai < 2; ++ai)
#pragma unroll
            for (int m = 0; m < 4; ++m) {
                const size_t off = (size_t)(row0 + ai * HALF + m * 16) * DM + col0;
#pragma unroll
                for (int bj = 0; bj < 2; ++bj)
#pragma unroll
                    for (int n = 0; n < 2; ++n) {
                        const f32x4 xv = *(const f32x4*)(x + off + bj * HALF + n * 16);
                        *(f32x4*)(h1 + off + bj * HALF + n * 16) = ALPHA * xv + acc[ai][bj][m][n] + bv[bj][n];
                    }
            }
    }
};
__device__ __forceinline__ void phase_outproj(const Params& p, LAS unsigned char* lds, int wg, int nwg) {
    DenseSched<DM> S; S.init(p.ws + WS_MERGED, p.ws + WS_WOUT, TOK, DM, nwg, wg);
    EpiOutProj E{p.in[0], p.in[11], (float*)(p.ws + WS_H1)};
    gemm_phase(lds, S, E);
}

constexpr int MOE_MISC = STAGE_BYTES;
__device__ __forceinline__ void moe_prefix(const Params& p, LAS unsigned char* lds) {
    LAS int* tpre = (LAS int*)(lds + MOE_MISC); LAS int* ecnt = tpre + 64;
    const int* cnt = (const int*)(p.ws + WS_SMALL + SM_CNT);
    if (threadIdx.x == 0) { int a = 0; for (int e = 0; e < NEXP; ++e) { const int c = cnt[e]; ecnt[e] = c; tpre[e] = a; a += (c + ROWPAD - 1) / ROWPAD; } tpre[NEXP] = a; }
    __syncthreads();
}
template <int NPN, bool GATHER>
struct MoeSched {
    static constexpr int K = DM;
    const char* A; const char* Bt; const int2* list; LAS int* tpre; LAS int* ecnt; int c;
    __device__ __forceinline__ bool next(int i, Unit& u) const {
        constexpr int MPR = 256 / NPN, MPX = 32 / NPN;
        const int xcd = c & 7, j = c >> 3;
        const int M = i * MPR + xcd * MPX + j / NPN;
        if (M >= tpre[NEXP]) return false;
        int e = 0;
        for (int k = 1; k < NEXP; ++k) e += (tpre[k] <= M) ? 1 : 0;
        u.e = e; u.pm = M - tpre[e]; u.pn = j % NPN; u.row0 = M * ROWPAD; u.nrows = ecnt[e] - u.pm * ROWPAD;
        return true;
    }
    __device__ __forceinline__ void a_offsets(const Unit& u, const int (&R)[2], const int (&C)[2], unsigned (&ao)[2][2]) const {
#pragma unroll
        for (int h = 0; h < 2; ++h)
#pragma unroll
            for (int i = 0; i < 2; ++i) {
                const int lr = h * HALF + R[i];
                if (GATHER) { int tok = list[(size_t)u.e * LISTCAP + u.pm * ROWPAD + lr].x; tok = lr < u.nrows ? tok : 0; ao[h][i] = (unsigned)(tok * K + C[i]) * 2u; }
                else ao[h][i] = (unsigned)((u.row0 + lr) * K + C[i]) * 2u;
            }
        if (GATHER) asm volatile("" : "+v"(ao[0][0]), "+v"(ao[0][1]), "+v"(ao[1][0]), "+v"(ao[1][1]));
    }
    __device__ __forceinline__ const char* b_base(const Unit& u) const { return Bt + ((size_t)u.e * (NPN * BM) + (size_t)u.pn * BM) * K * 2; }
};
struct EpiUp {
    static constexpr bool PERM = true;
    const float* bup; f16* act;
    __device__ __forceinline__ void operator()(const f32x4 (&acc)[2][2][4][2], const Unit& u, int wr, int wc, int fr, int fq) const {
        const int col0 = u.pn * HALF + wc * 32 + 8 * fq;
        const float* bg = bup + (size_t)u.e * 2048 + col0; const float* bu = bg + 1024;
        const f32x4 bg0 = *(const f32x4*)bg, bg1 = *(const f32x4*)(bg + 4), bu0 = *(const f32x4*)bu, bu1 = *(const f32x4*)(bu + 4);
#pragma unroll
        for (int ai = 0; ai < 2; ++ai)
#pragma unroll
            for (int m = 0; m < 4; ++m) {
                const size_t row = (size_t)(u.row0 + ai * HALF + wr * 64 + m * 16 + fr);
                float v[8];
#pragma unroll
                for (int n = 0; n < 2; ++n)
#pragma unroll
                    for (int j = 0; j < 4; ++j) {
                        const float hg = acc[ai][0][m][n][j] + (n == 0 ? bg0[j] : bg1[j]), hu = acc[ai][1][m][n][j] + (n == 0 ? bu0[j] : bu1[j]);
                        const float gate = fminf(hg, 7.0f), up = fminf(fmaxf(hu, -7.0f), 7.0f);
                        v[n * 4 + j] = gate * __builtin_amdgcn_rcpf(1.0f + __expf(-1.702f * gate)) * (up + 1.0f);
                    }
                u32x4 w; w.x = pk2(v[0], v[1]); w.y = pk2(v[2], v[3]); w.z = pk2(v[4], v[5]); w.w = pk2(v[6], v[7]);
                *(u32x4*)(act + row * DM + col0) = w;
            }
    }
};
struct EpiDown {
    static constexpr bool PERM = true;
    const float* bdn; const int2* list; f16* ys;
    __device__ __forceinline__ void operator()(const f32x4 (&acc)[2][2][4][2], const Unit& u, int wr, int wc, int fr, int fq) const {
        const int col0 = u.pn * BM + wc * 32 + 8 * fq;
        f32x4 bv[2][2];
#pragma unroll
        for (int bj = 0; bj < 2; ++bj)
#pragma unroll
            for (int n = 0; n < 2; ++n) bv[bj][n] = *(const f32x4*)(bdn + (size_t)u.e * DM + col0 + bj * HALF + 4 * n);
#pragma unroll
        for (int ai = 0; ai < 2; ++ai)
#pragma unroll
            for (int m = 0; m < 4; ++m) {
                const int lr = ai * HALF + wr * 64 + m * 16 + fr;
                float wgt = __int_as_float(list[(size_t)u.e * LISTCAP + u.pm * ROWPAD + lr].y); wgt = lr < u.nrows ? wgt : 0.f;
                f16* rowp = ys + (size_t)(u.row0 + lr) * DM + col0;
#pragma unroll
                for (int bj = 0; bj < 2; ++bj) {
                    const f32x4 v0 = (acc[ai][bj][m][0] + bv[bj][0]) * wgt, v1 = (acc[ai][bj][m][1] + bv[bj][1]) * wgt;
                    u32x4 w; w.x = pk2(v0[0], v0[1]); w.y = pk2(v0[2], v0[3]); w.z = pk2(v1[0], v1[1]); w.w = pk2(v1[2], v1[3]);
                    *(u32x4*)(rowp + bj * HALF) = w;
                }
            }
    }
};
__device__ __forceinline__ void phase_up(const Params& p, LAS unsigned char* lds, int wg, int nwg) {
    moe_prefix(p, lds);
    MoeSched<8, true> S{(const char*)(p.ws + WS_XH), (const char*)(p.ws + WS_WUP), (const int2*)(p.ws + WS_SMALL + SM_LIST), (LAS int*)(lds + MOE_MISC), (LAS int*)(lds + MOE_MISC) + 64, wg};
    EpiUp E{p.in[17], (f16*)(p.ws + WS_PROJ)};
    gemm_phase(lds, S, E);
}
__device__ __forceinline__ void phase_down(const Params& p, LAS unsigned char* lds, int wg, int nwg) {
    moe_prefix(p, lds);
    MoeSched<4, false> S{(const char*)(p.ws + WS_PROJ), (const char*)(p.ws + WS_WDN), (const int2*)(p.ws + WS_SMALL + SM_LIST), (LAS int*)(lds + MOE_MISC), (LAS int*)(lds + MOE_MISC) + 64, wg};
    EpiDown E{p.in[19], (const int2*)(p.ws + WS_SMALL + SM_LIST), (f16*)(p.ws + WS_YS)};
    gemm_phase(lds, S, E);
}
typedef short s16x4 __attribute__((ext_vector_type(4)));
__device__ __forceinline__ int crow(int r, int hi) { return (r & 3) + 8 * (r >> 2) + 4 * hi; }
__device__ __forceinline__ f16x4 vtr(const LAS unsigned char* p) { return __builtin_bit_cast(f16x4, __builtin_amdgcn_ds_read_tr16_b64_v4i16((LAS s16x4*)p)); }
#define MFMA32(a, b, c) __builtin_amdgcn_mfma_f32_32x32x16_f16(a, b, c, 0, 0, 0)
__device__ __forceinline__ float rowmax32(const f32x16& p0, const f32x16& p1) {
    float a = fmaxf(fmaxf(p0[0], p0[1]), p1[0]), b = fmaxf(fmaxf(p0[2], p0[3]), p1[1]); a = fmaxf(fmaxf(a, p1[2]), p1[3]);
#pragma unroll
    for (int r = 4; r < 16; r += 4) { a = fmaxf(fmaxf(a, p0[r]), p0[r + 1]); b = fmaxf(fmaxf(b, p0[r + 2]), p0[r + 3]); a = fmaxf(fmaxf(a, p1[r]), p1[r + 1]); b = fmaxf(fmaxf(b, p1[r + 2]), p1[r + 3]); }
    float m = fmaxf(a, b); auto rr = __builtin_amdgcn_permlane32_swap(__float_as_uint(m), __float_as_uint(m), false, false);
    return fmaxf(__uint_as_float(rr[0]), __uint_as_float(rr[1]));
}
__device__ __forceinline__ float half_sum(float v) { auto rr = __builtin_amdgcn_permlane32_swap(__float_as_uint(v), __float_as_uint(v), false, false); return __uint_as_float(rr[0]) + __uint_as_float(rr[1]); }

constexpr int AB_QSTR = 4160;
constexpr int AB_STG = 16384 + 4 * AB_QSTR;
constexpr int AB_STGS = 33280;
constexpr int AB_WSF = 131072;
constexpr float AB_THR = 8.0f;

__device__ __forceinline__ void phase_attnB(const Params& p, LAS unsigned char* lds, int wg, int nwg) {
    const int tid = threadIdx.x, lane = tid & 63, r32 = lane & 31, hi = lane >> 5;
    const int wave = __builtin_amdgcn_readfirstlane(tid >> 6), map = wave >> 2, qsub = wave & 3;
    const f16* proj = (const f16*)(p.ws + WS_PROJ);
    f16* ob = (f16*)(p.ws + WS_OAB) + (size_t)TOK * 512;
    const float lam = lambda_full(p.in[3], p.in[4], p.in[5], p.in[6], lane);
    const float* subg = p.in[7];
    LAS float* wsf = (LAS float*)(lds + AB_WSF) + wave * 32;
    const int ksw = (r32 >> 1) & 7;
    int koff[4];
#pragma unroll
    for (int d0 = 0; d0 < 4; ++d0) koff[d0] = r32 * 128 + (((2 * d0 + hi) ^ ksw) << 4);
    const int vl = ((lane >> 4) & 1) * 32 + (lane & 3) * 8 + (4 * hi + ((lane & 15) >> 2)) * 64;
    const int krow = tid >> 3, kch = tid & 7;
    const int kw_off = krow * 128 + ((kch ^ ((krow >> 1) & 7)) << 4);
    int vrow[2], vc16[2], vw_off[2];
#pragma unroll
    for (int j = 0; j < 2; ++j) { const int idx = tid + j * NTHR; vrow[j] = idx >> 4; vc16[j] = idx & 15; vw_off[j] = (vc16[j] >> 2) * AB_QSTR + vrow[j] * 64 + (vc16[j] & 3) * 16; }

    for (int ui = 0; ui < 4; ++ui) {
        const int bh = 8 * ui + (wg & 7), qb = wg >> 3;
        const int b = bh >> 2, h = bh & 3;
        const float sl2 = slope_of(3 * h + 2) * LOG2E;
        const f16* base = proj + (size_t)b * SEQ * INW;
        const int q0 = qb * 128 + qsub * 32, qpos = q0 + r32;
        f16x8 qr[4];
#pragma unroll
        for (int d0 = 0; d0 < 4; ++d0) qr[d0] = *(const f16x8*)(base + (size_t)qpos * INW + C_QB + h * 128 + map * 64 + 16 * d0 + 8 * hi);
        const f16* gk1 = base + (size_t)krow * INW + C_KB + h * 128 + kch * 8;
        const f16* gv0 = base + (size_t)vrow[0] * INW + C_VB + h * 128 + vc16[0] * 8;
        const f16* gv1 = base + (size_t)vrow[1] * INW + C_VB + h * 128 + vc16[1] * 8;
        u32x4 g0, g1, g2, g3;
        g0 = *(const u32x4*)gk1; g1 = *(const u32x4*)(gk1 + 64); g2 = *(const u32x4*)gv0; g3 = *(const u32x4*)gv1;
        *(LAS u32x4*)(lds + kw_off) = g0; *(LAS u32x4*)(lds + 8192 + kw_off) = g1; *(LAS u32x4*)(lds + 16384 + vw_off[0]) = g2; *(LAS u32x4*)(lds + 16384 + vw_off[1]) = g3;
        __syncthreads();
        f32x16 o[4];
#pragma unroll
        for (int i = 0; i < 4; ++i) o[i] = (f32x16){0.f, 0.f, 0.f, 0.f, 0.f, 0.f, 0.f, 0.f, 0.f, 0.f, 0.f, 0.f, 0.f, 0.f, 0.f, 0.f};
        float m = -1.0e30f, l = 0.f;
        for (int t = 0; t < SEQ / 64; ++t) {
            const int kb = t * 64;
            if (t + 1 < SEQ / 64) {
                const size_t adv = (size_t)(kb + 64) * INW;
                g0 = *(const u32x4*)(gk1 + adv); g1 = *(const u32x4*)(gk1 + adv + 64); g2 = *(const u32x4*)(gv0 + adv); g3 = *(const u32x4*)(gv1 + adv);
            }
            const LAS unsigned char* st = lds + (t & 1) * AB_STGS;
            const LAS unsigned char* kbse = st + map * 8192;
            f32x16 s0 = (f32x16){0.f, 0.f, 0.f, 0.f, 0.f, 0.f, 0.f, 0.f, 0.f, 0.f, 0.f, 0.f, 0.f, 0.f, 0.f, 0.f}, s1 = s0;
#pragma unroll
            for (int d0 = 0; d0 < 4; ++d0) {
                const f16x8 a0 = *(const LAS f16x8*)(kbse + koff[d0]), a1 = *(const LAS f16x8*)(kbse + 4096 + koff[d0]);
                s0 = MFMA32(a0, qr[d0], s0); s1 = MFMA32(a1, qr[d0], s1);
            }
            const float dq0 = (float)(qpos - kb - 4 * hi);
#pragma unroll
            for (int r = 0; r < 16; ++r) {
                const float c = (float)((r & 3) + 8 * (r >> 2));
                s0[r] = __builtin_fmaf(-sl2, __builtin_fabsf(dq0 - c), s0[r]);
                s1[r] = __builtin_fmaf(-sl2, __builtin_fabsf(dq0 - 32.0f - c), s1[r]);
            }
            const float mx = rowmax32(s0, s1);
            if (__any(mx > m + AB_THR)) {
                const float mn = fmaxf(m, mx), al = __builtin_amdgcn_exp2f(m - mn);
                l *= al; m = mn;
                if (hi == 0) wsf[r32] = al;
#pragma unroll
                for (int r = 0; r < 16; ++r) { const float f = wsf[crow(r, hi)];
#pragma unroll
                    for (int i = 0; i < 4; ++i) o[i][r] *= f; }
            }
            float ls = 0.f;
#pragma unroll
            for (int r = 0; r < 16; ++r) { s0[r] = __builtin_amdgcn_exp2f(s0[r] - m); s1[r] = __builtin_amdgcn_exp2f(s1[r] - m); ls += s0[r] + s1[r]; }
            l += ls;
            u32x4 pw[4];
            pw[0] = (u32x4){pk2(s0[0], s0[1]), pk2(s0[2], s0[3]), pk2(s0[4], s0[5]), pk2(s0[6], s0[7])};
            pw[1] = (u32x4){pk2(s0[8], s0[9]), pk2(s0[10], s0[11]), pk2(s0[12], s0[13]), pk2(s0[14], s0[15])};
            pw[2] = (u32x4){pk2(s1[0], s1[1]), pk2(s1[2], s1[3]), pk2(s1[4], s1[5]), pk2(s1[6], s1[7])};
            pw[3] = (u32x4){pk2(s1[8], s1[9]), pk2(s1[10], s1[11]), pk2(s1[12], s1[13]), pk2(s1[14], s1[15])};
            const LAS unsigned char* vb = st + 16384 + vl;
#pragma unroll
            for (int ks = 0; ks < 4; ++ks)
#pragma unroll
                for (int dq = 0; dq < 4; ++dq) {
                    const f16x4 lo = vtr(vb + dq * AB_QSTR + ks * 1024), hh = vtr(vb + dq * AB_QSTR + ks * 1024 + 512);
                    const f16x8 vf = (f16x8){lo[0], lo[1], lo[2], lo[3], hh[0], hh[1], hh[2], hh[3]};
                    o[dq] = MFMA32(__builtin_bit_cast(f16x8, pw[ks]), vf, o[dq]);
                }
            if (t + 1 < SEQ / 64) {
                LAS unsigned char* ns = lds + ((t + 1) & 1) * AB_STGS;
                *(LAS u32x4*)(ns + kw_off) = g0; *(LAS u32x4*)(ns + 8192 + kw_off) = g1; *(LAS u32x4*)(ns + 16384 + vw_off[0]) = g2; *(LAS u32x4*)(ns + 16384 + vw_off[1]) = g3;
            }
            __syncthreads();
        }
        l = half_sum(l);
        if (hi == 0) wsf[r32] = 1.0f / l;
        LAS float* ost = (LAS float*)lds + (size_t)map * 128 * 128;
#pragma unroll
        for (int r = 0; r < 16; ++r) { const float il = wsf[crow(r, hi)]; const int row = qsub * 32 + crow(r, hi);
#pragma unroll
            for (int i = 0; i < 4; ++i) ost[row * 128 + i * 32 + r32] = o[i][r] * il; }
        __syncthreads();
        {
            const LAS float* o1 = (const LAS float*)lds; const LAS float* o2 = o1 + 128 * 128;
            const float g0s = subg[lane], g1s = subg[64 + lane];
            for (int rr = 0; rr < 16; ++rr) {
                const int row = wave * 16 + rr;
                const float v0 = o1[row * 128 + lane] - lam * o2[row * 128 + lane], v1 = o1[row * 128 + 64 + lane] - lam * o2[row * 128 + 64 + lane];
                float ss = v0 * v0 + v1 * v1;
                for (int of = 32; of >= 1; of >>= 1) ss += __shfl_xor(ss, of);
                const float rs = rsqrtf(ss * (1.0f / 128.0f) + 1e-5f) * (1.0f - LAMBDA_INIT);
                f16* op = ob + ((size_t)b * SEQ + qb * 128 + row) * 512 + h * 128;
                op[lane] = (f16)(v0 * rs * g0s); op[64 + lane] = (f16)(v1 * rs * g1s);
            }
        }
        __syncthreads();
    }
}
constexpr int AA_HSTR = 2112;
constexpr int AA_BUF = 2 * AA_HSTR;
constexpr int AA_WAVE = 2 * AA_BUF + 128;
constexpr float AA_THR = 8.0f;
__device__ __forceinline__ float rowmax16(const f32x16& p0) {
    float a = fmaxf(fmaxf(p0[0], p0[1]), p0[2]), b = fmaxf(fmaxf(p0[3], p0[4]), p0[5]);
    a = fmaxf(fmaxf(a, p0[6]), p0[7]); b = fmaxf(fmaxf(b, p0[8]), p0[9]); a = fmaxf(fmaxf(a, p0[10]), p0[11]); b = fmaxf(fmaxf(b, p0[12]), p0[13]);
    a = fmaxf(fmaxf(a, p0[14]), p0[15]);
    float m = fmaxf(a, b); auto rr = __builtin_amdgcn_permlane32_swap(__float_as_uint(m), __float_as_uint(m), false, false);
    return fmaxf(__uint_as_float(rr[0]), __uint_as_float(rr[1]));
}
__device__ __forceinline__ void phase_attnA(const Params& p, LAS unsigned char* lds, int wg, int nwg) {
    const int tid = threadIdx.x, lane = tid & 63, r32 = lane & 31, hi = lane >> 5;
    const int wave = __builtin_amdgcn_readfirstlane(tid >> 6);
    const f16* proj = (const f16*)(p.ws + WS_PROJ);
    f16* oa = (f16*)(p.ws + WS_OAB);
    LAS unsigned char* wl = lds + wave * AA_WAVE;
    LAS float* wsf = (LAS float*)(wl + 2 * AA_BUF);
    const int vl = ((lane >> 4) & 1) * 32 + (lane & 3) * 8 + (4 * hi + ((lane & 15) >> 2)) * 64;
    int vrow[4], vch[4], vw_off[4];
#pragma unroll
    for (int jj = 0; jj < 4; ++jj) { const int idx = lane + 64 * jj; vrow[jj] = idx >> 3; vch[jj] = idx & 7; vw_off[jj] = (vch[jj] >> 2) * AA_HSTR + vrow[jj] * 64 + (vch[jj] & 3) * 16; }
    constexpr int NTILE = 33;
    for (int ui = 0; ui < 4; ++ui) {
        const int j = wg >> 3, bh = ui * 16 + (wg & 7) * 2 + (j >> 4), r16 = j & 15;
        const int b = bh >> 3, h = bh & 7;
        const float sl2 = slope_of(h + (h >> 1)) * LOG2E;
        const f16* base = proj + (size_t)b * SEQ * INW;
        const int P0 = r16 + 512 * wave, qpos = P0 + 16 * r32;
        f16x8 qr[4];
#pragma unroll
        for (int d0 = 0; d0 < 4; ++d0) qr[d0] = *(const f16x8*)(base + (size_t)qpos * INW + C_QA + h * 64 + 16 * d0 + 8 * hi);
        f32x16 o[2];
        o[0] = (f32x16){0.f, 0.f, 0.f, 0.f, 0.f, 0.f, 0.f, 0.f, 0.f, 0.f, 0.f, 0.f, 0.f, 0.f, 0.f, 0.f}; o[1] = o[0];
        float m = -1.0e30f, l = 0.f;
        f16x8 kfn[4]; u32x4 vsn[4];
#define AA_PARAMS(tt, d, n) const int d = (tt) < 5 ? 16 : ((tt) < 13 ? 4 : 1), n = (tt) < 5 ? (tt) : ((tt) < 13 ? (tt) - 5 : (tt) - 13)
#define AA_LOAD(tt) do { AA_PARAMS(tt, d_, n_); const int kb_ = P0 - 64 * d_ + 32 * d_ * n_; \
            { int kp = kb_ + d_ * r32; kp = kp < 0 ? 0 : (kp > SEQ - 1 ? SEQ - 1 : kp); const f16* kr = base + (size_t)kp * INW + C_KA + h * 64 + 8 * hi; \
              _Pragma("unroll") for (int d0 = 0; d0 < 4; ++d0) kfn[d0] = *(const f16x8*)(kr + 16 * d0); } \
            _Pragma("unroll") for (int jj = 0; jj < 4; ++jj) { int kp = kb_ + d_ * vrow[jj]; kp = kp < 0 ? 0 : (kp > SEQ - 1 ? SEQ - 1 : kp); \
              vsn[jj] = *(const u32x4*)(base + (size_t)kp * INW + C_VA + h * 64 + vch[jj] * 8); } } while (0)
        AA_LOAD(0);
        for (int tt = 0; tt < NTILE; ++tt) {
            f16x8 kf[4];
#pragma unroll
            for (int d0 = 0; d0 < 4; ++d0) kf[d0] = kfn[d0];
            LAS unsigned char* vbuf = wl + (tt & 1) * AA_BUF;
#pragma unroll
            for (int jj = 0; jj < 4; ++jj) *(LAS u32x4*)(vbuf + vw_off[jj]) = vsn[jj];
            if (tt + 1 < NTILE) AA_LOAD(tt + 1);
            AA_PARAMS(tt, d, n);
            const int kb = P0 - 64 * d + 32 * d * n;
            f32x16 s = (f32x16){0.f, 0.f, 0.f, 0.f, 0.f, 0.f, 0.f, 0.f, 0.f, 0.f, 0.f, 0.f, 0.f, 0.f, 0.f, 0.f};
#pragma unroll
            for (int d0 = 0; d0 < 4; ++d0) s = MFMA32(kf[d0], qr[d0], s);
            const float df = (float)d, basef = (float)(d * (32 * n + 4 * hi - 64) - 16 * r32), lim = 64.0f * df;
            const bool need_range = (kb < 0) || (kb + 31 * d >= SEQ);
            const float kpf0 = (float)(kb + 4 * hi * d);
#pragma unroll
            for (int r = 0; r < 16; ++r) {
                const float c = (float)((r & 3) + 8 * (r >> 2));
                const float ad = __builtin_fabsf(__builtin_fmaf(df, c, basef));
                bool valid = ad <= lim;
                if (need_range) { const float kpf = __builtin_fmaf(df, c, kpf0); valid = valid && (kpf >= 0.0f) && (kpf < (float)SEQ); }
                s[r] = valid ? __builtin_fmaf(-sl2, ad, s[r]) : -INFINITY;
            }
            const float mx = rowmax16(s);
            if (__any(mx > m + AA_THR)) {
                const float mn = fmaxf(m, mx), al = __builtin_amdgcn_exp2f(m - mn);
                l *= al; m = mn;
                if (hi == 0) wsf[r32] = al;
#pragma unroll
                for (int r = 0; r < 16; ++r) { const float f = wsf[crow(r, hi)]; o[0][r] *= f; o[1][r] *= f; }
            }
            float ls = 0.f;
#pragma unroll
            for (int r = 0; r < 16; ++r) { s[r] = __builtin_amdgcn_exp2f(s[r] - m); ls += s[r]; }
            l += ls;
            u32x4 pw[2];
            pw[0] = (u32x4){pk2(s[0], s[1]), pk2(s[2], s[3]), pk2(s[4], s[5]), pk2(s[6], s[7])};
            pw[1] = (u32x4){pk2(s[8], s[9]), pk2(s[10], s[11]), pk2(s[12], s[13]), pk2(s[14], s[15])};
            const LAS unsigned char* vb = vbuf + vl;
#pragma unroll
            for (int ks = 0; ks < 2; ++ks)
#pragma unroll
                for (int dh = 0; dh < 2; ++dh) {
                    const f16x4 lo = vtr(vb + dh * AA_HSTR + ks * 1024), hh = vtr(vb + dh * AA_HSTR + ks * 1024 + 512);
                    const f16x8 vf = (f16x8){lo[0], lo[1], lo[2], lo[3], hh[0], hh[1], hh[2], hh[3]};
                    o[dh] = MFMA32(__builtin_bit_cast(f16x8, pw[ks]), vf, o[dh]);
                }
        }
#undef AA_LOAD
#undef AA_PARAMS
        l = half_sum(l);
        if (hi == 0) wsf[r32] = 1.0f / l;
#pragma unroll
        for (int r = 0; r < 16; ++r) {
            const float il = wsf[crow(r, hi)];
            f16* op = oa + ((size_t)b * SEQ + P0 + 16 * crow(r, hi)) * 512 + h * 64 + r32;
            op[0] = (f16)(o[0][r] * il); op[32] = (f16)(o[1][r] * il);
        }
    }
    __syncthreads();
}
template <int PH>
__global__ void __launch_bounds__(NTHR, 2) k_phase(Params p) {
    extern __shared__ __attribute__((aligned(16))) unsigned char smem[];
    LAS unsigned char* lds = (LAS unsigned char*)smem;
    const int wg = blockIdx.x, nwg = gridDim.x;
    if (PH == 0) phase_prep(p, lds, wg, nwg);
    if (PH == 1) phase_inproj(p, lds, wg, nwg);
    if (PH == 21) phase_attnA(p, lds, wg, nwg);
    if (PH == 22) phase_attnB(p, lds, wg, nwg);
    if (PH == 3) phase_merge(p, lds, wg, nwg);
    if (PH == 4) phase_outproj(p, lds, wg, nwg);
    if (PH == 5) phase_router(p, lds, wg, nwg);
    if (PH == 7) phase_up(p, lds, wg, nwg);
    if (PH == 8) phase_down(p, lds, wg, nwg);
    if (PH == 9) phase_final(p, lds, wg, nwg);
}
}

#ifndef OPT_INPROJ
#define OPT_INPROJ 1
#endif
#ifndef OPT_MERGE
#define OPT_MERGE 1
#endif
#ifndef OPT_ATTNB
#define OPT_ATTNB 1
#endif
#ifndef OPT_ATTNA
#define OPT_ATTNA 1
#endif
#ifndef OPT_MOE
#define OPT_MOE 1
#endif

template <int PH> static void launch_phase(const Params& p, hipStream_t stream) {
    static bool attr = false;
    if (!attr) { (void)hipFuncSetAttribute((const void*)k_phase<PH>, hipFuncAttributeMaxDynamicSharedMemorySize, LDS_TOTAL); attr = true; }
    hipLaunchKernelGGL(k_phase<PH>, dim3(NWG), dim3(NTHR), LDS_TOTAL, stream, p);
}

extern "C" void kernel_launch(void* const* d_in, const int* in_sizes, int n_in, void* d_out, int out_size, void* d_ws, size_t ws_size,
                              hipStream_t stream) {
    Params p{};
    for (int i = 0; i < 22; ++i) p.in[i] = (const float*)d_in[i];
    p.out = (float*)d_out; p.ws = (unsigned char*)d_ws;
    unsigned char* ws = (unsigned char*)d_ws;
    const float* x = p.in[0];
    f16* proj = (f16*)(ws + WS_PROJ);
    f16* oa = (f16*)(ws + WS_OAB); f16* ob = oa + (size_t)TOK * 512;
    f16* merged = (f16*)(ws + WS_MERGED);
    float* h1 = (float*)(ws + WS_H1);
    float* obp = (float*)(ws + WS_H1);
    f16* mpart = (f16*)(ws + WS_H1);
    f16* x1h = (f16*)(ws + WS_XH);
    f16* act = (f16*)(ws + WS_PROJ);
    f16* ys = (f16*)(ws + WS_YS);
    int* cnt = (int*)(ws + WS_SMALL + SM_CNT);
    int2* list = (int2*)(ws + WS_SMALL + SM_LIST);

    launch_phase<0>(p, stream);
#if OPT_INPROJ
    launch_phase<1>(p, stream);
#else
    g_inproj<<<dim3(INW / 64, TOK / 64), 256, 0, stream>>>(x, p.in[1], p.in[2], proj);
#endif
#if OPT_ATTNA
    launch_phase<21>(p, stream);
#else
    g_mixA<<<dim3(SEQ / 256, 8, NB), 256, 0, stream>>>(proj, oa);
#endif
#if OPT_ATTNB
    launch_phase<22>(p, stream);
#else
    g_mixB<<<dim3(SEQ / 256, 16, NB), 256, 0, stream>>>(proj, obp);
    g_mixB_fin<<<TOK, 256, 0, stream>>>(obp, ob, p.in[3], p.in[4], p.in[5], p.in[6], p.in[7]);
#endif
#if OPT_MERGE
    launch_phase<3>(p, stream);
    launch_phase<4>(p, stream);
#else
    g_merge<0><<<dim3(DM / 64, TOK / 64), 256, 0, stream>>>(oa, p.in[8], proj, nullptr, mpart);
    g_merge<1><<<dim3(DM / 64, TOK / 64), 256, 0, stream>>>(ob, p.in[9], proj, mpart, merged);
    g_outproj<<<dim3(DM / 64, TOK / 64), 256, 0, stream>>>(merged, p.in[10], p.in[11], x, h1);
#endif
    launch_phase<5>(p, stream);
#if OPT_MOE
    launch_phase<7>(p, stream);
    launch_phase<8>(p, stream);
#else
    g_up<<<dim3(DM / 64, MOE_ROWS / 64), 256, 0, stream>>>(x1h, p.in[16], p.in[17], cnt, list, act);
    g_down<<<dim3(DM / 64, MOE_ROWS / 64), 256, 0, stream>>>(act, p.in[18], p.in[19], cnt, list, ys);
#endif
    launch_phase<9>(p, stream);
}
```

```cpp
#include <hip/hip_runtime.h>
#include <hip/hip_cooperative_groups.h>
#include <stdint.h>
#include <stdio.h>

namespace {
constexpr int NB = 8, SEQ = 4096, DM = 1024, TOK = NB * SEQ;
constexpr int INW = 5120;
constexpr int C_QA = 0, C_KA = 512, C_VA = 1024, C_QB = 1536, C_KB = 2048, C_VB = 2560, C_GA = 3072, C_GB = 4096;
constexpr int NEXP = 32, TOPK = 4, NASG = TOK * TOPK;
constexpr float ALPHA = 1.189207115002721f;
constexpr float LAMBDA_INIT = 0.2f;
constexpr float LOG2E = 1.4426950408889634f;
constexpr size_t MiB = 1048576;

__device__ __forceinline__ float sigmoidf_(float x) { return 1.0f / (1.0f + __expf(-x)); }
__device__ __forceinline__ float slope_of(int idx) { return exp2f(-8.0f * (float)(idx + 1) / 12.0f); }
#define LAS __attribute__((address_space(3)))
typedef _Float16 f16;
typedef _Float16 f16x8 __attribute__((ext_vector_type(8)));
typedef _Float16 f16x4 __attribute__((ext_vector_type(4)));
typedef _Float16 f16x2 __attribute__((ext_vector_type(2)));
typedef float f32x4 __attribute__((ext_vector_type(4)));
typedef float f32x16 __attribute__((ext_vector_type(16)));
typedef unsigned u32x4 __attribute__((ext_vector_type(4)));
typedef unsigned u32x2 __attribute__((ext_vector_type(2)));

constexpr int NTHR = 512, NWG = 256;
constexpr int BM = 256, BK = 64, HALF = 128, HTB = HALF * BK * 2, STAGE_BYTES = 8 * HTB;
constexpr int LDS_MISC = STAGE_BYTES;
constexpr int LDS_TOTAL = 155648;
constexpr float QSCALE = 0.125f * 1.4426950408889634f;
constexpr int ROWPAD = 256;
constexpr int MOE_ROWS = NASG + NEXP * ROWPAD;
constexpr int LISTCAP = TOK;

__device__ __forceinline__ unsigned pk2(float a, float b) { f16x2 v; v.x = (f16)a; v.y = (f16)b; return __builtin_bit_cast(unsigned, v); }
__device__ __forceinline__ int lds_byte(int r, int c) { const int st = (r >> 4) * 2 + (c >> 5), rr = r & 15, cc = c & 31, ob = rr * 64 + cc * 2; return st * 1024 + (ob ^ (((ob >> 9) & 1) << 5)); }
__device__ __forceinline__ void stage_rc(int b, int& R, int& C) { const int st = b / 1024, sb = b % 1024, swz = sb ^ (((sb >> 9) & 1) << 5); R = (st >> 1) * 16 + swz / 64; C = (st & 1) * 32 + (swz % 64) / 2; }
__device__ __forceinline__ int perm32(int rho) { const int n = rho >> 4, i = rho & 15; return 8 * (i >> 2) + 4 * n + (i & 3); }

struct Unit { int pm, pn, e, row0, nrows; };

template <int K_>
struct DenseSched {
    static constexpr int K = K_;
    const char* A; const char* Bt; int nM, nN, nwg, G, c;
    __device__ void init(const void* A_, const void* Bt_, int M, int N, int G_, int c_) { A = (const char*)A_; Bt = (const char*)Bt_; nM = M / BM; nN = N / BM; nwg = nM * nN; G = G_; c = c_; }
    __device__ __forceinline__ bool next(int i, Unit& u) const {
        const long L = (long)i * G + c; if (L >= nwg) return false;
        int wgid = (int)L; { const int q = nwg / 8, r = nwg % 8, xcd = wgid % 8, off = wgid / 8; wgid = (xcd < r ? xcd * (q + 1) : r * (q + 1) + (xcd - r) * q) + off; }
        const int nig = 8 * nN, gid = wgid / nig, fm = gid * 8, gsz = (nM - fm) < 8 ? (nM - fm) : 8;
        u.pm = fm + ((wgid % nig) % gsz); u.pn = (wgid % nig) / gsz; u.e = 0; u.row0 = u.pm * BM; u.nrows = BM; return true;
    }
    static __device__ __forceinline__ unsigned make_rc(int R, int C) { return (unsigned)(R * K + C) * 2u; }
    __device__ __forceinline__ void a_desc(const Unit& u, const unsigned (&rc)[2], unsigned (&ad)[2]) const { ad[0] = rc[0] + (unsigned)u.pm * (unsigned)(BM * K * 2); ad[1] = rc[1] + (unsigned)u.pm * (unsigned)(BM * K * 2); }
    static __device__ __forceinline__ unsigned aoff(unsigned ad, unsigned rc, int h) { return ad + (unsigned)h * (unsigned)(HALF * K * 2); }
    __device__ __forceinline__ const char* b_base(const Unit& u) const { return Bt + (size_t)u.pn * BM * K * 2; }
};

template <class Sched, class Epi>
__device__ __forceinline__ void gemm_phase(LAS unsigned char* lds, const Sched& S, const Epi& E) {
    constexpr int K = Sched::K, nt = K / BK;
    int tid = threadIdx.x; asm volatile("" : "+v"(tid));
    const int wid = __builtin_amdgcn_readfirstlane(tid >> 6), lane = tid & 63, wr = wid >> 2, wc = wid & 3, fr = lane & 15, fq = lane >> 4;
    unsigned rc[2], voffB[2];
#pragma unroll
    for (int i = 0; i < 2; ++i) { int R, C; stage_rc(tid * 16 + i * 8192, R, C); const int Rb = Epi::PERM ? ((R & ~31) + perm32(R & 31)) : R; voffB[i] = (unsigned)(Rb * K + C) * 2u; rc[i] = Sched::make_rc(R, C); }
    constexpr unsigned kstep = BK * 2;
    constexpr unsigned hstepB = HALF * K * 2;
    const unsigned ldsw = (unsigned)wid * 1024u;
    const int aoff = lds_byte(wr * 64 + fr, fq * 8), boff = lds_byte(wc * 32 + fr, fq * 8);
#define G_SA(b, h) (((b) * 2 + (h)) * HTB)
#define G_SB(b, h) ((4 + (b) * 2 + (h)) * HTB)
#define G_STAGE_A(bufoff, ad, h, kb) do { \
        __builtin_amdgcn_global_load_lds((const unsigned*)(Abase + (size_t)Sched::aoff((ad)[0], rc[0], h) + (kb)), (LAS unsigned*)(lds + (bufoff) + ldsw), 16, 0, 0); \
        __builtin_amdgcn_global_load_lds((const unsigned*)(Abase + (size_t)Sched::aoff((ad)[1], rc[1], h) + (kb)), (LAS unsigned*)(lds + (bufoff) + ldsw + 8192), 16, 0, 0); } while (0)
#define G_STAGE_B(bufoff, gbase) do { _Pragma("unroll") for (int _i = 0; _i < 2; ++_i) \
        __builtin_amdgcn_global_load_lds((const unsigned*)((const char*)(gbase) + voffB[_i]), (LAS unsigned*)(lds + (bufoff) + ldsw + _i * 8192), 16, 0, 0); } while (0)
#define G_LDA(dst, b, h) do { _Pragma("unroll") for (int m = 0; m < 4; ++m) _Pragma("unroll") for (int k = 0; k < 2; ++k) dst[m][k] = *(const LAS f16x8*)(lds + G_SA(b, h) + aoff + m * 2048 + k * 1024); } while (0)
#define G_LDB(dst, b, h) do { _Pragma("unroll") for (int n = 0; n < 2; ++n) _Pragma("unroll") for (int k = 0; k < 2; ++k) dst[n][k] = *(const LAS f16x8*)(lds + G_SB(b, h) + boff + n * 2048 + k * 1024); } while (0)
#define G_MMA(ai, bj, At, Bt) do { __builtin_amdgcn_s_setprio(1); _Pragma("unroll") for (int m = 0; m < 4; ++m) _Pragma("unroll") for (int n = 0; n < 2; ++n) _Pragma("unroll") for (int k = 0; k < 2; ++k) \
        acc[ai][bj][m][n] = __builtin_amdgcn_mfma_f32_16x16x32_f16(Bt[n][k], At[m][k], acc[ai][bj][m][n], 0, 0, 0); __builtin_amdgcn_s_setprio(0); } while (0)
#define G_WAIT_V(n) asm volatile("s_waitcnt vmcnt(" #n ")" ::: "memory")
#define G_WAIT_L(n) asm volatile("s_waitcnt lgkmcnt(" #n ")" ::: "memory")
#define G_BAR __builtin_amdgcn_s_barrier()
#define G_SCHED __builtin_amdgcn_sched_barrier(0)
    Unit cur, nxt; int ui = 0;
    if (!S.next(0, cur)) return;
    f32x4 acc[2][2][4][2];
#pragma unroll
    for (int a = 0; a < 2; ++a)
#pragma unroll
        for (int b = 0; b < 2; ++b)
#pragma unroll
            for (int m = 0; m < 4; ++m)
#pragma unroll
                for (int n = 0; n < 2; ++n) acc[a][b][m][n] = (f32x4){0.f, 0.f, 0.f, 0.f};
    f16x8 At[4][2], B0[2][2], B1[2][2];
    const char* const Abase = S.A;
    unsigned cad[2], nad[2];
    S.a_desc(cur, rc, cad);
    const char* cB = S.b_base(cur);
    G_STAGE_B(G_SB(0, 0), cB); G_STAGE_A(G_SA(0, 0), cad, 0, 0u); G_STAGE_B(G_SB(0, 1), cB + hstepB); G_STAGE_A(G_SA(0, 1), cad, 1, 0u);
    if (wr == 1) G_BAR;
    G_WAIT_V(4); G_BAR;
    G_STAGE_B(G_SB(1, 0), cB + kstep); G_STAGE_A(G_SA(1, 0), cad, 0, kstep); G_STAGE_B(G_SB(1, 1), cB + hstepB + kstep);
    G_WAIT_V(6); G_BAR;
    for (;;) {
        const bool has_next = S.next(ui + 1, nxt);
        const char* nB = cB;
        if (has_next) { S.a_desc(nxt, rc, nad); nB = S.b_base(nxt); }
        else { nad[0] = cad[0]; nad[1] = cad[1]; }
        for (int t = 0; t < nt; t += 2) {
            const bool last = (t == nt - 2);
            const unsigned k1 = (unsigned)(t + 1) * kstep;
            const unsigned k2 = last ? 0u : (unsigned)(t + 2) * kstep, k3 = k2 + kstep;
            const unsigned a2[2] = {last ? nad[0] : cad[0], last ? nad[1] : cad[1]};
            const char* b2 = (last ? nB : cB) + k2; const char* b3 = b2 + kstep;
            G_LDB(B0, 0, 0); G_SCHED; G_LDA(At, 0, 0); G_STAGE_A(G_SA(1, 1), cad, 1, k1);
            G_WAIT_L(8); G_BAR; G_WAIT_L(0); G_MMA(0, 0, At, B0); G_BAR; G_SCHED;
            G_LDB(B1, 0, 1); G_STAGE_B(G_SB(0, 0), b2);
            G_BAR; G_WAIT_L(0); G_MMA(0, 1, At, B1); G_BAR;
            G_LDA(At, 0, 1); G_STAGE_A(G_SA(0, 0), a2, 0, k2);
            G_BAR; G_WAIT_L(0); G_MMA(1, 0, At, B0); G_BAR; G_SCHED;
            G_STAGE_B(G_SB(0, 1), b2 + hstepB);
            G_WAIT_V(6); G_BAR; G_MMA(1, 1, At, B1); G_BAR;
            G_LDB(B0, 1, 0); G_SCHED; G_LDA(At, 1, 0); G_STAGE_A(G_SA(0, 1), a2, 1, k2);
            G_WAIT_L(8); G_BAR; G_WAIT_L(0); G_MMA(0, 0, At, B0); G_BAR; G_SCHED;
            G_LDB(B1, 1, 1); G_STAGE_B(G_SB(1, 0), b3);
            G_BAR; G_WAIT_L(0); G_MMA(0, 1, At, B1); G_BAR;
            G_LDA(At, 1, 1); G_STAGE_A(G_SA(1, 0), a2, 0, k3);
            G_BAR; G_WAIT_L(0); G_MMA(1, 0, At, B0); G_BAR; G_SCHED;
            G_STAGE_B(G_SB(1, 1), b3 + hstepB);
            G_WAIT_V(6); G_BAR; G_MMA(1, 1, At, B1); G_BAR;
        }
        E(acc, cur, wr, wc, fr, fq);
        if (!has_next) break;
#pragma unroll
        for (int a = 0; a < 2; ++a)
#pragma unroll
            for (int b = 0; b < 2; ++b)
#pragma unroll
                for (int m = 0; m < 4; ++m)
#pragma unroll
                    for (int n = 0; n < 2; ++n) acc[a][b][m][n] = (f32x4){0.f, 0.f, 0.f, 0.f};
        cur = nxt; cB = nB; ++ui; cad[0] = nad[0]; cad[1] = nad[1];
    }
    G_WAIT_V(0);
    if (wr == 0) G_BAR;
    G_BAR;
#undef G_SA
#undef G_SB
#undef G_STAGE_A
#undef G_STAGE_B
#undef G_LDA
#undef G_LDB
#undef G_MMA
#undef G_WAIT_V
#undef G_WAIT_L
#undef G_BAR
#undef G_SCHED
}
constexpr size_t WS_WIN = 0;
constexpr size_t WS_WPA = WS_WIN + (size_t)INW * DM * 2;
constexpr size_t WS_WPB = WS_WPA + (size_t)DM * 512 * 2;
constexpr size_t WS_WOUT = WS_WPB + (size_t)DM * 512 * 2;
constexpr size_t WS_WUP = WS_WOUT + (size_t)DM * DM * 2;
constexpr size_t WS_WDN = WS_WUP + (size_t)NEXP * 2048 * DM * 2;
constexpr size_t WS_XH = WS_WDN + (size_t)NEXP * DM * DM * 2;
constexpr size_t WS_PROJ = WS_XH + (size_t)TOK * DM * 2;
constexpr size_t WS_OAB = WS_PROJ + (size_t)TOK * INW * 2;
constexpr size_t WS_MERGED = WS_OAB + (size_t)TOK * DM * 2;
constexpr size_t WS_H1 = WS_MERGED + (size_t)TOK * DM * 2;
constexpr size_t WS_SMALL = WS_H1 + (size_t)TOK * DM * 4 + 16 * MiB;
constexpr size_t WS_YS = WS_OAB;
constexpr size_t SM_CNT = 0, SM_TK = 16384, SM_LIST = SM_TK + (size_t)NASG * 4;
constexpr size_t WS_END = WS_SMALL + SM_LIST + (size_t)NEXP * LISTCAP * 8;
static_assert(WS_YS + (size_t)MOE_ROWS * DM * 2 <= WS_SMALL, "ys overlaps bookkeeping");
static_assert((size_t)MOE_ROWS * DM * 2 <= (size_t)TOK * INW * 2, "act does not fit over proj");
static_assert(WS_END <= 1024 * MiB, "workspace");

struct Params {
    const float* in[22]; float* out; unsigned char* ws;
};

__device__ __forceinline__ void prep_tile(const float* __restrict__ src, int ldsrc, int srccol0, int k0, f16* __restrict__ dst, int K, int n0, LAS float* tile) {
    int tid = threadIdx.x; asm volatile("" : "+v"(tid));
#pragma unroll
    for (int j = 0; j < 2; ++j) {
        const int idx = tid + j * NTHR, k = idx >> 4, n4 = (idx & 15) * 4;
        const float4 v = *(const float4*)(src + (size_t)(k0 + k) * ldsrc + srccol0 + n4);
        tile[k * 65 + n4 + 0] = v.x; tile[k * 65 + n4 + 1] = v.y; tile[k * 65 + n4 + 2] = v.z; tile[k * 65 + n4 + 3] = v.w;
    }
    __syncthreads();
    {
        const int n = tid >> 3, kc = (tid & 7) * 8;
        u32x4 w;
        w.x = pk2(tile[(kc + 0) * 65 + n], tile[(kc + 1) * 65 + n]); w.y = pk2(tile[(kc + 2) * 65 + n], tile[(kc + 3) * 65 + n]);
        w.z = pk2(tile[(kc + 4) * 65 + n], tile[(kc + 5) * 65 + n]); w.w = pk2(tile[(kc + 6) * 65 + n], tile[(kc + 7) * 65 + n]);
        *(u32x4*)(dst + (size_t)(n0 + n) * K + k0 + kc) = w;
    }
    __syncthreads();
}
__device__ __forceinline__ void phase_prep(const Params& p, LAS unsigned char* lds, int wg, int nwg) {
    unsigned char* ws = p.ws;
    {
        const float4* src = (const float4*)p.in[0]; u32x4* dst = (u32x4*)(ws + WS_XH);
        const size_t n8 = (size_t)TOK * DM / 8;
        for (size_t i = (size_t)wg * NTHR + threadIdx.x; i < n8; i += (size_t)nwg * NTHR) {
            const float4 a = src[2 * i], b = src[2 * i + 1];
            u32x4 w; w.x = pk2(a.x, a.y); w.y = pk2(a.z, a.w); w.z = pk2(b.x, b.y); w.w = pk2(b.z, b.w);
            dst[i] = w;
        }
    }
    if (wg == 0 && threadIdx.x < 64) ((int*)(ws + WS_SMALL + SM_CNT))[threadIdx.x] = 0;
    LAS float* tile = (LAS float*)lds;
    constexpr int T_IN = (INW / 64) * (DM / 64), T_PA = (DM / 64) * (512 / 64), T_OUT = (DM / 64) * (DM / 64);
    constexpr int T_UP1 = (2048 / 64) * (DM / 64), T_DN1 = (DM / 64) * (DM / 64);
    constexpr int T0 = T_IN, T1 = T0 + T_PA, T2 = T1 + T_PA, T3 = T2 + T_OUT, T4 = T3 + NEXP * T_UP1, T5 = T4 + NEXP * T_DN1;
    for (int t = wg; t < T5; t += nwg) {
        if (t < T0) { const int tn = t / 16, tk = t % 16; prep_tile(p.in[1], INW, tn * 64, tk * 64, (f16*)(ws + WS_WIN), DM, tn * 64, tile); }
        else if (t < T1) { const int q = t - T0, tn = q / 8, tk = q % 8; prep_tile(p.in[8], DM, tn * 64, tk * 64, (f16*)(ws + WS_WPA), 512, tn * 64, tile); }
        else if (t < T2) { const int q = t - T1, tn = q / 8, tk = q % 8; prep_tile(p.in[9], DM, tn * 64, tk * 64, (f16*)(ws + WS_WPB), 512, tn * 64, tile); }
        else if (t < T3) { const int q = t - T2, tn = q / 16, tk = q % 16; prep_tile(p.in[10], DM, tn * 64, tk * 64, (f16*)(ws + WS_WOUT), DM, tn * 64, tile); }
        else if (t < T4) { const int q = t - T3, e = q / T_UP1, r = q % T_UP1, tn = r / 16, tk = r % 16;
            const int np = tn * 64, pn = np >> 8, j = np & 255;
            const int sc = j < 128 ? pn * 128 + j : 1024 + pn * 128 + (j - 128);
            prep_tile(p.in[16] + (size_t)e * DM * 2048, 2048, sc, tk * 64, (f16*)(ws + WS_WUP) + (size_t)e * 2048 * DM, DM, np, tile); }
        else { const int q = t - T4, e = q / T_DN1, r = q % T_DN1, tn = r / 16, tk = r % 16;
            prep_tile(p.in[18] + (size_t)e * DM * DM, DM, tn * 64, tk * 64, (f16*)(ws + WS_WDN) + (size_t)e * DM * DM, DM, tn * 64, tile); }
    }
}

struct EpiInProj {
    static constexpr bool PERM = true;
    f16* O; const float* bias;
    __device__ __forceinline__ void operator()(const f32x4 (&acc)[2][2][4][2], const Unit& u, int wr, int wc, int fr, int fq) const {
        const int row0 = u.pm * BM + wr * 64 + fr, col0 = u.pn * BM + wc * 32 + 8 * fq;
        const int cls = u.pn;
        const float scl = (cls < 2 || cls == 6 || cls == 7) ? QSCALE : 1.0f;
        const bool sig = cls >= 12;
        f32x4 bv[2][2];
#pragma unroll
        for (int bj = 0; bj < 2; ++bj)
#pragma unroll
            for (int n = 0; n < 2; ++n) bv[bj][n] = *(const f32x4*)(bias + col0 + bj * HALF + 4 * n);
#pragma unroll
        for (int ai = 0; ai < 2; ++ai)
#pragma unroll
            for (int m = 0; m < 4; ++m) {
                f16* rowp = O + (size_t)(row0 + ai * HALF + m * 16) * INW + col0;
#pragma unroll
                for (int bj = 0; bj < 2; ++bj) {
                    f32x4 v0 = acc[ai][bj][m][0] + bv[bj][0], v1 = acc[ai][bj][m][1] + bv[bj][1];
                    if (sig) {
#pragma unroll
                        for (int j = 0; j < 4; ++j) { v0[j] = __builtin_amdgcn_rcpf(1.0f + __expf(-v0[j])); v1[j] = __builtin_amdgcn_rcpf(1.0f + __expf(-v1[j])); }
                    } else { v0 *= scl; v1 *= scl; }
                    u32x4 w; w.x = pk2(v0[0], v0[1]); w.y = pk2(v0[2], v0[3]); w.z = pk2(v1[0], v1[1]); w.w = pk2(v1[2], v1[3]);
                    *(u32x4*)(rowp + bj * HALF) = w;
                }
            }
    }
};
__device__ __forceinline__ void phase_inproj(const Params& p, LAS unsigned char* lds, int wg, int nwg) {
    DenseSched<DM> S; S.init(p.ws + WS_XH, p.ws + WS_WIN, TOK, INW, nwg, wg);
    EpiInProj E{(f16*)(p.ws + WS_PROJ), p.in[2]};
    gemm_phase(lds, S, E);
}
constexpr int RT_LOG = 131072, RT_HIST = RT_LOG + 16384;
__device__ __forceinline__ void phase_router(const Params& p, LAS unsigned char* lds, int wg, int nwg) {
    int tid = threadIdx.x; asm volatile("" : "+v"(tid));
    const int lane = tid & 63, wave = tid >> 6;
    const float* h1 = (const float*)(p.ws + WS_H1);
    f16* x1h = (f16*)(p.ws + WS_XH);
    const float* lng = p.in[12]; const float* lnb = p.in[13];
    const float* wr = p.in[14]; const float* br = p.in[15];
    int* cnt = (int*)(p.ws + WS_SMALL + SM_CNT);
    int* tk = (int*)(p.ws + WS_SMALL + SM_TK);
    int2* list = (int2*)(p.ws + WS_SMALL + SM_LIST);
    LAS float* wl = (LAS float*)lds;
    LAS float* slog = (LAS float*)(lds + RT_LOG);
    LAS int* hist = (LAS int*)(lds + RT_HIST);
    LAS int* hbase = hist + 32;
    for (int i = tid; i < DM * 8; i += NTHR) {
        const int col = i >> 3, k = i & 7;
        const float4 v = *(const float4*)(wr + (size_t)col * NEXP + k * 4);
        LAS float* d = wl + col * 32 + ((k ^ ((col >> 1) & 7)) << 2);
        d[0] = v.x; d[1] = v.y; d[2] = v.z; d[3] = v.w;
    }
    if (tid < 32) hist[tid] = 0;
    __syncthreads();
    const int tpw = TOK / (nwg * 8);
    const int tok0 = wg * (TOK / nwg) + wave * tpw;
    float gam[16], bet[16];
#pragma unroll
    for (int r = 0; r < 16; ++r) { gam[r] = lng[r * 64 + lane]; bet[r] = lnb[r * 64 + lane]; }
    for (int j = 0; j < tpw; ++j) {
        const int t = tok0 + j;
        float x[16]; float s = 0.f;
#pragma unroll
        for (int r = 0; r < 16; ++r) { x[r] = h1[(size_t)t * DM + r * 64 + lane]; s += x[r]; }
        for (int o = 32; o >= 1; o >>= 1) s += __shfl_xor(s, o);
        const float mu = s * (1.0f / DM);
        float q = 0.f;
#pragma unroll
        for (int r = 0; r < 16; ++r) { const float d = x[r] - mu; q += d * d; }
        for (int o = 32; o >= 1; o >>= 1) q += __shfl_xor(q, o);
        const float rs = rsqrtf(q * (1.0f / DM) + 1e-5f);
#pragma unroll
        for (int r = 0; r < 16; ++r) { x[r] = (x[r] - mu) * rs * gam[r] + bet[r]; x1h[(size_t)t * DM + r * 64 + lane] = (f16)x[r]; }
        float acc[32];
#pragma unroll
        for (int e = 0; e < 32; ++e) acc[e] = 0.f;
#pragma unroll
        for (int r = 0; r < 16; ++r) {
            const int col = r * 64 + lane;
            const LAS float* wrow = wl + col * 32;
            const int sw = (col >> 1) & 7;
#pragma unroll
            for (int k = 0; k < 8; ++k) {
                const f32x4 w4 = *(const LAS f32x4*)(wrow + ((k ^ sw) << 2));
#pragma unroll
                for (int c = 0; c < 4; ++c) acc[k * 4 + c] = fmaf(x[r], w4[c], acc[k * 4 + c]);
            }
        }
        float a16[16], a8[8], a4[4], a2[2], a1;
        { const bool hi = (lane & 32) != 0;
#pragma unroll
          for (int k = 0; k < 16; ++k) { const float snd = hi ? acc[k] : acc[16 + k]; const float rcv = __shfl_xor(snd, 32); a16[k] = (hi ? acc[16 + k] : acc[k]) + rcv; } }
        { const bool hi = (lane & 16) != 0;
#pragma unroll
          for (int k = 0; k < 8; ++k) { const float snd = hi ? a16[k] : a16[8 + k]; const float rcv = __shfl_xor(snd, 16); a8[k] = (hi ? a16[8 + k] : a16[k]) + rcv; } }
        { const bool hi = (lane & 8) != 0;
#pragma unroll
          for (int k = 0; k < 4; ++k) { const float snd = hi ? a8[k] : a8[4 + k]; const float rcv = __shfl_xor(snd, 8); a4[k] = (hi ? a8[4 + k] : a8[k]) + rcv; } }
        { const bool hi = (lane & 4) != 0;
#pragma unroll
          for (int k = 0; k < 2; ++k) { const float snd = hi ? a4[k] : a4[2 + k]; const float rcv = __shfl_xor(snd, 4); a2[k] = (hi ? a4[2 + k] : a4[k]) + rcv; } }
        { const bool hi = (lane & 2) != 0; const float snd = hi ? a2[0] : a2[1]; const float rcv = __shfl_xor(snd, 2); a1 = (hi ? a2[1] : a2[0]) + rcv; }
        a1 += __shfl_xor(a1, 1);
        if ((lane & 1) == 0) slog[(wave * tpw + j) * 32 + (lane >> 1)] = a1 + br[lane >> 1];
    }
    __syncthreads();
    int my_e[4]; float my_g[4]; int my_loc[4];
    const bool act = lane < tpw;
    const int tl = wave * tpw + lane;
    if (act) {
        float v[32];
#pragma unroll
        for (int k = 0; k < 8; ++k) { const f32x4 t4 = *(const LAS f32x4*)(slog + tl * 32 + k * 4); v[k * 4] = t4[0]; v[k * 4 + 1] = t4[1]; v[k * 4 + 2] = t4[2]; v[k * 4 + 3] = t4[3]; }
        float tv[4];
#pragma unroll
        for (int k = 0; k < 4; ++k) {
            float bv = -3.0e38f; int bi = 0;
#pragma unroll
            for (int e = 0; e < 32; ++e) { if (v[e] > bv) { bv = v[e]; bi = e; } }
            tv[k] = bv; my_e[k] = bi;
#pragma unroll
            for (int e = 0; e < 32; ++e) v[e] = (e == bi) ? -3.0e38f : v[e];
        }
        const float e1 = __expf(tv[1] - tv[0]), e2 = __expf(tv[2] - tv[0]), e3 = __expf(tv[3] - tv[0]);
        const float inv = 1.0f / (1.0f + e1 + e2 + e3);
        my_g[0] = inv; my_g[1] = e1 * inv; my_g[2] = e2 * inv; my_g[3] = e3 * inv;
#pragma unroll
        for (int k = 0; k < 4; ++k) my_loc[k] = __hip_atomic_fetch_add(hist + my_e[k], 1, __ATOMIC_RELAXED, __HIP_MEMORY_SCOPE_WORKGROUP);
    }
    __syncthreads();
    if (tid < 32) hbase[tid] = atomicAdd(&cnt[tid], hist[tid]);
    __syncthreads();
    if (act) {
        const int t = tok0 + lane;
#pragma unroll
        for (int k = 0; k < 4; ++k) {
            const int slot = hbase[my_e[k]] + my_loc[k];
            tk[t * 4 + k] = (my_e[k] << 20) | slot;
            list[(size_t)my_e[k] * LISTCAP + slot] = make_int2(t, __float_as_int(my_g[k]));
        }
    }
    __syncthreads();
}

__device__ __forceinline__ void phase_final(const Params& p, LAS unsigned char* lds, int wg, int nwg) {
    int tid = threadIdx.x; asm volatile("" : "+v"(tid));
    const int lane = tid & 63, wave = tid >> 6;
    const f16* x1h = (const f16*)(p.ws + WS_XH);
    const f16* ys = (const f16*)(p.ws + WS_YS);
    const int* cnt = (const int*)(p.ws + WS_SMALL + SM_CNT);
    const int* tk = (const int*)(p.ws + WS_SMALL + SM_TK);
    const float* lng = p.in[20]; const float* lnb = p.in[21];
    LAS int* ps = (LAS int*)lds;
    if (tid == 0) { int a = 0; for (int e = 0; e < NEXP; ++e) { ps[e] = a; a += (cnt[e] + ROWPAD - 1) / ROWPAD * ROWPAD; } }
    __syncthreads();
    const int tpw = TOK / (nwg * 8);
    const int tok0 = wg * (TOK / nwg) + wave * tpw;
    for (int j = 0; j < tpw; ++j) {
        const int t = tok0 + j;
        float v[16];
        { const f16x8 a = *(const f16x8*)(x1h + (size_t)t * DM + 8 * lane), b = *(const f16x8*)(x1h + (size_t)t * DM + 512 + 8 * lane);
#pragma unroll
          for (int i = 0; i < 8; ++i) { v[i] = ALPHA * (float)a[i]; v[8 + i] = ALPHA * (float)b[i]; } }
#pragma unroll
        for (int k = 0; k < 4; ++k) {
            const int c = tk[t * 4 + k]; const int row = ps[c >> 20] + (c & 0xFFFFF);
            const f16x8 a = *(const f16x8*)(ys + (size_t)row * DM + 8 * lane), b = *(const f16x8*)(ys + (size_t)row * DM + 512 + 8 * lane);
#pragma unroll
            for (int i = 0; i < 8; ++i) { v[i] += (float)a[i]; v[8 + i] += (float)b[i]; }
        }
        float s = 0.f;
#pragma unroll
        for (int i = 0; i < 16; ++i) s += v[i];
        for (int o = 32; o >= 1; o >>= 1) s += __shfl_xor(s, o);
        const float mu = s * (1.0f / DM);
        float q = 0.f;
#pragma unroll
        for (int i = 0; i < 16; ++i) { const float d = v[i] - mu; q += d * d; }
        for (int o = 32; o >= 1; o >>= 1) q += __shfl_xor(q, o);
        const float rs = rsqrtf(q * (1.0f / DM) + 1e-5f);
        float* op = p.out + (size_t)t * DM;
#pragma unroll
        for (int hh = 0; hh < 2; ++hh) {
            const int c0 = hh * 512 + 8 * lane;
            const float4 g0 = *(const float4*)(lng + c0), g1 = *(const float4*)(lng + c0 + 4), b0 = *(const float4*)(lnb + c0), b1 = *(const float4*)(lnb + c0 + 4);
            float4 o0, o1;
            o0.x = (v[hh * 8 + 0] - mu) * rs * g0.x + b0.x; o0.y = (v[hh * 8 + 1] - mu) * rs * g0.y + b0.y; o0.z = (v[hh * 8 + 2] - mu) * rs * g0.z + b0.z; o0.w = (v[hh * 8 + 3] - mu) * rs * g0.w + b0.w;
            o1.x = (v[hh * 8 + 4] - mu) * rs * g1.x + b1.x; o1.y = (v[hh * 8 + 5] - mu) * rs * g1.y + b1.y; o1.z = (v[hh * 8 + 6] - mu) * rs * g1.z + b1.z; o1.w = (v[hh * 8 + 7] - mu) * rs * g1.w + b1.w;
            *(float4*)(op + c0) = o0; *(float4*)(op + c0 + 4) = o1;
        }
    }
    __syncthreads();
}
struct MergeSched {
    static constexpr int K = 512;
    const char* A; const char* Bt; DenseSched<512> D;
    __device__ void init(const void* oa, const void* wpa_t, int G, int c) { A = (const char*)oa; Bt = (const char*)wpa_t; D.init(oa, wpa_t, TOK, DM, G, c); }
    __device__ __forceinline__ bool next(int i, Unit& u) const { if (!D.next(i >> 1, u)) return false; u.e = i & 1; return true; }
    static __device__ __forceinline__ unsigned make_rc(int R, int C) { return (unsigned)(R * K + C) * 2u; }
    __device__ __forceinline__ void a_desc(const Unit& u, const unsigned (&rc)[2], unsigned (&ad)[2]) const {
        const unsigned o = (unsigned)u.pm * (unsigned)(BM * K * 2) + (unsigned)u.e * (unsigned)(TOK * 512 * 2); ad[0] = rc[0] + o; ad[1] = rc[1] + o; }
    static __device__ __forceinline__ unsigned aoff(unsigned ad, unsigned rc, int h) { return ad + (unsigned)h * (unsigned)(HALF * K * 2); }
    __device__ __forceinline__ const char* b_base(const Unit& u) const { return Bt + (size_t)u.e * DM * 512 * 2 + (size_t)u.pn * BM * K * 2; }
};
struct EpiMerge {
    static constexpr bool PERM = true;
    const f16* proj; f16* mpart; f16* merged;
    __device__ __forceinline__ void operator()(const f32x4 (&acc)[2][2][4][2], const Unit& u, int wr, int wc, int fr, int fq) const {
        const int row0 = u.pm * BM + wr * 64 + fr, col0 = u.pn * BM + wc * 32 + 8 * fq;
        const int gcol = (u.e == 0 ? C_GA : C_GB) + col0;
#pragma unroll
        for (int ai = 0; ai < 2; ++ai)
#pragma unroll
            for (int m = 0; m < 4; ++m) {
                const size_t row = (size_t)(row0 + ai * HALF + m * 16);
#pragma unroll
                for (int bj = 0; bj < 2; ++bj) {
                    const f16x8 g = *(const f16x8*)(proj + row * INW + gcol + bj * HALF);
                    float v[8];
#pragma unroll
                    for (int j = 0; j < 4; ++j) { v[j] = (float)g[j] * acc[ai][bj][m][0][j]; v[4 + j] = (float)g[4 + j] * acc[ai][bj][m][1][j]; }
                    if (u.e == 1) {
                        const f16x8 q = *(const f16x8*)(mpart + row * DM + col0 + bj * HALF);
#pragma unroll
                        for (int j = 0; j < 8; ++j) v[j] += (float)q[j];
                    }
                    u32x4 w; w.x = pk2(v[0], v[1]); w.y = pk2(v[2], v[3]); w.z = pk2(v[4], v[5]); w.w = pk2(v[6], v[7]);
                    *(u32x4*)((u.e == 0 ? mpart : merged) + row * DM + col0 + bj * HALF) = w;
                }
            }
    }
};
__device__ __forceinline__ void phase_merge(const Params& p, LAS unsigned char* lds, int wg, int nwg) {
    MergeSched S; S.init(p.ws + WS_OAB, p.ws + WS_WPA, nwg, wg);
    EpiMerge E{(const f16*)(p.ws + WS_PROJ), (f16*)(p.ws + WS_H1), (f16*)(p.ws + WS_MERGED)};
    gemm_phase(lds, S, E);
}
struct EpiOutProj {
    static constexpr bool PERM = false;
    const float* x; const float* bias; float* h1;
    __device__ __forceinline__ void operator()(const f32x4 (&acc)[2][2][4][2], const Unit& u, int wr, int wc, int fr, int fq) const {
        const int row0 = u.pm * BM + wr * 64 + fr, col0 = u.pn * BM + wc * 32 + 4 * fq;
        f32x4 bv[2][2];
#pragma unroll
        for (int bj = 0; bj < 2; ++bj)
#pragma unroll
            for (int n = 0; n < 2; ++n) bv[bj][n] = *(const f32x4*)(bias + col0 + bj * HALF + n * 16);
#pragma unroll
        for (int ai = 0; ai < 2; ++ai)
#pragma unroll
            for (int m = 0; m < 4; ++m) {
                const size_t off = (size_t)(row0 + ai * HALF + m * 16) * DM + col0;
#pragma unroll
                for (int bj = 0; bj < 2; ++bj)
#pragma unroll
                    for (int n = 0; n < 2; ++n) {
                        const f32x4 xv = *(const f32x4*)(x + off + bj * HALF + n * 16);
                        *(f32x4*)(h1 + off + bj * HALF + n * 16) = ALPHA * xv + acc[ai][bj][m][n] + bv[bj][n];
                    }
            }
    }
};
__device__ __forceinline__ void phase_outproj(const Params& p, LAS unsigned char* lds, int wg, int nwg) {
    DenseSched<DM> S; S.init(p.ws + WS_MERGED, p.ws + WS_WOUT, TOK, DM, nwg, wg);
    EpiOutProj E{p.in[0], p.in[11], (float*)(p.ws + WS_H1)};
    gemm_phase(lds, S, E);
}

constexpr int MOE_MISC = STAGE_BYTES;
__device__ __forceinline__ void moe_prefix(const Params& p, LAS unsigned char* lds) {
    LAS int* tpre = (LAS int*)(lds + MOE_MISC); LAS int* ecnt = tpre + 64;
    const int* cnt = (const int*)(p.ws + WS_SMALL + SM_CNT);
    if (threadIdx.x == 0) { int a = 0; for (int e = 0; e < NEXP; ++e) { const int c = cnt[e]; ecnt[e] = c; tpre[e] = a; a += (c + ROWPAD - 1) / ROWPAD; } tpre[NEXP] = a; }
    __syncthreads();
}
template <int NPN, bool GATHER>
struct MoeSched {
    static constexpr int K = DM;
    const char* A; const char* Bt; const int2* list; LAS int* tpre; LAS int* ecnt; int c;
    __device__ __forceinline__ bool next(int i, Unit& u) const {
        constexpr int MPR = 256 / NPN, MPX = 32 / NPN;
        const int xcd = c & 7, j = c >> 3;
        const int M = i * MPR + xcd * MPX + j / NPN;
        if (M >= tpre[NEXP]) return false;
        int e = 0;
        for (int k = 1; k < NEXP; ++k) e += (tpre[k] <= M) ? 1 : 0;
        u.e = e; u.pm = M - tpre[e]; u.pn = j % NPN; u.row0 = M * ROWPAD; u.nrows = ecnt[e] - u.pm * ROWPAD;
        return true;
    }
    static __device__ __forceinline__ unsigned make_rc(int R, int C) { return GATHER ? ((unsigned)R | ((unsigned)(2 * C) << 8)) : (unsigned)(R * K + C) * 2u; }
    __device__ __forceinline__ void a_desc(const Unit& u, const unsigned (&rc)[2], unsigned (&ad)[2]) const {
        if (GATHER) {
#pragma unroll
            for (int i = 0; i < 2; ++i) {
                const int R = (int)(rc[i] & 0xFFu);
                const int2* lp = list + (size_t)u.e * LISTCAP + u.pm * ROWPAD + R;
                int t0 = lp[0].x, t1 = lp[HALF].x;
                t0 = R < u.nrows ? t0 : 0; t1 = (R + HALF) < u.nrows ? t1 : 0;
                ad[i] = (unsigned)t0 | ((unsigned)t1 << 16);
            }
            asm volatile("" : "+v"(ad[0]), "+v"(ad[1]));
        } else { ad[0] = rc[0] + (unsigned)u.row0 * (unsigned)(K * 2); ad[1] = rc[1] + (unsigned)u.row0 * (unsigned)(K * 2); }
    }
    static __device__ __forceinline__ unsigned aoff(unsigned ad, unsigned rc, int h) {
        return GATHER ? (((ad >> (16 * h)) & 0xFFFFu) * (unsigned)(K * 2) + (rc >> 8)) : (ad + (unsigned)h * (unsigned)(HALF * K * 2)); }
    __device__ __forceinline__ const char* b_base(const Unit& u) const { return Bt + ((size_t)u.e * (NPN * BM) + (size_t)u.pn * BM) * K * 2; }
};
struct EpiUp {
    static constexpr bool PERM = true;
    const float* bup; f16* act;
    __device__ __forceinline__ void operator()(const f32x4 (&acc)[2][2][4][2], const Unit& u, int wr, int wc, int fr, int fq) const {
        const int col0 = u.pn * HALF + wc * 32 + 8 * fq;
        const float* bg = bup + (size_t)u.e * 2048 + col0; const float* bu = bg + 1024;
        const f32x4 bg0 = *(const f32x4*)bg, bg1 = *(const f32x4*)(bg + 4), bu0 = *(const f32x4*)bu, bu1 = *(const f32x4*)(bu + 4);
#pragma unroll
        for (int ai = 0; ai < 2; ++ai)
#pragma unroll
            for (int m = 0; m < 4; ++m) {
                const size_t row = (size_t)(u.row0 + ai * HALF + wr * 64 + m * 16 + fr);
                float v[8];
#pragma unroll
                for (int n = 0; n < 2; ++n)
#pragma unroll
                    for (int j = 0; j < 4; ++j) {
                        const float hg = acc[ai][0][m][n][j] + (n == 0 ? bg0[j] : bg1[j]), hu = acc[ai][1][m][n][j] + (n == 0 ? bu0[j] : bu1[j]);
                        const float gate = fminf(hg, 7.0f), up = fminf(fmaxf(hu, -7.0f), 7.0f);
                        v[n * 4 + j] = gate * __builtin_amdgcn_rcpf(1.0f + __expf(-1.702f * gate)) * (up + 1.0f);
                    }
                u32x4 w; w.x = pk2(v[0], v[1]); w.y = pk2(v[2], v[3]); w.z = pk2(v[4], v[5]); w.w = pk2(v[6], v[7]);
                *(u32x4*)(act + row * DM + col0) = w;
            }
    }
};
struct EpiDown {
    static constexpr bool PERM = true;
    const float* bdn; const int2* list; f16* ys;
    __device__ __forceinline__ void operator()(const f32x4 (&acc)[2][2][4][2], const Unit& u, int wr, int wc, int fr, int fq) const {
        const int col0 = u.pn * BM + wc * 32 + 8 * fq;
        f32x4 bv[2][2];
#pragma unroll
        for (int bj = 0; bj < 2; ++bj)
#pragma unroll
            for (int n = 0; n < 2; ++n) bv[bj][n] = *(const f32x4*)(bdn + (size_t)u.e * DM + col0 + bj * HALF + 4 * n);
#pragma unroll
        for (int ai = 0; ai < 2; ++ai)
#pragma unroll
            for (int m = 0; m < 4; ++m) {
                const int lr = ai * HALF + wr * 64 + m * 16 + fr;
                float wgt = __int_as_float(list[(size_t)u.e * LISTCAP + u.pm * ROWPAD + lr].y); wgt = lr < u.nrows ? wgt : 0.f;
                f16* rowp = ys + (size_t)(u.row0 + lr) * DM + col0;
#pragma unroll
                for (int bj = 0; bj < 2; ++bj) {
                    const f32x4 v0 = (acc[ai][bj][m][0] + bv[bj][0]) * wgt, v1 = (acc[ai][bj][m][1] + bv[bj][1]) * wgt;
                    u32x4 w; w.x = pk2(v0[0], v0[1]); w.y = pk2(v0[2], v0[3]); w.z = pk2(v1[0], v1[1]); w.w = pk2(v1[2], v1[3]);
                    *(u32x4*)(rowp + bj * HALF) = w;
                }
            }
    }
};
__device__ __forceinline__ void phase_up(const Params& p, LAS unsigned char* lds, int wg, int nwg) {
    moe_prefix(p, lds);
    MoeSched<8, true> S{(const char*)(p.ws + WS_XH), (const char*)(p.ws + WS_WUP), (const int2*)(p.ws + WS_SMALL + SM_LIST), (LAS int*)(lds + MOE_MISC), (LAS int*)(lds + MOE_MISC) + 64, wg};
    EpiUp E{p.in[17], (f16*)(p.ws + WS_PROJ)};
    gemm_phase(lds, S, E);
}
__device__ __forceinline__ void phase_down(const Params& p, LAS unsigned char* lds, int wg, int nwg) {
    moe_prefix(p, lds);
    MoeSched<4, false> S{(const char*)(p.ws + WS_PROJ), (const char*)(p.ws + WS_WDN), (const int2*)(p.ws + WS_SMALL + SM_LIST), (LAS int*)(lds + MOE_MISC), (LAS int*)(lds + MOE_MISC) + 64, wg};
    EpiDown E{p.in[19], (const int2*)(p.ws + WS_SMALL + SM_LIST), (f16*)(p.ws + WS_YS)};
    gemm_phase(lds, S, E);
}
__device__ __forceinline__ float lambda_full(const float* lq1, const float* lk1, const float* lq2, const float* lk2, int lane) {
    float a = lq1[lane] * lk1[lane], c = lq2[lane] * lk2[lane];
    for (int o = 32; o >= 1; o >>= 1) { a += __shfl_xor(a, o); c += __shfl_xor(c, o); }
    return __expf(a) - __expf(c) + LAMBDA_INIT;
}
typedef short s16x4 __attribute__((ext_vector_type(4)));
__device__ __forceinline__ int crow(int r, int hi) { return (r & 3) + 8 * (r >> 2) + 4 * hi; }
__device__ __forceinline__ f16x4 vtr(const LAS unsigned char* p) { return __builtin_bit_cast(f16x4, __builtin_amdgcn_ds_read_tr16_b64_v4i16((LAS s16x4*)p)); }
#define MFMA32(a, b, c) __builtin_amdgcn_mfma_f32_32x32x16_f16(a, b, c, 0, 0, 0)
__device__ __forceinline__ float rowmax32(const f32x16& p0, const f32x16& p1) {
    float a = fmaxf(fmaxf(p0[0], p0[1]), p1[0]), b = fmaxf(fmaxf(p0[2], p0[3]), p1[1]); a = fmaxf(fmaxf(a, p1[2]), p1[3]);
#pragma unroll
    for (int r = 4; r < 16; r += 4) { a = fmaxf(fmaxf(a, p0[r]), p0[r + 1]); b = fmaxf(fmaxf(b, p0[r + 2]), p0[r + 3]); a = fmaxf(fmaxf(a, p1[r]), p1[r + 1]); b = fmaxf(fmaxf(b, p1[r + 2]), p1[r + 3]); }
    float m = fmaxf(a, b); auto rr = __builtin_amdgcn_permlane32_swap(__float_as_uint(m), __float_as_uint(m), false, false);
    return fmaxf(__uint_as_float(rr[0]), __uint_as_float(rr[1]));
}
__device__ __forceinline__ float half_sum(float v) { auto rr = __builtin_amdgcn_permlane32_swap(__float_as_uint(v), __float_as_uint(v), false, false); return __uint_as_float(rr[0]) + __uint_as_float(rr[1]); }

constexpr int AB_QSTR = 4160;
constexpr int AB_STG = 16384 + 4 * AB_QSTR;
constexpr int AB_STGS = 33280;
constexpr int AB_WSF = 131072;
constexpr float AB_THR = 8.0f;

__device__ __forceinline__ void phase_attnB(const Params& p, LAS unsigned char* lds, int wg, int nwg) {
    int tid = threadIdx.x; asm volatile("" : "+v"(tid));
    const int lane = tid & 63, r32 = lane & 31, hi = lane >> 5;
    const int wave = __builtin_amdgcn_readfirstlane(tid >> 6), map = wave >> 2, qsub = wave & 3;
    const f16* proj = (const f16*)(p.ws + WS_PROJ);
    f16* ob = (f16*)(p.ws + WS_OAB) + (size_t)TOK * 512;
    const float lam = lambda_full(p.in[3], p.in[4], p.in[5], p.in[6], lane);
    const float* subg = p.in[7];
    LAS float* wsf = (LAS float*)(lds + AB_WSF) + wave * 32;
    const int ksw = (r32 >> 1) & 7;
    int koff[4];
#pragma unroll
    for (int d0 = 0; d0 < 4; ++d0) koff[d0] = r32 * 128 + (((2 * d0 + hi) ^ ksw) << 4);
    const int vl = ((lane >> 4) & 1) * 32 + (lane & 3) * 8 + (4 * hi + ((lane & 15) >> 2)) * 64;
    const int krow = tid >> 3, kch = tid & 7;
    const int kw_off = krow * 128 + ((kch ^ ((krow >> 1) & 7)) << 4);
    int vrow[2], vc16[2], vw_off[2];
#pragma unroll
    for (int j = 0; j < 2; ++j) { const int idx = tid + j * NTHR; vrow[j] = idx >> 4; vc16[j] = idx & 15; vw_off[j] = (vc16[j] >> 2) * AB_QSTR + vrow[j] * 64 + (vc16[j] & 3) * 16; }

    for (int ui = 0; ui < 4; ++ui) {
        const int bh = 8 * ui + (wg & 7), qb = wg >> 3;
        const int b = bh >> 2, h = bh & 3;
        const float sl2 = slope_of(3 * h + 2) * LOG2E;
        const f16* base = proj + (size_t)b * SEQ * INW;
        const int q0 = qb * 128 + qsub * 32, qpos = q0 + r32;
        f16x8 qr[4];
#pragma unroll
        for (int d0 = 0; d0 < 4; ++d0) qr[d0] = *(const f16x8*)(base + (size_t)qpos * INW + C_QB + h * 128 + map * 64 + 16 * d0 + 8 * hi);
        const f16* gk1 = base + (size_t)krow * INW + C_KB + h * 128 + kch * 8;
        const f16* gv0 = base + (size_t)vrow[0] * INW + C_VB + h * 128 + vc16[0] * 8;
        const f16* gv1 = base + (size_t)vrow[1] * INW + C_VB + h * 128 + vc16[1] * 8;
        u32x4 g0, g1, g2, g3;
        g0 = *(const u32x4*)gk1; g1 = *(const u32x4*)(gk1 + 64); g2 = *(const u32x4*)gv0; g3 = *(const u32x4*)gv1;
        *(LAS u32x4*)(lds + kw_off) = g0; *(LAS u32x4*)(lds + 8192 + kw_off) = g1; *(LAS u32x4*)(lds + 16384 + vw_off[0]) = g2; *(LAS u32x4*)(lds + 16384 + vw_off[1]) = g3;
        __syncthreads();
        f32x16 o[4];
#pragma unroll
        for (int i = 0; i < 4; ++i) o[i] = (f32x16){0.f, 0.f, 0.f, 0.f, 0.f, 0.f, 0.f, 0.f, 0.f, 0.f, 0.f, 0.f, 0.f, 0.f, 0.f, 0.f};
        float m = -1.0e30f, l = 0.f;
        for (int t = 0; t < SEQ / 64; ++t) {
            const int kb = t * 64;
            if (t + 1 < SEQ / 64) {
                const size_t adv = (size_t)(kb + 64) * INW;
                g0 = *(const u32x4*)(gk1 + adv); g1 = *(const u32x4*)(gk1 + adv + 64); g2 = *(const u32x4*)(gv0 + adv); g3 = *(const u32x4*)(gv1 + adv);
            }
            const LAS unsigned char* st = lds + (t & 1) * AB_STGS;
            const LAS unsigned char* kbse = st + map * 8192;
            f32x16 s0 = (f32x16){0.f, 0.f, 0.f, 0.f, 0.f, 0.f, 0.f, 0.f, 0.f, 0.f, 0.f, 0.f, 0.f, 0.f, 0.f, 0.f}, s1 = s0;
#pragma unroll
            for (int d0 = 0; d0 < 4; ++d0) {
                const f16x8 a0 = *(const LAS f16x8*)(kbse + koff[d0]), a1 = *(const LAS f16x8*)(kbse + 4096 + koff[d0]);
                s0 = MFMA32(a0, qr[d0], s0); s1 = MFMA32(a1, qr[d0], s1);
            }
            const float dq0 = (float)(qpos - kb - 4 * hi);
#pragma unroll
            for (int r = 0; r < 16; ++r) {
                const float c = (float)((r & 3) + 8 * (r >> 2));
                s0[r] = __builtin_fmaf(-sl2, __builtin_fabsf(dq0 - c), s0[r]);
                s1[r] = __builtin_fmaf(-sl2, __builtin_fabsf(dq0 - 32.0f - c), s1[r]);
            }
            const float mx = rowmax32(s0, s1);
            if (__any(mx > m + AB_THR)) {
                const float mn = fmaxf(m, mx), al = __builtin_amdgcn_exp2f(m - mn);
                l *= al; m = mn;
                if (hi == 0) wsf[r32] = al;
#pragma unroll
                for (int r = 0; r < 16; ++r) { const float f = wsf[crow(r, hi)];
#pragma unroll
                    for (int i = 0; i < 4; ++i) o[i][r] *= f; }
            }
            float ls = 0.f;
#pragma unroll
            for (int r = 0; r < 16; ++r) { s0[r] = __builtin_amdgcn_exp2f(s0[r] - m); s1[r] = __builtin_amdgcn_exp2f(s1[r] - m); ls += s0[r] + s1[r]; }
            l += ls;
            u32x4 pw[4];
            pw[0] = (u32x4){pk2(s0[0], s0[1]), pk2(s0[2], s0[3]), pk2(s0[4], s0[5]), pk2(s0[6], s0[7])};
            pw[1] = (u32x4){pk2(s0[8], s0[9]), pk2(s0[10], s0[11]), pk2(s0[12], s0[13]), pk2(s0[14], s0[15])};
            pw[2] = (u32x4){pk2(s1[0], s1[1]), pk2(s1[2], s1[3]), pk2(s1[4], s1[5]), pk2(s1[6], s1[7])};
            pw[3] = (u32x4){pk2(s1[8], s1[9]), pk2(s1[10], s1[11]), pk2(s1[12], s1[13]), pk2(s1[14], s1[15])};
            const LAS unsigned char* vb = st + 16384 + vl;
#pragma unroll
            for (int ks = 0; ks < 4; ++ks)
#pragma unroll
                for (int dq = 0; dq < 4; ++dq) {
                    const f16x4 lo = vtr(vb + dq * AB_QSTR + ks * 1024), hh = vtr(vb + dq * AB_QSTR + ks * 1024 + 512);
                    const f16x8 vf = (f16x8){lo[0], lo[1], lo[2], lo[3], hh[0], hh[1], hh[2], hh[3]};
                    o[dq] = MFMA32(__builtin_bit_cast(f16x8, pw[ks]), vf, o[dq]);
                }
            if (t + 1 < SEQ / 64) {
                LAS unsigned char* ns = lds + ((t + 1) & 1) * AB_STGS;
                *(LAS u32x4*)(ns + kw_off) = g0; *(LAS u32x4*)(ns + 8192 + kw_off) = g1; *(LAS u32x4*)(ns + 16384 + vw_off[0]) = g2; *(LAS u32x4*)(ns + 16384 + vw_off[1]) = g3;
            }
            __syncthreads();
        }
        l = half_sum(l);
        if (hi == 0) wsf[r32] = 1.0f / l;
        LAS float* ost = (LAS float*)lds + (size_t)map * 128 * 128;
#pragma unroll
        for (int r = 0; r < 16; ++r) { const float il = wsf[crow(r, hi)]; const int row = qsub * 32 + crow(r, hi);
#pragma unroll
            for (int i = 0; i < 4; ++i) ost[row * 128 + i * 32 + r32] = o[i][r] * il; }
        __syncthreads();
        {
            const LAS float* o1 = (const LAS float*)lds; const LAS float* o2 = o1 + 128 * 128;
            const float g0s = subg[lane], g1s = subg[64 + lane];
            for (int rr = 0; rr < 16; ++rr) {
                const int row = wave * 16 + rr;
                const float v0 = o1[row * 128 + lane] - lam * o2[row * 128 + lane], v1 = o1[row * 128 + 64 + lane] - lam * o2[row * 128 + 64 + lane];
                float ss = v0 * v0 + v1 * v1;
                for (int of = 32; of >= 1; of >>= 1) ss += __shfl_xor(ss, of);
                const float rs = rsqrtf(ss * (1.0f / 128.0f) + 1e-5f) * (1.0f - LAMBDA_INIT);
                f16* op = ob + ((size_t)b * SEQ + qb * 128 + row) * 512 + h * 128;
                op[lane] = (f16)(v0 * rs * g0s); op[64 + lane] = (f16)(v1 * rs * g1s);
            }
        }
        __syncthreads();
    }
}
constexpr int AA_HSTR = 2112;
constexpr int AA_BUF = 2 * AA_HSTR;
constexpr int AA_WAVE = 2 * AA_BUF + 128;
constexpr float AA_THR = 8.0f;
__device__ __forceinline__ float rowmax16(const f32x16& p0) {
    float a = fmaxf(fmaxf(p0[0], p0[1]), p0[2]), b = fmaxf(fmaxf(p0[3], p0[4]), p0[5]);
    a = fmaxf(fmaxf(a, p0[6]), p0[7]); b = fmaxf(fmaxf(b, p0[8]), p0[9]); a = fmaxf(fmaxf(a, p0[10]), p0[11]); b = fmaxf(fmaxf(b, p0[12]), p0[13]);
    a = fmaxf(fmaxf(a, p0[14]), p0[15]);
    float m = fmaxf(a, b); auto rr = __builtin_amdgcn_permlane32_swap(__float_as_uint(m), __float_as_uint(m), false, false);
    return fmaxf(__uint_as_float(rr[0]), __uint_as_float(rr[1]));
}
__device__ __forceinline__ void phase_attnA(const Params& p, LAS unsigned char* lds, int wg, int nwg) {
    int tid = threadIdx.x; asm volatile("" : "+v"(tid));
    const int lane = tid & 63, r32 = lane & 31, hi = lane >> 5;
    const int wave = __builtin_amdgcn_readfirstlane(tid >> 6);
    const f16* proj = (const f16*)(p.ws + WS_PROJ);
    f16* oa = (f16*)(p.ws + WS_OAB);
    LAS unsigned char* wl = lds + wave * AA_WAVE;
    LAS float* wsf = (LAS float*)(wl + 2 * AA_BUF);
    const int vl = ((lane >> 4) & 1) * 32 + (lane & 3) * 8 + (4 * hi + ((lane & 15) >> 2)) * 64;
    int vrow[4], vch[4], vw_off[4];
#pragma unroll
    for (int jj = 0; jj < 4; ++jj) { const int idx = lane + 64 * jj; vrow[jj] = idx >> 3; vch[jj] = idx & 7; vw_off[jj] = (vch[jj] >> 2) * AA_HSTR + vrow[jj] * 64 + (vch[jj] & 3) * 16; }
    constexpr int NTILE = 33;
    for (int ui = 0; ui < 4; ++ui) {
        const int j = wg >> 3, bh = ui * 16 + (wg & 7) * 2 + (j >> 4), r16 = j & 15;
        const int b = bh >> 3, h = bh & 7;
        const float sl2 = slope_of(h + (h >> 1)) * LOG2E;
        const f16* base = proj + (size_t)b * SEQ * INW;
        const int P0 = r16 + 512 * wave, qpos = P0 + 16 * r32;
        f16x8 qr[4];
#pragma unroll
        for (int d0 = 0; d0 < 4; ++d0) qr[d0] = *(const f16x8*)(base + (size_t)qpos * INW + C_QA + h * 64 + 16 * d0 + 8 * hi);
        f32x16 o[2];
        o[0] = (f32x16){0.f, 0.f, 0.f, 0.f, 0.f, 0.f, 0.f, 0.f, 0.f, 0.f, 0.f, 0.f, 0.f, 0.f, 0.f, 0.f}; o[1] = o[0];
        float m = -1.0e30f, l = 0.f;
        f16x8 kfn[4]; u32x4 vsn[4];
#define AA_PARAMS(tt, d, n) const int d = (tt) < 5 ? 16 : ((tt) < 13 ? 4 : 1), n = (tt) < 5 ? (tt) : ((tt) < 13 ? (tt) - 5 : (tt) - 13)
#define AA_LOAD(tt) do { AA_PARAMS(tt, d_, n_); const int kb_ = P0 - 64 * d_ + 32 * d_ * n_; \
            { int kp = kb_ + d_ * r32; kp = kp < 0 ? 0 : (kp > SEQ - 1 ? SEQ - 1 : kp); const f16* kr = base + (size_t)kp * INW + C_KA + h * 64 + 8 * hi; \
              _Pragma("unroll") for (int d0 = 0; d0 < 4; ++d0) kfn[d0] = *(const f16x8*)(kr + 16 * d0); } \
            _Pragma("unroll") for (int jj = 0; jj < 4; ++jj) { int kp = kb_ + d_ * vrow[jj]; kp = kp < 0 ? 0 : (kp > SEQ - 1 ? SEQ - 1 : kp); \
              vsn[jj] = *(const u32x4*)(base + (size_t)kp * INW + C_VA + h * 64 + vch[jj] * 8); } } while (0)
        AA_LOAD(0);
        for (int tt = 0; tt < NTILE; ++tt) {
            f16x8 kf[4];
#pragma unroll
            for (int d0 = 0; d0 < 4; ++d0) kf[d0] = kfn[d0];
            LAS unsigned char* vbuf = wl + (tt & 1) * AA_BUF;
#pragma unroll
            for (int jj = 0; jj < 4; ++jj) *(LAS u32x4*)(vbuf + vw_off[jj]) = vsn[jj];
            if (tt + 1 < NTILE) AA_LOAD(tt + 1);
            AA_PARAMS(tt, d, n);
            const int kb = P0 - 64 * d + 32 * d * n;
            f32x16 s = (f32x16){0.f, 0.f, 0.f, 0.f, 0.f, 0.f, 0.f, 0.f, 0.f, 0.f, 0.f, 0.f, 0.f, 0.f, 0.f, 0.f};
#pragma unroll
            for (int d0 = 0; d0 < 4; ++d0) s = MFMA32(kf[d0], qr[d0], s);
            const float df = (float)d, basef = (float)(d * (32 * n + 4 * hi - 64) - 16 * r32), lim = 64.0f * df;
            const bool need_range = (kb < 0) || (kb + 31 * d >= SEQ);
            const float kpf0 = (float)(kb + 4 * hi * d);
#pragma unroll
            for (int r = 0; r < 16; ++r) {
                const float c = (float)((r & 3) + 8 * (r >> 2));
                const float ad = __builtin_fabsf(__builtin_fmaf(df, c, basef));
                bool valid = ad <= lim;
                if (need_range) { const float kpf = __builtin_fmaf(df, c, kpf0); valid = valid && (kpf >= 0.0f) && (kpf < (float)SEQ); }
                s[r] = valid ? __builtin_fmaf(-sl2, ad, s[r]) : -INFINITY;
            }
            const float mx = rowmax16(s);
            if (__any(mx > m + AA_THR)) {
                const float mn = fmaxf(m, mx), al = __builtin_amdgcn_exp2f(m - mn);
                l *= al; m = mn;
                if (hi == 0) wsf[r32] = al;
#pragma unroll
                for (int r = 0; r < 16; ++r) { const float f = wsf[crow(r, hi)]; o[0][r] *= f; o[1][r] *= f; }
            }
            float ls = 0.f;
#pragma unroll
            for (int r = 0; r < 16; ++r) { s[r] = __builtin_amdgcn_exp2f(s[r] - m); ls += s[r]; }
            l += ls;
            u32x4 pw[2];
            pw[0] = (u32x4){pk2(s[0], s[1]), pk2(s[2], s[3]), pk2(s[4], s[5]), pk2(s[6], s[7])};
            pw[1] = (u32x4){pk2(s[8], s[9]), pk2(s[10], s[11]), pk2(s[12], s[13]), pk2(s[14], s[15])};
            const LAS unsigned char* vb = vbuf + vl;
#pragma unroll
            for (int ks = 0; ks < 2; ++ks)
#pragma unroll
                for (int dh = 0; dh < 2; ++dh) {
                    const f16x4 lo = vtr(vb + dh * AA_HSTR + ks * 1024), hh = vtr(vb + dh * AA_HSTR + ks * 1024 + 512);
                    const f16x8 vf = (f16x8){lo[0], lo[1], lo[2], lo[3], hh[0], hh[1], hh[2], hh[3]};
                    o[dh] = MFMA32(__builtin_bit_cast(f16x8, pw[ks]), vf, o[dh]);
                }
        }
#undef AA_LOAD
#undef AA_PARAMS
        l = half_sum(l);
        if (hi == 0) wsf[r32] = 1.0f / l;
#pragma unroll
        for (int r = 0; r < 16; ++r) {
            const float il = wsf[crow(r, hi)];
            f16* op = oa + ((size_t)b * SEQ + P0 + 16 * crow(r, hi)) * 512 + h * 64 + r32;
            op[0] = (f16)(o[0][r] * il); op[32] = (f16)(o[1][r] * il);
        }
    }
    __syncthreads();
}
#define XB_TMO      128
#define XB_XCNT(j)  (256  + 64 * (j))
#define XB_XSUB(j)  (1280 + 64 * (j))
#define XB_XGEN(j)  (2304 + 64 * (j))
#define XB_TOP      3328
#define XB_TOPGEN   3392
#define XCD_BAR_WORDS 3456
#define XB_SPIN_CAP (1u << 20)
__device__ __forceinline__ unsigned xb_ld(unsigned* p)              { return __hip_atomic_load(p, __ATOMIC_RELAXED, __HIP_MEMORY_SCOPE_AGENT); }
__device__ __forceinline__ unsigned xb_add(unsigned* p, unsigned v) { return __hip_atomic_fetch_add(p, v, __ATOMIC_RELAXED, __HIP_MEMORY_SCOPE_AGENT); }
__device__ __forceinline__ unsigned xb_xcc_id() { return (unsigned)__builtin_amdgcn_s_getreg((3 << 11) | 20) & 0xFu; }
#define XB_SPIN(cond, bar) do { unsigned _sp = 0; while (cond) { __builtin_amdgcn_s_sleep(1); \
    if ((++_sp & 255u) == 0u) { if (xb_ld(&(bar)[XB_TMO])) break; if (_sp > XB_SPIN_CAP) { atomicAdd(&(bar)[XB_TMO], 1u); break; } } } } while (0)
__device__ __forceinline__ void xcd_barrier_post(unsigned* bar) { if (threadIdx.x == 0) (void)xb_add(&bar[XB_XCNT(xb_xcc_id())], 1u); }
__device__ __forceinline__ void xcd_barrier_complete(unsigned* bar, unsigned x, unsigned& nloc, unsigned& nx) {
    const unsigned G = gridDim.x;
    unsigned sum, cnt, mine, sp = 0u;
    for (;;) {
        sum = 0u; cnt = 0u; mine = 0u;
#pragma unroll
        for (unsigned j = 0; j < 16; ++j) { const unsigned c = xb_ld(&bar[XB_XCNT(j)]); sum += c; cnt += (c > 0u) ? 1u : 0u; mine = (j == x) ? c : mine; }
        if (sum == G) break;
        __builtin_amdgcn_s_sleep(1);
        if ((++sp & 255u) == 0u) { if (xb_ld(&bar[XB_TMO])) break; if (sp > XB_SPIN_CAP) { atomicAdd(&bar[XB_TMO], 1u); break; } }
    }
    nloc = mine > 0u ? mine : 1u; nx = cnt > 0u ? cnt : 1u;
}
__device__ __forceinline__ void xcd_barrier(unsigned* bar, volatile LAS unsigned* st) {
    asm volatile("s_waitcnt vmcnt(0)" ::: "memory");
    __syncthreads();
    if (threadIdx.x == 0) {
        const unsigned x = xb_xcc_id();
        __builtin_amdgcn_s_waitcnt(0);
        unsigned nloc = st[0], nx = st[1];
        if (nloc == 0u) { xcd_barrier_complete(bar, x, nloc, nx); st[0] = nloc; st[1] = nx; }
        const unsigned old = xb_add(&bar[XB_XSUB(x)], 1u);
        const unsigned gen = old / nloc;
        if (old + 1u == (gen + 1u) * nloc) {
            __builtin_amdgcn_fence(__ATOMIC_RELEASE, "agent");
            asm volatile("s_waitcnt vmcnt(0)" ::: "memory");
            const unsigned og = xb_add(&bar[XB_TOP], 1u);
            const unsigned tg = og / nx;
            if (og + 1u == (tg + 1u) * nx) xb_add(&bar[XB_TOPGEN], 1u);
            else XB_SPIN(xb_ld(&bar[XB_TOPGEN]) == tg, bar);
            __builtin_amdgcn_fence(__ATOMIC_ACQUIRE, "agent");
            xb_add(&bar[XB_XGEN(x)], 1u);
            asm volatile("s_waitcnt vmcnt(0)" ::: "memory");
        } else {
            XB_SPIN(xb_ld(&bar[XB_XGEN(x)]) == gen, bar);
            __builtin_amdgcn_fence(__ATOMIC_ACQUIRE, "agent");
            asm volatile("s_waitcnt vmcnt(0)" ::: "memory");
        }
    }
    __syncthreads();
}
constexpr int LDS_BARST = LDS_TOTAL - 16;
constexpr size_t SM_BAR = 1024;
__global__ void __launch_bounds__(NTHR, 2) k_mega(Params p) {
    extern __shared__ __attribute__((aligned(16))) unsigned char smem[];
    LAS unsigned char* lds = (LAS unsigned char*)smem;
    const int wg = blockIdx.x, nwg = gridDim.x;
    unsigned* bar = (unsigned*)(p.ws + WS_SMALL + SM_BAR);
    volatile LAS unsigned* st = (volatile LAS unsigned*)(lds + LDS_BARST);
    if (threadIdx.x == 0) { st[0] = 0u; st[1] = 0u; }
    __syncthreads();
    xcd_barrier_post(bar);
#define GRID_SYNC() xcd_barrier(bar, st)
    phase_prep(p, lds, wg, nwg);      GRID_SYNC();
    phase_inproj(p, lds, wg, nwg);    GRID_SYNC();
    phase_attnA(p, lds, wg, nwg);
    phase_attnB(p, lds, wg, nwg);     GRID_SYNC();
    phase_merge(p, lds, wg, nwg);     GRID_SYNC();
    phase_outproj(p, lds, wg, nwg);   GRID_SYNC();
    phase_router(p, lds, wg, nwg);    GRID_SYNC();
    phase_up(p, lds, wg, nwg);        GRID_SYNC();
    phase_down(p, lds, wg, nwg);      GRID_SYNC();
    phase_final(p, lds, wg, nwg);
#undef GRID_SYNC
}
}

extern "C" void kernel_launch(void* const* d_in, const int* in_sizes, int n_in, void* d_out, int out_size, void* d_ws, size_t ws_size,
                              hipStream_t stream) {
    static int grid_blocks = 0;
    if (grid_blocks == 0) {
        int dev = 0, cus = 0, per_cu = 0;
        if (hipGetDevice(&dev) != hipSuccess || hipDeviceGetAttribute(&cus, hipDeviceAttributeMultiprocessorCount, dev) != hipSuccess) { fprintf(stderr, "kernel_launch: device query failed\n"); grid_blocks = -1; return; }
        if (hipFuncSetAttribute((const void*)k_mega, hipFuncAttributeMaxDynamicSharedMemorySize, LDS_TOTAL) != hipSuccess) { fprintf(stderr, "kernel_launch: hipFuncSetAttribute failed\n"); grid_blocks = -1; return; }
        if (hipOccupancyMaxActiveBlocksPerMultiprocessor(&per_cu, (const void*)k_mega, NTHR, LDS_TOTAL) != hipSuccess || per_cu < 1) { fprintf(stderr, "kernel_launch: occupancy query says %d blocks/CU\n", per_cu); grid_blocks = -1; return; }
        grid_blocks = cus * per_cu;
        if (grid_blocks > NWG) grid_blocks = NWG;
        if (grid_blocks != NWG) { fprintf(stderr, "kernel_launch: need %d co-resident workgroups, device offers %d\n", NWG, grid_blocks); grid_blocks = -1; return; }
        if (ws_size < WS_END) { fprintf(stderr, "kernel_launch: workspace too small (%zu < %zu)\n", ws_size, (size_t)WS_END); grid_blocks = -1; return; }
    }
    if (grid_blocks < 0) return;
    Params p{};
    for (int i = 0; i < 22; ++i) p.in[i] = (const float*)d_in[i];
    p.out = (float*)d_out; p.ws = (unsigned char*)d_ws;
    if (hipMemsetAsync((char*)d_ws + WS_SMALL, 0, 16384, stream) != hipSuccess) { fprintf(stderr, "kernel_launch: memset failed\n"); return; }
    void* args[] = {&p};
    hipError_t e = hipLaunchCooperativeKernel((const void*)k_mega, dim3(grid_blocks), dim3(NTHR), args, LDS_TOTAL, stream);
    if (e != hipSuccess) fprintf(stderr, "kernel_launch: cooperative launch failed: %s (grid %d)\n", hipGetErrorString(e), grid_blocks);
}
```

```cpp
#define DUP 0
#include <hip/hip_runtime.h>
#include <hip/hip_cooperative_groups.h>
#include <stdint.h>
#include <stdio.h>

namespace {
constexpr int NB = 8, SEQ = 4096, DM = 1024, TOK = NB * SEQ;
constexpr int INW = 5120;
constexpr int C_QA = 0, C_KA = 512, C_VA = 1024, C_QB = 1536, C_KB = 2048, C_VB = 2560, C_GA = 3072, C_GB = 4096;
constexpr int NEXP = 32, TOPK = 4, NASG = TOK * TOPK;
constexpr float ALPHA = 1.189207115002721f;
constexpr float LAMBDA_INIT = 0.2f;
constexpr float LOG2E = 1.4426950408889634f;
constexpr size_t MiB = 1048576;

__device__ __forceinline__ float sigmoidf_(float x) { return 1.0f / (1.0f + __expf(-x)); }
__device__ __forceinline__ float slope_of(int idx) { return exp2f(-8.0f * (float)(idx + 1) / 12.0f); }
#define LAS __attribute__((address_space(3)))
typedef _Float16 f16;
typedef _Float16 f16x8 __attribute__((ext_vector_type(8)));
typedef _Float16 f16x4 __attribute__((ext_vector_type(4)));
typedef _Float16 f16x2 __attribute__((ext_vector_type(2)));
typedef float f32x4 __attribute__((ext_vector_type(4)));
typedef float f32x16 __attribute__((ext_vector_type(16)));
typedef unsigned u32x4 __attribute__((ext_vector_type(4)));
typedef unsigned u32x2 __attribute__((ext_vector_type(2)));

constexpr int NTHR = 512, NWG = 256;
constexpr int BM = 256, BK = 64, HALF = 128, HTB = HALF * BK * 2, STAGE_BYTES = 8 * HTB;
constexpr int LDS_MISC = STAGE_BYTES;
constexpr int LDS_TOTAL = 155648;
constexpr float QSCALE = 0.125f * 1.4426950408889634f;
constexpr int ROWPAD = 256;
constexpr int MOE_ROWS = NASG + NEXP * ROWPAD;
constexpr int LISTCAP = TOK;


constexpr int LDS_WTAB = LDS_TOTAL - 16 - 256;
__device__ __forceinline__ int get_tid(LAS unsigned char* lds) {
    const unsigned hw = (unsigned)__builtin_amdgcn_s_getreg((5 << 11) | 4) & 63u;
    const int wave = __builtin_amdgcn_readfirstlane(((LAS int*)(lds + LDS_WTAB))[hw]);
    int lane; asm volatile("v_mbcnt_lo_u32_b32 %0, -1, 0\n\tv_mbcnt_hi_u32_b32 %0, -1, %0" : "=v"(lane));
    int t = wave * 64 + lane; asm volatile("" : "+v"(t));
    return t;
}
__device__ __forceinline__ float shx(float v, int mask, int lane) { return __int_as_float(__builtin_amdgcn_ds_bpermute((lane ^ mask) << 2, __float_as_int(v))); }
__device__ __forceinline__ unsigned pk2(float a, float b) { f16x2 v; v.x = (f16)a; v.y = (f16)b; return __builtin_bit_cast(unsigned, v); }
__device__ __forceinline__ int lds_byte(int r, int c) { const int st = (r >> 4) * 2 + (c >> 5), rr = r & 15, cc = c & 31, ob = rr * 64 + cc * 2; return st * 1024 + (ob ^ (((ob >> 9) & 1) << 5)); }
__device__ __forceinline__ void stage_rc(int b, int& R, int& C) { const int st = b / 1024, sb = b % 1024, swz = sb ^ (((sb >> 9) & 1) << 5); R = (st >> 1) * 16 + swz / 64; C = (st & 1) * 32 + (swz % 64) / 2; }
__device__ __forceinline__ int perm32(int rho) { const int n = rho >> 4, i = rho & 15; return 8 * (i >> 2) + 4 * n + (i & 3); }

struct Unit { int pm, pn, e, row0, nrows; };

template <int K_>
struct DenseSched {
    static constexpr int K = K_;
    const char* A; const char* Bt; int nM, nN, nwg, G, c;
    __device__ void init(const void* A_, const void* Bt_, int M, int N, int G_, int c_) { A = (const char*)A_; Bt = (const char*)Bt_; nM = M / BM; nN = N / BM; nwg = nM * nN; G = G_; c = c_; }
    __device__ __forceinline__ bool next(int i, Unit& u) const {
        const long L = (long)i * G + c; if (L >= nwg) return false;
        int wgid = (int)L; { const int q = nwg / 8, r = nwg % 8, xcd = wgid % 8, off = wgid / 8; wgid = (xcd < r ? xcd * (q + 1) : r * (q + 1) + (xcd - r) * q) + off; }
        const int nig = 8 * nN, gid = wgid / nig, fm = gid * 8, gsz = (nM - fm) < 8 ? (nM - fm) : 8;
        u.pm = fm + ((wgid % nig) % gsz); u.pn = (wgid % nig) / gsz; u.e = 0; u.row0 = u.pm * BM; u.nrows = BM; return true;
    }
    static constexpr int LDB = K_, MID = -1;
    static __device__ __forceinline__ unsigned ka(int kt) { return (unsigned)kt * 128u; }
    static __device__ __forceinline__ unsigned kb(int kt) { return (unsigned)kt * 128u; }
    static __device__ __forceinline__ unsigned make_rc(int R, int C) { return (unsigned)(R * K + C) * 2u; }
    __device__ __forceinline__ void a_desc(const Unit& u, const unsigned (&rc)[2], unsigned (&ad)[2]) const { ad[0] = rc[0] + (unsigned)u.pm * (unsigned)(BM * K * 2); ad[1] = rc[1] + (unsigned)u.pm * (unsigned)(BM * K * 2); }
    static __device__ __forceinline__ unsigned aoff(unsigned ad, unsigned rc, int h) { return ad + (unsigned)h * (unsigned)(HALF * K * 2); }
    __device__ __forceinline__ const char* b_base(const Unit& u) const { return Bt + (size_t)u.pn * BM * K * 2; }
};

template <class Sched, class Epi>
__device__ __forceinline__ void gemm_phase(LAS unsigned char* lds, const Sched& S, const Epi& E) {
    constexpr int K = Sched::K, nt = K / BK;
    const int tid = get_tid(lds);
    const int wid = __builtin_amdgcn_readfirstlane(tid >> 6), lane = tid & 63, wr = wid >> 2, wc = wid & 3, fr = lane & 15, fq = lane >> 4;
    unsigned rc[2], voffB[2];
#pragma unroll
    for (int i = 0; i < 2; ++i) { int R, C; stage_rc(tid * 16 + i * 8192, R, C); const int Rb = Epi::PERM ? ((R & ~31) + perm32(R & 31)) : R; voffB[i] = (unsigned)(Rb * Sched::LDB + C) * 2u; rc[i] = Sched::make_rc(R, C); }
    constexpr unsigned hstepB = HALF * Sched::LDB * 2;
    const unsigned ldsw = (unsigned)wid * 1024u;
    const int aoff = lds_byte(wr * 64 + fr, fq * 8), boff = lds_byte(wc * 32 + fr, fq * 8);
#define G_SA(b, h) (((b) * 2 + (h)) * HTB)
#define G_SB(b, h) ((4 + (b) * 2 + (h)) * HTB)
#define G_STAGE_A(bufoff, ad, h, kb) do { \
        __builtin_amdgcn_global_load_lds((const unsigned*)(Abase + (size_t)Sched::aoff((ad)[0], rc[0], h) + (kb)), (LAS unsigned*)(lds + (bufoff) + ldsw), 16, 0, 0); \
        __builtin_amdgcn_global_load_lds((const unsigned*)(Abase + (size_t)Sched::aoff((ad)[1], rc[1], h) + (kb)), (LAS unsigned*)(lds + (bufoff) + ldsw + 8192), 16, 0, 0); } while (0)
#define G_STAGE_B(bufoff, gbase) do { _Pragma("unroll") for (int _i = 0; _i < 2; ++_i) \
        __builtin_amdgcn_global_load_lds((const unsigned*)((const char*)(gbase) + voffB[_i]), (LAS unsigned*)(lds + (bufoff) + ldsw + _i * 8192), 16, 0, 0); } while (0)
#define G_LDA(dst, b, h) do { _Pragma("unroll") for (int m = 0; m < 4; ++m) _Pragma("unroll") for (int k = 0; k < 2; ++k) dst[m][k] = *(const LAS f16x8*)(lds + G_SA(b, h) + aoff + m * 2048 + k * 1024); } while (0)
#define G_LDB(dst, b, h) do { _Pragma("unroll") for (int n = 0; n < 2; ++n) _Pragma("unroll") for (int k = 0; k < 2; ++k) dst[n][k] = *(const LAS f16x8*)(lds + G_SB(b, h) + boff + n * 2048 + k * 1024); } while (0)
#define G_MMA(ai, bj, At, Bt) do { __builtin_amdgcn_s_setprio(1); _Pragma("unroll") for (int m = 0; m < 4; ++m) _Pragma("unroll") for (int n = 0; n < 2; ++n) _Pragma("unroll") for (int k = 0; k < 2; ++k) \
        acc[ai][bj][m][n] = __builtin_amdgcn_mfma_f32_16x16x32_f16(Bt[n][k], At[m][k], acc[ai][bj][m][n], 0, 0, 0); __builtin_amdgcn_s_setprio(0); } while (0)
#define G_WAIT_V(n) asm volatile("s_waitcnt vmcnt(" #n ")" ::: "memory")
#define G_WAIT_L(n) asm volatile("s_waitcnt lgkmcnt(" #n ")" ::: "memory")
#define G_BAR __builtin_amdgcn_s_barrier()
#define G_SCHED __builtin_amdgcn_sched_barrier(0)
    Unit cur, nxt; int ui = 0;
    if (!S.next(0, cur)) return;
    f32x4 acc[2][2][4][2];
#pragma unroll
    for (int a = 0; a < 2; ++a)
#pragma unroll
        for (int b = 0; b < 2; ++b)
#pragma unroll
            for (int m = 0; m < 4; ++m)
#pragma unroll
                for (int n = 0; n < 2; ++n) acc[a][b][m][n] = (f32x4){0.f, 0.f, 0.f, 0.f};
    f16x8 At[4][2], B0[2][2], B1[2][2];
    const char* const Abase = S.A;
    unsigned cad[2], nad[2];
    S.a_desc(cur, rc, cad);
    const char* cB = S.b_base(cur);
    G_STAGE_B(G_SB(0, 0), cB); G_STAGE_B(G_SB(0, 1), cB + hstepB); G_STAGE_A(G_SA(0, 0), cad, 0, 0u); G_STAGE_A(G_SA(0, 1), cad, 1, 0u);
    if (wr == 1) G_BAR;
    G_WAIT_V(2); G_BAR;
    G_STAGE_B(G_SB(1, 0), cB + Sched::kb(1)); G_STAGE_A(G_SA(1, 0), cad, 0, Sched::ka(1)); G_STAGE_B(G_SB(1, 1), cB + hstepB + Sched::kb(1));
    G_WAIT_V(6); G_BAR;
    for (;;) {
        const bool has_next = S.next(ui + 1, nxt);
        const char* nB = cB;
        if (has_next) { S.a_desc(nxt, rc, nad); nB = S.b_base(nxt); }
        else { nad[0] = cad[0]; nad[1] = cad[1]; }
        for (int t = 0; t < nt; t += 2) {
            const bool last = (t == nt - 2);
            const unsigned k1 = Sched::ka(t + 1);
            const unsigned k2 = last ? Sched::ka(0) : Sched::ka(t + 2), k3 = last ? Sched::ka(1) : Sched::ka(t + 3);
            const unsigned a2[2] = {last ? nad[0] : cad[0], last ? nad[1] : cad[1]};
            const char* b2 = (last ? nB + Sched::kb(0) : cB + Sched::kb(t + 2)); const char* b3 = (last ? nB + Sched::kb(1) : cB + Sched::kb(t + 3));
            if constexpr (Sched::MID >= 0) { if (t == Sched::MID) E.mid(acc, cur, wr, wc, fr, fq); }
            G_LDB(B0, 0, 0); G_LDB(B1, 0, 1); G_SCHED; G_LDA(At, 0, 0); G_STAGE_A(G_SA(1, 1), cad, 1, k1);
            G_WAIT_V(8); G_WAIT_L(0); G_BAR; G_MMA(0, 0, At, B0); G_MMA(0, 1, At, B1); G_BAR; G_SCHED;
            G_LDA(At, 0, 1); G_STAGE_B(G_SB(0, 0), b2); G_STAGE_B(G_SB(0, 1), b2 + hstepB); G_STAGE_A(G_SA(0, 0), a2, 0, k2);
            G_WAIT_V(8); G_WAIT_L(0); G_BAR; G_MMA(1, 0, At, B0); G_MMA(1, 1, At, B1); G_BAR; G_SCHED;
            G_LDB(B0, 1, 0); G_LDB(B1, 1, 1); G_SCHED; G_LDA(At, 1, 0); G_STAGE_A(G_SA(0, 1), a2, 1, k2);
            G_WAIT_V(8); G_WAIT_L(0); G_BAR; G_MMA(0, 0, At, B0); G_MMA(0, 1, At, B1); G_BAR; G_SCHED;
            G_LDA(At, 1, 1); G_STAGE_B(G_SB(1, 0), b3); G_STAGE_B(G_SB(1, 1), b3 + hstepB); G_STAGE_A(G_SA(1, 0), a2, 0, k3);
            G_WAIT_V(8); G_WAIT_L(0); G_BAR; G_MMA(1, 0, At, B0); G_MMA(1, 1, At, B1); G_BAR; G_SCHED;
        }
        if (wr == 0) G_BAR;
        E(acc, cur, wr, wc, fr, fq);
        if (!has_next) break;
#pragma unroll
        for (int a = 0; a < 2; ++a)
#pragma unroll
            for (int b = 0; b < 2; ++b)
#pragma unroll
                for (int m = 0; m < 4; ++m)
#pragma unroll
                    for (int n = 0; n < 2; ++n) acc[a][b][m][n] = (f32x4){0.f, 0.f, 0.f, 0.f};
        cur = nxt; cB = nB; ++ui; cad[0] = nad[0]; cad[1] = nad[1];
        if (wr == 1) G_BAR;
    }
    G_WAIT_V(0);
    G_BAR;
#undef G_SA
#undef G_SB
#undef G_STAGE_A
#undef G_STAGE_B
#undef G_LDA
#undef G_LDB
#undef G_MMA
#undef G_WAIT_V
#undef G_WAIT_L
#undef G_BAR
#undef G_SCHED
}
constexpr size_t WS_WIN = 0;
constexpr size_t WS_WPA = WS_WIN + (size_t)INW * DM * 2;
constexpr size_t WS_WPB = WS_WPA + (size_t)DM * 512 * 2;
constexpr size_t WS_WOUT = WS_WPB + (size_t)DM * 512 * 2;
constexpr size_t WS_WUP = WS_WOUT + (size_t)DM * DM * 2;
constexpr size_t WS_WDN = WS_WUP + (size_t)NEXP * 2048 * DM * 2;
constexpr size_t WS_XH = WS_WDN + (size_t)NEXP * DM * DM * 2;
constexpr size_t WS_PROJ = WS_XH + (size_t)TOK * DM * 2;
constexpr size_t WS_OAB = WS_PROJ + (size_t)TOK * INW * 2;
constexpr size_t WS_MERGED = WS_OAB + (size_t)TOK * DM * 2;
constexpr size_t WS_H1 = WS_MERGED + (size_t)TOK * DM * 2;
constexpr size_t WS_SMALL = WS_H1 + (size_t)TOK * DM * 4 + 16 * MiB;
constexpr size_t WS_YS = WS_OAB;
constexpr size_t SM_PQ = 16064;
constexpr size_t SM_CNT = 0, SM_TK = 16384, SM_LIST = SM_TK + (size_t)NASG * 4;
constexpr size_t WS_END = WS_SMALL + SM_LIST + (size_t)NEXP * LISTCAP * 8;
static_assert(WS_YS + (size_t)MOE_ROWS * DM * 2 <= WS_SMALL, "ys overlaps bookkeeping");
static_assert((size_t)MOE_ROWS * DM * 2 <= (size_t)TOK * INW * 2, "act does not fit over proj");
static_assert(WS_END <= 1024 * MiB, "workspace");

struct Params {
    const float* in[22]; float* out; unsigned char* ws;
};

constexpr int LDS_PARAMS = LDS_WTAB - 256;
__device__ __forceinline__ unsigned long long rfl64(unsigned long long v) {
    const unsigned lo = (unsigned)__builtin_amdgcn_readfirstlane((int)(unsigned)v), hi = (unsigned)__builtin_amdgcn_readfirstlane((int)(unsigned)(v >> 32));
    return ((unsigned long long)hi << 32) | lo; }
__device__ __forceinline__ Params get_params(LAS unsigned char* lds) {
    unsigned off = LDS_PARAMS; asm volatile("" : "+v"(off));
    const LAS unsigned long long* q = (const LAS unsigned long long*)(lds + off);
    Params p;
#pragma unroll
    for (int i = 0; i < 22; ++i) p.in[i] = (const float*)rfl64(q[i]);
    p.out = (float*)rfl64(q[22]); p.ws = (unsigned char*)rfl64(q[23]);
    return p;
}
__device__ __forceinline__ void put_params(const Params& p, LAS unsigned char* lds) {
    LAS unsigned long long* q = (LAS unsigned long long*)(lds + LDS_PARAMS);
#pragma unroll
    for (int i = 0; i < 22; ++i) q[i] = (unsigned long long)p.in[i];
    q[22] = (unsigned long long)p.out; q[23] = (unsigned long long)p.ws;
}


struct PrepTile { const float* src; int ldsrc; f16* dst; int K; int n0; };
__device__ __forceinline__ PrepTile prep_desc(const Params& p, int t) {
    unsigned char* ws = p.ws;
    constexpr int T_IN = (INW / 64) * (DM / 128), T_PA = (DM / 64) * (512 / 128), T_OUT = (DM / 64) * (DM / 128);
    constexpr int T_UP1 = (2048 / 64) * (DM / 128), T_DN1 = (DM / 64) * (DM / 128);
    constexpr int T0 = T_IN, T1 = T0 + T_PA, T2 = T1 + T_PA, T3 = T2 + T_OUT, T4 = T3 + NEXP * T_UP1;
    PrepTile d;
    if (t < T0) { const int tn = t / 8, tk = t % 8; d.src = p.in[1] + (size_t)(tk * 128) * INW + tn * 64; d.ldsrc = INW; d.dst = (f16*)(ws + WS_WIN) + tk * 128; d.K = DM; d.n0 = tn * 64; }
    else if (t < T1) { const int q = t - T0, tn = q / 4, tk = q % 4; d.src = p.in[8] + (size_t)(tk * 128) * DM + tn * 64; d.ldsrc = DM; d.dst = (f16*)(ws + WS_WPA) + tk * 128; d.K = 512; d.n0 = tn * 64; }
    else if (t < T2) { const int q = t - T1, tn = q / 4, tk = q % 4; d.src = p.in[9] + (size_t)(tk * 128) * DM + tn * 64; d.ldsrc = DM; d.dst = (f16*)(ws + WS_WPB) + tk * 128; d.K = 512; d.n0 = tn * 64; }
    else if (t < T3) { const int q = t - T2, tn = q / 8, tk = q % 8; d.src = p.in[10] + (size_t)(tk * 128) * DM + tn * 64; d.ldsrc = DM; d.dst = (f16*)(ws + WS_WOUT) + tk * 128; d.K = DM; d.n0 = tn * 64; }
    else if (t < T4) { const int q = t - T3, e = q / T_UP1, r = q % T_UP1, tn = r / 8, tk = r % 8;
        const int np = tn * 64, pn = np >> 8, jj = np & 255;
        const int sc = jj < 128 ? pn * 128 + jj : 1024 + pn * 128 + (jj - 128);
        d.src = p.in[16] + (size_t)e * DM * 2048 + (size_t)(tk * 128) * 2048 + sc; d.ldsrc = 2048; d.dst = (f16*)(ws + WS_WUP) + (size_t)e * 2048 * DM + tk * 128; d.K = DM; d.n0 = np; }
    else { const int q = t - T4, e = q / T_DN1, r = q % T_DN1, tn = r / 8, tk = r % 8;
        d.src = p.in[18] + (size_t)e * DM * DM + (size_t)(tk * 128) * DM + tn * 64; d.ldsrc = DM; d.dst = (f16*)(ws + WS_WDN) + (size_t)e * DM * DM + tk * 128; d.K = DM; d.n0 = tn * 64; }
    return d;
}
constexpr int PREP_NT = (INW / 64) * (DM / 128) + 2 * (DM / 64) * (512 / 128) + (DM / 64) * (DM / 128) + NEXP * ((2048 / 64) * (DM / 128) + (DM / 64) * (DM / 128));
__device__ __forceinline__ void phase_prep(const Params& p, LAS unsigned char* lds, int wg, int nwg) {
    const int tid = get_tid(lds);
    unsigned char* ws = p.ws;
    {
        const float4* src = (const float4*)p.in[0]; u32x4* dst = (u32x4*)(ws + WS_XH);
        constexpr size_t n8 = (size_t)TOK * DM / 8;
        const size_t stride = (size_t)nwg * NTHR;
        for (size_t i = (size_t)wg * NTHR + tid; i < n8; i += 4 * stride) {
            float4 a[4], c[4];
#pragma unroll
            for (int u = 0; u < 4; ++u) { a[u] = src[2 * (i + u * stride)]; c[u] = src[2 * (i + u * stride) + 1]; }
#pragma unroll
            for (int u = 0; u < 4; ++u) { u32x4 w; w.x = pk2(a[u].x, a[u].y); w.y = pk2(a[u].z, a[u].w); w.z = pk2(c[u].x, c[u].y); w.w = pk2(c[u].z, c[u].w); dst[i + u * stride] = w; }
        }
    }
    LAS float* tile = (LAS float*)lds;
    const int lk = tid >> 4, ln4 = (tid & 15) * 4;
    float4 va[4], vb[4];
#define PREP_LOAD(V, tt) do { if ((tt) < PREP_NT) { const PrepTile d_ = prep_desc(p, (tt)); \
        _Pragma("unroll") for (int j = 0; j < 4; ++j) V[j] = *(const float4*)(d_.src + (size_t)(lk + 32 * j) * d_.ldsrc + ln4); } } while (0)
#define PREP_DO2(V, tt, tnext) do { if ((tt) < PREP_NT) { const PrepTile d = prep_desc(p, (tt)); \
        _Pragma("unroll") for (int j = 0; j < 4; ++j) { LAS float* r = tile + (lk + 32 * j) * 65 + ln4; r[0] = V[j].x; r[1] = V[j].y; r[2] = V[j].z; r[3] = V[j].w; } \
        PREP_LOAD(V, (tnext)); \
        __syncthreads(); \
        { const int n = tid >> 3, kc = (tid & 7) * 16; u32x4 w0, w1; \
          w0.x = pk2(tile[(kc + 0) * 65 + n], tile[(kc + 1) * 65 + n]); w0.y = pk2(tile[(kc + 2) * 65 + n], tile[(kc + 3) * 65 + n]); \
          w0.z = pk2(tile[(kc + 4) * 65 + n], tile[(kc + 5) * 65 + n]); w0.w = pk2(tile[(kc + 6) * 65 + n], tile[(kc + 7) * 65 + n]); \
          w1.x = pk2(tile[(kc + 8) * 65 + n], tile[(kc + 9) * 65 + n]); w1.y = pk2(tile[(kc + 10) * 65 + n], tile[(kc + 11) * 65 + n]); \
          w1.z = pk2(tile[(kc + 12) * 65 + n], tile[(kc + 13) * 65 + n]); w1.w = pk2(tile[(kc + 14) * 65 + n], tile[(kc + 15) * 65 + n]); \
          f16* o = d.dst + (size_t)(d.n0 + n) * d.K + kc; *(u32x4*)o = w0; *(u32x4*)(o + 8) = w1; } \
        __syncthreads(); } } while (0)
    unsigned* pq = (unsigned*)(ws + WS_SMALL + SM_PQ);
    LAS int* qslot = (LAS int*)(lds + 36864);
    int ta, tb;
    if (tid == 0) { qslot[0] = (int)__hip_atomic_fetch_add(pq, 1u, __ATOMIC_RELAXED, __HIP_MEMORY_SCOPE_AGENT); qslot[1] = (int)__hip_atomic_fetch_add(pq, 1u, __ATOMIC_RELAXED, __HIP_MEMORY_SCOPE_AGENT); }
    __syncthreads();
    ta = qslot[0]; tb = qslot[1];
    PREP_LOAD(va, ta); PREP_LOAD(vb, tb);
#define PREP_DRAW(tv) do { __syncthreads(); if (tid == 0) qslot[0] = (int)__hip_atomic_fetch_add(pq, 1u, __ATOMIC_RELAXED, __HIP_MEMORY_SCOPE_AGENT); __syncthreads(); tv = qslot[0]; } while (0)
#pragma unroll 1
    for (;;) {
        if (ta >= PREP_NT && tb >= PREP_NT) break;
        int tn;
        if (ta < PREP_NT) { PREP_DRAW(tn); PREP_DO2(va, ta, tn); ta = tn; }
        if (tb < PREP_NT) { PREP_DRAW(tn); PREP_DO2(vb, tb, tn); tb = tn; }
    }
#undef PREP_DRAW
#undef PREP_LOAD
#undef PREP_DO2
}

struct EpiInProj {
    static constexpr bool PERM = true;
    f16* O; const float* bias;
    __device__ __forceinline__ void operator()(const f32x4 (&acc)[2][2][4][2], const Unit& u, int wr, int wc, int fr, int fq) const {
        const int row0 = u.pm * BM + wr * 64 + fr, col0 = u.pn * BM + wc * 32 + 8 * fq;
        const int cls = u.pn;
        const float scl = (cls < 2 || cls == 6 || cls == 7) ? QSCALE : 1.0f;
        const bool sig = cls >= 12;
        f32x4 bv[2][2];
#pragma unroll
        for (int bj = 0; bj < 2; ++bj)
#pragma unroll
            for (int n = 0; n < 2; ++n) bv[bj][n] = *(const f32x4*)(bias + col0 + bj * HALF + 4 * n);
#pragma unroll
        for (int ai = 0; ai < 2; ++ai)
#pragma unroll
            for (int m = 0; m < 4; ++m) {
                f16* rowp = O + (size_t)(row0 + ai * HALF + m * 16) * INW + col0;
#pragma unroll
                for (int bj = 0; bj < 2; ++bj) {
                    f32x4 v0 = acc[ai][bj][m][0] + bv[bj][0], v1 = acc[ai][bj][m][1] + bv[bj][1];
                    if (sig) {
#pragma unroll
                        for (int j = 0; j < 4; ++j) { v0[j] = __builtin_amdgcn_rcpf(1.0f + __expf(-v0[j])); v1[j] = __builtin_amdgcn_rcpf(1.0f + __expf(-v1[j])); }
                    } else { v0 *= scl; v1 *= scl; }
                    u32x4 w; w.x = pk2(v0[0], v0[1]); w.y = pk2(v0[2], v0[3]); w.z = pk2(v1[0], v1[1]); w.w = pk2(v1[2], v1[3]);
                    *(u32x4*)(rowp + bj * HALF) = w;
                }
            }
    }
};
__device__ __forceinline__ void phase_inproj(const Params& p, LAS unsigned char* lds, int wg, int nwg) {
    DenseSched<DM> S; S.init(p.ws + WS_XH, p.ws + WS_WIN, TOK, INW, nwg, wg);
    EpiInProj E{(f16*)(p.ws + WS_PROJ), p.in[2]};
    gemm_phase(lds, S, E);
}
constexpr int RT_LOG = 131072, RT_HIST = RT_LOG + 16384;
__device__ __forceinline__ void phase_router(const Params& p, LAS unsigned char* lds, int wg, int nwg) {
    const int tid = get_tid(lds);
    const int lane = tid & 63, wave = tid >> 6;
    const float* h1 = (const float*)(p.ws + WS_H1);
    f16* x1h = (f16*)(p.ws + WS_XH);
    const float* lng = p.in[12]; const float* lnb = p.in[13];
    const float* wr = p.in[14]; const float* br = p.in[15];
    int* cnt = (int*)(p.ws + WS_SMALL + SM_CNT);
    int* tk = (int*)(p.ws + WS_SMALL + SM_TK);
    int2* list = (int2*)(p.ws + WS_SMALL + SM_LIST);
    LAS float* wl = (LAS float*)lds;
    LAS float* slog = (LAS float*)(lds + RT_LOG);
    LAS int* hist = (LAS int*)(lds + RT_HIST);
    LAS int* hbase = hist + 32;
    for (int i = tid; i < DM * 8; i += NTHR) {
        const int col = i >> 3, k = i & 7;
        const float4 v = *(const float4*)(wr + (size_t)col * NEXP + k * 4);
        LAS float* d = wl + col * 32 + ((k ^ ((col >> 1) & 7)) << 2);
        d[0] = v.x; d[1] = v.y; d[2] = v.z; d[3] = v.w;
    }
    if (tid < 32) hist[tid] = 0;
    __syncthreads();
    const int tpw = TOK / (nwg * 8);
    const int tok0 = wg * (TOK / nwg) + wave * tpw;
    float gam[16], bet[16];
#pragma unroll
    for (int r = 0; r < 16; ++r) { gam[r] = lng[r * 64 + lane]; bet[r] = lnb[r * 64 + lane]; }
    float xa[16], xb[16];
#pragma unroll
    for (int r = 0; r < 16; ++r) { xa[r] = h1[(size_t)tok0 * DM + r * 64 + lane]; xb[r] = h1[(size_t)(tok0 + 1) * DM + r * 64 + lane]; }
#pragma unroll 1
    for (int j = 0; j < tpw; j += 2) {
        const int t = tok0 + j;
        float na[16], nb[16];
        if (j + 2 < tpw) {
#pragma unroll
            for (int r = 0; r < 16; ++r) { na[r] = h1[(size_t)(t + 2) * DM + r * 64 + lane]; nb[r] = h1[(size_t)(t + 3) * DM + r * 64 + lane]; }
        } else {
#pragma unroll
            for (int r = 0; r < 16; ++r) { na[r] = 0.f; nb[r] = 0.f; }
        }
        float sa = 0.f, sb = 0.f;
#pragma unroll
        for (int r = 0; r < 16; ++r) { sa += xa[r]; sb += xb[r]; }
        for (int o = 32; o >= 1; o >>= 1) { sa += shx(sa, o, lane); sb += shx(sb, o, lane); }
        const float mua = sa * (1.0f / DM), mub = sb * (1.0f / DM);
        float qa = 0.f, qb = 0.f;
#pragma unroll
        for (int r = 0; r < 16; ++r) { const float da = xa[r] - mua, db = xb[r] - mub; qa += da * da; qb += db * db; }
        for (int o = 32; o >= 1; o >>= 1) { qa += shx(qa, o, lane); qb += shx(qb, o, lane); }
        const float rsa = rsqrtf(qa * (1.0f / DM) + 1e-5f), rsb = rsqrtf(qb * (1.0f / DM) + 1e-5f);
#pragma unroll
        for (int r = 0; r < 16; ++r) {
            xa[r] = (xa[r] - mua) * rsa * gam[r] + bet[r]; xb[r] = (xb[r] - mub) * rsb * gam[r] + bet[r];
            x1h[(size_t)t * DM + r * 64 + lane] = (f16)xa[r]; x1h[(size_t)(t + 1) * DM + r * 64 + lane] = (f16)xb[r];
        }
        float acc[32], acd[32];
#pragma unroll
        for (int e = 0; e < 32; ++e) { acc[e] = 0.f; acd[e] = 0.f; }
#pragma unroll
        for (int r = 0; r < 16; ++r) {
            const int col = r * 64 + lane;
            const LAS float* wrow = wl + col * 32;
            const int sw = (col >> 1) & 7;
#pragma unroll
            for (int k = 0; k < 8; ++k) {
                const f32x4 w4 = *(const LAS f32x4*)(wrow + ((k ^ sw) << 2));
#pragma unroll
                for (int c = 0; c < 4; ++c) { acc[k * 4 + c] = fmaf(xa[r], w4[c], acc[k * 4 + c]); acd[k * 4 + c] = fmaf(xb[r], w4[c], acd[k * 4 + c]); }
            }
        }
#define RT_REDUCE(AC, OUT) do { float a16[16], a8[8], a4[4], a2[2]; \
        { const bool hi_ = (lane & 32) != 0; _Pragma("unroll") for (int k = 0; k < 16; ++k) { const float snd = hi_ ? AC[k] : AC[16 + k]; const float rcv = shx(snd, 32, lane); a16[k] = (hi_ ? AC[16 + k] : AC[k]) + rcv; } } \
        { const bool hi_ = (lane & 16) != 0; _Pragma("unroll") for (int k = 0; k < 8; ++k) { const float snd = hi_ ? a16[k] : a16[8 + k]; const float rcv = shx(snd, 16, lane); a8[k] = (hi_ ? a16[8 + k] : a16[k]) + rcv; } } \
        { const bool hi_ = (lane & 8) != 0; _Pragma("unroll") for (int k = 0; k < 4; ++k) { const float snd = hi_ ? a8[k] : a8[4 + k]; const float rcv = shx(snd, 8, lane); a4[k] = (hi_ ? a8[4 + k] : a8[k]) + rcv; } } \
        { const bool hi_ = (lane & 4) != 0; _Pragma("unroll") for (int k = 0; k < 2; ++k) { const float snd = hi_ ? a4[k] : a4[2 + k]; const float rcv = shx(snd, 4, lane); a2[k] = (hi_ ? a4[2 + k] : a4[k]) + rcv; } } \
        { const bool hi_ = (lane & 2) != 0; const float snd = hi_ ? a2[0] : a2[1]; const float rcv = shx(snd, 2, lane); OUT = (hi_ ? a2[1] : a2[0]) + rcv; } \
        OUT += shx(OUT, 1, lane); } while (0)
        float l0, l1;
        RT_REDUCE(acc, l0); RT_REDUCE(acd, l1);
#undef RT_REDUCE
        if ((lane & 1) == 0) { const float bb = br[lane >> 1]; slog[(wave * tpw + j) * 32 + (lane >> 1)] = l0 + bb; slog[(wave * tpw + j + 1) * 32 + (lane >> 1)] = l1 + bb; }
#pragma unroll
        for (int r = 0; r < 16; ++r) { xa[r] = na[r]; xb[r] = nb[r]; }
    }
    __syncthreads();
    int my_e[4]; float my_g[4]; int my_loc[4];
    const bool act = lane < tpw;
    const int tl = wave * tpw + lane;
    if (act) {
        float v[32];
#pragma unroll
        for (int k = 0; k < 8; ++k) { const f32x4 t4 = *(const LAS f32x4*)(slog + tl * 32 + k * 4); v[k * 4] = t4[0]; v[k * 4 + 1] = t4[1]; v[k * 4 + 2] = t4[2]; v[k * 4 + 3] = t4[3]; }
        float tv[4];
#pragma unroll
        for (int k = 0; k < 4; ++k) {
            float bv = -3.0e38f; int bi = 0;
#pragma unroll
            for (int e = 0; e < 32; ++e) { if (v[e] > bv) { bv = v[e]; bi = e; } }
            tv[k] = bv; my_e[k] = bi;
#pragma unroll
            for (int e = 0; e < 32; ++e) v[e] = (e == bi) ? -3.0e38f : v[e];
        }
        const float e1 = __expf(tv[1] - tv[0]), e2 = __expf(tv[2] - tv[0]), e3 = __expf(tv[3] - tv[0]);
        const float inv = 1.0f / (1.0f + e1 + e2 + e3);
        my_g[0] = inv; my_g[1] = e1 * inv; my_g[2] = e2 * inv; my_g[3] = e3 * inv;
#pragma unroll
        for (int k = 0; k < 4; ++k) my_loc[k] = __hip_atomic_fetch_add(hist + my_e[k], 1, __ATOMIC_RELAXED, __HIP_MEMORY_SCOPE_WORKGROUP);
    }
    __syncthreads();
    if (tid < 32) hbase[tid] = atomicAdd(&cnt[tid], hist[tid]);
    __syncthreads();
    if (act) {
        const int t = tok0 + lane;
#pragma unroll
        for (int k = 0; k < 4; ++k) {
            const int slot = hbase[my_e[k]] + my_loc[k];
            tk[t * 4 + k] = (my_e[k] << 20) | slot;
            list[(size_t)my_e[k] * LISTCAP + slot] = make_int2(t, __float_as_int(my_g[k]));
        }
    }
    __syncthreads();
}

__device__ __forceinline__ void phase_final(const Params& p, LAS unsigned char* lds, int wg, int nwg) {
    const int tid = get_tid(lds);
    const int lane = tid & 63, wave = tid >> 6;
    const f16* x1h = (const f16*)(p.ws + WS_XH);
    const f16* ys = (const f16*)(p.ws + WS_YS);
    const int* cnt = (const int*)(p.ws + WS_SMALL + SM_CNT);
    const int* tk = (const int*)(p.ws + WS_SMALL + SM_TK);
    const float* lng = p.in[20]; const float* lnb = p.in[21];
    LAS int* ps = (LAS int*)lds;
    if (tid == 0) { int a = 0; for (int e = 0; e < NEXP; ++e) { ps[e] = a; a += (cnt[e] + ROWPAD - 1) / ROWPAD * ROWPAD; } }
    __syncthreads();
    const int tpw = TOK / (nwg * 8);
    const int tok0 = wg * (TOK / nwg) + wave * tpw;
    for (int j = 0; j < tpw; ++j) {
        const int t = tok0 + j;
        float v[16];
        { const f16x8 a = *(const f16x8*)(x1h + (size_t)t * DM + 8 * lane), b = *(const f16x8*)(x1h + (size_t)t * DM + 512 + 8 * lane);
#pragma unroll
          for (int i = 0; i < 8; ++i) { v[i] = ALPHA * (float)a[i]; v[8 + i] = ALPHA * (float)b[i]; } }
#pragma unroll
        for (int k = 0; k < 4; ++k) {
            const int c = tk[t * 4 + k]; const int row = ps[c >> 20] + (c & 0xFFFFF);
            const f16x8 a = *(const f16x8*)(ys + (size_t)row * DM + 8 * lane), b = *(const f16x8*)(ys + (size_t)row * DM + 512 + 8 * lane);
#pragma unroll
            for (int i = 0; i < 8; ++i) { v[i] += (float)a[i]; v[8 + i] += (float)b[i]; }
        }
        float s = 0.f;
#pragma unroll
        for (int i = 0; i < 16; ++i) s += v[i];
        for (int o = 32; o >= 1; o >>= 1) s += shx(s, o, lane);
        const float mu = s * (1.0f / DM);
        float q = 0.f;
#pragma unroll
        for (int i = 0; i < 16; ++i) { const float d = v[i] - mu; q += d * d; }
        for (int o = 32; o >= 1; o >>= 1) q += shx(q, o, lane);
        const float rs = rsqrtf(q * (1.0f / DM) + 1e-5f);
        float* op = p.out + (size_t)t * DM;
#pragma unroll
        for (int hh = 0; hh < 2; ++hh) {
            const int c0 = hh * 512 + 8 * lane;
            const float4 g0 = *(const float4*)(lng + c0), g1 = *(const float4*)(lng + c0 + 4), b0 = *(const float4*)(lnb + c0), b1 = *(const float4*)(lnb + c0 + 4);
            float4 o0, o1;
            o0.x = (v[hh * 8 + 0] - mu) * rs * g0.x + b0.x; o0.y = (v[hh * 8 + 1] - mu) * rs * g0.y + b0.y; o0.z = (v[hh * 8 + 2] - mu) * rs * g0.z + b0.z; o0.w = (v[hh * 8 + 3] - mu) * rs * g0.w + b0.w;
            o1.x = (v[hh * 8 + 4] - mu) * rs * g1.x + b1.x; o1.y = (v[hh * 8 + 5] - mu) * rs * g1.y + b1.y; o1.z = (v[hh * 8 + 6] - mu) * rs * g1.z + b1.z; o1.w = (v[hh * 8 + 7] - mu) * rs * g1.w + b1.w;
            *(float4*)(op + c0) = o0; *(float4*)(op + c0 + 4) = o1;
        }
    }
    __syncthreads();
}
struct MergeSched {
    static constexpr int K = 1024, LDB = 512, MID = 8;
    static constexpr unsigned OB_JUMP = (unsigned)(TOK * 512 * 2) - 1024u, WB_JUMP = (unsigned)(DM * 512 * 2) - 1024u;
    const char* A; const char* Bt; DenseSched<512> D;
    __device__ void init(const void* oa, const void* wpa_t, int G, int c) { A = (const char*)oa; Bt = (const char*)wpa_t; D.init(oa, wpa_t, TOK, DM, G, c); }
    __device__ __forceinline__ bool next(int i, Unit& u) const { return D.next(i, u); }
    static __device__ __forceinline__ unsigned ka(int kt) { return (unsigned)kt * 128u + (kt >= 8 ? OB_JUMP : 0u); }
    static __device__ __forceinline__ unsigned kb(int kt) { return (unsigned)kt * 128u + (kt >= 8 ? WB_JUMP : 0u); }
    static __device__ __forceinline__ unsigned make_rc(int R, int C) { return (unsigned)(R * 512 + C) * 2u; }
    __device__ __forceinline__ void a_desc(const Unit& u, const unsigned (&rc)[2], unsigned (&ad)[2]) const { const unsigned o = (unsigned)u.pm * (unsigned)(BM * 512 * 2); ad[0] = rc[0] + o; ad[1] = rc[1] + o; }
    static __device__ __forceinline__ unsigned aoff(unsigned ad, unsigned rc, int h) { return ad + (unsigned)h * (unsigned)(HALF * 512 * 2); }
    __device__ __forceinline__ const char* b_base(const Unit& u) const { return Bt + (size_t)u.pn * BM * 512 * 2; }
};
struct EpiMerge {
    static constexpr bool PERM = true;
    const f16* proj; f16* merged;
    __device__ __forceinline__ void mid(f32x4 (&acc)[2][2][4][2], const Unit& u, int wr, int wc, int fr, int fq) const {
        asm volatile("" : "+v"(fr), "+v"(fq));
        const int row0 = u.pm * BM + wr * 64 + fr, col0 = u.pn * BM + wc * 32 + 8 * fq;
#pragma unroll
        for (int ai = 0; ai < 2; ++ai)
#pragma unroll
            for (int m = 0; m < 4; ++m) {
                const size_t row = (size_t)(row0 + ai * HALF + m * 16);
#pragma unroll
                for (int bj = 0; bj < 2; ++bj) {
                    const f16x8 ga = *(const f16x8*)(proj + row * INW + C_GA + col0 + bj * HALF), gb = *(const f16x8*)(proj + row * INW + C_GB + col0 + bj * HALF);
#pragma unroll
                    for (int j = 0; j < 4; ++j) {
                        acc[ai][bj][m][0][j] *= (float)ga[j] * __builtin_amdgcn_rcpf(fmaxf((float)gb[j], 5.9604645e-8f));
                        acc[ai][bj][m][1][j] *= (float)ga[4 + j] * __builtin_amdgcn_rcpf(fmaxf((float)gb[4 + j], 5.9604645e-8f));
                    }
                }
                asm volatile("" ::: "memory");
            }
    }
    __device__ __forceinline__ void operator()(const f32x4 (&acc)[2][2][4][2], const Unit& u, int wr, int wc, int fr, int fq) const {
        const int row0 = u.pm * BM + wr * 64 + fr, col0 = u.pn * BM + wc * 32 + 8 * fq;
#pragma unroll
        for (int ai = 0; ai < 2; ++ai)
#pragma unroll
            for (int m = 0; m < 4; ++m) {
                const size_t row = (size_t)(row0 + ai * HALF + m * 16);
#pragma unroll
                for (int bj = 0; bj < 2; ++bj) {
                    const f16x8 gb = *(const f16x8*)(proj + row * INW + C_GB + col0 + bj * HALF);
                    float v[8];
#pragma unroll
                    for (int j = 0; j < 4; ++j) { v[j] = fmaxf((float)gb[j], 5.9604645e-8f) * acc[ai][bj][m][0][j]; v[4 + j] = fmaxf((float)gb[4 + j], 5.9604645e-8f) * acc[ai][bj][m][1][j]; }
                    u32x4 w; w.x = pk2(v[0], v[1]); w.y = pk2(v[2], v[3]); w.z = pk2(v[4], v[5]); w.w = pk2(v[6], v[7]);
                    *(u32x4*)(merged + row * DM + col0 + bj * HALF) = w;
                }
            }
    }
};
__device__ __forceinline__ void phase_merge(const Params& p, LAS unsigned char* lds, int wg, int nwg) {
    MergeSched S; S.init(p.ws + WS_OAB, p.ws + WS_WPA, nwg, wg);
    EpiMerge E{(const f16*)(p.ws + WS_PROJ), (f16*)(p.ws + WS_MERGED)};
    gemm_phase(lds, S, E);
}
struct EpiOutProj {
    static constexpr bool PERM = false;
    const float* x; const float* bias; float* h1;
    __device__ __forceinline__ void operator()(const f32x4 (&acc)[2][2][4][2], const Unit& u, int wr, int wc, int fr, int fq) const {
        const int row0 = u.pm * BM + wr * 64 + fr, col0 = u.pn * BM + wc * 32 + 4 * fq;
        f32x4 bv[2][2];
#pragma unroll
        for (int bj = 0; bj < 2; ++bj)
#pragma unroll
            for (int n = 0; n < 2; ++n) bv[bj][n] = *(const f32x4*)(bias + col0 + bj * HALF + n * 16);
#pragma unroll
        for (int ai = 0; ai < 2; ++ai)
#pragma unroll
            for (int m = 0; m < 4; ++m) {
                const size_t off = (size_t)(row0 + ai * HALF + m * 16) * DM + col0;
#pragma unroll
                for (int bj = 0; bj < 2; ++bj)
#pragma unroll
                    for (int n = 0; n < 2; ++n) {
                        const f32x4 xv = *(const f32x4*)(x + off + bj * HALF + n * 16);
                        *(f32x4*)(h1 + off + bj * HALF + n * 16) = ALPHA * xv + acc[ai][bj][m][n] + bv[bj][n];
                    }
            }
    }
};
__device__ __forceinline__ void phase_outproj(const Params& p, LAS unsigned char* lds, int wg, int nwg) {
    DenseSched<DM> S; S.init(p.ws + WS_MERGED, p.ws + WS_WOUT, TOK, DM, nwg, wg);
    EpiOutProj E{p.in[0], p.in[11], (float*)(p.ws + WS_H1)};
    gemm_phase(lds, S, E);
}

constexpr int MOE_MISC = STAGE_BYTES;
__device__ __forceinline__ void moe_prefix(const Params& p, LAS unsigned char* lds) {
    LAS int* tpre = (LAS int*)(lds + MOE_MISC); LAS int* ecnt = tpre + 64;
    const int* cnt = (const int*)(p.ws + WS_SMALL + SM_CNT);
    if (get_tid(lds) == 0) { int a = 0; for (int e = 0; e < NEXP; ++e) { const int c = cnt[e]; ecnt[e] = c; tpre[e] = a; a += (c + ROWPAD - 1) / ROWPAD; } tpre[NEXP] = a; }
    __syncthreads();
}
template <int NPN, bool GATHER>
struct MoeSched {
    static constexpr int K = DM;
    const char* A; const char* Bt; const int2* list; LAS int* tpre; LAS int* ecnt; int c;
    __device__ __forceinline__ bool next(int i, Unit& u) const {
        constexpr int MPR = 256 / NPN, MPX = 32 / NPN;
        const int xcd = c & 7, j = c >> 3;
        const int M = i * MPR + xcd * MPX + j / NPN;
        if (M >= tpre[NEXP]) return false;
        int e = 0;
        for (int k = 1; k < NEXP; ++k) e += (tpre[k] <= M) ? 1 : 0;
        u.e = e; u.pm = M - tpre[e]; u.pn = j % NPN; u.row0 = M * ROWPAD; u.nrows = ecnt[e] - u.pm * ROWPAD;
        return true;
    }
    static constexpr int LDB = DM, MID = -1;
    static __device__ __forceinline__ unsigned ka(int kt) { return (unsigned)kt * 128u; }
    static __device__ __forceinline__ unsigned kb(int kt) { return (unsigned)kt * 128u; }
    static __device__ __forceinline__ unsigned make_rc(int R, int C) { return GATHER ? ((unsigned)R | ((unsigned)(2 * C) << 8)) : (unsigned)(R * K + C) * 2u; }
    __device__ __forceinline__ void a_desc(const Unit& u, const unsigned (&rc)[2], unsigned (&ad)[2]) const {
        if (GATHER) {
#pragma unroll
            for (int i = 0; i < 2; ++i) {
                const int R = (int)(rc[i] & 0xFFu);
                const int2* lp = list + (size_t)u.e * LISTCAP + u.pm * ROWPAD + R;
                int t0 = lp[0].x, t1 = lp[HALF].x;
                t0 = R < u.nrows ? t0 : 0; t1 = (R + HALF) < u.nrows ? t1 : 0;
                ad[i] = (unsigned)t0 | ((unsigned)t1 << 16);
            }
            asm volatile("" : "+v"(ad[0]), "+v"(ad[1]));
        } else { ad[0] = rc[0] + (unsigned)u.row0 * (unsigned)(K * 2); ad[1] = rc[1] + (unsigned)u.row0 * (unsigned)(K * 2); }
    }
    static __device__ __forceinline__ unsigned aoff(unsigned ad, unsigned rc, int h) {
        return GATHER ? (((ad >> (16 * h)) & 0xFFFFu) * (unsigned)(K * 2) + (rc >> 8)) : (ad + (unsigned)h * (unsigned)(HALF * K * 2)); }
    __device__ __forceinline__ const char* b_base(const Unit& u) const { return Bt + ((size_t)u.e * (NPN * BM) + (size_t)u.pn * BM) * K * 2; }
};
struct EpiUp {
    static constexpr bool PERM = true;
    const float* bup; f16* act;
    __device__ __forceinline__ void operator()(const f32x4 (&acc)[2][2][4][2], const Unit& u, int wr, int wc, int fr, int fq) const {
        const int col0 = u.pn * HALF + wc * 32 + 8 * fq;
        const float* bg = bup + (size_t)u.e * 2048 + col0; const float* bu = bg + 1024;
        const f32x4 bg0 = *(const f32x4*)bg, bg1 = *(const f32x4*)(bg + 4), bu0 = *(const f32x4*)bu, bu1 = *(const f32x4*)(bu + 4);
#pragma unroll
        for (int ai = 0; ai < 2; ++ai)
#pragma unroll
            for (int m = 0; m < 4; ++m) {
                const size_t row = (size_t)(u.row0 + ai * HALF + wr * 64 + m * 16 + fr);
                float v[8];
#pragma unroll
                for (int n = 0; n < 2; ++n)
#pragma unroll
                    for (int j = 0; j < 4; ++j) {
                        const float hg = acc[ai][0][m][n][j] + (n == 0 ? bg0[j] : bg1[j]), hu = acc[ai][1][m][n][j] + (n == 0 ? bu0[j] : bu1[j]);
                        const float gate = fminf(hg, 7.0f), up = fminf(fmaxf(hu, -7.0f), 7.0f);
                        v[n * 4 + j] = gate * __builtin_amdgcn_rcpf(1.0f + __expf(-1.702f * gate)) * (up + 1.0f);
                    }
                u32x4 w; w.x = pk2(v[0], v[1]); w.y = pk2(v[2], v[3]); w.z = pk2(v[4], v[5]); w.w = pk2(v[6], v[7]);
                *(u32x4*)(act + row * DM + col0) = w;
            }
    }
};
struct EpiDown {
    static constexpr bool PERM = true;
    const float* bdn; const int2* list; f16* ys;
    __device__ __forceinline__ void operator()(const f32x4 (&acc)[2][2][4][2], const Unit& u, int wr, int wc, int fr, int fq) const {
        const int col0 = u.pn * BM + wc * 32 + 8 * fq;
        f32x4 bv[2][2];
#pragma unroll
        for (int bj = 0; bj < 2; ++bj)
#pragma unroll
            for (int n = 0; n < 2; ++n) bv[bj][n] = *(const f32x4*)(bdn + (size_t)u.e * DM + col0 + bj * HALF + 4 * n);
#pragma unroll
        for (int ai = 0; ai < 2; ++ai)
#pragma unroll
            for (int m = 0; m < 4; ++m) {
                const int lr = ai * HALF + wr * 64 + m * 16 + fr;
                float wgt = __int_as_float(list[(size_t)u.e * LISTCAP + u.pm * ROWPAD + lr].y); wgt = lr < u.nrows ? wgt : 0.f;
                f16* rowp = ys + (size_t)(u.row0 + lr) * DM + col0;
#pragma unroll
                for (int bj = 0; bj < 2; ++bj) {
                    const f32x4 v0 = (acc[ai][bj][m][0] + bv[bj][0]) * wgt, v1 = (acc[ai][bj][m][1] + bv[bj][1]) * wgt;
                    u32x4 w; w.x = pk2(v0[0], v0[1]); w.y = pk2(v0[2], v0[3]); w.z = pk2(v1[0], v1[1]); w.w = pk2(v1[2], v1[3]);
                    *(u32x4*)(rowp + bj * HALF) = w;
                }
            }
    }
};
__device__ __forceinline__ void phase_up(const Params& p, LAS unsigned char* lds, int wg, int nwg) {
    moe_prefix(p, lds);
    MoeSched<8, true> S{(const char*)(p.ws + WS_XH), (const char*)(p.ws + WS_WUP), (const int2*)(p.ws + WS_SMALL + SM_LIST), (LAS int*)(lds + MOE_MISC), (LAS int*)(lds + MOE_MISC) + 64, wg};
    EpiUp E{p.in[17], (f16*)(p.ws + WS_PROJ)};
    gemm_phase(lds, S, E);
}
__device__ __forceinline__ void phase_down(const Params& p, LAS unsigned char* lds, int wg, int nwg) {
    moe_prefix(p, lds);
    MoeSched<4, false> S{(const char*)(p.ws + WS_PROJ), (const char*)(p.ws + WS_WDN), (const int2*)(p.ws + WS_SMALL + SM_LIST), (LAS int*)(lds + MOE_MISC), (LAS int*)(lds + MOE_MISC) + 64, wg};
    EpiDown E{p.in[19], (const int2*)(p.ws + WS_SMALL + SM_LIST), (f16*)(p.ws + WS_YS)};
    gemm_phase(lds, S, E);
}
__device__ __forceinline__ float lambda_full(const float* lq1, const float* lk1, const float* lq2, const float* lk2, int lane) {
    float a = lq1[lane] * lk1[lane], c = lq2[lane] * lk2[lane];
    for (int o = 32; o >= 1; o >>= 1) { a += shx(a, o, lane); c += shx(c, o, lane); }
    return __expf(a) - __expf(c) + LAMBDA_INIT;
}
typedef short s16x4 __attribute__((ext_vector_type(4)));
__device__ __forceinline__ int crow(int r, int hi) { return (r & 3) + 8 * (r >> 2) + 4 * hi; }
__device__ __forceinline__ f16x4 vtr(const LAS unsigned char* p) { return __builtin_bit_cast(f16x4, __builtin_amdgcn_ds_read_tr16_b64_v4i16((LAS s16x4*)p)); }
#define MFMA32(a, b, c) __builtin_amdgcn_mfma_f32_32x32x16_f16(a, b, c, 0, 0, 0)
__device__ __forceinline__ float rowmax32(const f32x16& p0, const f32x16& p1) {
    float a = fmaxf(fmaxf(p0[0], p0[1]), p1[0]), b = fmaxf(fmaxf(p0[2], p0[3]), p1[1]); a = fmaxf(fmaxf(a, p1[2]), p1[3]);
#pragma unroll
    for (int r = 4; r < 16; r += 4) { a = fmaxf(fmaxf(a, p0[r]), p0[r + 1]); b = fmaxf(fmaxf(b, p0[r + 2]), p0[r + 3]); a = fmaxf(fmaxf(a, p1[r]), p1[r + 1]); b = fmaxf(fmaxf(b, p1[r + 2]), p1[r + 3]); }
    float m = fmaxf(a, b); auto rr = __builtin_amdgcn_permlane32_swap(__float_as_uint(m), __float_as_uint(m), false, false);
    return fmaxf(__uint_as_float(rr[0]), __uint_as_float(rr[1]));
}
__device__ __forceinline__ float half_sum(float v) { auto rr = __builtin_amdgcn_permlane32_swap(__float_as_uint(v), __float_as_uint(v), false, false); return __uint_as_float(rr[0]) + __uint_as_float(rr[1]); }

constexpr int AB_QSTR = 4160;
constexpr int AB_STG = 16384 + 4 * AB_QSTR;
constexpr int AB_STGS = 33280;
constexpr int AB_WSF = 131072;
constexpr float AB_THR = 8.0f;

__device__ __forceinline__ void phase_attnB(const Params& p, LAS unsigned char* lds, int wg, int nwg) {
    const int tid = get_tid(lds);
    const int lane = tid & 63, r32 = lane & 31, hi = lane >> 5;
    const int wave = __builtin_amdgcn_readfirstlane(tid >> 6), map = wave >> 2, qsub = wave & 3;
    const f16* proj = (const f16*)(p.ws + WS_PROJ);
    f16* ob = (f16*)(p.ws + WS_OAB) + (size_t)TOK * 512;
    const float lam = lambda_full(p.in[3], p.in[4], p.in[5], p.in[6], lane);
    const float* subg = p.in[7];
    LAS float* wsf = (LAS float*)(lds + AB_WSF) + wave * 32;
    const int ksw = (r32 >> 1) & 7;
    int koff[4];
#pragma unroll
    for (int d0 = 0; d0 < 4; ++d0) koff[d0] = r32 * 128 + (((2 * d0 + hi) ^ ksw) << 4);
    const int vl = ((lane >> 4) & 1) * 32 + (lane & 3) * 8 + (4 * hi + ((lane & 15) >> 2)) * 64;
    const int krow = tid >> 3, kch = tid & 7;
    const int kw_off = krow * 128 + ((kch ^ ((krow >> 1) & 7)) << 4);
    int vrow[2], vc16[2], vw_off[2];
#pragma unroll
    for (int j = 0; j < 2; ++j) { const int idx = tid + j * NTHR; vrow[j] = idx >> 4; vc16[j] = idx & 15; vw_off[j] = (vc16[j] >> 2) * AB_QSTR + vrow[j] * 64 + (vc16[j] & 3) * 16; }

    for (int ui = 0; ui < 4; ++ui) {
        const int bh = 8 * ui + (wg & 7), qb = wg >> 3;
        const int b = bh >> 2, h = bh & 3;
        const float sl2 = slope_of(3 * h + 2) * LOG2E;
        const f16* base = proj + (size_t)b * SEQ * INW;
        const int q0 = qb * 128 + qsub * 32, qpos = q0 + r32;
        f16x8 qr[4];
#pragma unroll
        for (int d0 = 0; d0 < 4; ++d0) qr[d0] = *(const f16x8*)(base + (size_t)qpos * INW + C_QB + h * 128 + map * 64 + 16 * d0 + 8 * hi);
        const f16* gk1 = base + (size_t)krow * INW + C_KB + h * 128 + kch * 8;
        const f16* gv0 = base + (size_t)vrow[0] * INW + C_VB + h * 128 + vc16[0] * 8;
        const f16* gv1 = base + (size_t)vrow[1] * INW + C_VB + h * 128 + vc16[1] * 8;
        u32x4 g0, g1, g2, g3;
        g0 = *(const u32x4*)gk1; g1 = *(const u32x4*)(gk1 + 64); g2 = *(const u32x4*)gv0; g3 = *(const u32x4*)gv1;
        *(LAS u32x4*)(lds + kw_off) = g0; *(LAS u32x4*)(lds + 8192 + kw_off) = g1; *(LAS u32x4*)(lds + 16384 + vw_off[0]) = g2; *(LAS u32x4*)(lds + 16384 + vw_off[1]) = g3;
        __syncthreads();
        f32x16 o[4];
#pragma unroll
        for (int i = 0; i < 4; ++i) o[i] = (f32x16){0.f, 0.f, 0.f, 0.f, 0.f, 0.f, 0.f, 0.f, 0.f, 0.f, 0.f, 0.f, 0.f, 0.f, 0.f, 0.f};
        float m = -1.0e30f, l = 0.f;
        for (int t = 0; t < SEQ / 64; ++t) {
            const int kb = t * 64;
            if (t + 1 < SEQ / 64) {
                const size_t adv = (size_t)(kb + 64) * INW;
                g0 = *(const u32x4*)(gk1 + adv); g1 = *(const u32x4*)(gk1 + adv + 64); g2 = *(const u32x4*)(gv0 + adv); g3 = *(const u32x4*)(gv1 + adv);
            }
            const LAS unsigned char* st = lds + (t & 1) * AB_STGS;
            const LAS unsigned char* kbse = st + map * 8192;
            f32x16 s0 = (f32x16){0.f, 0.f, 0.f, 0.f, 0.f, 0.f, 0.f, 0.f, 0.f, 0.f, 0.f, 0.f, 0.f, 0.f, 0.f, 0.f}, s1 = s0;
#pragma unroll
            for (int d0 = 0; d0 < 4; ++d0) {
                const f16x8 a0 = *(const LAS f16x8*)(kbse + koff[d0]), a1 = *(const LAS f16x8*)(kbse + 4096 + koff[d0]);
                s0 = MFMA32(a0, qr[d0], s0); s1 = MFMA32(a1, qr[d0], s1);
            }
            const float dq0 = (float)(qpos - kb - 4 * hi);
#pragma unroll
            for (int r = 0; r < 16; ++r) {
                const float c = (float)((r & 3) + 8 * (r >> 2));
                s0[r] = __builtin_fmaf(-sl2, __builtin_fabsf(dq0 - c), s0[r]);
                s1[r] = __builtin_fmaf(-sl2, __builtin_fabsf(dq0 - 32.0f - c), s1[r]);
            }
            const float mx = rowmax32(s0, s1);
            if (__any(mx > m + AB_THR)) {
                const float mn = fmaxf(m, mx), al = __builtin_amdgcn_exp2f(m - mn);
                l *= al; m = mn;
                if (hi == 0) wsf[r32] = al;
#pragma unroll
                for (int r = 0; r < 16; ++r) { const float f = wsf[crow(r, hi)];
#pragma unroll
                    for (int i = 0; i < 4; ++i) o[i][r] *= f; }
            }
            float ls = 0.f;
#pragma unroll
            for (int r = 0; r < 16; ++r) { s0[r] = __builtin_amdgcn_exp2f(s0[r] - m); s1[r] = __builtin_amdgcn_exp2f(s1[r] - m); ls += s0[r] + s1[r]; }
            l += ls;
            u32x4 pw[4];
            pw[0] = (u32x4){pk2(s0[0], s0[1]), pk2(s0[2], s0[3]), pk2(s0[4], s0[5]), pk2(s0[6], s0[7])};
            pw[1] = (u32x4){pk2(s0[8], s0[9]), pk2(s0[10], s0[11]), pk2(s0[12], s0[13]), pk2(s0[14], s0[15])};
            pw[2] = (u32x4){pk2(s1[0], s1[1]), pk2(s1[2], s1[3]), pk2(s1[4], s1[5]), pk2(s1[6], s1[7])};
            pw[3] = (u32x4){pk2(s1[8], s1[9]), pk2(s1[10], s1[11]), pk2(s1[12], s1[13]), pk2(s1[14], s1[15])};
            const LAS unsigned char* vb = st + 16384 + vl;
#pragma unroll
            for (int ks = 0; ks < 4; ++ks)
#pragma unroll
                for (int dq = 0; dq < 4; ++dq) {
                    const f16x4 lo = vtr(vb + dq * AB_QSTR + ks * 1024), hh = vtr(vb + dq * AB_QSTR + ks * 1024 + 512);
                    const f16x8 vf = (f16x8){lo[0], lo[1], lo[2], lo[3], hh[0], hh[1], hh[2], hh[3]};
                    o[dq] = MFMA32(__builtin_bit_cast(f16x8, pw[ks]), vf, o[dq]);
                }
            if (t + 1 < SEQ / 64) {
                LAS unsigned char* ns = lds + ((t + 1) & 1) * AB_STGS;
                *(LAS u32x4*)(ns + kw_off) = g0; *(LAS u32x4*)(ns + 8192 + kw_off) = g1; *(LAS u32x4*)(ns + 16384 + vw_off[0]) = g2; *(LAS u32x4*)(ns + 16384 + vw_off[1]) = g3;
            }
            __syncthreads();
        }
        l = half_sum(l);
        if (hi == 0) wsf[r32] = 1.0f / l;
        LAS float* ost = (LAS float*)lds + (size_t)map * 128 * 128;
#pragma unroll
        for (int r = 0; r < 16; ++r) { const float il = wsf[crow(r, hi)]; const int row = qsub * 32 + crow(r, hi);
#pragma unroll
            for (int i = 0; i < 4; ++i) ost[row * 128 + i * 32 + r32] = o[i][r] * il; }
        __syncthreads();
        {
            const LAS float* o1 = (const LAS float*)lds; const LAS float* o2 = o1 + 128 * 128;
            const float g0s = subg[lane], g1s = subg[64 + lane];
            for (int rr = 0; rr < 16; ++rr) {
                const int row = wave * 16 + rr;
                const float v0 = o1[row * 128 + lane] - lam * o2[row * 128 + lane], v1 = o1[row * 128 + 64 + lane] - lam * o2[row * 128 + 64 + lane];
                float ss = v0 * v0 + v1 * v1;
                for (int of = 32; of >= 1; of >>= 1) ss += shx(ss, of, lane);
                const float rs = rsqrtf(ss * (1.0f / 128.0f) + 1e-5f) * (1.0f - LAMBDA_INIT);
                f16* op = ob + ((size_t)b * SEQ + qb * 128 + row) * 512 + h * 128;
                op[lane] = (f16)(v0 * rs * g0s); op[64 + lane] = (f16)(v1 * rs * g1s);
            }
        }
        __syncthreads();
    }
}
constexpr int AA_HSTR = 2112;
constexpr int AA_BUF = 2 * AA_HSTR;
constexpr int AA_KBUF = 4096;
constexpr int AA_WAVE = 2 * AA_BUF + 2 * AA_KBUF + 128;
constexpr float AA_THR = 8.0f;
__device__ __forceinline__ float rowmax16(const f32x16& p0) {
    float a = fmaxf(fmaxf(p0[0], p0[1]), p0[2]), b = fmaxf(fmaxf(p0[3], p0[4]), p0[5]);
    a = fmaxf(fmaxf(a, p0[6]), p0[7]); b = fmaxf(fmaxf(b, p0[8]), p0[9]); a = fmaxf(fmaxf(a, p0[10]), p0[11]); b = fmaxf(fmaxf(b, p0[12]), p0[13]);
    a = fmaxf(fmaxf(a, p0[14]), p0[15]);
    float m = fmaxf(a, b); auto rr = __builtin_amdgcn_permlane32_swap(__float_as_uint(m), __float_as_uint(m), false, false);
    return fmaxf(__uint_as_float(rr[0]), __uint_as_float(rr[1]));
}
__device__ __forceinline__ void phase_attnA(const Params& p, LAS unsigned char* lds, int wg, int nwg) {
    const int tid = get_tid(lds);
    const int lane = tid & 63, r32 = lane & 31, hi = lane >> 5;
    const int wave = __builtin_amdgcn_readfirstlane(tid >> 6);
    const f16* proj = (const f16*)(p.ws + WS_PROJ);
    f16* oa = (f16*)(p.ws + WS_OAB);
    LAS unsigned char* wl = lds + wave * AA_WAVE;
    LAS float* wsf = (LAS float*)(wl + 2 * AA_BUF + 2 * AA_KBUF);
    const int kw0 = (lane >> 3) * 128 + (((lane & 7) ^ (((lane >> 3) >> 1) & 7)) << 4);
    const int kr0 = r32 * 128, kx = (hi ^ ((r32 >> 1) & 7)) << 4;
    const int vl = ((lane >> 4) & 1) * 32 + (lane & 3) * 8 + (4 * hi + ((lane & 15) >> 2)) * 64;
    const int vrow0 = lane >> 3, vch0 = lane & 7, vw0 = (vch0 >> 2) * AA_HSTR + vrow0 * 64 + (vch0 & 3) * 16;
    constexpr int NTILE = 33;
#pragma unroll 1
    for (int ui = 0; ui < 4; ++ui) {
        const int j = wg >> 3, bh = ui * 16 + (wg & 7) * 2 + (j >> 4), r16 = j & 15;
        const int b = bh >> 3, h = bh & 7;
        const float sl2 = slope_of(h + (h >> 1)) * LOG2E;
        const f16* base = proj + (size_t)b * SEQ * INW;
        const int P0 = r16 + 512 * wave, qpos = P0 + 16 * r32;
        f16x8 qr[4];
#pragma unroll
        for (int d0 = 0; d0 < 4; ++d0) qr[d0] = *(const f16x8*)(base + (size_t)qpos * INW + C_QA + h * 64 + 16 * d0 + 8 * hi);
        f32x16 o[2];
        o[0] = (f32x16){0.f, 0.f, 0.f, 0.f, 0.f, 0.f, 0.f, 0.f, 0.f, 0.f, 0.f, 0.f, 0.f, 0.f, 0.f, 0.f}; o[1] = o[0];
        float m = -1.0e30f, l = 0.f;
        u32x4 kS[4], vA[4];
#define AA_PARAMS(tt, d, n) const int d = (tt) < 5 ? 16 : ((tt) < 13 ? 4 : 1), n = (tt) < 5 ? (tt) : ((tt) < 13 ? (tt) - 5 : (tt) - 13)
#define AA_LOADK(tt, KS) do { AA_PARAMS(tt, d_, n_); const int kb_ = P0 - 64 * d_ + 32 * d_ * n_; \
            _Pragma("unroll") for (int jj = 0; jj < 4; ++jj) { int kp = kb_ + d_ * (vrow0 + 8 * jj); kp = kp < 0 ? 0 : (kp > SEQ - 1 ? SEQ - 1 : kp); \
              KS[jj] = *(const u32x4*)(base + (size_t)kp * INW + C_KA + h * 64 + vch0 * 8); } } while (0)
#define AA_LOADV(tt, VS) do { AA_PARAMS(tt, d_, n_); const int kb_ = P0 - 64 * d_ + 32 * d_ * n_; \
            _Pragma("unroll") for (int jj = 0; jj < 4; ++jj) { int kp = kb_ + d_ * (vrow0 + 8 * jj); kp = kp < 0 ? 0 : (kp > SEQ - 1 ? SEQ - 1 : kp); \
              VS[jj] = *(const u32x4*)(base + (size_t)kp * INW + C_VA + h * 64 + vch0 * 8); } } while (0)
#define AA_STEP(tt) do { \
            LAS unsigned char* vbuf = wl + ((tt) & 1) * AA_BUF; \
            LAS unsigned char* kbuf = wl + 2 * AA_BUF + ((tt) & 1) * AA_KBUF; \
            _Pragma("unroll") for (int jj = 0; jj < 4; ++jj) { *(LAS u32x4*)(vbuf + vw0 + jj * 512) = vA[jj]; *(LAS u32x4*)(kbuf + ((kw0 + jj * 1024) ^ ((jj & 1) << 6))) = kS[jj]; } \
            if ((tt) + 1 < NTILE) { AA_LOADK((tt) + 1, kS); AA_LOADV((tt) + 1, vA); } \
            AA_PARAMS(tt, d, n); \
            const int kb = P0 - 64 * d + 32 * d * n; \
            f32x16 s = (f32x16){0.f, 0.f, 0.f, 0.f, 0.f, 0.f, 0.f, 0.f, 0.f, 0.f, 0.f, 0.f, 0.f, 0.f, 0.f, 0.f}; \
            _Pragma("unroll") for (int d0 = 0; d0 < 4; ++d0) { const f16x8 kf = *(const LAS f16x8*)(kbuf + kr0 + ((d0 << 5) ^ kx)); s = MFMA32(kf, qr[d0], s); } \
            const float df = (float)d, basef = (float)(d * (32 * n + 4 * hi - 64) - 16 * r32), lim = 64.0f * df; \
            const bool need_range = (kb < 0) || (kb + 31 * d >= SEQ); \
            const float kpf0 = (float)(kb + 4 * hi * d); \
            if (need_range) { \
                _Pragma("unroll") for (int r = 0; r < 16; ++r) { \
                    const float c = (float)((r & 3) + 8 * (r >> 2)); \
                    const float ad = __builtin_fabsf(__builtin_fmaf(df, c, basef)), kpf = __builtin_fmaf(df, c, kpf0); \
                    const bool valid = (ad <= lim) && (kpf >= 0.0f) && (kpf < (float)SEQ); \
                    s[r] = valid ? __builtin_fmaf(-sl2, ad, s[r]) : -INFINITY; } \
            } else { \
                _Pragma("unroll") for (int r = 0; r < 16; ++r) { \
                    const float c = (float)((r & 3) + 8 * (r >> 2)); \
                    const float ad = __builtin_fabsf(__builtin_fmaf(df, c, basef)); \
                    s[r] = (ad <= lim) ? __builtin_fmaf(-sl2, ad, s[r]) : -INFINITY; } \
            } \
            const float mx = rowmax16(s); \
            if (__any(mx > m + AA_THR)) { \
                const float mn = fmaxf(m, mx), al = __builtin_amdgcn_exp2f(m - mn); \
                l *= al; m = mn; \
                if (hi == 0) wsf[r32] = al; \
                _Pragma("unroll") for (int r = 0; r < 16; ++r) { const float f = wsf[crow(r, hi)]; o[0][r] *= f; o[1][r] *= f; } } \
            float ls = 0.f; \
            _Pragma("unroll") for (int r = 0; r < 16; ++r) { s[r] = __builtin_amdgcn_exp2f(s[r] - m); ls += s[r]; } \
            l += ls; \
            u32x4 pw[2]; \
            pw[0] = (u32x4){pk2(s[0], s[1]), pk2(s[2], s[3]), pk2(s[4], s[5]), pk2(s[6], s[7])}; \
            pw[1] = (u32x4){pk2(s[8], s[9]), pk2(s[10], s[11]), pk2(s[12], s[13]), pk2(s[14], s[15])}; \
            const LAS unsigned char* vb = vbuf + vl; \
            _Pragma("unroll") for (int ks = 0; ks < 2; ++ks) _Pragma("unroll") for (int dh = 0; dh < 2; ++dh) { \
                    const f16x4 lo = vtr(vb + dh * AA_HSTR + ks * 1024), hh = vtr(vb + dh * AA_HSTR + ks * 1024 + 512); \
                    const f16x8 vf = (f16x8){lo[0], lo[1], lo[2], lo[3], hh[0], hh[1], hh[2], hh[3]}; \
                    o[dh] = MFMA32(__builtin_bit_cast(f16x8, pw[ks]), vf, o[dh]); } \
        } while (0)
        AA_LOADK(0, kS); AA_LOADV(0, vA);
#pragma unroll 1
        for (int tt = 0; tt < NTILE - 1; tt += 2) { AA_STEP(tt); AA_STEP(tt + 1); }
        AA_STEP(NTILE - 1);
#undef AA_STEP
#undef AA_LOADK
#undef AA_LOADV
#undef AA_PARAMS
        l = half_sum(l);
        if (hi == 0) wsf[r32] = 1.0f / l;
#pragma unroll
        for (int r = 0; r < 16; ++r) {
            const float il = wsf[crow(r, hi)];
            f16* op = oa + ((size_t)b * SEQ + P0 + 16 * crow(r, hi)) * 512 + h * 64 + r32;
            op[0] = (f16)(o[0][r] * il); op[32] = (f16)(o[1][r] * il);
        }
    }
    __syncthreads();
}
constexpr int B2_STGS = 33280, B2_WSF = 4 * B2_STGS, B2_CMX = B2_WSF + 1024;
constexpr float B2_THR = 8.0f, B2_SKIP_T = 40.0f;
constexpr size_t SM_KMAX = 15360, SM_KDONE = 15872, SM_AQ = 16000;

__device__ __forceinline__ void glds16_asm(const void* gsrc, unsigned lds_dst) {
    unsigned keep;
    asm volatile("s_mov_b32 %0, m0\n\ts_mov_b32 m0, %2\n\ts_nop 0\n\tglobal_load_lds_dwordx4 %1, off\n\ts_mov_b32 m0, %0" : "=&s"(keep) : "v"(gsrc), "s"(lds_dst) : "memory");
}
__device__ __forceinline__ void phase_knorm(const Params& p, LAS unsigned char* lds, int wg, int nwg) {
    const int tid = get_tid(lds);
    const int lane = tid & 63;
    const f16* proj = (const f16*)(p.ws + WS_PROJ);
    unsigned* kmax2 = (unsigned*)(p.ws + WS_SMALL + SM_KMAX);
    unsigned* kdone = (unsigned*)(p.ws + WS_SMALL + SM_KDONE);
    const int tpw = TOK / nwg;
    const int t = wg * tpw + (tid >> 2), part = tid & 3;
    float n2[2];
#pragma unroll
    for (int g = 0; g < 2; ++g) {
        const f16* kr = proj + (size_t)t * INW + C_KB + (part * 2 + g) * 64;
        float s = 0.f;
#pragma unroll
        for (int c = 0; c < 8; ++c) { const f16x8 v = *(const f16x8*)(kr + c * 8);
#pragma unroll
            for (int j = 0; j < 8; ++j) s = fmaf((float)v[j], (float)v[j], s); }
        n2[g] = s;
    }
#pragma unroll
    for (int g = 0; g < 2; ++g) { for (int o = 4; o <= 32; o <<= 1) n2[g] = fmaxf(n2[g], shx(n2[g], o, lane)); }
    if (lane < 4) {
        const int b = (wg * tpw) / SEQ;
#pragma unroll
        for (int g = 0; g < 2; ++g) { const int hm = part * 2 + g;
            __hip_atomic_fetch_max(kmax2 + b * 8 + hm, __float_as_uint(n2[g]), __ATOMIC_RELAXED, __HIP_MEMORY_SCOPE_AGENT); }
    }
    asm volatile("s_waitcnt vmcnt(0)" ::: "memory");
    __syncthreads();
    if (tid == 0) __hip_atomic_fetch_add(kdone, 1u, __ATOMIC_RELAXED, __HIP_MEMORY_SCOPE_AGENT);
}

__device__ __forceinline__ void dma8(const void* sbase, const unsigned (&vo)[8], unsigned ldk, unsigned ldv) {
    unsigned keep;
    asm volatile(
        "s_mov_b32 %0, m0\n\t"
        "s_mov_b32 m0, %10\n\ts_nop 0\n\tglobal_load_lds_dwordx4 %2, %1\n\t"
        "s_add_i32 m0, %10, 0x400\n\ts_nop 0\n\tglobal_load_lds_dwordx4 %3, %1\n\t"
        "s_add_i32 m0, %10, 0x4000\n\ts_nop 0\n\tglobal_load_lds_dwordx4 %4, %1\n\t"
        "s_add_i32 m0, %10, 0x4400\n\ts_nop 0\n\tglobal_load_lds_dwordx4 %5, %1\n\t"
        "s_mov_b32 m0, %11\n\ts_nop 0\n\tglobal_load_lds_dwordx4 %6, %1\n\t"
        "s_add_i32 m0, %11, 0x400\n\ts_nop 0\n\tglobal_load_lds_dwordx4 %7, %1\n\t"
        "s_add_i32 m0, %11, 0x800\n\ts_nop 0\n\tglobal_load_lds_dwordx4 %8, %1\n\t"
        "s_add_i32 m0, %11, 0xc00\n\ts_nop 0\n\tglobal_load_lds_dwordx4 %9, %1\n\t"
        "s_mov_b32 m0, %0"
        : "=&s"(keep)
        : "s"(sbase), "v"(vo[0]), "v"(vo[1]), "v"(vo[2]), "v"(vo[3]), "v"(vo[4]), "v"(vo[5]), "v"(vo[6]), "v"(vo[7]), "s"(ldk), "s"(ldv)
        : "memory", "scc");
}

constexpr int B3_VQ = 8256;
constexpr int B3_STG = 32768 + 4 * B3_VQ;
constexpr int B3_WSF = 2 * B3_STG, B3_CMX = B3_WSF + 1024;
__device__ __forceinline__ void phase_attnB3(const Params& p, LAS unsigned char* lds, int wg, int nwg) {
    const int tid = get_tid(lds);
    const int lane = tid & 63, r32 = lane & 31, hi = lane >> 5;
    const int wave = __builtin_amdgcn_readfirstlane(tid >> 6), grp = wave >> 2, qsub = wave & 3;
    const f16* proj = (const f16*)(p.ws + WS_PROJ);
    f16* ob = (f16*)(p.ws + WS_OAB) + (size_t)TOK * 512;
    const float lam = lambda_full(p.in[3], p.in[4], p.in[5], p.in[6], lane);
    const float* subg = p.in[7];
    LAS float* wsf = (LAS float*)(lds + B3_WSF) + wave * 32;
    LAS float* cmx = (LAS float*)(lds + B3_CMX);
    if (tid == 0) { unsigned* kdone = (unsigned*)(p.ws + WS_SMALL + SM_KDONE); unsigned sp = 0;
        while (__hip_atomic_load(kdone, __ATOMIC_RELAXED, __HIP_MEMORY_SCOPE_AGENT) < (unsigned)nwg) { __builtin_amdgcn_s_sleep(2); if (++sp > (1u << 22)) break; } }
    __syncthreads();
    const unsigned* kmax2 = (const unsigned*)(p.ws + WS_SMALL + SM_KMAX);
    const int kx4 = (hi ^ ((r32 >> 1) & 7)) << 4, krow = r32 * 128;
#define KOFF(d0) (krow + (((d0) << 5) ^ kx4))
    const int vl = ((lane >> 4) & 1) * 32 + (lane & 3) * 8 + (4 * hi + ((lane & 15) >> 2)) * 64;
    const unsigned vo_k = (unsigned)((16 * wave + (lane >> 3)) * INW + ((lane & 7) ^ (((16 * wave + (lane >> 3)) >> 1) & 7)) * 8) * 2u;
    const unsigned vo_v = (unsigned)((16 * ((4 * wave) & 7) + (lane >> 2)) * INW + (C_VB - C_KB) + (wave >> 1) * 32 + (lane & 3) * 8) * 2u;
    const unsigned ldk_w = (unsigned)wave * 2048u, ldv_w = 32768u + (unsigned)(wave >> 1) * B3_VQ + (unsigned)(wave & 1) * 4096u;
#ifndef TIMEQ
#define TIMEQ 0
#endif
    long long tacc = 0;
    const unsigned lds0 = (unsigned)(size_t)lds;
    const f32x16 z16 = (f32x16){0.f, 0.f, 0.f, 0.f, 0.f, 0.f, 0.f, 0.f, 0.f, 0.f, 0.f, 0.f, 0.f, 0.f, 0.f, 0.f};

    unsigned* aq = (unsigned*)(p.ws + WS_SMALL + SM_AQ) + (wg & 7);
#pragma unroll 1
    for (;;) {
        if (tid == 0) cmx[8] = __uint_as_float(__hip_atomic_fetch_add(aq, 1u, __ATOMIC_RELAXED, __HIP_MEMORY_SCOPE_AGENT));
        __syncthreads();
        const int u = __builtin_amdgcn_readfirstlane((int)__float_as_uint(cmx[8]));
        if (u >= 128) break;
        const int g8 = wg & 7, h = 3 - (u >> 5), ui = (h - (g8 & 3)) & 3, qb = u & 31;
        const int b = 2 * ui + (g8 >> 2);
        const float sl2 = slope_of(3 * h + 2) * LOG2E;
        const f16* base = proj + (size_t)b * SEQ * INW;
        const int dw = 2 * qb + (qsub >> 1);
        const int qrel = qsub * 32 + r32, qpos = qb * 128 + qrel;
        f16x8 qr[4], ks4[4];
        { int lu = lane; asm volatile("" : "+v"(lu));
          const unsigned qo = (unsigned)((qb * 128 + qsub * 32 + (lu & 31)) * INW + h * 128 + grp * 64 + 8 * (lu >> 5));
#pragma unroll
          for (int d0 = 0; d0 < 4; ++d0) { qr[d0] = *(const f16x8*)(base + qo + C_QB + 16 * d0); ks4[d0] = *(const f16x8*)(base + qo + C_KB + 16 * d0); } }
        float qn2 = 0.f, sii = 0.f;
#pragma unroll
        for (int d0 = 0; d0 < 4; ++d0)
#pragma unroll
            for (int j = 0; j < 8; ++j) { const float qv = (float)qr[d0][j]; qn2 = fmaf(qv, qv, qn2); sii = fmaf(qv, (float)ks4[d0][j], sii); }
        qn2 = half_sum(qn2); sii = half_sum(sii);
        const float kmx = sqrtf(__uint_as_float(__hip_atomic_load(kmax2 + b * 8 + h * 2 + grp, __ATOMIC_RELAXED, __HIP_MEMORY_SCOPE_AGENT)));
        float cb = sqrtf(qn2) * kmx * 1.001f - sii;
        for (int of = 16; of >= 1; of >>= 1) cb = fmaxf(cb, shx(cb, of, lane));
        if (lane == 0) cmx[wave] = cb;
        const float a64 = 64.0f * sl2; const f16 aH = (f16)a64, aL = (f16)(a64 - (float)aH), bH = (f16)sl2, bL = (f16)(sl2 - (float)bH);
        const f16 zz = (f16)0.f;
        const unsigned qx01 = hi == 0 ? __builtin_bit_cast(unsigned, (f16x2){aH, aL}) : 0u, qx23 = hi == 0 ? __builtin_bit_cast(unsigned, (f16x2){bH, bL}) : 0u;
        asm volatile("s_waitcnt lgkmcnt(0)" ::: "memory"); __syncthreads();
        float cmax = cmx[0];
#pragma unroll
        for (int w = 1; w < 8; ++w) cmax = fmaxf(cmax, cmx[w]);
        const float Dm = (cmax + B2_SKIP_T + 1.0f) / sl2;
        int t_lo, t_hi;
        { const float lo = ((float)(qb * 128 - 127) - Dm) * (1.0f / 128.0f), hh = ((float)(qb * 128 + 127) + Dm) * (1.0f / 128.0f);
          t_lo = lo <= 0.f ? 0 : (int)lo; t_hi = hh >= 31.f ? 31 : (int)hh; if (t_lo > qb) t_lo = qb; if (t_hi < qb) t_hi = qb; }
        t_lo = __builtin_amdgcn_readfirstlane(t_lo); t_hi = __builtin_amdgcn_readfirstlane(t_hi);
        const int nL = qb - t_lo, U = 1 + nL + (t_hi - qb);
#define B3_SEQ(pp) ((pp) == 0 ? qb : ((pp) - 1 < nL ? qb - 1 - ((pp) - 1) : qb + 1 + ((pp) - 1 - nL)))
        const f16* gk = base + C_KB + h * 128;
#define B3_ISSUE(pp) do { const int T2_ = B3_SEQ(pp); const unsigned st_ = lds0 + (unsigned)((pp) & 1) * (unsigned)B3_STG; \
            const unsigned vo_[8] = {vo_k, (vo_k + 8u * INW * 2u) ^ 64u, vo_k + 128u, ((vo_k + 8u * INW * 2u) ^ 64u) + 128u,     \
                 vo_v, vo_v + 16u * INW * 2u, vo_v + 32u * INW * 2u, vo_v + 48u * INW * 2u}; \
            dma8(gk + (size_t)T2_ * 128 * INW, vo_, (unsigned)__builtin_amdgcn_readfirstlane(st_ + ldk_w), (unsigned)__builtin_amdgcn_readfirstlane(st_ + ldv_w)); } while (0)
        B3_ISSUE(0);
        f32x16 o[4]; o[0] = z16; o[1] = z16; o[2] = z16; o[3] = z16;
        float m = sii, l = 0.f;
        asm volatile("s_waitcnt vmcnt(0) lgkmcnt(0)\n\ts_barrier" ::: "memory");
#define SBAR() __builtin_amdgcn_sched_barrier(0)
#define PIN(x) asm volatile("" : "+v"(x))
#define B3_QK(S0, S1, T, JJ) do { \
            const LAS unsigned char* kbse = st + grp * 16384 + (JJ) * 8192; \
            const int side = (T) <= dw ? 0 : 1; \
            const float sq = sl2 * (float)qrel; \
            const float mr = side == 0 ? -(m + sq) : -(m - sq); \
            const f16 mH = (f16)mr, mL = (f16)(mr - (float)mH), one = (f16)1.0f; \
            const f16 trel = (f16)(float)((T) - 2 * qb), l0 = (f16)(float)r32, l1 = (f16)(float)(32 + r32); \
            const f16x8 kx0 = hi == 0 ? (f16x8){trel, trel, l0, l0, one, one, zz, zz} : (f16x8){zz, zz, zz, zz, zz, zz, zz, zz}; \
            const f16x8 kx1 = hi == 0 ? (f16x8){trel, trel, l1, l1, one, one, zz, zz} : (f16x8){zz, zz, zz, zz, zz, zz, zz, zz}; \
            u32x4 qxb = (u32x4){qx01, qx23, 0u, 0u}; if (side) { qxb.x ^= 0x80008000u; qxb.y ^= 0x80008000u; } \
            if (hi == 0) qxb.z = __builtin_bit_cast(unsigned, (f16x2){mH, mL}); \
            const f16x8 qx = __builtin_bit_cast(f16x8, qxb); \
            S0 = MFMA32(kx0, qx, z16); S1 = MFMA32(kx1, qx, z16); \
            _Pragma("unroll") for (int d0 = 0; d0 < 4; ++d0) { \
                const f16x8 a0 = *(const LAS f16x8*)(kbse + KOFF(d0)), a1 = *(const LAS f16x8*)(kbse + 4096 + KOFF(d0)); \
                S0 = MFMA32(a0, qr[d0], S0); S1 = MFMA32(a1, qr[d0], S1); } } while (0)
#define B3_FIX(S0, S1, T) do { if ((T) == dw) { const float dq0 = (float)(64 * ((T) - 2 * qb) + 4 * hi - qrel), m2 = -2.0f * sl2; \
            _Pragma("unroll") for (int r = 0; r < 16; ++r) { const float c = (float)((r & 3) + 8 * (r >> 2)); \
                S0[r] = __builtin_fmaf(m2, fmaxf(dq0 + c, 0.f), S0[r]); S1[r] = __builtin_fmaf(m2, fmaxf(dq0 + 32.0f + c, 0.f), S1[r]); } } } while (0)
#define B3_EXP(S0, S1, PW) do { float ls = 0.f; \
            _Pragma("unroll") for (int r = 0; r < 16; ++r) { S0[r] = __builtin_amdgcn_exp2f(S0[r]); S1[r] = __builtin_amdgcn_exp2f(S1[r]); ls += S0[r] + S1[r]; } \
            l += ls; \
            PW[0] = (u32x4){pk2(S0[0], S0[1]), pk2(S0[2], S0[3]), pk2(S0[4], S0[5]), pk2(S0[6], S0[7])}; \
            PW[1] = (u32x4){pk2(S0[8], S0[9]), pk2(S0[10], S0[11]), pk2(S0[12], S0[13]), pk2(S0[14], S0[15])}; \
            PW[2] = (u32x4){pk2(S1[0], S1[1]), pk2(S1[2], S1[3]), pk2(S1[4], S1[5]), pk2(S1[6], S1[7])}; \
            PW[3] = (u32x4){pk2(S1[8], S1[9]), pk2(S1[10], S1[11]), pk2(S1[12], S1[13]), pk2(S1[14], S1[15])}; } while (0)
#define B3_PV(PW, JJ) do { const LAS unsigned char* vb = st + 32768 + (JJ) * 4096 + vl; \
            _Pragma("unroll") for (int ks = 0; ks < 4; ++ks) { _Pragma("unroll") for (int dq = 0; dq < 4; ++dq) { \
                const f16x4 lo = vtr(vb + dq * B3_VQ + ks * 1024), hh = vtr(vb + dq * B3_VQ + ks * 1024 + 512); \
                const f16x8 vf = (f16x8){lo[0], lo[1], lo[2], lo[3], hh[0], hh[1], hh[2], hh[3]}; \
                o[dq] = MFMA32(__builtin_bit_cast(f16x8, PW[ks]), vf, o[dq]); } } } while (0)
#pragma unroll 1
        for (int pp = 0; pp < U; ++pp) {
            if (pp + 1 < U) B3_ISSUE(pp + 1);
            const LAS unsigned char* st = lds + (pp & 1) * B3_STG;
            const int T2 = B3_SEQ(pp), TA = 2 * T2, TB = 2 * T2 + 1;
            f32x16 a0s, a1s, b0s, b1s; u32x4 pwA[4], pwB[4];
            B3_QK(a0s, a1s, TA, 0);
            __builtin_amdgcn_sched_group_barrier(0x100, 4, 0); __builtin_amdgcn_sched_group_barrier(0x8, 2, 0);
            __builtin_amdgcn_sched_group_barrier(0x8, 2, 0); __builtin_amdgcn_sched_group_barrier(0x100, 2, 0);
            __builtin_amdgcn_sched_group_barrier(0x8, 2, 0); __builtin_amdgcn_sched_group_barrier(0x100, 2, 0);
            __builtin_amdgcn_sched_group_barrier(0x8, 4, 0);
            B3_FIX(a0s, a1s, TA);
            { const float mx = rowmax32(a0s, a1s);
              if (__any(mx > B2_THR)) {
                const float dl = fmaxf(mx, 0.f), al = __builtin_amdgcn_exp2f(-dl);
                m += dl; l *= al;
                if (hi == 0) wsf[r32] = al;
#pragma unroll
                for (int r = 0; r < 16; ++r) { const float f = wsf[crow(r, hi)];
#pragma unroll
                    for (int i = 0; i < 4; ++i) o[i][r] *= f;
                    a0s[r] -= dl; a1s[r] -= dl; }
              } }
            {
                const LAS unsigned char* kbse = st + grp * 16384 + 8192;
                const int side = TB <= dw ? 0 : 1;
                const float sq = sl2 * (float)qrel;
                const float mr = side == 0 ? -(m + sq) : -(m - sq);
                const f16 mH = (f16)mr, mL = (f16)(mr - (float)mH), one = (f16)1.0f;
                const f16 trel = (f16)(float)(TB - 2 * qb), l0 = (f16)(float)r32, l1 = (f16)(float)(32 + r32);
                const f16x8 kx0 = hi == 0 ? (f16x8){trel, trel, l0, l0, one, one, zz, zz} : (f16x8){zz, zz, zz, zz, zz, zz, zz, zz};
                const f16x8 kx1 = hi == 0 ? (f16x8){trel, trel, l1, l1, one, one, zz, zz} : (f16x8){zz, zz, zz, zz, zz, zz, zz, zz};
                u32x4 qxb = (u32x4){qx01, qx23, 0u, 0u}; if (side) { qxb.x ^= 0x80008000u; qxb.y ^= 0x80008000u; }
                if (hi == 0) qxb.z = __builtin_bit_cast(unsigned, (f16x2){mH, mL});
                const f16x8 qx = __builtin_bit_cast(f16x8, qxb);
                f16x8 kf0 = *(const LAS f16x8*)(kbse + KOFF(0)), kf1 = *(const LAS f16x8*)(kbse + 4096 + KOFF(0));
                f16x8 kf2 = *(const LAS f16x8*)(kbse + KOFF(1)), kf3 = *(const LAS f16x8*)(kbse + 4096 + KOFF(1));
                float ls = 0.f;
                SBAR();
#define EX3(S, i0) do { S[i0] = __builtin_amdgcn_exp2f(S[i0]); S[i0 + 1] = __builtin_amdgcn_exp2f(S[i0 + 1]); S[i0 + 2] = __builtin_amdgcn_exp2f(S[i0 + 2]); ls += S[i0]; ls += S[i0 + 1]; ls += S[i0 + 2]; PIN(ls); } while (0)
#define EX4(S, i0) do { S[i0] = __builtin_amdgcn_exp2f(S[i0]); S[i0 + 1] = __builtin_amdgcn_exp2f(S[i0 + 1]); S[i0 + 2] = __builtin_amdgcn_exp2f(S[i0 + 2]); S[i0 + 3] = __builtin_amdgcn_exp2f(S[i0 + 3]); ls += S[i0]; ls += S[i0 + 1]; ls += S[i0 + 2]; ls += S[i0 + 3]; PIN(ls); } while (0)
                b0s = MFMA32(kx0, qx, z16); EX3(a0s, 0); SBAR();
                b1s = MFMA32(kx1, qx, z16); EX3(a0s, 3); SBAR();
                b0s = MFMA32(kf0, qr[0], b0s); kf0 = *(const LAS f16x8*)(kbse + KOFF(2)); EX3(a0s, 6); SBAR();
                b1s = MFMA32(kf1, qr[0], b1s); kf1 = *(const LAS f16x8*)(kbse + 4096 + KOFF(2)); EX3(a0s, 9); SBAR();
                b0s = MFMA32(kf2, qr[1], b0s); kf2 = *(const LAS f16x8*)(kbse + KOFF(3)); EX4(a0s, 12); SBAR();
                b1s = MFMA32(kf3, qr[1], b1s); kf3 = *(const LAS f16x8*)(kbse + 4096 + KOFF(3)); EX4(a1s, 0); SBAR();
                b0s = MFMA32(kf0, qr[2], b0s); EX4(a1s, 4); SBAR();
                b1s = MFMA32(kf1, qr[2], b1s); EX4(a1s, 8); SBAR();
                b0s = MFMA32(kf2, qr[3], b0s); EX4(a1s, 12);
                pwA[0] = (u32x4){pk2(a0s[0], a0s[1]), pk2(a0s[2], a0s[3]), pk2(a0s[4], a0s[5]), pk2(a0s[6], a0s[7])};
                pwA[1] = (u32x4){pk2(a0s[8], a0s[9]), pk2(a0s[10], a0s[11]), pk2(a0s[12], a0s[13]), pk2(a0s[14], a0s[15])};
                SBAR();
                b1s = MFMA32(kf3, qr[3], b1s);
                pwA[2] = (u32x4){pk2(a1s[0], a1s[1]), pk2(a1s[2], a1s[3]), pk2(a1s[4], a1s[5]), pk2(a1s[6], a1s[7])};
                pwA[3] = (u32x4){pk2(a1s[8], a1s[9]), pk2(a1s[10], a1s[11]), pk2(a1s[12], a1s[13]), pk2(a1s[14], a1s[15])};
                SBAR();
                l += ls;
            }
            B3_FIX(b0s, b1s, TB);
            { const float mx = rowmax32(b0s, b1s);
              if (__any(mx > B2_THR)) {
                const float dl = fmaxf(mx, 0.f), al = __builtin_amdgcn_exp2f(-dl);
                m += dl; l *= al;
                if (hi == 0) wsf[r32] = al;
#pragma unroll
                for (int r = 0; r < 16; ++r) { const float f = wsf[crow(r, hi)];
#pragma unroll
                    for (int i = 0; i < 4; ++i) o[i][r] *= f;
                    b0s[r] -= dl; b1s[r] -= dl; a0s[r] *= al; a1s[r] *= al; }
                pwA[0] = (u32x4){pk2(a0s[0], a0s[1]), pk2(a0s[2], a0s[3]), pk2(a0s[4], a0s[5]), pk2(a0s[6], a0s[7])};
                pwA[1] = (u32x4){pk2(a0s[8], a0s[9]), pk2(a0s[10], a0s[11]), pk2(a0s[12], a0s[13]), pk2(a0s[14], a0s[15])};
                pwA[2] = (u32x4){pk2(a1s[0], a1s[1]), pk2(a1s[2], a1s[3]), pk2(a1s[4], a1s[5]), pk2(a1s[6], a1s[7])};
                pwA[3] = (u32x4){pk2(a1s[8], a1s[9]), pk2(a1s[10], a1s[11]), pk2(a1s[12], a1s[13]), pk2(a1s[14], a1s[15])};
              } }
            {
                const LAS unsigned char* vb = st + 32768 + vl;
                float ls = 0.f;
#define VFR_(ks, dq) do { const f16x4 lo_ = vtr(vb + (dq) * B3_VQ + (ks) * 1024), hh_ = vtr(vb + (dq) * B3_VQ + (ks) * 1024 + 512); vnx = (f16x8){lo_[0], lo_[1], lo_[2], lo_[3], hh_[0], hh_[1], hh_[2], hh_[3]}; } while (0)
#define EX2(S, i0) do { S[i0] = __builtin_amdgcn_exp2f(S[i0]); S[i0 + 1] = __builtin_amdgcn_exp2f(S[i0 + 1]); ls += S[i0]; ls += S[i0 + 1]; PIN(ls); } while (0)
                f16x8 vcu, vnx;
                VFR_(0, 0); vcu = vnx; SBAR();
#define PVG(ks, dq, nks, ndq, S, i0) do { VFR_(nks, ndq); o[dq] = MFMA32(__builtin_bit_cast(f16x8, pwA[ks]), vcu, o[dq]); EX2(S, i0); vcu = vnx; SBAR(); } while (0)
                PVG(0, 0, 0, 1, b0s, 0);  PVG(0, 1, 0, 2, b0s, 2);  PVG(0, 2, 0, 3, b0s, 4);  PVG(0, 3, 1, 0, b0s, 6);
                PVG(1, 0, 1, 1, b0s, 8);  PVG(1, 1, 1, 2, b0s, 10); PVG(1, 2, 1, 3, b0s, 12); PVG(1, 3, 2, 0, b0s, 14);
                PVG(2, 0, 2, 1, b1s, 0);  PVG(2, 1, 2, 2, b1s, 2);  PVG(2, 2, 2, 3, b1s, 4);  PVG(2, 3, 3, 0, b1s, 6);
                PVG(3, 0, 3, 1, b1s, 8);  PVG(3, 1, 3, 2, b1s, 10); PVG(3, 2, 3, 3, b1s, 12);
                o[3] = MFMA32(__builtin_bit_cast(f16x8, pwA[3]), vcu, o[3]); EX2(b1s, 14); SBAR();
#undef PVG
#undef VFR_
                l += ls;
                pwB[0] = (u32x4){pk2(b0s[0], b0s[1]), pk2(b0s[2], b0s[3]), pk2(b0s[4], b0s[5]), pk2(b0s[6], b0s[7])};
                pwB[1] = (u32x4){pk2(b0s[8], b0s[9]), pk2(b0s[10], b0s[11]), pk2(b0s[12], b0s[13]), pk2(b0s[14], b0s[15])};
                pwB[2] = (u32x4){pk2(b1s[0], b1s[1]), pk2(b1s[2], b1s[3]), pk2(b1s[4], b1s[5]), pk2(b1s[6], b1s[7])};
                pwB[3] = (u32x4){pk2(b1s[8], b1s[9]), pk2(b1s[10], b1s[11]), pk2(b1s[12], b1s[13]), pk2(b1s[14], b1s[15])};
            }
            B3_PV(pwB, 1);
            __builtin_amdgcn_sched_group_barrier(0x100, 4, 3);
#pragma unroll
            for (int i = 0; i < 14; ++i) { __builtin_amdgcn_sched_group_barrier(0x8, 1, 3); __builtin_amdgcn_sched_group_barrier(0x100, 2, 3); }
            __builtin_amdgcn_sched_group_barrier(0x8, 2, 3);
#if TIMEQ == 1
            { const long long tq0 = __builtin_readcyclecounter(); asm volatile("s_waitcnt vmcnt(0)" ::: "memory"); tacc += __builtin_readcyclecounter() - tq0; }
#endif
#if TIMEQ == 2
            asm volatile("s_waitcnt vmcnt(0)" ::: "memory");
            const long long tq0 = __builtin_readcyclecounter();
#endif
            asm volatile("s_waitcnt vmcnt(0) lgkmcnt(0)\n\ts_barrier" ::: "memory");
#if TIMEQ == 2
            tacc += __builtin_readcyclecounter() - tq0;
#endif
        }
#undef B3_QK
#undef SBAR
#undef PIN
#undef EX2
#undef EX3
#undef EX4
#undef B3_FIX
#undef B3_EXP
#undef B3_PV
#undef B3_ISSUE
#undef B3_SEQ
        l = half_sum(l);
        if (hi == 0) wsf[r32] = 1.0f / l;
        LAS float* ost = (LAS float*)lds + (size_t)grp * 128 * 128;
#pragma unroll
        for (int r = 0; r < 16; ++r) { const float il = wsf[crow(r, hi)]; const int row = qsub * 32 + crow(r, hi);
#pragma unroll
            for (int i = 0; i < 4; ++i) ost[row * 128 + i * 32 + r32] = o[i][r] * il; }
        __syncthreads();
        {
            const LAS float* o1 = (const LAS float*)lds; const LAS float* o2 = o1 + 128 * 128;
            int l2 = lane; asm volatile("" : "+v"(l2));
            const float g0s = subg[l2], g1s = subg[64 + l2];
            for (int rr = 0; rr < 16; ++rr) {
                const int row = wave * 16 + rr;
                const float v0 = o1[row * 128 + l2] - lam * o2[row * 128 + l2], v1 = o1[row * 128 + 64 + l2] - lam * o2[row * 128 + 64 + l2];
                float ss = v0 * v0 + v1 * v1;
                for (int of = 32; of >= 1; of >>= 1) ss += shx(ss, of, lane);
                const float rs = rsqrtf(ss * (1.0f / 128.0f) + 1e-5f) * (1.0f - LAMBDA_INIT);
                f16* op = ob + ((size_t)b * SEQ + qb * 128 + row) * 512 + h * 128;
                op[l2] = (f16)(v0 * rs * g0s); op[64 + l2] = (f16)(v1 * rs * g1s);
            }
        }
        __syncthreads();
    }
#if TIMEQ
    { const long long t0 = __builtin_readcyclecounter(); while (__builtin_readcyclecounter() - t0 < tacc) __builtin_amdgcn_s_sleep(1); }
    __syncthreads();
#endif
#undef KOFF
}
#define XB_TMO      128
#define XB_XCNT(j)  (256  + 64 * (j))
#define XB_XSUB(j)  (1280 + 64 * (j))
#define XB_XGEN(j)  (2304 + 64 * (j))
#define XB_TOP      3328
#define XB_TOPGEN   3392
#define XCD_BAR_WORDS 3456
#define XB_SPIN_CAP (1u << 20)
__device__ __forceinline__ unsigned xb_ld(unsigned* p)              { return __hip_atomic_load(p, __ATOMIC_RELAXED, __HIP_MEMORY_SCOPE_AGENT); }
__device__ __forceinline__ unsigned xb_add(unsigned* p, unsigned v) { return __hip_atomic_fetch_add(p, v, __ATOMIC_RELAXED, __HIP_MEMORY_SCOPE_AGENT); }
__device__ __forceinline__ unsigned xb_xcc_id() { return (unsigned)__builtin_amdgcn_s_getreg((3 << 11) | 20) & 0xFu; }
#define XB_SPIN(cond, bar) do { unsigned _sp = 0; while (cond) { __builtin_amdgcn_s_sleep(1); \
    if ((++_sp & 255u) == 0u) { if (xb_ld(&(bar)[XB_TMO])) break; if (_sp > XB_SPIN_CAP) { atomicAdd(&(bar)[XB_TMO], 1u); break; } } } } while (0)
__device__ __forceinline__ void xcd_barrier_post(unsigned* bar, int tid) { if (tid == 0) (void)xb_add(&bar[XB_XCNT(xb_xcc_id())], 1u); }
__device__ __forceinline__ void xcd_barrier_complete(unsigned* bar, unsigned x, unsigned& nloc, unsigned& nx) {
    const unsigned G = gridDim.x;
    unsigned sum, cnt, mine, sp = 0u;
    for (;;) {
        sum = 0u; cnt = 0u; mine = 0u;
#pragma unroll
        for (unsigned j = 0; j < 16; ++j) { const unsigned c = xb_ld(&bar[XB_XCNT(j)]); sum += c; cnt += (c > 0u) ? 1u : 0u; mine = (j == x) ? c : mine; }
        if (sum == G) break;
        __builtin_amdgcn_s_sleep(1);
        if ((++sp & 255u) == 0u) { if (xb_ld(&bar[XB_TMO])) break; if (sp > XB_SPIN_CAP) { atomicAdd(&bar[XB_TMO], 1u); break; } }
    }
    nloc = mine > 0u ? mine : 1u; nx = cnt > 0u ? cnt : 1u;
}
__device__ __forceinline__ void xcd_barrier(unsigned* bar, volatile LAS unsigned* st, LAS unsigned char* lds) {
    const int tid = get_tid(lds);
    asm volatile("s_waitcnt vmcnt(0)" ::: "memory");
    __syncthreads();
    if (tid == 0) {
        const unsigned x = xb_xcc_id();
        __builtin_amdgcn_s_waitcnt(0);
        unsigned nloc = st[0], nx = st[1];
        if (nloc == 0u) { xcd_barrier_complete(bar, x, nloc, nx); st[0] = nloc; st[1] = nx; }
        const unsigned old = xb_add(&bar[XB_XSUB(x)], 1u);
        const unsigned gen = old / nloc;
        if (old + 1u == (gen + 1u) * nloc) {
            __builtin_amdgcn_fence(__ATOMIC_RELEASE, "agent");
            asm volatile("s_waitcnt vmcnt(0)" ::: "memory");
            const unsigned og = xb_add(&bar[XB_TOP], 1u);
            const unsigned tg = og / nx;
            if (og + 1u == (tg + 1u) * nx) xb_add(&bar[XB_TOPGEN], 1u);
            else XB_SPIN(xb_ld(&bar[XB_TOPGEN]) == tg, bar);
            __builtin_amdgcn_fence(__ATOMIC_ACQUIRE, "agent");
            xb_add(&bar[XB_XGEN(x)], 1u);
            asm volatile("s_waitcnt vmcnt(0)" ::: "memory");
        } else {
            XB_SPIN(xb_ld(&bar[XB_XGEN(x)]) == gen, bar);
            __builtin_amdgcn_fence(__ATOMIC_ACQUIRE, "agent");
            asm volatile("s_waitcnt vmcnt(0)" ::: "memory");
        }
    }
    __syncthreads();
}
constexpr int LDS_BARST = LDS_TOTAL - 16;
constexpr size_t SM_BAR = 1024;
__global__ void __launch_bounds__(NTHR, 2) k_mega(Params p) {
    extern __shared__ __attribute__((aligned(16))) unsigned char smem[];
    LAS unsigned char* lds = (LAS unsigned char*)smem;
    const int wg = blockIdx.x, nwg = gridDim.x;
    volatile LAS unsigned* st = (volatile LAS unsigned*)(lds + LDS_BARST);
    { const unsigned hw = (unsigned)__builtin_amdgcn_s_getreg((5 << 11) | 4) & 63u; if ((threadIdx.x & 63) == 0) ((LAS int*)(lds + LDS_WTAB))[hw] = (int)(threadIdx.x >> 6); }
    if (threadIdx.x == 0) { st[0] = 0u; st[1] = 0u; put_params(p, lds); }
    __syncthreads();
    xcd_barrier_post((unsigned*)(get_params(lds).ws + WS_SMALL + SM_BAR), get_tid(lds));
#define GRID_SYNC() xcd_barrier((unsigned*)(get_params(lds).ws + WS_SMALL + SM_BAR), st, lds)
#ifndef TIMEPH
#define TIMEPH 0
#endif
    long long tph = 0;
#define TPH2(n, call) do { if (TIMEPH == (n) || TIMEPH == 11) { const long long t0_ = __builtin_readcyclecounter(); call; tph += __builtin_readcyclecounter() - t0_; } else { call; } } while (0)
#define TPH(n, call) do { if (TIMEPH == (n)) { const long long t0_ = __builtin_readcyclecounter(); call; tph += __builtin_readcyclecounter() - t0_; } else { call; } } while (0)
    TPH(1, phase_prep(get_params(lds), lds, wg, nwg));      TPH2(21, GRID_SYNC());
    TPH(2, phase_inproj(get_params(lds), lds, wg, nwg));    TPH2(22, GRID_SYNC());
    TPH(10, phase_knorm(get_params(lds), lds, wg, nwg));
    TPH(3, phase_attnA(get_params(lds), lds, wg, nwg));
    TPH(4, phase_attnB3(get_params(lds), lds, wg, nwg));
    TPH2(23, GRID_SYNC());
#ifdef EXTRA_SYNC
    GRID_SYNC(); GRID_SYNC(); GRID_SYNC(); GRID_SYNC();
#endif
    TPH(5, phase_merge(get_params(lds), lds, wg, nwg));     TPH2(24, GRID_SYNC());
    TPH(6, phase_outproj(get_params(lds), lds, wg, nwg));   TPH2(25, GRID_SYNC());
    TPH(12, phase_router(get_params(lds), lds, wg, nwg));   TPH2(26, GRID_SYNC());
    TPH(7, phase_up(get_params(lds), lds, wg, nwg));        TPH2(27, GRID_SYNC());
    TPH(8, phase_down(get_params(lds), lds, wg, nwg));      TPH2(28, GRID_SYNC());
    TPH(9, phase_final(get_params(lds), lds, wg, nwg));
    if (TIMEPH) { const long long t0_ = __builtin_readcyclecounter(); while (__builtin_readcyclecounter() - t0_ < tph) __builtin_amdgcn_s_sleep(1); }
#undef TPH
#undef GRID_SYNC
}
}

extern "C" void kernel_launch(void* const* d_in, const int* in_sizes, int n_in, void* d_out, int out_size, void* d_ws, size_t ws_size,
                              hipStream_t stream) {
    static int grid_blocks = 0;
    if (grid_blocks == 0) {
        int dev = 0, cus = 0, per_cu = 0;
        if (hipGetDevice(&dev) != hipSuccess || hipDeviceGetAttribute(&cus, hipDeviceAttributeMultiprocessorCount, dev) != hipSuccess) { fprintf(stderr, "kernel_launch: device query failed\n"); grid_blocks = -1; return; }
        if (hipFuncSetAttribute((const void*)k_mega, hipFuncAttributeMaxDynamicSharedMemorySize, LDS_TOTAL) != hipSuccess) { fprintf(stderr, "kernel_launch: hipFuncSetAttribute failed\n"); grid_blocks = -1; return; }
        if (hipOccupancyMaxActiveBlocksPerMultiprocessor(&per_cu, (const void*)k_mega, NTHR, LDS_TOTAL) != hipSuccess || per_cu < 1) { fprintf(stderr, "kernel_launch: occupancy query says %d blocks/CU\n", per_cu); grid_blocks = -1; return; }
        grid_blocks = cus * per_cu;
        if (grid_blocks > NWG) grid_blocks = NWG;
        if (grid_blocks != NWG) { fprintf(stderr, "kernel_launch: need %d co-resident workgroups, device offers %d\n", NWG, grid_blocks); grid_blocks = -1; return; }
        if (ws_size < WS_END) { fprintf(stderr, "kernel_launch: workspace too small (%zu < %zu)\n", ws_size, (size_t)WS_END); grid_blocks = -1; return; }
    }
    if (grid_blocks < 0) return;
    Params p{};
    for (int i = 0; i < 22; ++i) p.in[i] = (const float*)d_in[i];
    p.out = (float*)d_out; p.ws = (unsigned char*)d_ws;
    if (hipMemsetAsync((char*)d_ws + WS_SMALL, 0, 16384, stream) != hipSuccess) { fprintf(stderr, "kernel_launch: memset failed\n"); return; }
    void* args[] = {&p};
    hipError_t e = hipLaunchCooperativeKernel((const void*)k_mega, dim3(grid_blocks), dim3(NTHR), args, LDS_TOTAL, stream);
    if (e != hipSuccess) fprintf(stderr, "kernel_launch: cooperative launch failed: %s (grid %d)\n", hipGetErrorString(e), grid_blocks);
}
```

```cpp
#include <hip/hip_runtime.h>
#include <hip/hip_cooperative_groups.h>
#include <stdint.h>
#include <stdio.h>

namespace {
constexpr int NB = 8, SEQ = 4096, DM = 1024, TOK = NB * SEQ;
constexpr int INW = 5120;
constexpr int C_QA = 0, C_KA = 512, C_VA = 1024, C_QB = 1536, C_KB = 2048, C_VB = 2560, C_GA = 3072, C_GB = 4096;
constexpr int NEXP = 32, TOPK = 4, NASG = TOK * TOPK;
constexpr float ALPHA = 1.189207115002721f;
constexpr float LAMBDA_INIT = 0.2f;
constexpr float LOG2E = 1.4426950408889634f;
constexpr size_t MiB = 1048576;

__device__ __forceinline__ float sigmoidf_(float x) { return 1.0f / (1.0f + __expf(-x)); }
__device__ __forceinline__ float slope_of(int idx) { return exp2f(-8.0f * (float)(idx + 1) / 12.0f); }
#define LAS __attribute__((address_space(3)))
typedef _Float16 f16;
typedef _Float16 f16x8 __attribute__((ext_vector_type(8)));
typedef _Float16 f16x4 __attribute__((ext_vector_type(4)));
typedef _Float16 f16x2 __attribute__((ext_vector_type(2)));
typedef float f32x4 __attribute__((ext_vector_type(4)));
typedef float f32x16 __attribute__((ext_vector_type(16)));
typedef unsigned u32x4 __attribute__((ext_vector_type(4)));
typedef unsigned u32x2 __attribute__((ext_vector_type(2)));

constexpr int NTHR = 512, NWG = 256;
constexpr int BM = 256, BK = 64, HALF = 128, HTB = HALF * BK * 2, STAGE_BYTES = 8 * HTB;
constexpr int LDS_MISC = STAGE_BYTES;
constexpr int LDS_TOTAL = 155648;
constexpr float QSCALE = 0.125f * 1.4426950408889634f;
constexpr int ROWPAD = 256;
constexpr int MOE_ROWS = NASG + NEXP * ROWPAD;
constexpr int LISTCAP = TOK;


constexpr int LDS_WTAB = LDS_TOTAL - 16 - 256;
__device__ __forceinline__ int get_tid(LAS unsigned char* lds) {
    const unsigned hw = (unsigned)__builtin_amdgcn_s_getreg((5 << 11) | 4) & 63u;
    const int wave = __builtin_amdgcn_readfirstlane(((LAS int*)(lds + LDS_WTAB))[hw]);
    int lane; asm volatile("v_mbcnt_lo_u32_b32 %0, -1, 0\n\tv_mbcnt_hi_u32_b32 %0, -1, %0" : "=v"(lane));
    int t = wave * 64 + lane; asm volatile("" : "+v"(t));
    return t;
}
__device__ __forceinline__ float shx(float v, int mask, int lane) { return __int_as_float(__builtin_amdgcn_ds_bpermute((lane ^ mask) << 2, __float_as_int(v))); }
__device__ __forceinline__ unsigned pk2(float a, float b) { f16x2 v; v.x = (f16)a; v.y = (f16)b; return __builtin_bit_cast(unsigned, v); }
__device__ __forceinline__ int lds_byte(int r, int c) { const int st = (r >> 4) * 2 + (c >> 5), rr = r & 15, cc = c & 31, ob = rr * 64 + cc * 2; return st * 1024 + (ob ^ (((ob >> 9) & 1) << 5)); }
__device__ __forceinline__ void stage_rc(int b, int& R, int& C) { const int st = b / 1024, sb = b % 1024, swz = sb ^ (((sb >> 9) & 1) << 5); R = (st >> 1) * 16 + swz / 64; C = (st & 1) * 32 + (swz % 64) / 2; }
__device__ __forceinline__ int perm32(int rho) { const int n = rho >> 4, i = rho & 15; return 8 * (i >> 2) + 4 * n + (i & 3); }

struct Unit { int pm, pn, e, row0, nrows; };

template <int K_>
struct DenseSched {
    static constexpr int K = K_;
    const char* A; const char* Bt; int nM, nN, nwg, G, c;
    __device__ void init(const void* A_, const void* Bt_, int M, int N, int G_, int c_) { A = (const char*)A_; Bt = (const char*)Bt_; nM = M / BM; nN = N / BM; nwg = nM * nN; G = G_; c = c_; }
    __device__ __forceinline__ bool next(int i, Unit& u) const {
        const long L = (long)i * G + c; if (L >= nwg) return false;
        int wgid = (int)L; { const int q = nwg / 8, r = nwg % 8, xcd = wgid % 8, off = wgid / 8; wgid = (xcd < r ? xcd * (q + 1) : r * (q + 1) + (xcd - r) * q) + off; }
        const int nig = 8 * nN, gid = wgid / nig, fm = gid * 8, gsz = (nM - fm) < 8 ? (nM - fm) : 8;
        u.pm = fm + ((wgid % nig) % gsz); u.pn = (wgid % nig) / gsz; u.e = 0; u.row0 = u.pm * BM; u.nrows = BM; return true;
    }
    static constexpr int LDB = K_, MID = -1;
    static __device__ __forceinline__ unsigned ka(int kt) { return (unsigned)kt * 128u; }
    static __device__ __forceinline__ unsigned kb(int kt) { return (unsigned)kt * 128u; }
    static __device__ __forceinline__ unsigned make_rc(int R, int C) { return (unsigned)(R * K + C) * 2u; }
    __device__ __forceinline__ void a_desc(const Unit& u, const unsigned (&rc)[2], unsigned (&ad)[2]) const { ad[0] = rc[0] + (unsigned)u.pm * (unsigned)(BM * K * 2); ad[1] = rc[1] + (unsigned)u.pm * (unsigned)(BM * K * 2); }
    static __device__ __forceinline__ unsigned aoff(unsigned ad, unsigned rc, int h) { return ad + (unsigned)h * (unsigned)(HALF * K * 2); }
    __device__ __forceinline__ const char* b_base(const Unit& u) const { return Bt + (size_t)u.pn * BM * K * 2; }
};

template <class Sched, class Epi>
__device__ __forceinline__ void gemm_phase(LAS unsigned char* lds, const Sched& S, const Epi& E) {
    constexpr int K = Sched::K, nt = K / BK;
    const int tid = get_tid(lds);
    const int wid = __builtin_amdgcn_readfirstlane(tid >> 6), lane = tid & 63, wr = wid >> 2, wc = wid & 3, fr = lane & 15, fq = lane >> 4;
    unsigned rc[2], voffB[2];
#pragma unroll
    for (int i = 0; i < 2; ++i) { int R, C; stage_rc(tid * 16 + i * 8192, R, C); const int Rb = Epi::PERM ? ((R & ~31) + perm32(R & 31)) : R; voffB[i] = (unsigned)(Rb * Sched::LDB + C) * 2u; rc[i] = Sched::make_rc(R, C); }
    constexpr unsigned hstepB = HALF * Sched::LDB * 2;
    const unsigned ldsw = (unsigned)wid * 1024u;
    const int aoff = lds_byte(wr * 64 + fr, fq * 8), boff = lds_byte(wc * 32 + fr, fq * 8);
#define G_SA(b, h) (((b) * 2 + (h)) * HTB)
#define G_SB(b, h) ((4 + (b) * 2 + (h)) * HTB)
#define G_STAGE_A(bufoff, ad, h, kb) do { \
        __builtin_amdgcn_global_load_lds((const unsigned*)(Abase + (size_t)Sched::aoff((ad)[0], rc[0], h) + (kb)), (LAS unsigned*)(lds + (bufoff) + ldsw), 16, 0, 0); \
        __builtin_amdgcn_global_load_lds((const unsigned*)(Abase + (size_t)Sched::aoff((ad)[1], rc[1], h) + (kb)), (LAS unsigned*)(lds + (bufoff) + ldsw + 8192), 16, 0, 0); } while (0)
#define G_STAGE_B(bufoff, gbase) do { _Pragma("unroll") for (int _i = 0; _i < 2; ++_i) \
        __builtin_amdgcn_global_load_lds((const unsigned*)((const char*)(gbase) + voffB[_i]), (LAS unsigned*)(lds + (bufoff) + ldsw + _i * 8192), 16, 0, 0); } while (0)
#define G_LDA(dst, b, h) do { _Pragma("unroll") for (int m = 0; m < 4; ++m) _Pragma("unroll") for (int k = 0; k < 2; ++k) dst[m][k] = *(const LAS f16x8*)(lds + G_SA(b, h) + aoff + m * 2048 + k * 1024); } while (0)
#define G_LDB(dst, b, h) do { _Pragma("unroll") for (int n = 0; n < 2; ++n) _Pragma("unroll") for (int k = 0; k < 2; ++k) dst[n][k] = *(const LAS f16x8*)(lds + G_SB(b, h) + boff + n * 2048 + k * 1024); } while (0)
#define G_MMA(ai, bj, At, Bt) do { __builtin_amdgcn_s_setprio(1); _Pragma("unroll") for (int m = 0; m < 4; ++m) _Pragma("unroll") for (int n = 0; n < 2; ++n) _Pragma("unroll") for (int k = 0; k < 2; ++k) \
        acc[ai][bj][m][n] = __builtin_amdgcn_mfma_f32_16x16x32_f16(Bt[n][k], At[m][k], acc[ai][bj][m][n], 0, 0, 0); __builtin_amdgcn_s_setprio(0); } while (0)
#define G_WAIT_V(n) asm volatile("s_waitcnt vmcnt(" #n ")" ::: "memory")
#define G_WAIT_L(n) asm volatile("s_waitcnt lgkmcnt(" #n ")" ::: "memory")
#define G_BAR __builtin_amdgcn_s_barrier()
#define G_SCHED __builtin_amdgcn_sched_barrier(0)
    Unit cur, nxt; int ui = 0;
    if (!S.next(0, cur)) return;
    f32x4 acc[2][2][4][2];
#pragma unroll
    for (int a = 0; a < 2; ++a)
#pragma unroll
        for (int b = 0; b < 2; ++b)
#pragma unroll
            for (int m = 0; m < 4; ++m)
#pragma unroll
                for (int n = 0; n < 2; ++n) acc[a][b][m][n] = (f32x4){0.f, 0.f, 0.f, 0.f};
    f16x8 At[4][2], B0[2][2], B1[2][2];
    const char* const Abase = S.A;
    unsigned cad[2], nad[2];
    S.a_desc(cur, rc, cad);
    const char* cB = S.b_base(cur);
    G_STAGE_B(G_SB(0, 0), cB); G_STAGE_B(G_SB(0, 1), cB + hstepB); G_STAGE_A(G_SA(0, 0), cad, 0, 0u); G_STAGE_A(G_SA(0, 1), cad, 1, 0u);
    if (wr == 1) G_BAR;
    G_WAIT_V(2); G_BAR;
    G_STAGE_B(G_SB(1, 0), cB + Sched::kb(1)); G_STAGE_A(G_SA(1, 0), cad, 0, Sched::ka(1)); G_STAGE_B(G_SB(1, 1), cB + hstepB + Sched::kb(1));
    G_WAIT_V(6); G_BAR;
    for (;;) {
        const bool has_next = S.next(ui + 1, nxt);
        const char* nB = cB;
        if (has_next) { S.a_desc(nxt, rc, nad); nB = S.b_base(nxt); }
        else { nad[0] = cad[0]; nad[1] = cad[1]; }
        for (int t = 0; t < nt; t += 2) {
            const bool last = (t == nt - 2);
            const unsigned k1 = Sched::ka(t + 1);
            const unsigned k2 = last ? Sched::ka(0) : Sched::ka(t + 2), k3 = last ? Sched::ka(1) : Sched::ka(t + 3);
            const unsigned a2[2] = {last ? nad[0] : cad[0], last ? nad[1] : cad[1]};
            const char* b2 = (last ? nB + Sched::kb(0) : cB + Sched::kb(t + 2)); const char* b3 = (last ? nB + Sched::kb(1) : cB + Sched::kb(t + 3));
            if constexpr (Sched::MID >= 0) { if (t == Sched::MID) E.mid(acc, cur, wr, wc, fr, fq); }
            G_LDB(B0, 0, 0); G_LDB(B1, 0, 1); G_SCHED; G_LDA(At, 0, 0); G_STAGE_A(G_SA(1, 1), cad, 1, k1);
            G_WAIT_V(8); G_WAIT_L(0); G_BAR; G_MMA(0, 0, At, B0); G_MMA(0, 1, At, B1); G_BAR; G_SCHED;
            G_LDA(At, 0, 1); G_STAGE_B(G_SB(0, 0), b2); G_STAGE_B(G_SB(0, 1), b2 + hstepB); G_STAGE_A(G_SA(0, 0), a2, 0, k2);
            G_WAIT_V(8); G_WAIT_L(0); G_BAR; G_MMA(1, 0, At, B0); G_MMA(1, 1, At, B1); G_BAR; G_SCHED;
            G_LDB(B0, 1, 0); G_LDB(B1, 1, 1); G_SCHED; G_LDA(At, 1, 0); G_STAGE_A(G_SA(0, 1), a2, 1, k2);
            G_WAIT_V(8); G_WAIT_L(0); G_BAR; G_MMA(0, 0, At, B0); G_MMA(0, 1, At, B1); G_BAR; G_SCHED;
            G_LDA(At, 1, 1); G_STAGE_B(G_SB(1, 0), b3); G_STAGE_B(G_SB(1, 1), b3 + hstepB); G_STAGE_A(G_SA(1, 0), a2, 0, k3);
            G_WAIT_V(8); G_WAIT_L(0); G_BAR; G_MMA(1, 0, At, B0); G_MMA(1, 1, At, B1); G_BAR; G_SCHED;
        }
        if (wr == 0) G_BAR;
        E(acc, cur, wr, wc, fr, fq);
        if (!has_next) break;
#pragma unroll
        for (int a = 0; a < 2; ++a)
#pragma unroll
            for (int b = 0; b < 2; ++b)
#pragma unroll
                for (int m = 0; m < 4; ++m)
#pragma unroll
                    for (int n = 0; n < 2; ++n) acc[a][b][m][n] = (f32x4){0.f, 0.f, 0.f, 0.f};
        cur = nxt; cB = nB; ++ui; cad[0] = nad[0]; cad[1] = nad[1];
        if (wr == 1) G_BAR;
    }
    G_WAIT_V(0);
    G_BAR;
#undef G_SA
#undef G_SB
#undef G_STAGE_A
#undef G_STAGE_B
#undef G_LDA
#undef G_LDB
#undef G_MMA
#undef G_WAIT_V
#undef G_WAIT_L
#undef G_BAR
#undef G_SCHED
}
constexpr size_t WS_WIN = 0;
constexpr size_t WS_WPA = WS_WIN + (size_t)INW * DM * 2;
constexpr size_t WS_WPB = WS_WPA + (size_t)DM * 512 * 2;
constexpr size_t WS_WOUT = WS_WPB + (size_t)DM * 512 * 2;
constexpr size_t WS_WUP = WS_WOUT + (size_t)DM * DM * 2;
constexpr size_t WS_WDN = WS_WUP + (size_t)NEXP * 2048 * DM * 2;
constexpr size_t WS_XH = WS_WDN + (size_t)NEXP * DM * DM * 2;
constexpr size_t WS_PROJ = WS_XH + (size_t)TOK * DM * 2;
constexpr size_t WS_OAB = WS_PROJ + (size_t)TOK * INW * 2;
constexpr size_t WS_MERGED = WS_OAB + (size_t)TOK * DM * 2;
constexpr size_t WS_H1 = WS_MERGED + (size_t)TOK * DM * 2;
constexpr size_t WS_SMALL = WS_H1 + (size_t)TOK * DM * 4 + 16 * MiB;
constexpr size_t WS_YS = WS_OAB;
constexpr size_t SM_PQ = 16064;
constexpr size_t SM_CNT = 0, SM_TK = 16384, SM_LIST = SM_TK + (size_t)NASG * 4;
constexpr size_t WS_END = WS_SMALL + SM_LIST + (size_t)NEXP * LISTCAP * 8;
static_assert(WS_YS + (size_t)MOE_ROWS * DM * 2 <= WS_SMALL, "ys overlaps bookkeeping");
static_assert((size_t)MOE_ROWS * DM * 2 <= (size_t)TOK * INW * 2, "act does not fit over proj");
static_assert(WS_END <= 1024 * MiB, "workspace");

struct Params {
    const float* in[22]; float* out; unsigned char* ws;
};

constexpr int LDS_PARAMS = LDS_WTAB - 256;
__device__ __forceinline__ unsigned long long rfl64(unsigned long long v) {
    const unsigned lo = (unsigned)__builtin_amdgcn_readfirstlane((int)(unsigned)v), hi = (unsigned)__builtin_amdgcn_readfirstlane((int)(unsigned)(v >> 32));
    return ((unsigned long long)hi << 32) | lo; }
__device__ __forceinline__ Params get_params(LAS unsigned char* lds) {
    unsigned off = LDS_PARAMS; asm volatile("" : "+v"(off));
    const LAS unsigned long long* q = (const LAS unsigned long long*)(lds + off);
    Params p;
#pragma unroll
    for (int i = 0; i < 22; ++i) p.in[i] = (const float*)rfl64(q[i]);
    p.out = (float*)rfl64(q[22]); p.ws = (unsigned char*)rfl64(q[23]);
    return p;
}
__device__ __forceinline__ void put_params(const Params& p, LAS unsigned char* lds) {
    LAS unsigned long long* q = (LAS unsigned long long*)(lds + LDS_PARAMS);
#pragma unroll
    for (int i = 0; i < 22; ++i) q[i] = (unsigned long long)p.in[i];
    q[22] = (unsigned long long)p.out; q[23] = (unsigned long long)p.ws;
}


struct PrepTile { const float* src; int ldsrc; f16* dst; int K; int n0; };
__device__ __forceinline__ PrepTile prep_desc(const Params& p, int t) {
    unsigned char* ws = p.ws;
    constexpr int T_IN = (INW / 64) * (DM / 128), T_PA = (DM / 64) * (512 / 128), T_OUT = (DM / 64) * (DM / 128);
    constexpr int T_UP1 = (2048 / 64) * (DM / 128), T_DN1 = (DM / 64) * (DM / 128);
    constexpr int T0 = T_IN, T1 = T0 + T_PA, T2 = T1 + T_PA, T3 = T2 + T_OUT, T4 = T3 + NEXP * T_UP1;
    PrepTile d;
    if (t < T0) { const int tn = t / 8, tk = t % 8; d.src = p.in[1] + (size_t)(tk * 128) * INW + tn * 64; d.ldsrc = INW; d.dst = (f16*)(ws + WS_WIN) + tk * 128; d.K = DM; d.n0 = tn * 64; }
    else if (t < T1) { const int q = t - T0, tn = q / 4, tk = q % 4; d.src = p.in[8] + (size_t)(tk * 128) * DM + tn * 64; d.ldsrc = DM; d.dst = (f16*)(ws + WS_WPA) + tk * 128; d.K = 512; d.n0 = tn * 64; }
    else if (t < T2) { const int q = t - T1, tn = q / 4, tk = q % 4; d.src = p.in[9] + (size_t)(tk * 128) * DM + tn * 64; d.ldsrc = DM; d.dst = (f16*)(ws + WS_WPB) + tk * 128; d.K = 512; d.n0 = tn * 64; }
    else if (t < T3) { const int q = t - T2, tn = q / 8, tk = q % 8; d.src = p.in[10] + (size_t)(tk * 128) * DM + tn * 64; d.ldsrc = DM; d.dst = (f16*)(ws + WS_WOUT) + tk * 128; d.K = DM; d.n0 = tn * 64; }
    else if (t < T4) { const int q = t - T3, e = q / T_UP1, r = q % T_UP1, tn = r / 8, tk = r % 8;
        const int np = tn * 64, pn = np >> 8, jj = np & 255;
        const int sc = jj < 128 ? pn * 128 + jj : 1024 + pn * 128 + (jj - 128);
        d.src = p.in[16] + (size_t)e * DM * 2048 + (size_t)(tk * 128) * 2048 + sc; d.ldsrc = 2048; d.dst = (f16*)(ws + WS_WUP) + (size_t)e * 2048 * DM + tk * 128; d.K = DM; d.n0 = np; }
    else { const int q = t - T4, e = q / T_DN1, r = q % T_DN1, tn = r / 8, tk = r % 8;
        d.src = p.in[18] + (size_t)e * DM * DM + (size_t)(tk * 128) * DM + tn * 64; d.ldsrc = DM; d.dst = (f16*)(ws + WS_WDN) + (size_t)e * DM * DM + tk * 128; d.K = DM; d.n0 = tn * 64; }
    return d;
}
constexpr int PREP_NT = (INW / 64) * (DM / 128) + 2 * (DM / 64) * (512 / 128) + (DM / 64) * (DM / 128) + NEXP * ((2048 / 64) * (DM / 128) + (DM / 64) * (DM / 128));
__device__ __forceinline__ void phase_prep(const Params& p, LAS unsigned char* lds, int wg, int nwg) {
    const int tid = get_tid(lds);
    unsigned char* ws = p.ws;
    {
        const float4* src = (const float4*)p.in[0]; u32x4* dst = (u32x4*)(ws + WS_XH);
        constexpr size_t n8 = (size_t)TOK * DM / 8;
        const size_t stride = (size_t)nwg * NTHR;
        for (size_t i = (size_t)wg * NTHR + tid; i < n8; i += 4 * stride) {
            float4 a[4], c[4];
#pragma unroll
            for (int u = 0; u < 4; ++u) { a[u] = src[2 * (i + u * stride)]; c[u] = src[2 * (i + u * stride) + 1]; }
#pragma unroll
            for (int u = 0; u < 4; ++u) { u32x4 w; w.x = pk2(a[u].x, a[u].y); w.y = pk2(a[u].z, a[u].w); w.z = pk2(c[u].x, c[u].y); w.w = pk2(c[u].z, c[u].w); dst[i + u * stride] = w; }
        }
    }
    LAS float* tile = (LAS float*)lds;
    const int lk = tid >> 4, ln4 = (tid & 15) * 4;
    float4 va[4], vb[4];
#define PREP_LOAD(V, tt) do { if ((tt) < PREP_NT) { const PrepTile d_ = prep_desc(p, (tt)); \
        _Pragma("unroll") for (int j = 0; j < 4; ++j) V[j] = *(const float4*)(d_.src + (size_t)(lk + 32 * j) * d_.ldsrc + ln4); } } while (0)
#define PREP_DO2(V, tt, tnext) do { if ((tt) < PREP_NT) { const PrepTile d = prep_desc(p, (tt)); \
        _Pragma("unroll") for (int j = 0; j < 4; ++j) { LAS float* r = tile + (lk + 32 * j) * 65 + ln4; r[0] = V[j].x; r[1] = V[j].y; r[2] = V[j].z; r[3] = V[j].w; } \
        PREP_LOAD(V, (tnext)); \
        __syncthreads(); \
        { const int n = tid >> 3, kc = (tid & 7) * 16; u32x4 w0, w1; \
          w0.x = pk2(tile[(kc + 0) * 65 + n], tile[(kc + 1) * 65 + n]); w0.y = pk2(tile[(kc + 2) * 65 + n], tile[(kc + 3) * 65 + n]); \
          w0.z = pk2(tile[(kc + 4) * 65 + n], tile[(kc + 5) * 65 + n]); w0.w = pk2(tile[(kc + 6) * 65 + n], tile[(kc + 7) * 65 + n]); \
          w1.x = pk2(tile[(kc + 8) * 65 + n], tile[(kc + 9) * 65 + n]); w1.y = pk2(tile[(kc + 10) * 65 + n], tile[(kc + 11) * 65 + n]); \
          w1.z = pk2(tile[(kc + 12) * 65 + n], tile[(kc + 13) * 65 + n]); w1.w = pk2(tile[(kc + 14) * 65 + n], tile[(kc + 15) * 65 + n]); \
          f16* o = d.dst + (size_t)(d.n0 + n) * d.K + kc; *(u32x4*)o = w0; *(u32x4*)(o + 8) = w1; } \
        __syncthreads(); } } while (0)
    unsigned* pq = (unsigned*)(ws + WS_SMALL + SM_PQ);
    LAS int* qslot = (LAS int*)(lds + 36864);
    int ta, tb;
    if (tid == 0) { qslot[0] = (int)__hip_atomic_fetch_add(pq, 1u, __ATOMIC_RELAXED, __HIP_MEMORY_SCOPE_AGENT); qslot[1] = (int)__hip_atomic_fetch_add(pq, 1u, __ATOMIC_RELAXED, __HIP_MEMORY_SCOPE_AGENT); }
    __syncthreads();
    ta = qslot[0]; tb = qslot[1];
    PREP_LOAD(va, ta); PREP_LOAD(vb, tb);
#define PREP_DRAW(tv) do { __syncthreads(); if (tid == 0) qslot[0] = (int)__hip_atomic_fetch_add(pq, 1u, __ATOMIC_RELAXED, __HIP_MEMORY_SCOPE_AGENT); __syncthreads(); tv = qslot[0]; } while (0)
#pragma unroll 1
    for (;;) {
        if (ta >= PREP_NT && tb >= PREP_NT) break;
        int tn;
        if (ta < PREP_NT) { PREP_DRAW(tn); PREP_DO2(va, ta, tn); ta = tn; }
        if (tb < PREP_NT) { PREP_DRAW(tn); PREP_DO2(vb, tb, tn); tb = tn; }
    }
#undef PREP_DRAW
#undef PREP_LOAD
#undef PREP_DO2
}

struct EpiInProj {
    static constexpr bool PERM = true;
    f16* O; const float* bias;
    __device__ __forceinline__ void operator()(const f32x4 (&acc)[2][2][4][2], const Unit& u, int wr, int wc, int fr, int fq) const {
        const int row0 = u.pm * BM + wr * 64 + fr, col0 = u.pn * BM + wc * 32 + 8 * fq;
        const int cls = u.pn;
        const float scl = (cls < 2 || cls == 6 || cls == 7) ? QSCALE : 1.0f;
        const bool sig = cls >= 12;
        f32x4 bv[2][2];
#pragma unroll
        for (int bj = 0; bj < 2; ++bj)
#pragma unroll
            for (int n = 0; n < 2; ++n) bv[bj][n] = *(const f32x4*)(bias + col0 + bj * HALF + 4 * n);
#pragma unroll
        for (int ai = 0; ai < 2; ++ai)
#pragma unroll
            for (int m = 0; m < 4; ++m) {
                f16* rowp = O + (size_t)(row0 + ai * HALF + m * 16) * INW + col0;
#pragma unroll
                for (int bj = 0; bj < 2; ++bj) {
                    f32x4 v0 = acc[ai][bj][m][0] + bv[bj][0], v1 = acc[ai][bj][m][1] + bv[bj][1];
                    if (sig) {
#pragma unroll
                        for (int j = 0; j < 4; ++j) { v0[j] = __builtin_amdgcn_rcpf(1.0f + __expf(-v0[j])); v1[j] = __builtin_amdgcn_rcpf(1.0f + __expf(-v1[j])); }
                    } else { v0 *= scl; v1 *= scl; }
                    u32x4 w; w.x = pk2(v0[0], v0[1]); w.y = pk2(v0[2], v0[3]); w.z = pk2(v1[0], v1[1]); w.w = pk2(v1[2], v1[3]);
                    *(u32x4*)(rowp + bj * HALF) = w;
                }
            }
    }
};
__device__ __forceinline__ void phase_inproj(const Params& p, LAS unsigned char* lds, int wg, int nwg) {
    DenseSched<DM> S; S.init(p.ws + WS_XH, p.ws + WS_WIN, TOK, INW, nwg, wg);
    EpiInProj E{(f16*)(p.ws + WS_PROJ), p.in[2]};
    gemm_phase(lds, S, E);
}
constexpr int RT_LOG = 131072, RT_HIST = RT_LOG + 16384;
__device__ __forceinline__ void phase_router(const Params& p, LAS unsigned char* lds, int wg, int nwg) {
    const int tid = get_tid(lds);
    const int lane = tid & 63, wave = tid >> 6;
    const float* h1 = (const float*)(p.ws + WS_H1);
    f16* x1h = (f16*)(p.ws + WS_XH);
    const float* lng = p.in[12]; const float* lnb = p.in[13];
    const float* wr = p.in[14]; const float* br = p.in[15];
    int* cnt = (int*)(p.ws + WS_SMALL + SM_CNT);
    int* tk = (int*)(p.ws + WS_SMALL + SM_TK);
    int2* list = (int2*)(p.ws + WS_SMALL + SM_LIST);
    LAS float* wl = (LAS float*)lds;
    LAS float* slog = (LAS float*)(lds + RT_LOG);
    LAS int* hist = (LAS int*)(lds + RT_HIST);
    LAS int* hbase = hist + 32;
    for (int i = tid; i < DM * 8; i += NTHR) {
        const int col = i >> 3, k = i & 7;
        const float4 v = *(const float4*)(wr + (size_t)col * NEXP + k * 4);
        LAS float* d = wl + col * 32 + ((k ^ ((col >> 1) & 7)) << 2);
        d[0] = v.x; d[1] = v.y; d[2] = v.z; d[3] = v.w;
    }
    if (tid < 32) hist[tid] = 0;
    __syncthreads();
    const int tpw = TOK / (nwg * 8);
    const int tok0 = wg * (TOK / nwg) + wave * tpw;
    float gam[16], bet[16];
#pragma unroll
    for (int r = 0; r < 16; ++r) { gam[r] = lng[r * 64 + lane]; bet[r] = lnb[r * 64 + lane]; }
    float xa[16], xb[16];
#pragma unroll
    for (int r = 0; r < 16; ++r) { xa[r] = h1[(size_t)tok0 * DM + r * 64 + lane]; xb[r] = h1[(size_t)(tok0 + 1) * DM + r * 64 + lane]; }
#pragma unroll 1
    for (int j = 0; j < tpw; j += 2) {
        const int t = tok0 + j;
        float na[16], nb[16];
        if (j + 2 < tpw) {
#pragma unroll
            for (int r = 0; r < 16; ++r) { na[r] = h1[(size_t)(t + 2) * DM + r * 64 + lane]; nb[r] = h1[(size_t)(t + 3) * DM + r * 64 + lane]; }
        } else {
#pragma unroll
            for (int r = 0; r < 16; ++r) { na[r] = 0.f; nb[r] = 0.f; }
        }
        float sa = 0.f, sb = 0.f;
#pragma unroll
        for (int r = 0; r < 16; ++r) { sa += xa[r]; sb += xb[r]; }
        for (int o = 32; o >= 1; o >>= 1) { sa += shx(sa, o, lane); sb += shx(sb, o, lane); }
        const float mua = sa * (1.0f / DM), mub = sb * (1.0f / DM);
        float qa = 0.f, qb = 0.f;
#pragma unroll
        for (int r = 0; r < 16; ++r) { const float da = xa[r] - mua, db = xb[r] - mub; qa += da * da; qb += db * db; }
        for (int o = 32; o >= 1; o >>= 1) { qa += shx(qa, o, lane); qb += shx(qb, o, lane); }
        const float rsa = rsqrtf(qa * (1.0f / DM) + 1e-5f), rsb = rsqrtf(qb * (1.0f / DM) + 1e-5f);
#pragma unroll
        for (int r = 0; r < 16; ++r) {
            xa[r] = (xa[r] - mua) * rsa * gam[r] + bet[r]; xb[r] = (xb[r] - mub) * rsb * gam[r] + bet[r];
            x1h[(size_t)t * DM + r * 64 + lane] = (f16)xa[r]; x1h[(size_t)(t + 1) * DM + r * 64 + lane] = (f16)xb[r];
        }
        float acc[32], acd[32];
#pragma unroll
        for (int e = 0; e < 32; ++e) { acc[e] = 0.f; acd[e] = 0.f; }
#pragma unroll
        for (int r = 0; r < 16; ++r) {
            const int col = r * 64 + lane;
            const LAS float* wrow = wl + col * 32;
            const int sw = (col >> 1) & 7;
#pragma unroll
            for (int k = 0; k < 8; ++k) {
                const f32x4 w4 = *(const LAS f32x4*)(wrow + ((k ^ sw) << 2));
#pragma unroll
                for (int c = 0; c < 4; ++c) { acc[k * 4 + c] = fmaf(xa[r], w4[c], acc[k * 4 + c]); acd[k * 4 + c] = fmaf(xb[r], w4[c], acd[k * 4 + c]); }
            }
        }
#define RT_REDUCE(AC, OUT) do { float a16[16], a8[8], a4[4], a2[2]; \
        { const bool hi_ = (lane & 32) != 0; _Pragma("unroll") for (int k = 0; k < 16; ++k) { const float snd = hi_ ? AC[k] : AC[16 + k]; const float rcv = shx(snd, 32, lane); a16[k] = (hi_ ? AC[16 + k] : AC[k]) + rcv; } } \
        { const bool hi_ = (lane & 16) != 0; _Pragma("unroll") for (int k = 0; k < 8; ++k) { const float snd = hi_ ? a16[k] : a16[8 + k]; const float rcv = shx(snd, 16, lane); a8[k] = (hi_ ? a16[8 + k] : a16[k]) + rcv; } } \
        { const bool hi_ = (lane & 8) != 0; _Pragma("unroll") for (int k = 0; k < 4; ++k) { const float snd = hi_ ? a8[k] : a8[4 + k]; const float rcv = shx(snd, 8, lane); a4[k] = (hi_ ? a8[4 + k] : a8[k]) + rcv; } } \
        { const bool hi_ = (lane & 4) != 0; _Pragma("unroll") for (int k = 0; k < 2; ++k) { const float snd = hi_ ? a4[k] : a4[2 + k]; const float rcv = shx(snd, 4, lane); a2[k] = (hi_ ? a4[2 + k] : a4[k]) + rcv; } } \
        { const bool hi_ = (lane & 2) != 0; const float snd = hi_ ? a2[0] : a2[1]; const float rcv = shx(snd, 2, lane); OUT = (hi_ ? a2[1] : a2[0]) + rcv; } \
        OUT += shx(OUT, 1, lane); } while (0)
        float l0, l1;
        RT_REDUCE(acc, l0); RT_REDUCE(acd, l1);
#undef RT_REDUCE
        if ((lane & 1) == 0) { const float bb = br[lane >> 1]; slog[(wave * tpw + j) * 32 + (lane >> 1)] = l0 + bb; slog[(wave * tpw + j + 1) * 32 + (lane >> 1)] = l1 + bb; }
#pragma unroll
        for (int r = 0; r < 16; ++r) { xa[r] = na[r]; xb[r] = nb[r]; }
    }
    __syncthreads();
    int my_e[4]; float my_g[4]; int my_loc[4];
    const bool act = lane < tpw;
    const int tl = wave * tpw + lane;
    if (act) {
        float v[32];
#pragma unroll
        for (int k = 0; k < 8; ++k) { const f32x4 t4 = *(const LAS f32x4*)(slog + tl * 32 + k * 4); v[k * 4] = t4[0]; v[k * 4 + 1] = t4[1]; v[k * 4 + 2] = t4[2]; v[k * 4 + 3] = t4[3]; }
        float tv[4];
#pragma unroll
        for (int k = 0; k < 4; ++k) {
            float bv = -3.0e38f; int bi = 0;
#pragma unroll
            for (int e = 0; e < 32; ++e) { if (v[e] > bv) { bv = v[e]; bi = e; } }
            tv[k] = bv; my_e[k] = bi;
#pragma unroll
            for (int e = 0; e < 32; ++e) v[e] = (e == bi) ? -3.0e38f : v[e];
        }
        const float e1 = __expf(tv[1] - tv[0]), e2 = __expf(tv[2] - tv[0]), e3 = __expf(tv[3] - tv[0]);
        const float inv = 1.0f / (1.0f + e1 + e2 + e3);
        my_g[0] = inv; my_g[1] = e1 * inv; my_g[2] = e2 * inv; my_g[3] = e3 * inv;
#pragma unroll
        for (int k = 0; k < 4; ++k) my_loc[k] = __hip_atomic_fetch_add(hist + my_e[k], 1, __ATOMIC_RELAXED, __HIP_MEMORY_SCOPE_WORKGROUP);
    }
    __syncthreads();
    if (tid < 32) hbase[tid] = atomicAdd(&cnt[tid], hist[tid]);
    __syncthreads();
    if (act) {
        const int t = tok0 + lane;
#pragma unroll
        for (int k = 0; k < 4; ++k) {
            const int slot = hbase[my_e[k]] + my_loc[k];
            tk[t * 4 + k] = (my_e[k] << 20) | slot;
            list[(size_t)my_e[k] * LISTCAP + slot] = make_int2(t, __float_as_int(my_g[k]));
        }
    }
    __syncthreads();
}

__device__ __forceinline__ void phase_final(const Params& p, LAS unsigned char* lds, int wg, int nwg) {
    const int tid = get_tid(lds);
    const int lane = tid & 63, wave = tid >> 6;
    const f16* x1h = (const f16*)(p.ws + WS_XH);
    const f16* ys = (const f16*)(p.ws + WS_YS);
    const int* cnt = (const int*)(p.ws + WS_SMALL + SM_CNT);
    const int* tk = (const int*)(p.ws + WS_SMALL + SM_TK);
    const float* lng = p.in[20]; const float* lnb = p.in[21];
    LAS int* ps = (LAS int*)lds;
    if (tid == 0) { int a = 0; for (int e = 0; e < NEXP; ++e) { ps[e] = a; a += (cnt[e] + ROWPAD - 1) / ROWPAD * ROWPAD; } }
    __syncthreads();
    const int tpw = TOK / (nwg * 8);
    const int tok0 = wg * (TOK / nwg) + wave * tpw;
    for (int j = 0; j < tpw; ++j) {
        const int t = tok0 + j;
        float v[16];
        { const f16x8 a = *(const f16x8*)(x1h + (size_t)t * DM + 8 * lane), b = *(const f16x8*)(x1h + (size_t)t * DM + 512 + 8 * lane);
#pragma unroll
          for (int i = 0; i < 8; ++i) { v[i] = ALPHA * (float)a[i]; v[8 + i] = ALPHA * (float)b[i]; } }
#pragma unroll
        for (int k = 0; k < 4; ++k) {
            const int c = tk[t * 4 + k]; const int row = ps[c >> 20] + (c & 0xFFFFF);
            const f16x8 a = *(const f16x8*)(ys + (size_t)row * DM + 8 * lane), b = *(const f16x8*)(ys + (size_t)row * DM + 512 + 8 * lane);
#pragma unroll
            for (int i = 0; i < 8; ++i) { v[i] += (float)a[i]; v[8 + i] += (float)b[i]; }
        }
        float s = 0.f;
#pragma unroll
        for (int i = 0; i < 16; ++i) s += v[i];
        for (int o = 32; o >= 1; o >>= 1) s += shx(s, o, lane);
        const float mu = s * (1.0f / DM);
        float q = 0.f;
#pragma unroll
        for (int i = 0; i < 16; ++i) { const float d = v[i] - mu; q += d * d; }
        for (int o = 32; o >= 1; o >>= 1) q += shx(q, o, lane);
        const float rs = rsqrtf(q * (1.0f / DM) + 1e-5f);
        float* op = p.out + (size_t)t * DM;
#pragma unroll
        for (int hh = 0; hh < 2; ++hh) {
            const int c0 = hh * 512 + 8 * lane;
            const float4 g0 = *(const float4*)(lng + c0), g1 = *(const float4*)(lng + c0 + 4), b0 = *(const float4*)(lnb + c0), b1 = *(const float4*)(lnb + c0 + 4);
            float4 o0, o1;
            o0.x = (v[hh * 8 + 0] - mu) * rs * g0.x + b0.x; o0.y = (v[hh * 8 + 1] - mu) * rs * g0.y + b0.y; o0.z = (v[hh * 8 + 2] - mu) * rs * g0.z + b0.z; o0.w = (v[hh * 8 + 3] - mu) * rs * g0.w + b0.w;
            o1.x = (v[hh * 8 + 4] - mu) * rs * g1.x + b1.x; o1.y = (v[hh * 8 + 5] - mu) * rs * g1.y + b1.y; o1.z = (v[hh * 8 + 6] - mu) * rs * g1.z + b1.z; o1.w = (v[hh * 8 + 7] - mu) * rs * g1.w + b1.w;
            *(float4*)(op + c0) = o0; *(float4*)(op + c0 + 4) = o1;
        }
    }
    __syncthreads();
}
struct MergeSched {
    static constexpr int K = 1024, LDB = 512, MID = 8;
    static constexpr unsigned OB_JUMP = (unsigned)(TOK * 512 * 2) - 1024u, WB_JUMP = (unsigned)(DM * 512 * 2) - 1024u;
    const char* A; const char* Bt; DenseSched<512> D;
    __device__ void init(const void* oa, const void* wpa_t, int G, int c) { A = (const char*)oa; Bt = (const char*)wpa_t; D.init(oa, wpa_t, TOK, DM, G, c); }
    __device__ __forceinline__ bool next(int i, Unit& u) const { return D.next(i, u); }
    static __device__ __forceinline__ unsigned ka(int kt) { return (unsigned)kt * 128u + (kt >= 8 ? OB_JUMP : 0u); }
    static __device__ __forceinline__ unsigned kb(int kt) { return (unsigned)kt * 128u + (kt >= 8 ? WB_JUMP : 0u); }
    static __device__ __forceinline__ unsigned make_rc(int R, int C) { return (unsigned)(R * 512 + C) * 2u; }
    __device__ __forceinline__ void a_desc(const Unit& u, const unsigned (&rc)[2], unsigned (&ad)[2]) const { const unsigned o = (unsigned)u.pm * (unsigned)(BM * 512 * 2); ad[0] = rc[0] + o; ad[1] = rc[1] + o; }
    static __device__ __forceinline__ unsigned aoff(unsigned ad, unsigned rc, int h) { return ad + (unsigned)h * (unsigned)(HALF * 512 * 2); }
    __device__ __forceinline__ const char* b_base(const Unit& u) const { return Bt + (size_t)u.pn * BM * 512 * 2; }
};
struct EpiMerge {
    static constexpr bool PERM = true;
    const f16* proj; f16* merged;
    __device__ __forceinline__ void mid(f32x4 (&acc)[2][2][4][2], const Unit& u, int wr, int wc, int fr, int fq) const {
        asm volatile("" : "+v"(fr), "+v"(fq));
        const int row0 = u.pm * BM + wr * 64 + fr, col0 = u.pn * BM + wc * 32 + 8 * fq;
#pragma unroll
        for (int ai = 0; ai < 2; ++ai)
#pragma unroll
            for (int m = 0; m < 4; ++m) {
                const size_t row = (size_t)(row0 + ai * HALF + m * 16);
#pragma unroll
                for (int bj = 0; bj < 2; ++bj) {
                    const f16x8 ga = *(const f16x8*)(proj + row * INW + C_GA + col0 + bj * HALF), gb = *(const f16x8*)(proj + row * INW + C_GB + col0 + bj * HALF);
#pragma unroll
                    for (int j = 0; j < 4; ++j) {
                        acc[ai][bj][m][0][j] *= (float)ga[j] * __builtin_amdgcn_rcpf(fmaxf((float)gb[j], 5.9604645e-8f));
                        acc[ai][bj][m][1][j] *= (float)ga[4 + j] * __builtin_amdgcn_rcpf(fmaxf((float)gb[4 + j], 5.9604645e-8f));
                    }
                }
                asm volatile("" ::: "memory");
            }
    }
    __device__ __forceinline__ void operator()(const f32x4 (&acc)[2][2][4][2], const Unit& u, int wr, int wc, int fr, int fq) const {
        const int row0 = u.pm * BM + wr * 64 + fr, col0 = u.pn * BM + wc * 32 + 8 * fq;
#pragma unroll
        for (int ai = 0; ai < 2; ++ai)
#pragma unroll
            for (int m = 0; m < 4; ++m) {
                const size_t row = (size_t)(row0 + ai * HALF + m * 16);
#pragma unroll
                for (int bj = 0; bj < 2; ++bj) {
                    const f16x8 gb = *(const f16x8*)(proj + row * INW + C_GB + col0 + bj * HALF);
                    float v[8];
#pragma unroll
                    for (int j = 0; j < 4; ++j) { v[j] = fmaxf((float)gb[j], 5.9604645e-8f) * acc[ai][bj][m][0][j]; v[4 + j] = fmaxf((float)gb[4 + j], 5.9604645e-8f) * acc[ai][bj][m][1][j]; }
                    u32x4 w; w.x = pk2(v[0], v[1]); w.y = pk2(v[2], v[3]); w.z = pk2(v[4], v[5]); w.w = pk2(v[6], v[7]);
                    *(u32x4*)(merged + row * DM + col0 + bj * HALF) = w;
                }
            }
    }
};
__device__ __forceinline__ void phase_merge(const Params& p, LAS unsigned char* lds, int wg, int nwg) {
    MergeSched S; S.init(p.ws + WS_OAB, p.ws + WS_WPA, nwg, wg);
    EpiMerge E{(const f16*)(p.ws + WS_PROJ), (f16*)(p.ws + WS_MERGED)};
    gemm_phase(lds, S, E);
}
struct EpiOutProj {
    static constexpr bool PERM = false;
    const float* x; const float* bias; float* h1;
    __device__ __forceinline__ void operator()(const f32x4 (&acc)[2][2][4][2], const Unit& u, int wr, int wc, int fr, int fq) const {
        const int row0 = u.pm * BM + wr * 64 + fr, col0 = u.pn * BM + wc * 32 + 4 * fq;
        f32x4 bv[2][2];
#pragma unroll
        for (int bj = 0; bj < 2; ++bj)
#pragma unroll
            for (int n = 0; n < 2; ++n) bv[bj][n] = *(const f32x4*)(bias + col0 + bj * HALF + n * 16);
#pragma unroll
        for (int ai = 0; ai < 2; ++ai)
#pragma unroll
            for (int m = 0; m < 4; ++m) {
                const size_t off = (size_t)(row0 + ai * HALF + m * 16) * DM + col0;
#pragma unroll
                for (int bj = 0; bj < 2; ++bj)
#pragma unroll
                    for (int n = 0; n < 2; ++n) {
                        const f32x4 xv = *(const f32x4*)(x + off + bj * HALF + n * 16);
                        *(f32x4*)(h1 + off + bj * HALF + n * 16) = ALPHA * xv + acc[ai][bj][m][n] + bv[bj][n];
                    }
            }
    }
};
__device__ __forceinline__ void phase_outproj(const Params& p, LAS unsigned char* lds, int wg, int nwg) {
    DenseSched<DM> S; S.init(p.ws + WS_MERGED, p.ws + WS_WOUT, TOK, DM, nwg, wg);
    EpiOutProj E{p.in[0], p.in[11], (float*)(p.ws + WS_H1)};
    gemm_phase(lds, S, E);
}

constexpr int MOE_MISC = STAGE_BYTES;
__device__ __forceinline__ void moe_prefix(const Params& p, LAS unsigned char* lds) {
    LAS int* tpre = (LAS int*)(lds + MOE_MISC); LAS int* ecnt = tpre + 64;
    const int* cnt = (const int*)(p.ws + WS_SMALL + SM_CNT);
    if (get_tid(lds) == 0) { int a = 0; for (int e = 0; e < NEXP; ++e) { const int c = cnt[e]; ecnt[e] = c; tpre[e] = a; a += (c + ROWPAD - 1) / ROWPAD; } tpre[NEXP] = a; }
    __syncthreads();
}
template <int NPN, bool GATHER>
struct MoeSched {
    static constexpr int K = DM;
    const char* A; const char* Bt; const int2* list; LAS int* tpre; LAS int* ecnt; int c;
    __device__ __forceinline__ bool next(int i, Unit& u) const {
        constexpr int MPR = 256 / NPN, MPX = 32 / NPN;
        const int xcd = c & 7, j = c >> 3;
        const int M = i * MPR + xcd * MPX + j / NPN;
        if (M >= tpre[NEXP]) return false;
        int e = 0;
        for (int k = 1; k < NEXP; ++k) e += (tpre[k] <= M) ? 1 : 0;
        u.e = e; u.pm = M - tpre[e]; u.pn = j % NPN; u.row0 = M * ROWPAD; u.nrows = ecnt[e] - u.pm * ROWPAD;
        return true;
    }
    static constexpr int LDB = DM, MID = -1;
    static __device__ __forceinline__ unsigned ka(int kt) { return (unsigned)kt * 128u; }
    static __device__ __forceinline__ unsigned kb(int kt) { return (unsigned)kt * 128u; }
    static __device__ __forceinline__ unsigned make_rc(int R, int C) { return GATHER ? ((unsigned)R | ((unsigned)(2 * C) << 8)) : (unsigned)(R * K + C) * 2u; }
    __device__ __forceinline__ void a_desc(const Unit& u, const unsigned (&rc)[2], unsigned (&ad)[2]) const {
        if (GATHER) {
#pragma unroll
            for (int i = 0; i < 2; ++i) {
                const int R = (int)(rc[i] & 0xFFu);
                const int2* lp = list + (size_t)u.e * LISTCAP + u.pm * ROWPAD + R;
                int t0 = lp[0].x, t1 = lp[HALF].x;
                t0 = R < u.nrows ? t0 : 0; t1 = (R + HALF) < u.nrows ? t1 : 0;
                ad[i] = (unsigned)t0 | ((unsigned)t1 << 16);
            }
            asm volatile("" : "+v"(ad[0]), "+v"(ad[1]));
        } else { ad[0] = rc[0] + (unsigned)u.row0 * (unsigned)(K * 2); ad[1] = rc[1] + (unsigned)u.row0 * (unsigned)(K * 2); }
    }
    static __device__ __forceinline__ unsigned aoff(unsigned ad, unsigned rc, int h) {
        return GATHER ? (((ad >> (16 * h)) & 0xFFFFu) * (unsigned)(K * 2) + (rc >> 8)) : (ad + (unsigned)h * (unsigned)(HALF * K * 2)); }
    __device__ __forceinline__ const char* b_base(const Unit& u) const { return Bt + ((size_t)u.e * (NPN * BM) + (size_t)u.pn * BM) * K * 2; }
};
struct EpiUp {
    static constexpr bool PERM = true;
    const float* bup; f16* act;
    __device__ __forceinline__ void operator()(const f32x4 (&acc)[2][2][4][2], const Unit& u, int wr, int wc, int fr, int fq) const {
        const int col0 = u.pn * HALF + wc * 32 + 8 * fq;
        const float* bg = bup + (size_t)u.e * 2048 + col0; const float* bu = bg + 1024;
        const f32x4 bg0 = *(const f32x4*)bg, bg1 = *(const f32x4*)(bg + 4), bu0 = *(const f32x4*)bu, bu1 = *(const f32x4*)(bu + 4);
#pragma unroll
        for (int ai = 0; ai < 2; ++ai)
#pragma unroll
            for (int m = 0; m < 4; ++m) {
                const size_t row = (size_t)(u.row0 + ai * HALF + wr * 64 + m * 16 + fr);
                float v[8];
#pragma unroll
                for (int n = 0; n < 2; ++n)
#pragma unroll
                    for (int j = 0; j < 4; ++j) {
                        const float hg = acc[ai][0][m][n][j] + (n == 0 ? bg0[j] : bg1[j]), hu = acc[ai][1][m][n][j] + (n == 0 ? bu0[j] : bu1[j]);
                        const float gate = fminf(hg, 7.0f), up = fminf(fmaxf(hu, -7.0f), 7.0f);
                        v[n * 4 + j] = gate * __builtin_amdgcn_rcpf(1.0f + __expf(-1.702f * gate)) * (up + 1.0f);
                    }
                u32x4 w; w.x = pk2(v[0], v[1]); w.y = pk2(v[2], v[3]); w.z = pk2(v[4], v[5]); w.w = pk2(v[6], v[7]);
                *(u32x4*)(act + row * DM + col0) = w;
            }
    }
};
struct EpiDown {
    static constexpr bool PERM = true;
    const float* bdn; const int2* list; f16* ys;
    __device__ __forceinline__ void operator()(const f32x4 (&acc)[2][2][4][2], const Unit& u, int wr, int wc, int fr, int fq) const {
        const int col0 = u.pn * BM + wc * 32 + 8 * fq;
        f32x4 bv[2][2];
#pragma unroll
        for (int bj = 0; bj < 2; ++bj)
#pragma unroll
            for (int n = 0; n < 2; ++n) bv[bj][n] = *(const f32x4*)(bdn + (size_t)u.e * DM + col0 + bj * HALF + 4 * n);
#pragma unroll
        for (int ai = 0; ai < 2; ++ai)
#pragma unroll
            for (int m = 0; m < 4; ++m) {
                const int lr = ai * HALF + wr * 64 + m * 16 + fr;
                float wgt = __int_as_float(list[(size_t)u.e * LISTCAP + u.pm * ROWPAD + lr].y); wgt = lr < u.nrows ? wgt : 0.f;
                f16* rowp = ys + (size_t)(u.row0 + lr) * DM + col0;
#pragma unroll
                for (int bj = 0; bj < 2; ++bj) {
                    const f32x4 v0 = (acc[ai][bj][m][0] + bv[bj][0]) * wgt, v1 = (acc[ai][bj][m][1] + bv[bj][1]) * wgt;
                    u32x4 w; w.x = pk2(v0[0], v0[1]); w.y = pk2(v0[2], v0[3]); w.z = pk2(v1[0], v1[1]); w.w = pk2(v1[2], v1[3]);
                    *(u32x4*)(rowp + bj * HALF) = w;
                }
            }
    }
};
__device__ __forceinline__ void phase_up(const Params& p, LAS unsigned char* lds, int wg, int nwg) {
    moe_prefix(p, lds);
    MoeSched<8, true> S{(const char*)(p.ws + WS_XH), (const char*)(p.ws + WS_WUP), (const int2*)(p.ws + WS_SMALL + SM_LIST), (LAS int*)(lds + MOE_MISC), (LAS int*)(lds + MOE_MISC) + 64, wg};
    EpiUp E{p.in[17], (f16*)(p.ws + WS_PROJ)};
    gemm_phase(lds, S, E);
}
__device__ __forceinline__ void phase_down(const Params& p, LAS unsigned char* lds, int wg, int nwg) {
    moe_prefix(p, lds);
    MoeSched<4, false> S{(const char*)(p.ws + WS_PROJ), (const char*)(p.ws + WS_WDN), (const int2*)(p.ws + WS_SMALL + SM_LIST), (LAS int*)(lds + MOE_MISC), (LAS int*)(lds + MOE_MISC) + 64, wg};
    EpiDown E{p.in[19], (const int2*)(p.ws + WS_SMALL + SM_LIST), (f16*)(p.ws + WS_YS)};
    gemm_phase(lds, S, E);
}
__device__ __forceinline__ float lambda_full(const float* lq1, const float* lk1, const float* lq2, const float* lk2, int lane) {
    float a = lq1[lane] * lk1[lane], c = lq2[lane] * lk2[lane];
    for (int o = 32; o >= 1; o >>= 1) { a += shx(a, o, lane); c += shx(c, o, lane); }
    return __expf(a) - __expf(c) + LAMBDA_INIT;
}
typedef short s16x4 __attribute__((ext_vector_type(4)));
__device__ __forceinline__ int crow(int r, int hi) { return (r & 3) + 8 * (r >> 2) + 4 * hi; }
__device__ __forceinline__ f16x4 vtr(const LAS unsigned char* p) { return __builtin_bit_cast(f16x4, __builtin_amdgcn_ds_read_tr16_b64_v4i16((LAS s16x4*)p)); }
#define MFMA32(a, b, c) __builtin_amdgcn_mfma_f32_32x32x16_f16(a, b, c, 0, 0, 0)
__device__ __forceinline__ float rowmax32(const f32x16& p0, const f32x16& p1) {
    float a = fmaxf(fmaxf(p0[0], p0[1]), p1[0]), b = fmaxf(fmaxf(p0[2], p0[3]), p1[1]); a = fmaxf(fmaxf(a, p1[2]), p1[3]);
#pragma unroll
    for (int r = 4; r < 16; r += 4) { a = fmaxf(fmaxf(a, p0[r]), p0[r + 1]); b = fmaxf(fmaxf(b, p0[r + 2]), p0[r + 3]); a = fmaxf(fmaxf(a, p1[r]), p1[r + 1]); b = fmaxf(fmaxf(b, p1[r + 2]), p1[r + 3]); }
    float m = fmaxf(a, b); auto rr = __builtin_amdgcn_permlane32_swap(__float_as_uint(m), __float_as_uint(m), false, false);
    return fmaxf(__uint_as_float(rr[0]), __uint_as_float(rr[1]));
}
__device__ __forceinline__ float half_sum(float v) { auto rr = __builtin_amdgcn_permlane32_swap(__float_as_uint(v), __float_as_uint(v), false, false); return __uint_as_float(rr[0]) + __uint_as_float(rr[1]); }

constexpr int AB_QSTR = 4160;
constexpr int AB_STG = 16384 + 4 * AB_QSTR;
constexpr int AB_STGS = 33280;
constexpr int AB_WSF = 131072;
constexpr float AB_THR = 8.0f;

constexpr int AA_HSTR = 2112;
constexpr int AA_BUF = 2 * AA_HSTR;
constexpr int AA_KBUF = 4096;
constexpr int AA_WAVE = 2 * AA_BUF + 2 * AA_KBUF + 128;
constexpr float AA_THR = 8.0f;
__device__ __forceinline__ float rowmax16(const f32x16& p0) {
    float a = fmaxf(fmaxf(p0[0], p0[1]), p0[2]), b = fmaxf(fmaxf(p0[3], p0[4]), p0[5]);
    a = fmaxf(fmaxf(a, p0[6]), p0[7]); b = fmaxf(fmaxf(b, p0[8]), p0[9]); a = fmaxf(fmaxf(a, p0[10]), p0[11]); b = fmaxf(fmaxf(b, p0[12]), p0[13]);
    a = fmaxf(fmaxf(a, p0[14]), p0[15]);
    float m = fmaxf(a, b); auto rr = __builtin_amdgcn_permlane32_swap(__float_as_uint(m), __float_as_uint(m), false, false);
    return fmaxf(__uint_as_float(rr[0]), __uint_as_float(rr[1]));
}
__device__ __forceinline__ void phase_attnA(const Params& p, LAS unsigned char* lds, int wg, int nwg) {
    const int tid = get_tid(lds);
    const int lane = tid & 63, r32 = lane & 31, hi = lane >> 5;
    const int wave = __builtin_amdgcn_readfirstlane(tid >> 6);
    const f16* proj = (const f16*)(p.ws + WS_PROJ);
    f16* oa = (f16*)(p.ws + WS_OAB);
    LAS unsigned char* wl = lds + wave * AA_WAVE;
    LAS float* wsf = (LAS float*)(wl + 2 * AA_BUF + 2 * AA_KBUF);
    const int kw0 = (lane >> 3) * 128 + (((lane & 7) ^ (((lane >> 3) >> 1) & 7)) << 4);
    const int kr0 = r32 * 128, kx = (hi ^ ((r32 >> 1) & 7)) << 4;
    const int vl = ((lane >> 4) & 1) * 32 + (lane & 3) * 8 + (4 * hi + ((lane & 15) >> 2)) * 64;
    const int vrow0 = lane >> 3, vch0 = lane & 7, vw0 = (vch0 >> 2) * AA_HSTR + vrow0 * 64 + (vch0 & 3) * 16;
    constexpr int NTILE = 33;
#pragma unroll 1
    for (int ui = 0; ui < 4; ++ui) {
        const int j = wg >> 3, bh = ui * 16 + (wg & 7) * 2 + (j >> 4), r16 = j & 15;
        const int b = bh >> 3, h = bh & 7;
        const float sl2 = slope_of(h + (h >> 1)) * LOG2E;
        const f16* base = proj + (size_t)b * SEQ * INW;
        const int P0 = r16 + 512 * wave, qpos = P0 + 16 * r32;
        f16x8 qr[4];
#pragma unroll
        for (int d0 = 0; d0 < 4; ++d0) qr[d0] = *(const f16x8*)(base + (size_t)qpos * INW + C_QA + h * 64 + 16 * d0 + 8 * hi);
        f32x16 o[2];
        o[0] = (f32x16){0.f, 0.f, 0.f, 0.f, 0.f, 0.f, 0.f, 0.f, 0.f, 0.f, 0.f, 0.f, 0.f, 0.f, 0.f, 0.f}; o[1] = o[0];
        float m = -1.0e30f, l = 0.f;
        u32x4 kS[4], vA[4];
#define AA_PARAMS(tt, d, n) const int d = (tt) < 5 ? 16 : ((tt) < 13 ? 4 : 1), n = (tt) < 5 ? (tt) : ((tt) < 13 ? (tt) - 5 : (tt) - 13)
#define AA_LOADK(tt, KS) do { AA_PARAMS(tt, d_, n_); const int kb_ = P0 - 64 * d_ + 32 * d_ * n_; \
            _Pragma("unroll") for (int jj = 0; jj < 4; ++jj) { int kp = kb_ + d_ * (vrow0 + 8 * jj); kp = kp < 0 ? 0 : (kp > SEQ - 1 ? SEQ - 1 : kp); \
              KS[jj] = *(const u32x4*)(base + (size_t)kp * INW + C_KA + h * 64 + vch0 * 8); } } while (0)
#define AA_LOADV(tt, VS) do { AA_PARAMS(tt, d_, n_); const int kb_ = P0 - 64 * d_ + 32 * d_ * n_; \
            _Pragma("unroll") for (int jj = 0; jj < 4; ++jj) { int kp = kb_ + d_ * (vrow0 + 8 * jj); kp = kp < 0 ? 0 : (kp > SEQ - 1 ? SEQ - 1 : kp); \
              VS[jj] = *(const u32x4*)(base + (size_t)kp * INW + C_VA + h * 64 + vch0 * 8); } } while (0)
#define AA_STEP(tt) do { \
            LAS unsigned char* vbuf = wl + ((tt) & 1) * AA_BUF; \
            LAS unsigned char* kbuf = wl + 2 * AA_BUF + ((tt) & 1) * AA_KBUF; \
            _Pragma("unroll") for (int jj = 0; jj < 4; ++jj) { *(LAS u32x4*)(vbuf + vw0 + jj * 512) = vA[jj]; *(LAS u32x4*)(kbuf + ((kw0 + jj * 1024) ^ ((jj & 1) << 6))) = kS[jj]; } \
            if ((tt) + 1 < NTILE) { AA_LOADK((tt) + 1, kS); AA_LOADV((tt) + 1, vA); } \
            AA_PARAMS(tt, d, n); \
            const int kb = P0 - 64 * d + 32 * d * n; \
            f32x16 s = (f32x16){0.f, 0.f, 0.f, 0.f, 0.f, 0.f, 0.f, 0.f, 0.f, 0.f, 0.f, 0.f, 0.f, 0.f, 0.f, 0.f}; \
            _Pragma("unroll") for (int d0 = 0; d0 < 4; ++d0) { const f16x8 kf = *(const LAS f16x8*)(kbuf + kr0 + ((d0 << 5) ^ kx)); s = MFMA32(kf, qr[d0], s); } \
            const float df = (float)d, basef = (float)(d * (32 * n + 4 * hi - 64) - 16 * r32), lim = 64.0f * df; \
            const bool need_range = (kb < 0) || (kb + 31 * d >= SEQ); \
            const float kpf0 = (float)(kb + 4 * hi * d); \
            if (need_range) { \
                _Pragma("unroll") for (int r = 0; r < 16; ++r) { \
                    const float c = (float)((r & 3) + 8 * (r >> 2)); \
                    const float ad = __builtin_fabsf(__builtin_fmaf(df, c, basef)), kpf = __builtin_fmaf(df, c, kpf0); \
                    const bool valid = (ad <= lim) && (kpf >= 0.0f) && (kpf < (float)SEQ); \
                    s[r] = valid ? __builtin_fmaf(-sl2, ad, s[r]) : -INFINITY; } \
            } else { \
                _Pragma("unroll") for (int r = 0; r < 16; ++r) { \
                    const float c = (float)((r & 3) + 8 * (r >> 2)); \
                    const float ad = __builtin_fabsf(__builtin_fmaf(df, c, basef)); \
                    s[r] = (ad <= lim) ? __builtin_fmaf(-sl2, ad, s[r]) : -INFINITY; } \
            } \
            const float mx = rowmax16(s); \
            if (__any(mx > m + AA_THR)) { \
                const float mn = fmaxf(m, mx), al = __builtin_amdgcn_exp2f(m - mn); \
                l *= al; m = mn; \
                if (hi == 0) wsf[r32] = al; \
                _Pragma("unroll") for (int r = 0; r < 16; ++r) { const float f = wsf[crow(r, hi)]; o[0][r] *= f; o[1][r] *= f; } } \
            float ls = 0.f; \
            _Pragma("unroll") for (int r = 0; r < 16; ++r) { s[r] = __builtin_amdgcn_exp2f(s[r] - m); ls += s[r]; } \
            l += ls; \
            u32x4 pw[2]; \
            pw[0] = (u32x4){pk2(s[0], s[1]), pk2(s[2], s[3]), pk2(s[4], s[5]), pk2(s[6], s[7])}; \
            pw[1] = (u32x4){pk2(s[8], s[9]), pk2(s[10], s[11]), pk2(s[12], s[13]), pk2(s[14], s[15])}; \
            const LAS unsigned char* vb = vbuf + vl; \
            _Pragma("unroll") for (int ks = 0; ks < 2; ++ks) _Pragma("unroll") for (int dh = 0; dh < 2; ++dh) { \
                    const f16x4 lo = vtr(vb + dh * AA_HSTR + ks * 1024), hh = vtr(vb + dh * AA_HSTR + ks * 1024 + 512); \
                    const f16x8 vf = (f16x8){lo[0], lo[1], lo[2], lo[3], hh[0], hh[1], hh[2], hh[3]}; \
                    o[dh] = MFMA32(__builtin_bit_cast(f16x8, pw[ks]), vf, o[dh]); } \
        } while (0)
        AA_LOADK(0, kS); AA_LOADV(0, vA);
#pragma unroll 1
        for (int tt = 0; tt < NTILE - 1; tt += 2) { AA_STEP(tt); AA_STEP(tt + 1); }
        AA_STEP(NTILE - 1);
#undef AA_STEP
#undef AA_LOADK
#undef AA_LOADV
#undef AA_PARAMS
        l = half_sum(l);
        if (hi == 0) wsf[r32] = 1.0f / l;
#pragma unroll
        for (int r = 0; r < 16; ++r) {
            const float il = wsf[crow(r, hi)];
            f16* op = oa + ((size_t)b * SEQ + P0 + 16 * crow(r, hi)) * 512 + h * 64 + r32;
            op[0] = (f16)(o[0][r] * il); op[32] = (f16)(o[1][r] * il);
        }
    }
    __syncthreads();
}
constexpr int B2_STGS = 33280, B2_WSF = 4 * B2_STGS, B2_CMX = B2_WSF + 1024;
constexpr float B2_THR = 8.0f, B2_SKIP_T = 40.0f;
constexpr size_t SM_KMAX = 15360, SM_KDONE = 15872, SM_AQ = 16000;

__device__ __forceinline__ void glds16_asm(const void* gsrc, unsigned lds_dst) {
    unsigned keep;
    asm volatile("s_mov_b32 %0, m0\n\ts_mov_b32 m0, %2\n\ts_nop 0\n\tglobal_load_lds_dwordx4 %1, off\n\ts_mov_b32 m0, %0" : "=&s"(keep) : "v"(gsrc), "s"(lds_dst) : "memory");
}
__device__ __forceinline__ void phase_knorm(const Params& p, LAS unsigned char* lds, int wg, int nwg) {
    const int tid = get_tid(lds);
    const int lane = tid & 63;
    const f16* proj = (const f16*)(p.ws + WS_PROJ);
    unsigned* kmax2 = (unsigned*)(p.ws + WS_SMALL + SM_KMAX);
    unsigned* kdone = (unsigned*)(p.ws + WS_SMALL + SM_KDONE);
    const int tpw = TOK / nwg;
    const int t = wg * tpw + (tid >> 2), part = tid & 3;
    float n2[2];
#pragma unroll
    for (int g = 0; g < 2; ++g) {
        const f16* kr = proj + (size_t)t * INW + C_KB + (part * 2 + g) * 64;
        float s = 0.f;
#pragma unroll
        for (int c = 0; c < 8; ++c) { const f16x8 v = *(const f16x8*)(kr + c * 8);
#pragma unroll
            for (int j = 0; j < 8; ++j) s = fmaf((float)v[j], (float)v[j], s); }
        n2[g] = s;
    }
#pragma unroll
    for (int g = 0; g < 2; ++g) { for (int o = 4; o <= 32; o <<= 1) n2[g] = fmaxf(n2[g], shx(n2[g], o, lane)); }
    if (lane < 4) {
        const int b = (wg * tpw) / SEQ;
#pragma unroll
        for (int g = 0; g < 2; ++g) { const int hm = part * 2 + g;
            __hip_atomic_fetch_max(kmax2 + b * 8 + hm, __float_as_uint(n2[g]), __ATOMIC_RELAXED, __HIP_MEMORY_SCOPE_AGENT); }
    }
    asm volatile("s_waitcnt vmcnt(0)" ::: "memory");
    __syncthreads();
    if (tid == 0) __hip_atomic_fetch_add(kdone, 1u, __ATOMIC_RELAXED, __HIP_MEMORY_SCOPE_AGENT);
}

__device__ __forceinline__ void dma8(const void* sbase, const unsigned (&vo)[8], unsigned ldk, unsigned ldv) {
    unsigned keep;
    asm volatile(
        "s_mov_b32 %0, m0\n\t"
        "s_mov_b32 m0, %10\n\ts_nop 0\n\tglobal_load_lds_dwordx4 %2, %1\n\t"
        "s_add_i32 m0, %10, 0x400\n\ts_nop 0\n\tglobal_load_lds_dwordx4 %3, %1\n\t"
        "s_add_i32 m0, %10, 0x4000\n\ts_nop 0\n\tglobal_load_lds_dwordx4 %4, %1\n\t"
        "s_add_i32 m0, %10, 0x4400\n\ts_nop 0\n\tglobal_load_lds_dwordx4 %5, %1\n\t"
        "s_mov_b32 m0, %11\n\ts_nop 0\n\tglobal_load_lds_dwordx4 %6, %1\n\t"
        "s_add_i32 m0, %11, 0x400\n\ts_nop 0\n\tglobal_load_lds_dwordx4 %7, %1\n\t"
        "s_add_i32 m0, %11, 0x800\n\ts_nop 0\n\tglobal_load_lds_dwordx4 %8, %1\n\t"
        "s_add_i32 m0, %11, 0xc00\n\ts_nop 0\n\tglobal_load_lds_dwordx4 %9, %1\n\t"
        "s_mov_b32 m0, %0"
        : "=&s"(keep)
        : "s"(sbase), "v"(vo[0]), "v"(vo[1]), "v"(vo[2]), "v"(vo[3]), "v"(vo[4]), "v"(vo[5]), "v"(vo[6]), "v"(vo[7]), "s"(ldk), "s"(ldv)
        : "memory", "scc");
}

constexpr int B3_VQ = 8256;
constexpr int B3_STG = 32768 + 4 * B3_VQ;
constexpr int B3_WSF = 2 * B3_STG, B3_CMX = B3_WSF + 1024;
__device__ __forceinline__ void phase_attnB3(const Params& p, LAS unsigned char* lds, int wg, int nwg) {
    const int tid = get_tid(lds);
    const int lane = tid & 63, r32 = lane & 31, hi = lane >> 5;
    const int wave = __builtin_amdgcn_readfirstlane(tid >> 6), grp = wave >> 2, qsub = wave & 3;
    const f16* proj = (const f16*)(p.ws + WS_PROJ);
    f16* ob = (f16*)(p.ws + WS_OAB) + (size_t)TOK * 512;
    const float lam = lambda_full(p.in[3], p.in[4], p.in[5], p.in[6], lane);
    const float* subg = p.in[7];
    LAS float* wsf = (LAS float*)(lds + B3_WSF) + wave * 32;
    LAS float* cmx = (LAS float*)(lds + B3_CMX);
    if (tid == 0) { unsigned* kdone = (unsigned*)(p.ws + WS_SMALL + SM_KDONE); unsigned sp = 0;
        while (__hip_atomic_load(kdone, __ATOMIC_RELAXED, __HIP_MEMORY_SCOPE_AGENT) < (unsigned)nwg) { __builtin_amdgcn_s_sleep(2); if (++sp > (1u << 22)) break; } }
    __syncthreads();
    const unsigned* kmax2 = (const unsigned*)(p.ws + WS_SMALL + SM_KMAX);
    const int kx4 = (hi ^ ((r32 >> 1) & 7)) << 4, krow = r32 * 128;
#define KOFF(d0) (krow + (((d0) << 5) ^ kx4))
    const int vl = ((lane >> 4) & 1) * 32 + (lane & 3) * 8 + (4 * hi + ((lane & 15) >> 2)) * 64;
    const unsigned vo_k = (unsigned)((16 * wave + (lane >> 3)) * INW + ((lane & 7) ^ (((16 * wave + (lane >> 3)) >> 1) & 7)) * 8) * 2u;
    const unsigned vo_v = (unsigned)((16 * ((4 * wave) & 7) + (lane >> 2)) * INW + (C_VB - C_KB) + (wave >> 1) * 32 + (lane & 3) * 8) * 2u;
    const unsigned ldk_w = (unsigned)wave * 2048u, ldv_w = 32768u + (unsigned)(wave >> 1) * B3_VQ + (unsigned)(wave & 1) * 4096u;
#ifndef TIMEQ
#define TIMEQ 0
#endif
    long long tacc = 0;
    const unsigned lds0 = (unsigned)(size_t)lds;
    const f32x16 z16 = (f32x16){0.f, 0.f, 0.f, 0.f, 0.f, 0.f, 0.f, 0.f, 0.f, 0.f, 0.f, 0.f, 0.f, 0.f, 0.f, 0.f};

    unsigned* aq = (unsigned*)(p.ws + WS_SMALL + SM_AQ) + (wg & 7);
#pragma unroll 1
    for (;;) {
        if (tid == 0) cmx[8] = __uint_as_float(__hip_atomic_fetch_add(aq, 1u, __ATOMIC_RELAXED, __HIP_MEMORY_SCOPE_AGENT));
        __syncthreads();
        const int u = __builtin_amdgcn_readfirstlane((int)__float_as_uint(cmx[8]));
        if (u >= 128) break;
        const int g8 = wg & 7, h = 3 - (u >> 5), ui = (h - (g8 & 3)) & 3, qb = u & 31;
        const int b = 2 * ui + (g8 >> 2);
        const float sl2 = slope_of(3 * h + 2) * LOG2E;
        const f16* base = proj + (size_t)b * SEQ * INW;
        const int dw = 2 * qb + (qsub >> 1);
        const int qrel = qsub * 32 + r32, qpos = qb * 128 + qrel;
        f16x8 qr[4], ks4[4];
        { int lu = lane; asm volatile("" : "+v"(lu));
          const unsigned qo = (unsigned)((qb * 128 + qsub * 32 + (lu & 31)) * INW + h * 128 + grp * 64 + 8 * (lu >> 5));
#pragma unroll
          for (int d0 = 0; d0 < 4; ++d0) { qr[d0] = *(const f16x8*)(base + qo + C_QB + 16 * d0); ks4[d0] = *(const f16x8*)(base + qo + C_KB + 16 * d0); } }
        float qn2 = 0.f, sii = 0.f;
#pragma unroll
        for (int d0 = 0; d0 < 4; ++d0)
#pragma unroll
            for (int j = 0; j < 8; ++j) { const float qv = (float)qr[d0][j]; qn2 = fmaf(qv, qv, qn2); sii = fmaf(qv, (float)ks4[d0][j], sii); }
        qn2 = half_sum(qn2); sii = half_sum(sii);
        const float kmx = sqrtf(__uint_as_float(__hip_atomic_load(kmax2 + b * 8 + h * 2 + grp, __ATOMIC_RELAXED, __HIP_MEMORY_SCOPE_AGENT)));
        float cb = sqrtf(qn2) * kmx * 1.001f - sii;
        for (int of = 16; of >= 1; of >>= 1) cb = fmaxf(cb, shx(cb, of, lane));
        if (lane == 0) cmx[wave] = cb;
        const float a64 = 64.0f * sl2; const f16 aH = (f16)a64, aL = (f16)(a64 - (float)aH), bH = (f16)sl2, bL = (f16)(sl2 - (float)bH);
        const f16 zz = (f16)0.f;
        const unsigned qx01 = hi == 0 ? __builtin_bit_cast(unsigned, (f16x2){aH, aL}) : 0u, qx23 = hi == 0 ? __builtin_bit_cast(unsigned, (f16x2){bH, bL}) : 0u;
        asm volatile("s_waitcnt lgkmcnt(0)" ::: "memory"); __syncthreads();
        float cmax = cmx[0];
#pragma unroll
        for (int w = 1; w < 8; ++w) cmax = fmaxf(cmax, cmx[w]);
        const float Dm = (cmax + B2_SKIP_T + 1.0f) / sl2;
        int t_lo, t_hi;
        { const float lo = ((float)(qb * 128 - 127) - Dm) * (1.0f / 128.0f), hh = ((float)(qb * 128 + 127) + Dm) * (1.0f / 128.0f);
          t_lo = lo <= 0.f ? 0 : (int)lo; t_hi = hh >= 31.f ? 31 : (int)hh; if (t_lo > qb) t_lo = qb; if (t_hi < qb) t_hi = qb; }
        t_lo = __builtin_amdgcn_readfirstlane(t_lo); t_hi = __builtin_amdgcn_readfirstlane(t_hi);
        const int nL = qb - t_lo, U = 1 + nL + (t_hi - qb);
#define B3_SEQ(pp) ((pp) == 0 ? qb : ((pp) - 1 < nL ? qb - 1 - ((pp) - 1) : qb + 1 + ((pp) - 1 - nL)))
        const f16* gk = base + C_KB + h * 128;
#define B3_ISSUE(pp) do { const int T2_ = B3_SEQ(pp); const unsigned st_ = lds0 + (unsigned)((pp) & 1) * (unsigned)B3_STG; \
            const unsigned vo_[8] = {vo_k, (vo_k + 8u * INW * 2u) ^ 64u, vo_k + 128u, ((vo_k + 8u * INW * 2u) ^ 64u) + 128u,     \
                 vo_v, vo_v + 16u * INW * 2u, vo_v + 32u * INW * 2u, vo_v + 48u * INW * 2u}; \
            dma8(gk + (size_t)T2_ * 128 * INW, vo_, (unsigned)__builtin_amdgcn_readfirstlane(st_ + ldk_w), (unsigned)__builtin_amdgcn_readfirstlane(st_ + ldv_w)); } while (0)
        B3_ISSUE(0);
        f32x16 o[4]; o[0] = z16; o[1] = z16; o[2] = z16; o[3] = z16;
        float m = sii, l = 0.f;
        asm volatile("s_waitcnt vmcnt(0) lgkmcnt(0)\n\ts_barrier" ::: "memory");
#define SBAR() __builtin_amdgcn_sched_barrier(0)
#define PIN(x) asm volatile("" : "+v"(x))
#define B3_QK(S0, S1, T, JJ) do { \
            const LAS unsigned char* kbse = st + grp * 16384 + (JJ) * 8192; \
            const int side = (T) <= dw ? 0 : 1; \
            const float sq = sl2 * (float)qrel; \
            const float mr = side == 0 ? -(m + sq) : -(m - sq); \
            const f16 mH = (f16)mr, mL = (f16)(mr - (float)mH), one = (f16)1.0f; \
            const f16 trel = (f16)(float)((T) - 2 * qb), l0 = (f16)(float)r32, l1 = (f16)(float)(32 + r32); \
            const f16x8 kx0 = hi == 0 ? (f16x8){trel, trel, l0, l0, one, one, zz, zz} : (f16x8){zz, zz, zz, zz, zz, zz, zz, zz}; \
            const f16x8 kx1 = hi == 0 ? (f16x8){trel, trel, l1, l1, one, one, zz, zz} : (f16x8){zz, zz, zz, zz, zz, zz, zz, zz}; \
            u32x4 qxb = (u32x4){qx01, qx23, 0u, 0u}; if (side) { qxb.x ^= 0x80008000u; qxb.y ^= 0x80008000u; } \
            if (hi == 0) qxb.z = __builtin_bit_cast(unsigned, (f16x2){mH, mL}); \
            const f16x8 qx = __builtin_bit_cast(f16x8, qxb); \
            S0 = MFMA32(kx0, qx, z16); S1 = MFMA32(kx1, qx, z16); \
            _Pragma("unroll") for (int d0 = 0; d0 < 4; ++d0) { \
                const f16x8 a0 = *(const LAS f16x8*)(kbse + KOFF(d0)), a1 = *(const LAS f16x8*)(kbse + 4096 + KOFF(d0)); \
                S0 = MFMA32(a0, qr[d0], S0); S1 = MFMA32(a1, qr[d0], S1); } } while (0)
#define B3_FIX(S0, S1, T) do { if ((T) == dw) { const float dq0 = (float)(64 * ((T) - 2 * qb) + 4 * hi - qrel), m2 = -2.0f * sl2; \
            _Pragma("unroll") for (int r = 0; r < 16; ++r) { const float c = (float)((r & 3) + 8 * (r >> 2)); \
                S0[r] = __builtin_fmaf(m2, fmaxf(dq0 + c, 0.f), S0[r]); S1[r] = __builtin_fmaf(m2, fmaxf(dq0 + 32.0f + c, 0.f), S1[r]); } } } while (0)
#define B3_EXP(S0, S1, PW) do { float ls = 0.f; \
            _Pragma("unroll") for (int r = 0; r < 16; ++r) { S0[r] = __builtin_amdgcn_exp2f(S0[r]); S1[r] = __builtin_amdgcn_exp2f(S1[r]); ls += S0[r] + S1[r]; } \
            l += ls; \
            PW[0] = (u32x4){pk2(S0[0], S0[1]), pk2(S0[2], S0[3]), pk2(S0[4], S0[5]), pk2(S0[6], S0[7])}; \
            PW[1] = (u32x4){pk2(S0[8], S0[9]), pk2(S0[10], S0[11]), pk2(S0[12], S0[13]), pk2(S0[14], S0[15])}; \
            PW[2] = (u32x4){pk2(S1[0], S1[1]), pk2(S1[2], S1[3]), pk2(S1[4], S1[5]), pk2(S1[6], S1[7])}; \
            PW[3] = (u32x4){pk2(S1[8], S1[9]), pk2(S1[10], S1[11]), pk2(S1[12], S1[13]), pk2(S1[14], S1[15])}; } while (0)
#define B3_PV(PW, JJ) do { const LAS unsigned char* vb = st + 32768 + (JJ) * 4096 + vl; \
            _Pragma("unroll") for (int ks = 0; ks < 4; ++ks) { _Pragma("unroll") for (int dq = 0; dq < 4; ++dq) { \
                const f16x4 lo = vtr(vb + dq * B3_VQ + ks * 1024), hh = vtr(vb + dq * B3_VQ + ks * 1024 + 512); \
                const f16x8 vf = (f16x8){lo[0], lo[1], lo[2], lo[3], hh[0], hh[1], hh[2], hh[3]}; \
                o[dq] = MFMA32(__builtin_bit_cast(f16x8, PW[ks]), vf, o[dq]); } } } while (0)
#pragma unroll 1
        for (int pp = 0; pp < U; ++pp) {
            if (pp + 1 < U) B3_ISSUE(pp + 1);
            const LAS unsigned char* st = lds + (pp & 1) * B3_STG;
            const int T2 = B3_SEQ(pp), TA = 2 * T2, TB = 2 * T2 + 1;
            f32x16 a0s, a1s, b0s, b1s; u32x4 pwA[4], pwB[4];
            B3_QK(a0s, a1s, TA, 0);
            __builtin_amdgcn_sched_group_barrier(0x100, 4, 0); __builtin_amdgcn_sched_group_barrier(0x8, 2, 0);
            __builtin_amdgcn_sched_group_barrier(0x8, 2, 0); __builtin_amdgcn_sched_group_barrier(0x100, 2, 0);
            __builtin_amdgcn_sched_group_barrier(0x8, 2, 0); __builtin_amdgcn_sched_group_barrier(0x100, 2, 0);
            __builtin_amdgcn_sched_group_barrier(0x8, 4, 0);
            B3_FIX(a0s, a1s, TA);
            { const float mx = rowmax32(a0s, a1s);
              if (__any(mx > B2_THR)) {
                const float dl = fmaxf(mx, 0.f), al = __builtin_amdgcn_exp2f(-dl);
                m += dl; l *= al;
                if (hi == 0) wsf[r32] = al;
#pragma unroll
                for (int r = 0; r < 16; ++r) { const float f = wsf[crow(r, hi)];
#pragma unroll
                    for (int i = 0; i < 4; ++i) o[i][r] *= f;
                    a0s[r] -= dl; a1s[r] -= dl; }
              } }
            {
                const LAS unsigned char* kbse = st + grp * 16384 + 8192;
                const int side = TB <= dw ? 0 : 1;
                const float sq = sl2 * (float)qrel;
                const float mr = side == 0 ? -(m + sq) : -(m - sq);
                const f16 mH = (f16)mr, mL = (f16)(mr - (float)mH), one = (f16)1.0f;
                const f16 trel = (f16)(float)(TB - 2 * qb), l0 = (f16)(float)r32, l1 = (f16)(float)(32 + r32);
                const f16x8 kx0 = hi == 0 ? (f16x8){trel, trel, l0, l0, one, one, zz, zz} : (f16x8){zz, zz, zz, zz, zz, zz, zz, zz};
                const f16x8 kx1 = hi == 0 ? (f16x8){trel, trel, l1, l1, one, one, zz, zz} : (f16x8){zz, zz, zz, zz, zz, zz, zz, zz};
                u32x4 qxb = (u32x4){qx01, qx23, 0u, 0u}; if (side) { qxb.x ^= 0x80008000u; qxb.y ^= 0x80008000u; }
                if (hi == 0) qxb.z = __builtin_bit_cast(unsigned, (f16x2){mH, mL});
                const f16x8 qx = __builtin_bit_cast(f16x8, qxb);
                f16x8 kf0 = *(const LAS f16x8*)(kbse + KOFF(0)), kf1 = *(const LAS f16x8*)(kbse + 4096 + KOFF(0));
                f16x8 kf2 = *(const LAS f16x8*)(kbse + KOFF(1)), kf3 = *(const LAS f16x8*)(kbse + 4096 + KOFF(1));
                float ls = 0.f;
                SBAR();
#define EX3(S, i0) do { S[i0] = __builtin_amdgcn_exp2f(S[i0]); S[i0 + 1] = __builtin_amdgcn_exp2f(S[i0 + 1]); S[i0 + 2] = __builtin_amdgcn_exp2f(S[i0 + 2]); ls += S[i0]; ls += S[i0 + 1]; ls += S[i0 + 2]; PIN(ls); } while (0)
#define EX4(S, i0) do { S[i0] = __builtin_amdgcn_exp2f(S[i0]); S[i0 + 1] = __builtin_amdgcn_exp2f(S[i0 + 1]); S[i0 + 2] = __builtin_amdgcn_exp2f(S[i0 + 2]); S[i0 + 3] = __builtin_amdgcn_exp2f(S[i0 + 3]); ls += S[i0]; ls += S[i0 + 1]; ls += S[i0 + 2]; ls += S[i0 + 3]; PIN(ls); } while (0)
                b0s = MFMA32(kx0, qx, z16); EX3(a0s, 0); SBAR();
                b1s = MFMA32(kx1, qx, z16); EX3(a0s, 3); SBAR();
                b0s = MFMA32(kf0, qr[0], b0s); kf0 = *(const LAS f16x8*)(kbse + KOFF(2)); EX3(a0s, 6); SBAR();
                b1s = MFMA32(kf1, qr[0], b1s); kf1 = *(const LAS f16x8*)(kbse + 4096 + KOFF(2)); EX3(a0s, 9); SBAR();
                b0s = MFMA32(kf2, qr[1], b0s); kf2 = *(const LAS f16x8*)(kbse + KOFF(3)); EX4(a0s, 12); SBAR();
                b1s = MFMA32(kf3, qr[1], b1s); kf3 = *(const LAS f16x8*)(kbse + 4096 + KOFF(3)); EX4(a1s, 0); SBAR();
                b0s = MFMA32(kf0, qr[2], b0s); EX4(a1s, 4); SBAR();
                b1s = MFMA32(kf1, qr[2], b1s); EX4(a1s, 8); SBAR();
                b0s = MFMA32(kf2, qr[3], b0s); EX4(a1s, 12);
                pwA[0] = (u32x4){pk2(a0s[0], a0s[1]), pk2(a0s[2], a0s[3]), pk2(a0s[4], a0s[5]), pk2(a0s[6], a0s[7])};
                pwA[1] = (u32x4){pk2(a0s[8], a0s[9]), pk2(a0s[10], a0s[11]), pk2(a0s[12], a0s[13]), pk2(a0s[14], a0s[15])};
                SBAR();
                b1s = MFMA32(kf3, qr[3], b1s);
                pwA[2] = (u32x4){pk2(a1s[0], a1s[1]), pk2(a1s[2], a1s[3]), pk2(a1s[4], a1s[5]), pk2(a1s[6], a1s[7])};
                pwA[3] = (u32x4){pk2(a1s[8], a1s[9]), pk2(a1s[10], a1s[11]), pk2(a1s[12], a1s[13]), pk2(a1s[14], a1s[15])};
                SBAR();
                l += ls;
            }
            B3_FIX(b0s, b1s, TB);
            { const float mx = rowmax32(b0s, b1s);
              if (__any(mx > B2_THR)) {
                const float dl = fmaxf(mx, 0.f), al = __builtin_amdgcn_exp2f(-dl);
                m += dl; l *= al;
                if (hi == 0) wsf[r32] = al;
#pragma unroll
                for (int r = 0; r < 16; ++r) { const float f = wsf[crow(r, hi)];
#pragma unroll
                    for (int i = 0; i < 4; ++i) o[i][r] *= f;
                    b0s[r] -= dl; b1s[r] -= dl; a0s[r] *= al; a1s[r] *= al; }
                pwA[0] = (u32x4){pk2(a0s[0], a0s[1]), pk2(a0s[2], a0s[3]), pk2(a0s[4], a0s[5]), pk2(a0s[6], a0s[7])};
                pwA[1] = (u32x4){pk2(a0s[8], a0s[9]), pk2(a0s[10], a0s[11]), pk2(a0s[12], a0s[13]), pk2(a0s[14], a0s[15])};
                pwA[2] = (u32x4){pk2(a1s[0], a1s[1]), pk2(a1s[2], a1s[3]), pk2(a1s[4], a1s[5]), pk2(a1s[6], a1s[7])};
                pwA[3] = (u32x4){pk2(a1s[8], a1s[9]), pk2(a1s[10], a1s[11]), pk2(a1s[12], a1s[13]), pk2(a1s[14], a1s[15])};
              } }
            {
                const LAS unsigned char* vb = st + 32768 + vl;
                float ls = 0.f;
#define VFR_(ks, dq) do { const f16x4 lo_ = vtr(vb + (dq) * B3_VQ + (ks) * 1024), hh_ = vtr(vb + (dq) * B3_VQ + (ks) * 1024 + 512); vnx = (f16x8){lo_[0], lo_[1], lo_[2], lo_[3], hh_[0], hh_[1], hh_[2], hh_[3]}; } while (0)
#define EX2(S, i0) do { S[i0] = __builtin_amdgcn_exp2f(S[i0]); S[i0 + 1] = __builtin_amdgcn_exp2f(S[i0 + 1]); ls += S[i0]; ls += S[i0 + 1]; PIN(ls); } while (0)
                f16x8 vcu, vnx;
                VFR_(0, 0); vcu = vnx; SBAR();
#define PVG(ks, dq, nks, ndq, S, i0) do { VFR_(nks, ndq); o[dq] = MFMA32(__builtin_bit_cast(f16x8, pwA[ks]), vcu, o[dq]); EX2(S, i0); vcu = vnx; SBAR(); } while (0)
                PVG(0, 0, 0, 1, b0s, 0);  PVG(0, 1, 0, 2, b0s, 2);  PVG(0, 2, 0, 3, b0s, 4);  PVG(0, 3, 1, 0, b0s, 6);
                PVG(1, 0, 1, 1, b0s, 8);  PVG(1, 1, 1, 2, b0s, 10); PVG(1, 2, 1, 3, b0s, 12); PVG(1, 3, 2, 0, b0s, 14);
                PVG(2, 0, 2, 1, b1s, 0);  PVG(2, 1, 2, 2, b1s, 2);  PVG(2, 2, 2, 3, b1s, 4);  PVG(2, 3, 3, 0, b1s, 6);
                PVG(3, 0, 3, 1, b1s, 8);  PVG(3, 1, 3, 2, b1s, 10); PVG(3, 2, 3, 3, b1s, 12);
                o[3] = MFMA32(__builtin_bit_cast(f16x8, pwA[3]), vcu, o[3]); EX2(b1s, 14); SBAR();
#undef PVG
#undef VFR_
                l += ls;
                pwB[0] = (u32x4){pk2(b0s[0], b0s[1]), pk2(b0s[2], b0s[3]), pk2(b0s[4], b0s[5]), pk2(b0s[6], b0s[7])};
                pwB[1] = (u32x4){pk2(b0s[8], b0s[9]), pk2(b0s[10], b0s[11]), pk2(b0s[12], b0s[13]), pk2(b0s[14], b0s[15])};
                pwB[2] = (u32x4){pk2(b1s[0], b1s[1]), pk2(b1s[2], b1s[3]), pk2(b1s[4], b1s[5]), pk2(b1s[6], b1s[7])};
                pwB[3] = (u32x4){pk2(b1s[8], b1s[9]), pk2(b1s[10], b1s[11]), pk2(b1s[12], b1s[13]), pk2(b1s[14], b1s[15])};
            }
            B3_PV(pwB, 1);
            __builtin_amdgcn_sched_group_barrier(0x100, 4, 3);
#pragma unroll
            for (int i = 0; i < 14; ++i) { __builtin_amdgcn_sched_group_barrier(0x8, 1, 3); __builtin_amdgcn_sched_group_barrier(0x100, 2, 3); }
            __builtin_amdgcn_sched_group_barrier(0x8, 2, 3);
#if TIMEQ == 1
            { const long long tq0 = __builtin_readcyclecounter(); asm volatile("s_waitcnt vmcnt(0)" ::: "memory"); tacc += __builtin_readcyclecounter() - tq0; }
#endif
#if TIMEQ == 2
            asm volatile("s_waitcnt vmcnt(0)" ::: "memory");
            const long long tq0 = __builtin_readcyclecounter();
#endif
            asm volatile("s_waitcnt vmcnt(0) lgkmcnt(0)\n\ts_barrier" ::: "memory");
#if TIMEQ == 2
            tacc += __builtin_readcyclecounter() - tq0;
#endif
        }
#undef B3_QK
#undef SBAR
#undef PIN
#undef EX2
#undef EX3
#undef EX4
#undef B3_FIX
#undef B3_EXP
#undef B3_PV
#undef B3_ISSUE
#undef B3_SEQ
        l = half_sum(l);
        if (hi == 0) wsf[r32] = 1.0f / l;
        LAS float* ost = (LAS float*)lds + (size_t)grp * 128 * 128;
#pragma unroll
        for (int r = 0; r < 16; ++r) { const float il = wsf[crow(r, hi)]; const int row = qsub * 32 + crow(r, hi);
#pragma unroll
            for (int i = 0; i < 4; ++i) ost[row * 128 + i * 32 + r32] = o[i][r] * il; }
        __syncthreads();
        {
            const LAS float* o1 = (const LAS float*)lds; const LAS float* o2 = o1 + 128 * 128;
            int l2 = lane; asm volatile("" : "+v"(l2));
            const float g0s = subg[l2], g1s = subg[64 + l2];
            for (int rr = 0; rr < 16; ++rr) {
                const int row = wave * 16 + rr;
                const float v0 = o1[row * 128 + l2] - lam * o2[row * 128 + l2], v1 = o1[row * 128 + 64 + l2] - lam * o2[row * 128 + 64 + l2];
                float ss = v0 * v0 + v1 * v1;
                for (int of = 32; of >= 1; of >>= 1) ss += shx(ss, of, lane);
                const float rs = rsqrtf(ss * (1.0f / 128.0f) + 1e-5f) * (1.0f - LAMBDA_INIT);
                f16* op = ob + ((size_t)b * SEQ + qb * 128 + row) * 512 + h * 128;
                op[l2] = (f16)(v0 * rs * g0s); op[64 + l2] = (f16)(v1 * rs * g1s);
            }
        }
        __syncthreads();
    }
#if TIMEQ
    { const long long t0 = __builtin_readcyclecounter(); while (__builtin_readcyclecounter() - t0 < tacc) __builtin_amdgcn_s_sleep(1); }
    __syncthreads();
#endif
#undef KOFF
}
#define XB_TMO      128
#define XB_XCNT(j)  (256  + 64 * (j))
#define XB_XSUB(j)  (1280 + 64 * (j))
#define XB_XGEN(j)  (2304 + 64 * (j))
#define XB_TOP      3328
#define XB_TOPGEN   3392
#define XCD_BAR_WORDS 3456
#define XB_SPIN_CAP (1u << 20)
__device__ __forceinline__ unsigned xb_ld(unsigned* p)              { return __hip_atomic_load(p, __ATOMIC_RELAXED, __HIP_MEMORY_SCOPE_AGENT); }
__device__ __forceinline__ unsigned xb_add(unsigned* p, unsigned v) { return __hip_atomic_fetch_add(p, v, __ATOMIC_RELAXED, __HIP_MEMORY_SCOPE_AGENT); }
__device__ __forceinline__ unsigned xb_xcc_id() { return (unsigned)__builtin_amdgcn_s_getreg((3 << 11) | 20) & 0xFu; }
#define XB_SPIN(cond, bar) do { unsigned _sp = 0; while (cond) { __builtin_amdgcn_s_sleep(1); \
    if ((++_sp & 255u) == 0u) { if (xb_ld(&(bar)[XB_TMO])) break; if (_sp > XB_SPIN_CAP) { atomicAdd(&(bar)[XB_TMO], 1u); break; } } } } while (0)
__device__ __forceinline__ void xcd_barrier_post(unsigned* bar, int tid) { if (tid == 0) (void)xb_add(&bar[XB_XCNT(xb_xcc_id())], 1u); }
__device__ __forceinline__ void xcd_barrier_complete(unsigned* bar, unsigned x, unsigned& nloc, unsigned& nx) {
    const unsigned G = gridDim.x;
    unsigned sum, cnt, mine, sp = 0u;
    for (;;) {
        sum = 0u; cnt = 0u; mine = 0u;
#pragma unroll
        for (unsigned j = 0; j < 16; ++j) { const unsigned c = xb_ld(&bar[XB_XCNT(j)]); sum += c; cnt += (c > 0u) ? 1u : 0u; mine = (j == x) ? c : mine; }
        if (sum == G) break;
        __builtin_amdgcn_s_sleep(1);
        if ((++sp & 255u) == 0u) { if (xb_ld(&bar[XB_TMO])) break; if (sp > XB_SPIN_CAP) { atomicAdd(&bar[XB_TMO], 1u); break; } }
    }
    nloc = mine > 0u ? mine : 1u; nx = cnt > 0u ? cnt : 1u;
}
__device__ __forceinline__ void xcd_barrier(unsigned* bar, volatile LAS unsigned* st, LAS unsigned char* lds) {
    const int tid = get_tid(lds);
    asm volatile("s_waitcnt vmcnt(0)" ::: "memory");
    __syncthreads();
    if (tid == 0) {
        const unsigned x = xb_xcc_id();
        __builtin_amdgcn_s_waitcnt(0);
        unsigned nloc = st[0], nx = st[1];
        if (nloc == 0u) { xcd_barrier_complete(bar, x, nloc, nx); st[0] = nloc; st[1] = nx; }
        const unsigned old = xb_add(&bar[XB_XSUB(x)], 1u);
        const unsigned gen = old / nloc;
        if (old + 1u == (gen + 1u) * nloc) {
            __builtin_amdgcn_fence(__ATOMIC_RELEASE, "agent");
            asm volatile("s_waitcnt vmcnt(0)" ::: "memory");
            const unsigned og = xb_add(&bar[XB_TOP], 1u);
            const unsigned tg = og / nx;
            if (og + 1u == (tg + 1u) * nx) xb_add(&bar[XB_TOPGEN], 1u);
            else XB_SPIN(xb_ld(&bar[XB_TOPGEN]) == tg, bar);
            __builtin_amdgcn_fence(__ATOMIC_ACQUIRE, "agent");
            xb_add(&bar[XB_XGEN(x)], 1u);
            asm volatile("s_waitcnt vmcnt(0)" ::: "memory");
        } else {
            XB_SPIN(xb_ld(&bar[XB_XGEN(x)]) == gen, bar);
            __builtin_amdgcn_fence(__ATOMIC_ACQUIRE, "agent");
            asm volatile("s_waitcnt vmcnt(0)" ::: "memory");
        }
    }
    __syncthreads();
}
constexpr int LDS_BARST = LDS_TOTAL - 16;
constexpr size_t SM_BAR = 1024;
__global__ void __launch_bounds__(NTHR, 2) k_mega(Params p) {
    extern __shared__ __attribute__((aligned(16))) unsigned char smem[];
    LAS unsigned char* lds = (LAS unsigned char*)smem;
    const int wg = blockIdx.x, nwg = gridDim.x;
    volatile LAS unsigned* st = (volatile LAS unsigned*)(lds + LDS_BARST);
    { const unsigned hw = (unsigned)__builtin_amdgcn_s_getreg((5 << 11) | 4) & 63u; if ((threadIdx.x & 63) == 0) ((LAS int*)(lds + LDS_WTAB))[hw] = (int)(threadIdx.x >> 6); }
    if (threadIdx.x == 0) { st[0] = 0u; st[1] = 0u; put_params(p, lds); }
    __syncthreads();
    xcd_barrier_post((unsigned*)(get_params(lds).ws + WS_SMALL + SM_BAR), get_tid(lds));
#define GRID_SYNC() xcd_barrier((unsigned*)(get_params(lds).ws + WS_SMALL + SM_BAR), st, lds)
#ifndef TIMEPH
#define TIMEPH 0
#endif
    long long tph = 0;
#define TPH2(n, call) do { if (TIMEPH == (n) || TIMEPH == 11) { const long long t0_ = __builtin_readcyclecounter(); call; tph += __builtin_readcyclecounter() - t0_; } else { call; } } while (0)
#define TPH(n, call) do { if (TIMEPH == (n)) { const long long t0_ = __builtin_readcyclecounter(); call; tph += __builtin_readcyclecounter() - t0_; } else { call; } } while (0)
    TPH(1, phase_prep(get_params(lds), lds, wg, nwg));      TPH2(21, GRID_SYNC());
    TPH(2, phase_inproj(get_params(lds), lds, wg, nwg));    TPH2(22, GRID_SYNC());
    TPH(10, phase_knorm(get_params(lds), lds, wg, nwg));
    TPH(3, phase_attnA(get_params(lds), lds, wg, nwg));
    TPH(4, phase_attnB3(get_params(lds), lds, wg, nwg));
    TPH2(23, GRID_SYNC());
#ifdef EXTRA_SYNC
    GRID_SYNC(); GRID_SYNC(); GRID_SYNC(); GRID_SYNC();
#endif
    TPH(5, phase_merge(get_params(lds), lds, wg, nwg));     TPH2(24, GRID_SYNC());
    TPH(6, phase_outproj(get_params(lds), lds, wg, nwg));   TPH2(25, GRID_SYNC());
    TPH(12, phase_router(get_params(lds), lds, wg, nwg));   TPH2(26, GRID_SYNC());
    TPH(7, phase_up(get_params(lds), lds, wg, nwg));        TPH2(27, GRID_SYNC());
    TPH(8, phase_down(get_params(lds), lds, wg, nwg));      TPH2(28, GRID_SYNC());
    TPH(9, phase_final(get_params(lds), lds, wg, nwg));
    if (TIMEPH) { const long long t0_ = __builtin_readcyclecounter(); while (__builtin_readcyclecounter() - t0_ < tph) __builtin_amdgcn_s_sleep(1); }
#undef TPH
#undef GRID_SYNC
}
}

extern "C" void kernel_launch(void* const* d_in, const int* in_sizes, int n_in, void* d_out, int out_size, void* d_ws, size_t ws_size,
                              hipStream_t stream) {
    static int grid_blocks = 0;
    if (grid_blocks == 0) {
        int dev = 0, cus = 0, per_cu = 0;
        if (hipGetDevice(&dev) != hipSuccess || hipDeviceGetAttribute(&cus, hipDeviceAttributeMultiprocessorCount, dev) != hipSuccess) { fprintf(stderr, "kernel_launch: device query failed\n"); grid_blocks = -1; return; }
        if (hipFuncSetAttribute((const void*)k_mega, hipFuncAttributeMaxDynamicSharedMemorySize, LDS_TOTAL) != hipSuccess) { fprintf(stderr, "kernel_launch: hipFuncSetAttribute failed\n"); grid_blocks = -1; return; }
        if (hipOccupancyMaxActiveBlocksPerMultiprocessor(&per_cu, (const void*)k_mega, NTHR, LDS_TOTAL) != hipSuccess || per_cu < 1) { fprintf(stderr, "kernel_launch: occupancy query says %d blocks/CU\n", per_cu); grid_blocks = -1; return; }
        grid_blocks = cus * per_cu;
        if (grid_blocks > NWG) grid_blocks = NWG;
        if (grid_blocks != NWG) { fprintf(stderr, "kernel_launch: need %d co-resident workgroups, device offers %d\n", NWG, grid_blocks); grid_blocks = -1; return; }
        if (ws_size < WS_END) { fprintf(stderr, "kernel_launch: workspace too small (%zu < %zu)\n", ws_size, (size_t)WS_END); grid_blocks = -1; return; }
    }
    if (grid_blocks < 0) return;
    Params p{};
    for (int i = 0; i < 22; ++i) p.in[i] = (const float*)d_in[i];
    p.out = (float*)d_out; p.ws = (unsigned char*)d_ws;
    if (hipMemsetAsync((char*)d_ws + WS_SMALL, 0, 16384, stream) != hipSuccess) { fprintf(stderr, "kernel_launch: memset failed\n"); return; }
    void* args[] = {&p};
    hipError_t e = hipLaunchCooperativeKernel((const void*)k_mega, dim3(grid_blocks), dim3(NTHR), args, LDS_TOTAL, stream);
    if (e != hipSuccess) fprintf(stderr, "kernel_launch: cooperative launch failed: %s (grid %d)\n", hipGetErrorString(e), grid_blocks);
}
```

```cpp
#include <hip/hip_runtime.h>
#include <hip/hip_cooperative_groups.h>
#include <stdint.h>
#include <stdio.h>

namespace {
constexpr int NB = 8, SEQ = 4096, DM = 1024, TOK = NB * SEQ;
constexpr int INW = 5120;
constexpr int C_QA = 0, C_KA = 512, C_VA = 1024, C_QB = 1536, C_KB = 2048, C_VB = 2560, C_GA = 3072, C_GB = 4096;
constexpr int NEXP = 32, TOPK = 4, NASG = TOK * TOPK;
constexpr float ALPHA = 1.189207115002721f;
constexpr float LAMBDA_INIT = 0.2f;
constexpr float LOG2E = 1.4426950408889634f;
constexpr size_t MiB = 1048576;

__device__ __forceinline__ float sigmoidf_(float x) { return 1.0f / (1.0f + __expf(-x)); }
__device__ __forceinline__ float slope_of(int idx) { return exp2f(-8.0f * (float)(idx + 1) / 12.0f); }
#define LAS __attribute__((address_space(3)))
typedef _Float16 f16;
typedef _Float16 f16x8 __attribute__((ext_vector_type(8)));
typedef _Float16 f16x4 __attribute__((ext_vector_type(4)));
typedef _Float16 f16x2 __attribute__((ext_vector_type(2)));
typedef float f32x4 __attribute__((ext_vector_type(4)));
typedef float f32x16 __attribute__((ext_vector_type(16)));
typedef unsigned u32x4 __attribute__((ext_vector_type(4)));
typedef unsigned u32x2 __attribute__((ext_vector_type(2)));

constexpr int NTHR = 512, NWG = 256;
constexpr int BM = 256, BK = 64, HALF = 128, HTB = HALF * BK * 2, STAGE_BYTES = 8 * HTB;
constexpr int LDS_MISC = STAGE_BYTES;
constexpr int LDS_TOTAL = 155648;
constexpr float QSCALE = 0.125f * 1.4426950408889634f;
constexpr int ROWPAD = 256;
constexpr int MOE_ROWS = NASG + NEXP * ROWPAD;
constexpr int LISTCAP = TOK;


constexpr int LDS_WTAB = LDS_TOTAL - 16 - 256;
__device__ __forceinline__ int get_tid(LAS unsigned char* lds) {
    const unsigned hw = (unsigned)__builtin_amdgcn_s_getreg((5 << 11) | 4) & 63u;
    const int wave = __builtin_amdgcn_readfirstlane(((LAS int*)(lds + LDS_WTAB))[hw]);
    int lane; asm volatile("v_mbcnt_lo_u32_b32 %0, -1, 0\n\tv_mbcnt_hi_u32_b32 %0, -1, %0" : "=v"(lane));
    int t = wave * 64 + lane; asm volatile("" : "+v"(t));
    return t;
}
__device__ __forceinline__ float shx(float v, int mask, int lane) { return __int_as_float(__builtin_amdgcn_ds_bpermute((lane ^ mask) << 2, __float_as_int(v))); }
__device__ __forceinline__ unsigned pk2(float a, float b) { f16x2 v; v.x = (f16)a; v.y = (f16)b; return __builtin_bit_cast(unsigned, v); }
__device__ __forceinline__ int lds_byte(int r, int c) { const int st = (r >> 4) * 2 + (c >> 5), rr = r & 15, cc = c & 31, ob = rr * 64 + cc * 2; return st * 1024 + (ob ^ (((ob >> 9) & 1) << 5)); }
__device__ __forceinline__ void stage_rc(int b, int& R, int& C) { const int st = b / 1024, sb = b % 1024, swz = sb ^ (((sb >> 9) & 1) << 5); R = (st >> 1) * 16 + swz / 64; C = (st & 1) * 32 + (swz % 64) / 2; }
__device__ __forceinline__ int perm32(int rho) { const int n = rho >> 4, i = rho & 15; return 8 * (i >> 2) + 4 * n + (i & 3); }

struct Unit { int pm, pn, e, row0, nrows; };

template <int K_>
struct DenseSched {
    static constexpr int K = K_;
    const char* A; const char* Bt; int nM, nN, nwg, G, c;
    __device__ void init(const void* A_, const void* Bt_, int M, int N, int G_, int c_) { A = (const char*)A_; Bt = (const char*)Bt_; nM = M / BM; nN = N / BM; nwg = nM * nN; G = G_; c = c_; }
    __device__ __forceinline__ bool next(int i, Unit& u) const {
        const long L = (long)i * G + c; if (L >= nwg) return false;
        int wgid = (int)L; { const int q = nwg / 8, r = nwg % 8, xcd = wgid % 8, off = wgid / 8; wgid = (xcd < r ? xcd * (q + 1) : r * (q + 1) + (xcd - r) * q) + off; }
        const int nig = 8 * nN, gid = wgid / nig, fm = gid * 8, gsz = (nM - fm) < 8 ? (nM - fm) : 8;
        u.pm = fm + ((wgid % nig) % gsz); u.pn = (wgid % nig) / gsz; u.e = 0; u.row0 = u.pm * BM; u.nrows = BM; return true;
    }
    static constexpr int LDB = K_, MID = -1;
    static __device__ __forceinline__ unsigned ka(int kt) { return (unsigned)kt * 128u; }
    static __device__ __forceinline__ unsigned kb(int kt) { return (unsigned)kt * 128u; }
    static __device__ __forceinline__ unsigned make_rc(int R, int C) { return (unsigned)(R * K + C) * 2u; }
    __device__ __forceinline__ void a_desc(const Unit& u, const unsigned (&rc)[2], unsigned (&ad)[2]) const { ad[0] = rc[0] + (unsigned)u.pm * (unsigned)(BM * K * 2); ad[1] = rc[1] + (unsigned)u.pm * (unsigned)(BM * K * 2); }
    static __device__ __forceinline__ unsigned aoff(unsigned ad, unsigned rc, int h) { return ad + (unsigned)h * (unsigned)(HALF * K * 2); }
    __device__ __forceinline__ const char* b_base(const Unit& u) const { return Bt + (size_t)u.pn * BM * K * 2; }
};

template <class Sched, class Epi>
__device__ __forceinline__ void gemm_phase(LAS unsigned char* lds, const Sched& S, const Epi& E) {
    constexpr int K = Sched::K, nt = K / BK;
    const int tid = get_tid(lds);
    const int wid = __builtin_amdgcn_readfirstlane(tid >> 6), lane = tid & 63, wr = wid >> 2, wc = wid & 3, fr = lane & 15, fq = lane >> 4;
    unsigned rc[2], voffB[2];
#pragma unroll
    for (int i = 0; i < 2; ++i) { int R, C; stage_rc(tid * 16 + i * 8192, R, C); const int Rb = Epi::PERM ? ((R & ~31) + perm32(R & 31)) : R; voffB[i] = (unsigned)(Rb * Sched::LDB + C) * 2u; rc[i] = Sched::make_rc(R, C); }
    constexpr unsigned hstepB = HALF * Sched::LDB * 2;
    const unsigned ldsw = (unsigned)wid * 1024u;
    const int aoff = lds_byte(wr * 64 + fr, fq * 8), boff = lds_byte(wc * 32 + fr, fq * 8);
#define G_SA(b, h) (((b) * 2 + (h)) * HTB)
#define G_SB(b, h) ((4 + (b) * 2 + (h)) * HTB)
#define G_STAGE_A(bufoff, ad, h, kb) do { \
        __builtin_amdgcn_global_load_lds((const unsigned*)(Abase + (size_t)Sched::aoff((ad)[0], rc[0], h) + (kb)), (LAS unsigned*)(lds + (bufoff) + ldsw), 16, 0, 0); \
        __builtin_amdgcn_global_load_lds((const unsigned*)(Abase + (size_t)Sched::aoff((ad)[1], rc[1], h) + (kb)), (LAS unsigned*)(lds + (bufoff) + ldsw + 8192), 16, 0, 0); } while (0)
#define G_STAGE_B(bufoff, gbase) do { _Pragma("unroll") for (int _i = 0; _i < 2; ++_i) \
        __builtin_amdgcn_global_load_lds((const unsigned*)((const char*)(gbase) + voffB[_i]), (LAS unsigned*)(lds + (bufoff) + ldsw + _i * 8192), 16, 0, 0); } while (0)
#define G_LDA(dst, b, h) do { _Pragma("unroll") for (int m = 0; m < 4; ++m) _Pragma("unroll") for (int k = 0; k < 2; ++k) dst[m][k] = *(const LAS f16x8*)(lds + G_SA(b, h) + aoff + m * 2048 + k * 1024); } while (0)
#define G_LDB(dst, b, h) do { _Pragma("unroll") for (int n = 0; n < 2; ++n) _Pragma("unroll") for (int k = 0; k < 2; ++k) dst[n][k] = *(const LAS f16x8*)(lds + G_SB(b, h) + boff + n * 2048 + k * 1024); } while (0)
#define G_MMA(ai, bj, At, Bt) do { __builtin_amdgcn_s_setprio(1); _Pragma("unroll") for (int m = 0; m < 4; ++m) _Pragma("unroll") for (int n = 0; n < 2; ++n) _Pragma("unroll") for (int k = 0; k < 2; ++k) \
        acc[ai][bj][m][n] = __builtin_amdgcn_mfma_f32_16x16x32_f16(Bt[n][k], At[m][k], acc[ai][bj][m][n], 0, 0, 0); __builtin_amdgcn_s_setprio(0); } while (0)
#define G_WAIT_V(n) asm volatile("s_waitcnt vmcnt(" #n ")" ::: "memory")
#define G_WAIT_L(n) asm volatile("s_waitcnt lgkmcnt(" #n ")" ::: "memory")
#define G_BAR __builtin_amdgcn_s_barrier()
#define G_SCHED __builtin_amdgcn_sched_barrier(0)
    Unit cur, nxt; int ui = 0;
    if (!S.next(0, cur)) return;
    f32x4 acc[2][2][4][2];
#pragma unroll
    for (int a = 0; a < 2; ++a)
#pragma unroll
        for (int b = 0; b < 2; ++b)
#pragma unroll
            for (int m = 0; m < 4; ++m)
#pragma unroll
                for (int n = 0; n < 2; ++n) acc[a][b][m][n] = (f32x4){0.f, 0.f, 0.f, 0.f};
    f16x8 At[4][2], B0[2][2], B1[2][2];
    const char* const Abase = S.A;
    unsigned cad[2], nad[2];
    S.a_desc(cur, rc, cad);
    const char* cB = S.b_base(cur);
    G_STAGE_B(G_SB(0, 0), cB); G_STAGE_B(G_SB(0, 1), cB + hstepB); G_STAGE_A(G_SA(0, 0), cad, 0, 0u); G_STAGE_A(G_SA(0, 1), cad, 1, 0u);
    if (wr == 1) G_BAR;
    G_WAIT_V(2); G_BAR;
    G_STAGE_B(G_SB(1, 0), cB + Sched::kb(1)); G_STAGE_A(G_SA(1, 0), cad, 0, Sched::ka(1)); G_STAGE_B(G_SB(1, 1), cB + hstepB + Sched::kb(1));
    G_WAIT_V(6); G_BAR;
    for (;;) {
        const bool has_next = S.next(ui + 1, nxt);
        const char* nB = cB;
        if (has_next) { S.a_desc(nxt, rc, nad); nB = S.b_base(nxt); }
        else { nad[0] = cad[0]; nad[1] = cad[1]; }
        for (int t = 0; t < nt; t += 2) {
            const bool last = (t == nt - 2);
            const unsigned k1 = Sched::ka(t + 1);
            const unsigned k2 = last ? Sched::ka(0) : Sched::ka(t + 2), k3 = last ? Sched::ka(1) : Sched::ka(t + 3);
            const unsigned a2[2] = {last ? nad[0] : cad[0], last ? nad[1] : cad[1]};
            const char* b2 = (last ? nB + Sched::kb(0) : cB + Sched::kb(t + 2)); const char* b3 = (last ? nB + Sched::kb(1) : cB + Sched::kb(t + 3));
            if constexpr (Sched::MID >= 0) { if (t == Sched::MID) E.mid(acc, cur, wr, wc, fr, fq); }
            G_LDB(B0, 0, 0); G_LDB(B1, 0, 1); G_SCHED; G_LDA(At, 0, 0); G_STAGE_A(G_SA(1, 1), cad, 1, k1);
            G_WAIT_V(8); G_WAIT_L(0); G_BAR; G_MMA(0, 0, At, B0); G_MMA(0, 1, At, B1); G_BAR; G_SCHED;
            G_LDA(At, 0, 1); G_STAGE_B(G_SB(0, 0), b2); G_STAGE_B(G_SB(0, 1), b2 + hstepB); G_STAGE_A(G_SA(0, 0), a2, 0, k2);
            G_WAIT_V(8); G_WAIT_L(0); G_BAR; G_MMA(1, 0, At, B0); G_MMA(1, 1, At, B1); G_BAR; G_SCHED;
            G_LDB(B0, 1, 0); G_LDB(B1, 1, 1); G_SCHED; G_LDA(At, 1, 0); G_STAGE_A(G_SA(0, 1), a2, 1, k2);
            G_WAIT_V(8); G_WAIT_L(0); G_BAR; G_MMA(0, 0, At, B0); G_MMA(0, 1, At, B1); G_BAR; G_SCHED;
            G_LDA(At, 1, 1); G_STAGE_B(G_SB(1, 0), b3); G_STAGE_B(G_SB(1, 1), b3 + hstepB); G_STAGE_A(G_SA(1, 0), a2, 0, k3);
            G_WAIT_V(8); G_WAIT_L(0); G_BAR; G_MMA(1, 0, At, B0); G_MMA(1, 1, At, B1); G_BAR; G_SCHED;
        }
        if (wr == 0) G_BAR;
        E(acc, cur, wr, wc, fr, fq);
        if (!has_next) break;
#pragma unroll
        for (int a = 0; a < 2; ++a)
#pragma unroll
            for (int b = 0; b < 2; ++b)
#pragma unroll
                for (int m = 0; m < 4; ++m)
#pragma unroll
                    for (int n = 0; n < 2; ++n) acc[a][b][m][n] = (f32x4){0.f, 0.f, 0.f, 0.f};
        cur = nxt; cB = nB; ++ui; cad[0] = nad[0]; cad[1] = nad[1];
        if (wr == 1) G_BAR;
    }
    G_WAIT_V(0);
    G_BAR;
#undef G_SA
#undef G_SB
#undef G_STAGE_A
#undef G_STAGE_B
#undef G_LDA
#undef G_LDB
#undef G_MMA
#undef G_WAIT_V
#undef G_WAIT_L
#undef G_BAR
#undef G_SCHED
}
constexpr size_t WS_WIN = 0;
constexpr size_t WS_WPA = WS_WIN + (size_t)INW * DM * 2;
constexpr size_t WS_WPB = WS_WPA + (size_t)DM * 512 * 2;
constexpr size_t WS_WOUT = WS_WPB + (size_t)DM * 512 * 2;
constexpr size_t WS_WUP = WS_WOUT + (size_t)DM * DM * 2;
constexpr size_t WS_WDN = WS_WUP + (size_t)NEXP * 2048 * DM * 2;
constexpr size_t WS_XH = WS_WDN + (size_t)NEXP * DM * DM * 2;
constexpr size_t WS_PROJ = WS_XH + (size_t)TOK * DM * 2;
constexpr size_t WS_OAB = WS_PROJ + (size_t)TOK * INW * 2;
constexpr size_t WS_MERGED = WS_OAB + (size_t)TOK * DM * 2;
constexpr size_t WS_H1 = WS_MERGED + (size_t)TOK * DM * 2;
constexpr size_t WS_SMALL = WS_H1 + (size_t)TOK * DM * 4 + 16 * MiB;
constexpr size_t WS_YS = WS_OAB;
constexpr size_t SM_PQ = 16064;
constexpr size_t SM_CNT = 0, SM_TK = 16384, SM_LIST = SM_TK + (size_t)NASG * 4;
constexpr size_t WS_END = WS_SMALL + SM_LIST + (size_t)NEXP * LISTCAP * 8;
static_assert(WS_YS + (size_t)MOE_ROWS * DM * 2 <= WS_SMALL, "ys overlaps bookkeeping");
static_assert((size_t)MOE_ROWS * DM * 2 <= (size_t)TOK * INW * 2, "act does not fit over proj");
static_assert(WS_END <= 1024 * MiB, "workspace");

struct Params {
    const float* in[22]; float* out; unsigned char* ws;
};

constexpr int LDS_PARAMS = LDS_WTAB - 256;
__device__ __forceinline__ unsigned long long rfl64(unsigned long long v) {
    const unsigned lo = (unsigned)__builtin_amdgcn_readfirstlane((int)(unsigned)v), hi = (unsigned)__builtin_amdgcn_readfirstlane((int)(unsigned)(v >> 32));
    return ((unsigned long long)hi << 32) | lo; }
__device__ __forceinline__ Params get_params(LAS unsigned char* lds) {
    unsigned off = LDS_PARAMS; asm volatile("" : "+v"(off));
    const LAS unsigned long long* q = (const LAS unsigned long long*)(lds + off);
    Params p;
#pragma unroll
    for (int i = 0; i < 22; ++i) p.in[i] = (const float*)rfl64(q[i]);
    p.out = (float*)rfl64(q[22]); p.ws = (unsigned char*)rfl64(q[23]);
    return p;
}
__device__ __forceinline__ void put_params(const Params& p, LAS unsigned char* lds) {
    LAS unsigned long long* q = (LAS unsigned long long*)(lds + LDS_PARAMS);
#pragma unroll
    for (int i = 0; i < 22; ++i) q[i] = (unsigned long long)p.in[i];
    q[22] = (unsigned long long)p.out; q[23] = (unsigned long long)p.ws;
}


struct PrepTile { const float* src; int ldsrc; f16* dst; int K; int n0; };
__device__ __forceinline__ PrepTile prep_desc(const Params& p, int t) {
    unsigned char* ws = p.ws;
    constexpr int T_IN = (INW / 64) * (DM / 128), T_PA = (DM / 64) * (512 / 128), T_OUT = (DM / 64) * (DM / 128);
    constexpr int T_UP1 = (2048 / 64) * (DM / 128), T_DN1 = (DM / 64) * (DM / 128);
    constexpr int T0 = T_IN, T1 = T0 + T_PA, T2 = T1 + T_PA, T3 = T2 + T_OUT, T4 = T3 + NEXP * T_UP1;
    PrepTile d;
    if (t < T0) { const int tn = t / 8, tk = t % 8; d.src = p.in[1] + (size_t)(tk * 128) * INW + tn * 64; d.ldsrc = INW; d.dst = (f16*)(ws + WS_WIN) + tk * 128; d.K = DM; d.n0 = tn * 64; }
    else if (t < T1) { const int q = t - T0, tn = q / 4, tk = q % 4; d.src = p.in[8] + (size_t)(tk * 128) * DM + tn * 64; d.ldsrc = DM; d.dst = (f16*)(ws + WS_WPA) + tk * 128; d.K = 512; d.n0 = tn * 64; }
    else if (t < T2) { const int q = t - T1, tn = q / 4, tk = q % 4; d.src = p.in[9] + (size_t)(tk * 128) * DM + tn * 64; d.ldsrc = DM; d.dst = (f16*)(ws + WS_WPB) + tk * 128; d.K = 512; d.n0 = tn * 64; }
    else if (t < T3) { const int q = t - T2, tn = q / 8, tk = q % 8; d.src = p.in[10] + (size_t)(tk * 128) * DM + tn * 64; d.ldsrc = DM; d.dst = (f16*)(ws + WS_WOUT) + tk * 128; d.K = DM; d.n0 = tn * 64; }
    else if (t < T4) { const int q = t - T3, e = q / T_UP1, r = q % T_UP1, tn = r / 8, tk = r % 8;
        const int np = tn * 64, pn = np >> 8, jj = np & 255;
        const int sc = jj < 128 ? pn * 128 + jj : 1024 + pn * 128 + (jj - 128);
        d.src = p.in[16] + (size_t)e * DM * 2048 + (size_t)(tk * 128) * 2048 + sc; d.ldsrc = 2048; d.dst = (f16*)(ws + WS_WUP) + (size_t)e * 2048 * DM + tk * 128; d.K = DM; d.n0 = np; }
    else { const int q = t - T4, e = q / T_DN1, r = q % T_DN1, tn = r / 8, tk = r % 8;
        d.src = p.in[18] + (size_t)e * DM * DM + (size_t)(tk * 128) * DM + tn * 64; d.ldsrc = DM; d.dst = (f16*)(ws + WS_WDN) + (size_t)e * DM * DM + tk * 128; d.K = DM; d.n0 = tn * 64; }
    return d;
}
constexpr int PREP_NT = (INW / 64) * (DM / 128) + 2 * (DM / 64) * (512 / 128) + (DM / 64) * (DM / 128) + NEXP * ((2048 / 64) * (DM / 128) + (DM / 64) * (DM / 128));
__device__ __forceinline__ void phase_prep(const Params& p, LAS unsigned char* lds, int wg, int nwg) {
    const int tid = get_tid(lds);
    unsigned char* ws = p.ws;
    {
        const float4* src = (const float4*)p.in[0]; u32x4* dst = (u32x4*)(ws + WS_XH);
        constexpr size_t n8 = (size_t)TOK * DM / 8;
        const size_t stride = (size_t)nwg * NTHR;
        for (size_t i = (size_t)wg * NTHR + tid; i < n8; i += 4 * stride) {
            float4 a[4], c[4];
#pragma unroll
            for (int u = 0; u < 4; ++u) { { const f32x4 t0_ = __builtin_nontemporal_load((const f32x4*)(src + 2 * (i + u * stride))), t1_ = __builtin_nontemporal_load((const f32x4*)(src + 2 * (i + u * stride) + 1)); a[u] = make_float4(t0_[0], t0_[1], t0_[2], t0_[3]); c[u] = make_float4(t1_[0], t1_[1], t1_[2], t1_[3]); } }
#pragma unroll
            for (int u = 0; u < 4; ++u) { u32x4 w; w.x = pk2(a[u].x, a[u].y); w.y = pk2(a[u].z, a[u].w); w.z = pk2(c[u].x, c[u].y); w.w = pk2(c[u].z, c[u].w); dst[i + u * stride] = w; }
        }
    }
    LAS float* tile = (LAS float*)lds;
    const int lk = tid >> 4, ln4 = (tid & 15) * 4;
    float4 va[4], vb[4];
#define PREP_LOAD(V, tt) do { if ((tt) < PREP_NT) { const PrepTile d_ = prep_desc(p, (tt)); \
        _Pragma("unroll") for (int j = 0; j < 4; ++j) { const f32x4 t_ = __builtin_nontemporal_load((const f32x4*)(d_.src + (size_t)(lk + 32 * j) * d_.ldsrc + ln4)); V[j] = make_float4(t_[0], t_[1], t_[2], t_[3]); } } } while (0)
#define PREP_DO2(V, tt, tnext) do { if ((tt) < PREP_NT) { const PrepTile d = prep_desc(p, (tt)); \
        _Pragma("unroll") for (int j = 0; j < 4; ++j) { LAS float* r = tile + (lk + 32 * j) * 65 + ln4; r[0] = V[j].x; r[1] = V[j].y; r[2] = V[j].z; r[3] = V[j].w; } \
        PREP_LOAD(V, (tnext)); \
        __syncthreads(); \
        { const int n = tid >> 3, kc = (tid & 7) * 16; u32x4 w0, w1; \
          w0.x = pk2(tile[(kc + 0) * 65 + n], tile[(kc + 1) * 65 + n]); w0.y = pk2(tile[(kc + 2) * 65 + n], tile[(kc + 3) * 65 + n]); \
          w0.z = pk2(tile[(kc + 4) * 65 + n], tile[(kc + 5) * 65 + n]); w0.w = pk2(tile[(kc + 6) * 65 + n], tile[(kc + 7) * 65 + n]); \
          w1.x = pk2(tile[(kc + 8) * 65 + n], tile[(kc + 9) * 65 + n]); w1.y = pk2(tile[(kc + 10) * 65 + n], tile[(kc + 11) * 65 + n]); \
          w1.z = pk2(tile[(kc + 12) * 65 + n], tile[(kc + 13) * 65 + n]); w1.w = pk2(tile[(kc + 14) * 65 + n], tile[(kc + 15) * 65 + n]); \
          f16* o = d.dst + (size_t)(d.n0 + n) * d.K + kc; *(u32x4*)o = w0; *(u32x4*)(o + 8) = w1; } \
        __syncthreads(); } } while (0)
    unsigned* pq = (unsigned*)(ws + WS_SMALL + SM_PQ);
    LAS int* qslot = (LAS int*)(lds + 36864);
    int ta, tb;
    if (tid == 0) { qslot[0] = (int)__hip_atomic_fetch_add(pq, 1u, __ATOMIC_RELAXED, __HIP_MEMORY_SCOPE_AGENT); qslot[1] = (int)__hip_atomic_fetch_add(pq, 1u, __ATOMIC_RELAXED, __HIP_MEMORY_SCOPE_AGENT); }
    __syncthreads();
    ta = qslot[0]; tb = qslot[1];
    PREP_LOAD(va, ta); PREP_LOAD(vb, tb);
#define PREP_DRAW(tv) do { __syncthreads(); if (tid == 0) qslot[0] = (int)__hip_atomic_fetch_add(pq, 1u, __ATOMIC_RELAXED, __HIP_MEMORY_SCOPE_AGENT); __syncthreads(); tv = qslot[0]; } while (0)
#pragma unroll 1
    for (;;) {
        if (ta >= PREP_NT && tb >= PREP_NT) break;
        int tn;
        if (ta < PREP_NT) { PREP_DRAW(tn); PREP_DO2(va, ta, tn); ta = tn; }
        if (tb < PREP_NT) { PREP_DRAW(tn); PREP_DO2(vb, tb, tn); tb = tn; }
    }
#undef PREP_DRAW
#undef PREP_LOAD
#undef PREP_DO2
}

struct EpiInProj {
    static constexpr bool PERM = true;
    f16* O; const float* bias;
    __device__ __forceinline__ void operator()(const f32x4 (&acc)[2][2][4][2], const Unit& u, int wr, int wc, int fr, int fq) const {
        const int row0 = u.pm * BM + wr * 64 + fr, col0 = u.pn * BM + wc * 32 + 8 * fq;
        const int cls = u.pn;
        const float scl = (cls < 2 || cls == 6 || cls == 7) ? QSCALE : 1.0f;
        const bool sig = cls >= 12;
        f32x4 bv[2][2];
#pragma unroll
        for (int bj = 0; bj < 2; ++bj)
#pragma unroll
            for (int n = 0; n < 2; ++n) bv[bj][n] = *(const f32x4*)(bias + col0 + bj * HALF + 4 * n);
#pragma unroll
        for (int ai = 0; ai < 2; ++ai)
#pragma unroll
            for (int m = 0; m < 4; ++m) {
                f16* rowp = O + (size_t)(row0 + ai * HALF + m * 16) * INW + col0;
#pragma unroll
                for (int bj = 0; bj < 2; ++bj) {
                    f32x4 v0 = acc[ai][bj][m][0] + bv[bj][0], v1 = acc[ai][bj][m][1] + bv[bj][1];
                    if (sig) {
#pragma unroll
                        for (int j = 0; j < 4; ++j) { v0[j] = __builtin_amdgcn_rcpf(1.0f + __expf(-v0[j])); v1[j] = __builtin_amdgcn_rcpf(1.0f + __expf(-v1[j])); }
                    } else { v0 *= scl; v1 *= scl; }
                    u32x4 w; w.x = pk2(v0[0], v0[1]); w.y = pk2(v0[2], v0[3]); w.z = pk2(v1[0], v1[1]); w.w = pk2(v1[2], v1[3]);
                    *(u32x4*)(rowp + bj * HALF) = w;
                }
            }
    }
};
__device__ __forceinline__ void phase_inproj(const Params& p, LAS unsigned char* lds, int wg, int nwg) {
    DenseSched<DM> S; S.init(p.ws + WS_XH, p.ws + WS_WIN, TOK, INW, nwg, wg);
    EpiInProj E{(f16*)(p.ws + WS_PROJ), p.in[2]};
    gemm_phase(lds, S, E);
}
constexpr int RT_LOG = 131072, RT_HIST = RT_LOG + 16384;
__device__ __forceinline__ void phase_router(const Params& p, LAS unsigned char* lds, int wg, int nwg) {
    const int tid = get_tid(lds);
    const int lane = tid & 63, wave = tid >> 6;
    const float* h1 = (const float*)(p.ws + WS_H1);
    f16* x1h = (f16*)(p.ws + WS_XH);
    const float* lng = p.in[12]; const float* lnb = p.in[13];
    const float* wr = p.in[14]; const float* br = p.in[15];
    int* cnt = (int*)(p.ws + WS_SMALL + SM_CNT);
    int* tk = (int*)(p.ws + WS_SMALL + SM_TK);
    int2* list = (int2*)(p.ws + WS_SMALL + SM_LIST);
    LAS float* wl = (LAS float*)lds;
    LAS float* slog = (LAS float*)(lds + RT_LOG);
    LAS int* hist = (LAS int*)(lds + RT_HIST);
    LAS int* hbase = hist + 32;
    for (int i = tid; i < DM * 8; i += NTHR) {
        const int col = i >> 3, k = i & 7;
        const float4 v = *(const float4*)(wr + (size_t)col * NEXP + k * 4);
        LAS float* d = wl + col * 32 + ((k ^ ((col >> 1) & 7)) << 2);
        d[0] = v.x; d[1] = v.y; d[2] = v.z; d[3] = v.w;
    }
    if (tid < 32) hist[tid] = 0;
    __syncthreads();
    const int tpw = TOK / (nwg * 8);
    const int tok0 = wg * (TOK / nwg) + wave * tpw;
    float gam[16], bet[16];
#pragma unroll
    for (int r = 0; r < 16; ++r) { gam[r] = lng[r * 64 + lane]; bet[r] = lnb[r * 64 + lane]; }
    float xa[16], xb[16];
#pragma unroll
    for (int r = 0; r < 16; ++r) { xa[r] = h1[(size_t)tok0 * DM + r * 64 + lane]; xb[r] = h1[(size_t)(tok0 + 1) * DM + r * 64 + lane]; }
#pragma unroll 1
    for (int j = 0; j < tpw; j += 2) {
        const int t = tok0 + j;
        float na[16], nb[16];
        if (j + 2 < tpw) {
#pragma unroll
            for (int r = 0; r < 16; ++r) { na[r] = h1[(size_t)(t + 2) * DM + r * 64 + lane]; nb[r] = h1[(size_t)(t + 3) * DM + r * 64 + lane]; }
        } else {
#pragma unroll
            for (int r = 0; r < 16; ++r) { na[r] = 0.f; nb[r] = 0.f; }
        }
        float sa = 0.f, sb = 0.f;
#pragma unroll
        for (int r = 0; r < 16; ++r) { sa += xa[r]; sb += xb[r]; }
        for (int o = 32; o >= 1; o >>= 1) { sa += shx(sa, o, lane); sb += shx(sb, o, lane); }
        const float mua = sa * (1.0f / DM), mub = sb * (1.0f / DM);
        float qa = 0.f, qb = 0.f;
#pragma unroll
        for (int r = 0; r < 16; ++r) { const float da = xa[r] - mua, db = xb[r] - mub; qa += da * da; qb += db * db; }
        for (int o = 32; o >= 1; o >>= 1) { qa += shx(qa, o, lane); qb += shx(qb, o, lane); }
        const float rsa = rsqrtf(qa * (1.0f / DM) + 1e-5f), rsb = rsqrtf(qb * (1.0f / DM) + 1e-5f);
#pragma unroll
        for (int r = 0; r < 16; ++r) {
            xa[r] = (xa[r] - mua) * rsa * gam[r] + bet[r]; xb[r] = (xb[r] - mub) * rsb * gam[r] + bet[r];
            x1h[(size_t)t * DM + r * 64 + lane] = (f16)xa[r]; x1h[(size_t)(t + 1) * DM + r * 64 + lane] = (f16)xb[r];
        }
        float acc[32], acd[32];
#pragma unroll
        for (int e = 0; e < 32; ++e) { acc[e] = 0.f; acd[e] = 0.f; }
#pragma unroll
        for (int r = 0; r < 16; ++r) {
            const int col = r * 64 + lane;
            const LAS float* wrow = wl + col * 32;
            const int sw = (col >> 1) & 7;
#pragma unroll
            for (int k = 0; k < 8; ++k) {
                const f32x4 w4 = *(const LAS f32x4*)(wrow + ((k ^ sw) << 2));
#pragma unroll
                for (int c = 0; c < 4; ++c) { acc[k * 4 + c] = fmaf(xa[r], w4[c], acc[k * 4 + c]); acd[k * 4 + c] = fmaf(xb[r], w4[c], acd[k * 4 + c]); }
            }
        }
#define RT_REDUCE(AC, OUT) do { float a16[16], a8[8], a4[4], a2[2]; \
        { const bool hi_ = (lane & 32) != 0; _Pragma("unroll") for (int k = 0; k < 16; ++k) { const float snd = hi_ ? AC[k] : AC[16 + k]; const float rcv = shx(snd, 32, lane); a16[k] = (hi_ ? AC[16 + k] : AC[k]) + rcv; } } \
        { const bool hi_ = (lane & 16) != 0; _Pragma("unroll") for (int k = 0; k < 8; ++k) { const float snd = hi_ ? a16[k] : a16[8 + k]; const float rcv = shx(snd, 16, lane); a8[k] = (hi_ ? a16[8 + k] : a16[k]) + rcv; } } \
        { const bool hi_ = (lane & 8) != 0; _Pragma("unroll") for (int k = 0; k < 4; ++k) { const float snd = hi_ ? a8[k] : a8[4 + k]; const float rcv = shx(snd, 8, lane); a4[k] = (hi_ ? a8[4 + k] : a8[k]) + rcv; } } \
        { const bool hi_ = (lane & 4) != 0; _Pragma("unroll") for (int k = 0; k < 2; ++k) { const float snd = hi_ ? a4[k] : a4[2 + k]; const float rcv = shx(snd, 4, lane); a2[k] = (hi_ ? a4[2 + k] : a4[k]) + rcv; } } \
        { const bool hi_ = (lane & 2) != 0; const float snd = hi_ ? a2[0] : a2[1]; const float rcv = shx(snd, 2, lane); OUT = (hi_ ? a2[1] : a2[0]) + rcv; } \
        OUT += shx(OUT, 1, lane); } while (0)
        float l0, l1;
        RT_REDUCE(acc, l0); RT_REDUCE(acd, l1);
#undef RT_REDUCE
        if ((lane & 1) == 0) { const float bb = br[lane >> 1]; slog[(wave * tpw + j) * 32 + (lane >> 1)] = l0 + bb; slog[(wave * tpw + j + 1) * 32 + (lane >> 1)] = l1 + bb; }
#pragma unroll
        for (int r = 0; r < 16; ++r) { xa[r] = na[r]; xb[r] = nb[r]; }
    }
    __syncthreads();
    int my_e[4]; float my_g[4]; int my_loc[4];
    const bool act = lane < tpw;
    const int tl = wave * tpw + lane;
    if (act) {
        float v[32];
#pragma unroll
        for (int k = 0; k < 8; ++k) { const f32x4 t4 = *(const LAS f32x4*)(slog + tl * 32 + k * 4); v[k * 4] = t4[0]; v[k * 4 + 1] = t4[1]; v[k * 4 + 2] = t4[2]; v[k * 4 + 3] = t4[3]; }
        float tv[4];
#pragma unroll
        for (int k = 0; k < 4; ++k) {
            float bv = -3.0e38f; int bi = 0;
#pragma unroll
            for (int e = 0; e < 32; ++e) { if (v[e] > bv) { bv = v[e]; bi = e; } }
            tv[k] = bv; my_e[k] = bi;
#pragma unroll
            for (int e = 0; e < 32; ++e) v[e] = (e == bi) ? -3.0e38f : v[e];
        }
        const float e1 = __expf(tv[1] - tv[0]), e2 = __expf(tv[2] - tv[0]), e3 = __expf(tv[3] - tv[0]);
        const float inv = 1.0f / (1.0f + e1 + e2 + e3);
        my_g[0] = inv; my_g[1] = e1 * inv; my_g[2] = e2 * inv; my_g[3] = e3 * inv;
#pragma unroll
        for (int k = 0; k < 4; ++k) my_loc[k] = __hip_atomic_fetch_add(hist + my_e[k], 1, __ATOMIC_RELAXED, __HIP_MEMORY_SCOPE_WORKGROUP);
    }
    __syncthreads();
    if (tid < 32) hbase[tid] = atomicAdd(&cnt[tid], hist[tid]);
    __syncthreads();
    if (act) {
        const int t = tok0 + lane;
#pragma unroll
        for (int k = 0; k < 4; ++k) {
            const int slot = hbase[my_e[k]] + my_loc[k];
            tk[t * 4 + k] = (my_e[k] << 20) | slot;
            list[(size_t)my_e[k] * LISTCAP + slot] = make_int2(t, __float_as_int(my_g[k]));
        }
    }
    __syncthreads();
}

__device__ __forceinline__ void phase_final(const Params& p, LAS unsigned char* lds, int wg, int nwg) {
    const int tid = get_tid(lds);
    const int lane = tid & 63, wave = tid >> 6;
    const f16* x1h = (const f16*)(p.ws + WS_XH);
    const f16* ys = (const f16*)(p.ws + WS_YS);
    const int* cnt = (const int*)(p.ws + WS_SMALL + SM_CNT);
    const int* tk = (const int*)(p.ws + WS_SMALL + SM_TK);
    const float* lng = p.in[20]; const float* lnb = p.in[21];
    LAS int* ps = (LAS int*)lds;
    if (tid == 0) { int a = 0; for (int e = 0; e < NEXP; ++e) { ps[e] = a; a += (cnt[e] + ROWPAD - 1) / ROWPAD * ROWPAD; } }
    __syncthreads();
    const int tpw = TOK / (nwg * 8);
    const int tok0 = wg * (TOK / nwg) + wave * tpw;
    float gm[16], bt[16];
#pragma unroll
    for (int hh = 0; hh < 2; ++hh) { const int c0 = hh * 512 + 8 * lane;
        const float4 g0 = *(const float4*)(lng + c0), g1 = *(const float4*)(lng + c0 + 4), b0 = *(const float4*)(lnb + c0), b1 = *(const float4*)(lnb + c0 + 4);
        gm[hh * 8 + 0] = g0.x; gm[hh * 8 + 1] = g0.y; gm[hh * 8 + 2] = g0.z; gm[hh * 8 + 3] = g0.w; gm[hh * 8 + 4] = g1.x; gm[hh * 8 + 5] = g1.y; gm[hh * 8 + 6] = g1.z; gm[hh * 8 + 7] = g1.w;
        bt[hh * 8 + 0] = b0.x; bt[hh * 8 + 1] = b0.y; bt[hh * 8 + 2] = b0.z; bt[hh * 8 + 3] = b0.w; bt[hh * 8 + 4] = b1.x; bt[hh * 8 + 5] = b1.y; bt[hh * 8 + 6] = b1.z; bt[hh * 8 + 7] = b1.w; }
    f16x8 ra[5], rb[5];
#define FN_LOAD(t_) do { ra[0] = *(const f16x8*)(x1h + (size_t)(t_) * DM + 8 * lane); rb[0] = *(const f16x8*)(x1h + (size_t)(t_) * DM + 512 + 8 * lane); \
        _Pragma("unroll") for (int k = 0; k < 4; ++k) { const int c = tk[(t_) * 4 + k]; const int row = ps[c >> 20] + (c & 0xFFFFF); \
            ra[1 + k] = *(const f16x8*)(ys + (size_t)row * DM + 8 * lane); rb[1 + k] = *(const f16x8*)(ys + (size_t)row * DM + 512 + 8 * lane); } } while (0)
    FN_LOAD(tok0);
#pragma unroll 1
    for (int j = 0; j < tpw; ++j) {
        const int t = tok0 + j;
        float v[16];
#pragma unroll
        for (int i = 0; i < 8; ++i) { v[i] = ALPHA * (float)ra[0][i]; v[8 + i] = ALPHA * (float)rb[0][i]; }
#pragma unroll
        for (int k = 1; k < 5; ++k)
#pragma unroll
            for (int i = 0; i < 8; ++i) { v[i] += (float)ra[k][i]; v[8 + i] += (float)rb[k][i]; }
        if (j + 1 < tpw) FN_LOAD(t + 1);
        float s = 0.f;
#pragma unroll
        for (int i = 0; i < 16; ++i) s += v[i];
        for (int o = 32; o >= 1; o >>= 1) s += shx(s, o, lane);
        const float mu = s * (1.0f / DM);
        float q = 0.f;
#pragma unroll
        for (int i = 0; i < 16; ++i) { const float d = v[i] - mu; q += d * d; }
        for (int o = 32; o >= 1; o >>= 1) q += shx(q, o, lane);
        const float rs = rsqrtf(q * (1.0f / DM) + 1e-5f);
        float* op = p.out + (size_t)t * DM;
#pragma unroll
        for (int hh = 0; hh < 2; ++hh) {
            const int c0 = hh * 512 + 8 * lane;
            float4 o0, o1;
            o0.x = (v[hh * 8 + 0] - mu) * rs * gm[hh * 8 + 0] + bt[hh * 8 + 0]; o0.y = (v[hh * 8 + 1] - mu) * rs * gm[hh * 8 + 1] + bt[hh * 8 + 1];
            o0.z = (v[hh * 8 + 2] - mu) * rs * gm[hh * 8 + 2] + bt[hh * 8 + 2]; o0.w = (v[hh * 8 + 3] - mu) * rs * gm[hh * 8 + 3] + bt[hh * 8 + 3];
            o1.x = (v[hh * 8 + 4] - mu) * rs * gm[hh * 8 + 4] + bt[hh * 8 + 4]; o1.y = (v[hh * 8 + 5] - mu) * rs * gm[hh * 8 + 5] + bt[hh * 8 + 5];
            o1.z = (v[hh * 8 + 6] - mu) * rs * gm[hh * 8 + 6] + bt[hh * 8 + 6]; o1.w = (v[hh * 8 + 7] - mu) * rs * gm[hh * 8 + 7] + bt[hh * 8 + 7];
            *(float4*)(op + c0) = o0; *(float4*)(op + c0 + 4) = o1;
        }
    }
#undef FN_LOAD
    __syncthreads();
}
struct MergeSched {
    static constexpr int K = 1024, LDB = 512, MID = 8;
    static constexpr unsigned OB_JUMP = (unsigned)(TOK * 512 * 2) - 1024u, WB_JUMP = (unsigned)(DM * 512 * 2) - 1024u;
    const char* A; const char* Bt; DenseSched<512> D;
    __device__ void init(const void* oa, const void* wpa_t, int G, int c) { A = (const char*)oa; Bt = (const char*)wpa_t; D.init(oa, wpa_t, TOK, DM, G, c); }
    __device__ __forceinline__ bool next(int i, Unit& u) const { return D.next(i, u); }
    static __device__ __forceinline__ unsigned ka(int kt) { return (unsigned)kt * 128u + (kt >= 8 ? OB_JUMP : 0u); }
    static __device__ __forceinline__ unsigned kb(int kt) { return (unsigned)kt * 128u + (kt >= 8 ? WB_JUMP : 0u); }
    static __device__ __forceinline__ unsigned make_rc(int R, int C) { return (unsigned)(R * 512 + C) * 2u; }
    __device__ __forceinline__ void a_desc(const Unit& u, const unsigned (&rc)[2], unsigned (&ad)[2]) const { const unsigned o = (unsigned)u.pm * (unsigned)(BM * 512 * 2); ad[0] = rc[0] + o; ad[1] = rc[1] + o; }
    static __device__ __forceinline__ unsigned aoff(unsigned ad, unsigned rc, int h) { return ad + (unsigned)h * (unsigned)(HALF * 512 * 2); }
    __device__ __forceinline__ const char* b_base(const Unit& u) const { return Bt + (size_t)u.pn * BM * 512 * 2; }
};
struct EpiMerge {
    static constexpr bool PERM = true;
    const f16* proj; f16* merged;
    __device__ __forceinline__ void mid(f32x4 (&acc)[2][2][4][2], const Unit& u, int wr, int wc, int fr, int fq) const {
        asm volatile("" : "+v"(fr), "+v"(fq));
        const int row0 = u.pm * BM + wr * 64 + fr, col0 = u.pn * BM + wc * 32 + 8 * fq;
#pragma unroll
        for (int ai = 0; ai < 2; ++ai)
#pragma unroll
            for (int m = 0; m < 4; ++m) {
                const size_t row = (size_t)(row0 + ai * HALF + m * 16);
#pragma unroll
                for (int bj = 0; bj < 2; ++bj) {
                    const f16x8 ga = *(const f16x8*)(proj + row * INW + C_GA + col0 + bj * HALF), gb = *(const f16x8*)(proj + row * INW + C_GB + col0 + bj * HALF);
#pragma unroll
                    for (int j = 0; j < 4; ++j) {
                        acc[ai][bj][m][0][j] *= (float)ga[j] * __builtin_amdgcn_rcpf(fmaxf((float)gb[j], 5.9604645e-8f));
                        acc[ai][bj][m][1][j] *= (float)ga[4 + j] * __builtin_amdgcn_rcpf(fmaxf((float)gb[4 + j], 5.9604645e-8f));
                    }
                }
                asm volatile("" ::: "memory");
            }
    }
    __device__ __forceinline__ void operator()(const f32x4 (&acc)[2][2][4][2], const Unit& u, int wr, int wc, int fr, int fq) const {
        const int row0 = u.pm * BM + wr * 64 + fr, col0 = u.pn * BM + wc * 32 + 8 * fq;
#pragma unroll
        for (int ai = 0; ai < 2; ++ai)
#pragma unroll
            for (int m = 0; m < 4; ++m) {
                const size_t row = (size_t)(row0 + ai * HALF + m * 16);
#pragma unroll
                for (int bj = 0; bj < 2; ++bj) {
                    const f16x8 gb = *(const f16x8*)(proj + row * INW + C_GB + col0 + bj * HALF);
                    float v[8];
#pragma unroll
                    for (int j = 0; j < 4; ++j) { v[j] = fmaxf((float)gb[j], 5.9604645e-8f) * acc[ai][bj][m][0][j]; v[4 + j] = fmaxf((float)gb[4 + j], 5.9604645e-8f) * acc[ai][bj][m][1][j]; }
                    u32x4 w; w.x = pk2(v[0], v[1]); w.y = pk2(v[2], v[3]); w.z = pk2(v[4], v[5]); w.w = pk2(v[6], v[7]);
                    *(u32x4*)(merged + row * DM + col0 + bj * HALF) = w;
                }
            }
    }
};
__device__ __forceinline__ void phase_merge(const Params& p, LAS unsigned char* lds, int wg, int nwg) {
    MergeSched S; S.init(p.ws + WS_OAB, p.ws + WS_WPA, nwg, wg);
    EpiMerge E{(const f16*)(p.ws + WS_PROJ), (f16*)(p.ws + WS_MERGED)};
    gemm_phase(lds, S, E);
}
struct EpiOutProj {
    static constexpr bool PERM = false;
    const float* x; const float* bias; float* h1;
    __device__ __forceinline__ void operator()(const f32x4 (&acc)[2][2][4][2], const Unit& u, int wr, int wc, int fr, int fq) const {
        const int row0 = u.pm * BM + wr * 64 + fr, col0 = u.pn * BM + wc * 32 + 4 * fq;
        f32x4 bv[2][2];
#pragma unroll
        for (int bj = 0; bj < 2; ++bj)
#pragma unroll
            for (int n = 0; n < 2; ++n) bv[bj][n] = *(const f32x4*)(bias + col0 + bj * HALF + n * 16);
#pragma unroll
        for (int ai = 0; ai < 2; ++ai)
#pragma unroll
            for (int m = 0; m < 4; ++m) {
                const size_t off = (size_t)(row0 + ai * HALF + m * 16) * DM + col0;
#pragma unroll
                for (int bj = 0; bj < 2; ++bj)
#pragma unroll
                    for (int n = 0; n < 2; ++n) {
                        const f32x4 xv = *(const f32x4*)(x + off + bj * HALF + n * 16);
                        *(f32x4*)(h1 + off + bj * HALF + n * 16) = ALPHA * xv + acc[ai][bj][m][n] + bv[bj][n];
                    }
            }
    }
};
__device__ __forceinline__ void phase_outproj(const Params& p, LAS unsigned char* lds, int wg, int nwg) {
    DenseSched<DM> S; S.init(p.ws + WS_MERGED, p.ws + WS_WOUT, TOK, DM, nwg, wg);
    EpiOutProj E{p.in[0], p.in[11], (float*)(p.ws + WS_H1)};
    gemm_phase(lds, S, E);
}

constexpr int MOE_MISC = STAGE_BYTES;
__device__ __forceinline__ void moe_prefix(const Params& p, LAS unsigned char* lds) {
    LAS int* tpre = (LAS int*)(lds + MOE_MISC); LAS int* ecnt = tpre + 64;
    const int* cnt = (const int*)(p.ws + WS_SMALL + SM_CNT);
    if (get_tid(lds) == 0) { int a = 0; for (int e = 0; e < NEXP; ++e) { const int c = cnt[e]; ecnt[e] = c; tpre[e] = a; a += (c + ROWPAD - 1) / ROWPAD; } tpre[NEXP] = a; }
    __syncthreads();
}
template <int NPN, bool GATHER>
struct MoeSched {
    static constexpr int K = DM;
    const char* A; const char* Bt; const int2* list; LAS int* tpre; LAS int* ecnt; int c;
    __device__ __forceinline__ bool next(int i, Unit& u) const {
        constexpr int MPR = 256 / NPN, MPX = 32 / NPN;
        const int xcd = c & 7, j = c >> 3;
        const int M = i * MPR + xcd * MPX + j / NPN;
        if (M >= tpre[NEXP]) return false;
        int e = 0;
        for (int k = 1; k < NEXP; ++k) e += (tpre[k] <= M) ? 1 : 0;
        u.e = e; u.pm = M - tpre[e]; u.pn = j % NPN; u.row0 = M * ROWPAD; u.nrows = ecnt[e] - u.pm * ROWPAD;
        return true;
    }
    static constexpr int LDB = DM, MID = -1;
    static __device__ __forceinline__ unsigned ka(int kt) { return (unsigned)kt * 128u; }
    static __device__ __forceinline__ unsigned kb(int kt) { return (unsigned)kt * 128u; }
    static __device__ __forceinline__ unsigned make_rc(int R, int C) { return GATHER ? ((unsigned)R | ((unsigned)(2 * C) << 8)) : (unsigned)(R * K + C) * 2u; }
    __device__ __forceinline__ void a_desc(const Unit& u, const unsigned (&rc)[2], unsigned (&ad)[2]) const {
        if (GATHER) {
#pragma unroll
            for (int i = 0; i < 2; ++i) {
                const int R = (int)(rc[i] & 0xFFu);
                const int2* lp = list + (size_t)u.e * LISTCAP + u.pm * ROWPAD + R;
                int t0 = lp[0].x, t1 = lp[HALF].x;
                t0 = R < u.nrows ? t0 : 0; t1 = (R + HALF) < u.nrows ? t1 : 0;
                ad[i] = (unsigned)t0 | ((unsigned)t1 << 16);
            }
            asm volatile("" : "+v"(ad[0]), "+v"(ad[1]));
        } else { ad[0] = rc[0] + (unsigned)u.row0 * (unsigned)(K * 2); ad[1] = rc[1] + (unsigned)u.row0 * (unsigned)(K * 2); }
    }
    static __device__ __forceinline__ unsigned aoff(unsigned ad, unsigned rc, int h) {
        return GATHER ? (((ad >> (16 * h)) & 0xFFFFu) * (unsigned)(K * 2) + (rc >> 8)) : (ad + (unsigned)h * (unsigned)(HALF * K * 2)); }
    __device__ __forceinline__ const char* b_base(const Unit& u) const { return Bt + ((size_t)u.e * (NPN * BM) + (size_t)u.pn * BM) * K * 2; }
};
struct EpiUp {
    static constexpr bool PERM = true;
    const float* bup; f16* act;
    __device__ __forceinline__ void operator()(const f32x4 (&acc)[2][2][4][2], const Unit& u, int wr, int wc, int fr, int fq) const {
        const int col0 = u.pn * HALF + wc * 32 + 8 * fq;
        const float* bg = bup + (size_t)u.e * 2048 + col0; const float* bu = bg + 1024;
        const f32x4 bg0 = *(const f32x4*)bg, bg1 = *(const f32x4*)(bg + 4), bu0 = *(const f32x4*)bu, bu1 = *(const f32x4*)(bu + 4);
#pragma unroll
        for (int ai = 0; ai < 2; ++ai)
#pragma unroll
            for (int m = 0; m < 4; ++m) {
                const size_t row = (size_t)(u.row0 + ai * HALF + wr * 64 + m * 16 + fr);
                float v[8];
#pragma unroll
                for (int n = 0; n < 2; ++n)
#pragma unroll
                    for (int j = 0; j < 4; ++j) {
                        const float hg = acc[ai][0][m][n][j] + (n == 0 ? bg0[j] : bg1[j]), hu = acc[ai][1][m][n][j] + (n == 0 ? bu0[j] : bu1[j]);
                        const float gate = fminf(hg, 7.0f), up = fminf(fmaxf(hu, -7.0f), 7.0f);
                        v[n * 4 + j] = gate * __builtin_amdgcn_rcpf(1.0f + __expf(-1.702f * gate)) * (up + 1.0f);
                    }
                u32x4 w; w.x = pk2(v[0], v[1]); w.y = pk2(v[2], v[3]); w.z = pk2(v[4], v[5]); w.w = pk2(v[6], v[7]);
                *(u32x4*)(act + row * DM + col0) = w;
            }
    }
};
struct EpiDown {
    static constexpr bool PERM = true;
    const float* bdn; const int2* list; f16* ys;
    __device__ __forceinline__ void operator()(const f32x4 (&acc)[2][2][4][2], const Unit& u, int wr, int wc, int fr, int fq) const {
        const int col0 = u.pn * BM + wc * 32 + 8 * fq;
        f32x4 bv[2][2];
#pragma unroll
        for (int bj = 0; bj < 2; ++bj)
#pragma unroll
            for (int n = 0; n < 2; ++n) bv[bj][n] = *(const f32x4*)(bdn + (size_t)u.e * DM + col0 + bj * HALF + 4 * n);
#pragma unroll
        for (int ai = 0; ai < 2; ++ai)
#pragma unroll
            for (int m = 0; m < 4; ++m) {
                const int lr = ai * HALF + wr * 64 + m * 16 + fr;
                float wgt = __int_as_float(list[(size_t)u.e * LISTCAP + u.pm * ROWPAD + lr].y); wgt = lr < u.nrows ? wgt : 0.f;
                f16* rowp = ys + (size_t)(u.row0 + lr) * DM + col0;
#pragma unroll
                for (int bj = 0; bj < 2; ++bj) {
                    const f32x4 v0 = (acc[ai][bj][m][0] + bv[bj][0]) * wgt, v1 = (acc[ai][bj][m][1] + bv[bj][1]) * wgt;
                    u32x4 w; w.x = pk2(v0[0], v0[1]); w.y = pk2(v0[2], v0[3]); w.z = pk2(v1[0], v1[1]); w.w = pk2(v1[2], v1[3]);
                    *(u32x4*)(rowp + bj * HALF) = w;
                }
            }
    }
};
__device__ __forceinline__ void phase_up(const Params& p, LAS unsigned char* lds, int wg, int nwg) {
    moe_prefix(p, lds);
    MoeSched<8, true> S{(const char*)(p.ws + WS_XH), (const char*)(p.ws + WS_WUP), (const int2*)(p.ws + WS_SMALL + SM_LIST), (LAS int*)(lds + MOE_MISC), (LAS int*)(lds + MOE_MISC) + 64, wg};
    EpiUp E{p.in[17], (f16*)(p.ws + WS_PROJ)};
    gemm_phase(lds, S, E);
}
__device__ __forceinline__ void phase_down(const Params& p, LAS unsigned char* lds, int wg, int nwg) {
    moe_prefix(p, lds);
    MoeSched<4, false> S{(const char*)(p.ws + WS_PROJ), (const char*)(p.ws + WS_WDN), (const int2*)(p.ws + WS_SMALL + SM_LIST), (LAS int*)(lds + MOE_MISC), (LAS int*)(lds + MOE_MISC) + 64, wg};
    EpiDown E{p.in[19], (const int2*)(p.ws + WS_SMALL + SM_LIST), (f16*)(p.ws + WS_YS)};
    gemm_phase(lds, S, E);
}
__device__ __forceinline__ float lambda_full(const float* lq1, const float* lk1, const float* lq2, const float* lk2, int lane) {
    float a = lq1[lane] * lk1[lane], c = lq2[lane] * lk2[lane];
    for (int o = 32; o >= 1; o >>= 1) { a += shx(a, o, lane); c += shx(c, o, lane); }
    return __expf(a) - __expf(c) + LAMBDA_INIT;
}
typedef short s16x4 __attribute__((ext_vector_type(4)));
__device__ __forceinline__ int crow(int r, int hi) { return (r & 3) + 8 * (r >> 2) + 4 * hi; }
__device__ __forceinline__ f16x4 vtr(const LAS unsigned char* p) { return __builtin_bit_cast(f16x4, __builtin_amdgcn_ds_read_tr16_b64_v4i16((LAS s16x4*)p)); }
#define MFMA32(a, b, c) __builtin_amdgcn_mfma_f32_32x32x16_f16(a, b, c, 0, 0, 0)
__device__ __forceinline__ float rowmax32(const f32x16& p0, const f32x16& p1) {
    float a = fmaxf(fmaxf(p0[0], p0[1]), p1[0]), b = fmaxf(fmaxf(p0[2], p0[3]), p1[1]); a = fmaxf(fmaxf(a, p1[2]), p1[3]);
#pragma unroll
    for (int r = 4; r < 16; r += 4) { a = fmaxf(fmaxf(a, p0[r]), p0[r + 1]); b = fmaxf(fmaxf(b, p0[r + 2]), p0[r + 3]); a = fmaxf(fmaxf(a, p1[r]), p1[r + 1]); b = fmaxf(fmaxf(b, p1[r + 2]), p1[r + 3]); }
    float m = fmaxf(a, b); auto rr = __builtin_amdgcn_permlane32_swap(__float_as_uint(m), __float_as_uint(m), false, false);
    return fmaxf(__uint_as_float(rr[0]), __uint_as_float(rr[1]));
}
__device__ __forceinline__ float half_sum(float v) { auto rr = __builtin_amdgcn_permlane32_swap(__float_as_uint(v), __float_as_uint(v), false, false); return __uint_as_float(rr[0]) + __uint_as_float(rr[1]); }

constexpr int AB_QSTR = 4160;
constexpr int AB_STG = 16384 + 4 * AB_QSTR;
constexpr int AB_STGS = 33280;
constexpr int AB_WSF = 131072;
constexpr float AB_THR = 8.0f;

constexpr int AA_HSTR = 2112;
constexpr int AA_BUF = 2 * AA_HSTR;
constexpr int AA_KBUF = 4096;
constexpr int AA_WAVE = 2 * AA_BUF + 2 * AA_KBUF + 128;
constexpr float AA_THR = 8.0f;
__device__ __forceinline__ float rowmax16(const f32x16& p0) {
    float a = fmaxf(fmaxf(p0[0], p0[1]), p0[2]), b = fmaxf(fmaxf(p0[3], p0[4]), p0[5]);
    a = fmaxf(fmaxf(a, p0[6]), p0[7]); b = fmaxf(fmaxf(b, p0[8]), p0[9]); a = fmaxf(fmaxf(a, p0[10]), p0[11]); b = fmaxf(fmaxf(b, p0[12]), p0[13]);
    a = fmaxf(fmaxf(a, p0[14]), p0[15]);
    float m = fmaxf(a, b); auto rr = __builtin_amdgcn_permlane32_swap(__float_as_uint(m), __float_as_uint(m), false, false);
    return fmaxf(__uint_as_float(rr[0]), __uint_as_float(rr[1]));
}
__device__ __forceinline__ void phase_attnA(const Params& p, LAS unsigned char* lds, int wg, int nwg) {
    const int tid = get_tid(lds);
    const int lane = tid & 63, r32 = lane & 31, hi = lane >> 5;
    const int wave = __builtin_amdgcn_readfirstlane(tid >> 6);
    const f16* proj = (const f16*)(p.ws + WS_PROJ);
    f16* oa = (f16*)(p.ws + WS_OAB);
    LAS unsigned char* wl = lds + wave * AA_WAVE;
    LAS float* wsf = (LAS float*)(wl + 2 * AA_BUF + 2 * AA_KBUF);
    const int kw0 = (lane >> 3) * 128 + (((lane & 7) ^ (((lane >> 3) >> 1) & 7)) << 4);
    const int kr0 = r32 * 128, kx = (hi ^ ((r32 >> 1) & 7)) << 4;
    const int vl = ((lane >> 4) & 1) * 32 + (lane & 3) * 8 + (4 * hi + ((lane & 15) >> 2)) * 64;
    const int vrow0 = lane >> 3, vch0 = lane & 7, vw0 = (vch0 >> 2) * AA_HSTR + vrow0 * 64 + (vch0 & 3) * 16;
#if defined(AA_TIMEQ)
#define AA_TQ0 const long long tq0_ = __builtin_readcyclecounter();
#define AA_TQ1 tacc += __builtin_readcyclecounter() - tq0_;
#else
#define AA_TQ0
#define AA_TQ1
#endif
    long long tacc = 0;
    constexpr int NTILE = 33;
#pragma unroll 1
    for (int ui = 0; ui < 4; ++ui) {
        const int j = wg >> 3, bh = ui * 16 + (wg & 7) * 2 + (j >> 4), r16 = j & 15;
        const int b = bh >> 3, h = bh & 7;
        const float sl2 = slope_of(h + (h >> 1)) * LOG2E;
        const f16* base = proj + (size_t)b * SEQ * INW;
        const int P0 = r16 + 512 * wave, qpos = P0 + 16 * r32;
        f16x8 qr[4];
#pragma unroll
        for (int d0 = 0; d0 < 4; ++d0) qr[d0] = *(const f16x8*)(base + (size_t)qpos * INW + C_QA + h * 64 + 16 * d0 + 8 * hi);
        f32x16 o[2];
        o[0] = (f32x16){0.f, 0.f, 0.f, 0.f, 0.f, 0.f, 0.f, 0.f, 0.f, 0.f, 0.f, 0.f, 0.f, 0.f, 0.f, 0.f}; o[1] = o[0];
        float m = -1.0e30f, l = 0.f;
        u32x4 kS[4], vA[4];
#define AA_PARAMS(tt, d, n) const int d = (tt) < 5 ? 16 : ((tt) < 13 ? 4 : 1), n = (tt) < 5 ? (tt) : ((tt) < 13 ? (tt) - 5 : (tt) - 13)
#define AA_LOADK(tt, KS) do { AA_PARAMS(tt, d_, n_); const int kb_ = P0 - 64 * d_ + 32 * d_ * n_; \
            _Pragma("unroll") for (int jj = 0; jj < 4; ++jj) { int kp = kb_ + d_ * (vrow0 + 8 * jj); kp = kp < 0 ? 0 : (kp > SEQ - 1 ? SEQ - 1 : kp); \
              KS[jj] = *(const u32x4*)(base + (size_t)kp * INW + C_KA + h * 64 + vch0 * 8); } } while (0)
#define AA_LOADV(tt, VS) do { AA_PARAMS(tt, d_, n_); const int kb_ = P0 - 64 * d_ + 32 * d_ * n_; \
            _Pragma("unroll") for (int jj = 0; jj < 4; ++jj) { int kp = kb_ + d_ * (vrow0 + 8 * jj); kp = kp < 0 ? 0 : (kp > SEQ - 1 ? SEQ - 1 : kp); \
              VS[jj] = *(const u32x4*)(base + (size_t)kp * INW + C_VA + h * 64 + vch0 * 8); } } while (0)
#define AA_STEP(tt) do { \
            AA_TQ0 asm volatile("s_waitcnt vmcnt(0)" ::: "memory"); AA_TQ1 \
            LAS unsigned char* vbuf = wl + ((tt) & 1) * AA_BUF; \
            LAS unsigned char* kbuf = wl + 2 * AA_BUF + ((tt) & 1) * AA_KBUF; \
            _Pragma("unroll") for (int jj = 0; jj < 4; ++jj) { *(LAS u32x4*)(vbuf + vw0 + jj * 512) = vA[jj]; *(LAS u32x4*)(kbuf + ((kw0 + jj * 1024) ^ ((jj & 1) << 6))) = kS[jj]; } \
            if ((tt) + 1 < NTILE) { AA_LOADK((tt) + 1, kS); AA_LOADV((tt) + 1, vA); } \
            AA_PARAMS(tt, d, n); \
            const int kb = P0 - 64 * d + 32 * d * n; \
            f32x16 s = (f32x16){0.f, 0.f, 0.f, 0.f, 0.f, 0.f, 0.f, 0.f, 0.f, 0.f, 0.f, 0.f, 0.f, 0.f, 0.f, 0.f}; \
            _Pragma("unroll") for (int d0 = 0; d0 < 4; ++d0) { const f16x8 kf = *(const LAS f16x8*)(kbuf + kr0 + ((d0 << 5) ^ kx)); s = MFMA32(kf, qr[d0], s); } \
            const float df = (float)d, basef = (float)(d * (32 * n + 4 * hi - 64) - 16 * r32), lim = 64.0f * df; \
            const bool need_range = (kb < 0) || (kb + 31 * d >= SEQ); \
            const float kpf0 = (float)(kb + 4 * hi * d); \
            if (need_range) { \
                _Pragma("unroll") for (int r = 0; r < 16; ++r) { \
                    const float c = (float)((r & 3) + 8 * (r >> 2)); \
                    const float ad = __builtin_fabsf(__builtin_fmaf(df, c, basef)), kpf = __builtin_fmaf(df, c, kpf0); \
                    const bool valid = (ad <= lim) && (kpf >= 0.0f) && (kpf < (float)SEQ); \
                    s[r] = valid ? __builtin_fmaf(-sl2, ad, s[r]) : -INFINITY; } \
            } else { \
                _Pragma("unroll") for (int r = 0; r < 16; ++r) { \
                    const float c = (float)((r & 3) + 8 * (r >> 2)); \
                    const float ad = __builtin_fabsf(__builtin_fmaf(df, c, basef)); \
                    s[r] = (ad <= lim) ? __builtin_fmaf(-sl2, ad, s[r]) : -INFINITY; } \
            } \
            const float mx = rowmax16(s); \
            if (__any(mx > m + AA_THR)) { \
                const float mn = fmaxf(m, mx), al = __builtin_amdgcn_exp2f(m - mn); \
                l *= al; m = mn; \
                if (hi == 0) wsf[r32] = al; \
                _Pragma("unroll") for (int r = 0; r < 16; ++r) { const float f = wsf[crow(r, hi)]; o[0][r] *= f; o[1][r] *= f; } } \
            float ls = 0.f; \
            _Pragma("unroll") for (int r = 0; r < 16; ++r) { s[r] = __builtin_amdgcn_exp2f(s[r] - m); ls += s[r]; } \
            l += ls; \
            u32x4 pw[2]; \
            pw[0] = (u32x4){pk2(s[0], s[1]), pk2(s[2], s[3]), pk2(s[4], s[5]), pk2(s[6], s[7])}; \
            pw[1] = (u32x4){pk2(s[8], s[9]), pk2(s[10], s[11]), pk2(s[12], s[13]), pk2(s[14], s[15])}; \
            const LAS unsigned char* vb = vbuf + vl; \
            _Pragma("unroll") for (int ks = 0; ks < 2; ++ks) _Pragma("unroll") for (int dh = 0; dh < 2; ++dh) { \
                    const f16x4 lo = vtr(vb + dh * AA_HSTR + ks * 1024), hh = vtr(vb + dh * AA_HSTR + ks * 1024 + 512); \
                    const f16x8 vf = (f16x8){lo[0], lo[1], lo[2], lo[3], hh[0], hh[1], hh[2], hh[3]}; \
                    o[dh] = MFMA32(__builtin_bit_cast(f16x8, pw[ks]), vf, o[dh]); } \
        } while (0)
        AA_LOADK(0, kS); AA_LOADV(0, vA);
#pragma unroll 1
        for (int tt = 0; tt < NTILE - 1; tt += 2) { AA_STEP(tt); AA_STEP(tt + 1); }
        AA_STEP(NTILE - 1);
#undef AA_STEP
#undef AA_LOADK
#undef AA_LOADV
#undef AA_PARAMS
        l = half_sum(l);
        if (hi == 0) wsf[r32] = 1.0f / l;
#pragma unroll
        for (int r = 0; r < 16; ++r) {
            const float il = wsf[crow(r, hi)];
            f16* op = oa + ((size_t)b * SEQ + P0 + 16 * crow(r, hi)) * 512 + h * 64 + r32;
            op[0] = (f16)(o[0][r] * il); op[32] = (f16)(o[1][r] * il);
        }
    }
#if defined(AA_TIMEQ)
    { const long long t0 = __builtin_readcyclecounter(); while (__builtin_readcyclecounter() - t0 < tacc) __builtin_amdgcn_s_sleep(1); }
#endif
    __syncthreads();
}
constexpr int B2_STGS = 33280, B2_WSF = 4 * B2_STGS, B2_CMX = B2_WSF + 1024;
constexpr float B2_THR = 8.0f, B2_SKIP_T = 40.0f;
constexpr size_t SM_KMAX = 15360, SM_KDONE = 15872, SM_AQ = 16000;

__device__ __forceinline__ void glds16_asm(const void* gsrc, unsigned lds_dst) {
    unsigned keep;
    asm volatile("s_mov_b32 %0, m0\n\ts_mov_b32 m0, %2\n\ts_nop 0\n\tglobal_load_lds_dwordx4 %1, off\n\ts_mov_b32 m0, %0" : "=&s"(keep) : "v"(gsrc), "s"(lds_dst) : "memory");
}
__device__ __forceinline__ void phase_knorm(const Params& p, LAS unsigned char* lds, int wg, int nwg) {
    const int tid = get_tid(lds);
    const int lane = tid & 63;
    const f16* proj = (const f16*)(p.ws + WS_PROJ);
    unsigned* kmax2 = (unsigned*)(p.ws + WS_SMALL + SM_KMAX);
    unsigned* kdone = (unsigned*)(p.ws + WS_SMALL + SM_KDONE);
    const int tpw = TOK / nwg;
    const int t = wg * tpw + (tid >> 2), part = tid & 3;
    float n2[2];
#pragma unroll
    for (int g = 0; g < 2; ++g) {
        const f16* kr = proj + (size_t)t * INW + C_KB + (part * 2 + g) * 64;
        float s = 0.f;
#pragma unroll
        for (int c = 0; c < 8; ++c) { const f16x8 v = *(const f16x8*)(kr + c * 8);
#pragma unroll
            for (int j = 0; j < 8; ++j) s = fmaf((float)v[j], (float)v[j], s); }
        n2[g] = s;
    }
#pragma unroll
    for (int g = 0; g < 2; ++g) { for (int o = 4; o <= 32; o <<= 1) n2[g] = fmaxf(n2[g], shx(n2[g], o, lane)); }
    if (lane < 4) {
        const int b = (wg * tpw) / SEQ;
#pragma unroll
        for (int g = 0; g < 2; ++g) { const int hm = part * 2 + g;
            __hip_atomic_fetch_max(kmax2 + b * 8 + hm, __float_as_uint(n2[g]), __ATOMIC_RELAXED, __HIP_MEMORY_SCOPE_AGENT); }
    }
    asm volatile("s_waitcnt vmcnt(0)" ::: "memory");
    __syncthreads();
    if (tid == 0) __hip_atomic_fetch_add(kdone, 1u, __ATOMIC_RELAXED, __HIP_MEMORY_SCOPE_AGENT);
}

__device__ __forceinline__ void dma8(const void* sbase, const unsigned (&vo)[8], unsigned ldk, unsigned ldv) {
    unsigned keep;
    asm volatile(
        "s_mov_b32 %0, m0\n\t"
        "s_mov_b32 m0, %10\n\ts_nop 0\n\tglobal_load_lds_dwordx4 %2, %1\n\t"
        "s_add_i32 m0, %10, 0x400\n\ts_nop 0\n\tglobal_load_lds_dwordx4 %3, %1\n\t"
        "s_add_i32 m0, %10, 0x4000\n\ts_nop 0\n\tglobal_load_lds_dwordx4 %4, %1\n\t"
        "s_add_i32 m0, %10, 0x4400\n\ts_nop 0\n\tglobal_load_lds_dwordx4 %5, %1\n\t"
        "s_mov_b32 m0, %11\n\ts_nop 0\n\tglobal_load_lds_dwordx4 %6, %1\n\t"
        "s_add_i32 m0, %11, 0x400\n\ts_nop 0\n\tglobal_load_lds_dwordx4 %7, %1\n\t"
        "s_add_i32 m0, %11, 0x800\n\ts_nop 0\n\tglobal_load_lds_dwordx4 %8, %1\n\t"
        "s_add_i32 m0, %11, 0xc00\n\ts_nop 0\n\tglobal_load_lds_dwordx4 %9, %1\n\t"
        "s_mov_b32 m0, %0"
        : "=&s"(keep)
        : "s"(sbase), "v"(vo[0]), "v"(vo[1]), "v"(vo[2]), "v"(vo[3]), "v"(vo[4]), "v"(vo[5]), "v"(vo[6]), "v"(vo[7]), "s"(ldk), "s"(ldv)
        : "memory", "scc");
}

constexpr int B3_VQ = 8256;
constexpr int B3_STG = 32768 + 4 * B3_VQ;
constexpr int B3_WSF = 2 * B3_STG, B3_CMX = B3_WSF + 1024;
__device__ __forceinline__ void phase_attnB3(const Params& p, LAS unsigned char* lds, int wg, int nwg) {
    const int tid = get_tid(lds);
    const int lane = tid & 63, r32 = lane & 31, hi = lane >> 5;
    const int wave = __builtin_amdgcn_readfirstlane(tid >> 6), grp = wave >> 2, qsub = wave & 3;
    const f16* proj = (const f16*)(p.ws + WS_PROJ);
    f16* ob = (f16*)(p.ws + WS_OAB) + (size_t)TOK * 512;
    const float lam = lambda_full(p.in[3], p.in[4], p.in[5], p.in[6], lane);
    const float* subg = p.in[7];
    LAS float* wsf = (LAS float*)(lds + B3_WSF) + wave * 32;
    LAS float* cmx = (LAS float*)(lds + B3_CMX);
    if (tid == 0) { unsigned* kdone = (unsigned*)(p.ws + WS_SMALL + SM_KDONE); unsigned sp = 0;
        while (__hip_atomic_load(kdone, __ATOMIC_RELAXED, __HIP_MEMORY_SCOPE_AGENT) < (unsigned)nwg) { __builtin_amdgcn_s_sleep(2); if (++sp > (1u << 22)) break; } }
    __syncthreads();
    const unsigned* kmax2 = (const unsigned*)(p.ws + WS_SMALL + SM_KMAX);
    const int kx4 = (hi ^ ((r32 >> 1) & 7)) << 4, krow = r32 * 128;
#define KOFF(d0) (krow + (((d0) << 5) ^ kx4))
    const int vl = ((lane >> 4) & 1) * 32 + (lane & 3) * 8 + (4 * hi + ((lane & 15) >> 2)) * 64;
    const unsigned vo_k = (unsigned)((16 * wave + (lane >> 3)) * INW + ((lane & 7) ^ (((16 * wave + (lane >> 3)) >> 1) & 7)) * 8) * 2u;
    const unsigned vo_v = (unsigned)((16 * ((4 * wave) & 7) + (lane >> 2)) * INW + (C_VB - C_KB) + (wave >> 1) * 32 + (lane & 3) * 8) * 2u;
    const unsigned ldk_w = (unsigned)wave * 2048u, ldv_w = 32768u + (unsigned)(wave >> 1) * B3_VQ + (unsigned)(wave & 1) * 4096u;
#ifndef TIMEQ
#define TIMEQ 0
#endif
    long long tacc = 0;
    const unsigned lds0 = (unsigned)(size_t)lds;
    const f32x16 z16 = (f32x16){0.f, 0.f, 0.f, 0.f, 0.f, 0.f, 0.f, 0.f, 0.f, 0.f, 0.f, 0.f, 0.f, 0.f, 0.f, 0.f};

    unsigned* aq = (unsigned*)(p.ws + WS_SMALL + SM_AQ) + (wg & 7);
#pragma unroll 1
    for (;;) {
        if (tid == 0) cmx[8] = __uint_as_float(__hip_atomic_fetch_add(aq, 1u, __ATOMIC_RELAXED, __HIP_MEMORY_SCOPE_AGENT));
        __syncthreads();
        const int u = __builtin_amdgcn_readfirstlane((int)__float_as_uint(cmx[8]));
        if (u >= 128) break;
        const int g8 = wg & 7, h = 3 - (u >> 5), ui = (h - (g8 & 3)) & 3, qb = u & 31;
        const int b = 2 * ui + (g8 >> 2);
        const float sl2 = slope_of(3 * h + 2) * LOG2E;
        const f16* base = proj + (size_t)b * SEQ * INW;
        const int dw = 2 * qb + (qsub >> 1);
        const int qrel = qsub * 32 + r32, qpos = qb * 128 + qrel;
        f16x8 qr[4], ks4[4];
        { int lu = lane; asm volatile("" : "+v"(lu));
          const unsigned qo = (unsigned)((qb * 128 + qsub * 32 + (lu & 31)) * INW + h * 128 + grp * 64 + 8 * (lu >> 5));
#pragma unroll
          for (int d0 = 0; d0 < 4; ++d0) { qr[d0] = *(const f16x8*)(base + qo + C_QB + 16 * d0); ks4[d0] = *(const f16x8*)(base + qo + C_KB + 16 * d0); } }
        float qn2 = 0.f, sii = 0.f;
#pragma unroll
        for (int d0 = 0; d0 < 4; ++d0)
#pragma unroll
            for (int j = 0; j < 8; ++j) { const float qv = (float)qr[d0][j]; qn2 = fmaf(qv, qv, qn2); sii = fmaf(qv, (float)ks4[d0][j], sii); }
        qn2 = half_sum(qn2); sii = half_sum(sii);
        const float kmx = sqrtf(__uint_as_float(__hip_atomic_load(kmax2 + b * 8 + h * 2 + grp, __ATOMIC_RELAXED, __HIP_MEMORY_SCOPE_AGENT)));
        float cb = sqrtf(qn2) * kmx * 1.001f - sii;
        for (int of = 16; of >= 1; of >>= 1) cb = fmaxf(cb, shx(cb, of, lane));
        if (lane == 0) cmx[wave] = cb;
        const float a64 = 64.0f * sl2; const f16 aH = (f16)a64, aL = (f16)(a64 - (float)aH), bH = (f16)sl2, bL = (f16)(sl2 - (float)bH);
        const f16 zz = (f16)0.f;
        const unsigned qx01 = hi == 0 ? __builtin_bit_cast(unsigned, (f16x2){aH, aL}) : 0u, qx23 = hi == 0 ? __builtin_bit_cast(unsigned, (f16x2){bH, bL}) : 0u;
        asm volatile("s_waitcnt lgkmcnt(0)" ::: "memory"); __syncthreads();
        float cmax = cmx[0];
#pragma unroll
        for (int w = 1; w < 8; ++w) cmax = fmaxf(cmax, cmx[w]);
        const float Dm = (cmax + B2_SKIP_T + 1.0f) / sl2;
        int t_lo, t_hi;
        { const float lo = ((float)(qb * 128 - 127) - Dm) * (1.0f / 128.0f), hh = ((float)(qb * 128 + 127) + Dm) * (1.0f / 128.0f);
          t_lo = lo <= 0.f ? 0 : (int)lo; t_hi = hh >= 31.f ? 31 : (int)hh; if (t_lo > qb) t_lo = qb; if (t_hi < qb) t_hi = qb; }
        t_lo = __builtin_amdgcn_readfirstlane(t_lo); t_hi = __builtin_amdgcn_readfirstlane(t_hi);
        const int nL = qb - t_lo, U = 1 + nL + (t_hi - qb);
#define B3_SEQ(pp) ((pp) == 0 ? qb : ((pp) - 1 < nL ? qb - 1 - ((pp) - 1) : qb + 1 + ((pp) - 1 - nL)))
        const f16* gk = base + C_KB + h * 128;
#define B3_ISSUE(pp) do { const int T2_ = B3_SEQ(pp); const unsigned st_ = lds0 + (unsigned)((pp) & 1) * (unsigned)B3_STG; \
            const unsigned vo_[8] = {vo_k, (vo_k + 8u * INW * 2u) ^ 64u, vo_k + 128u, ((vo_k + 8u * INW * 2u) ^ 64u) + 128u,     \
                 vo_v, vo_v + 16u * INW * 2u, vo_v + 32u * INW * 2u, vo_v + 48u * INW * 2u}; \
            dma8(gk + (size_t)T2_ * 128 * INW, vo_, (unsigned)__builtin_amdgcn_readfirstlane(st_ + ldk_w), (unsigned)__builtin_amdgcn_readfirstlane(st_ + ldv_w)); } while (0)
        B3_ISSUE(0);
        f32x16 o[4]; o[0] = z16; o[1] = z16; o[2] = z16; o[3] = z16;
        float m = sii, l = 0.f;
        asm volatile("s_waitcnt vmcnt(0) lgkmcnt(0)\n\ts_barrier" ::: "memory");
#define SBAR() __builtin_amdgcn_sched_barrier(0)
#define PIN(x) asm volatile("" : "+v"(x))
#define B3_QK(S0, S1, T, JJ) do { \
            const LAS unsigned char* kbse = st + grp * 16384 + (JJ) * 8192; \
            const int side = (T) <= dw ? 0 : 1; \
            const float sq = sl2 * (float)qrel; \
            const float mr = side == 0 ? -(m + sq) : -(m - sq); \
            const f16 mH = (f16)mr, mL = (f16)(mr - (float)mH), one = (f16)1.0f; \
            const f16 trel = (f16)(float)((T) - 2 * qb), l0 = (f16)(float)r32, l1 = (f16)(float)(32 + r32); \
            const f16x8 kx0 = hi == 0 ? (f16x8){trel, trel, l0, l0, one, one, zz, zz} : (f16x8){zz, zz, zz, zz, zz, zz, zz, zz}; \
            const f16x8 kx1 = hi == 0 ? (f16x8){trel, trel, l1, l1, one, one, zz, zz} : (f16x8){zz, zz, zz, zz, zz, zz, zz, zz}; \
            u32x4 qxb = (u32x4){qx01, qx23, 0u, 0u}; if (side) { qxb.x ^= 0x80008000u; qxb.y ^= 0x80008000u; } \
            if (hi == 0) qxb.z = __builtin_bit_cast(unsigned, (f16x2){mH, mL}); \
            const f16x8 qx = __builtin_bit_cast(f16x8, qxb); \
            S0 = MFMA32(kx0, qx, z16); S1 = MFMA32(kx1, qx, z16); \
            _Pragma("unroll") for (int d0 = 0; d0 < 4; ++d0) { \
                const f16x8 a0 = *(const LAS f16x8*)(kbse + KOFF(d0)), a1 = *(const LAS f16x8*)(kbse + 4096 + KOFF(d0)); \
                S0 = MFMA32(a0, qr[d0], S0); S1 = MFMA32(a1, qr[d0], S1); } } while (0)
#define B3_FIX(S0, S1, T) do { if ((T) == dw) { const float dq0 = (float)(64 * ((T) - 2 * qb) + 4 * hi - qrel), m2 = -2.0f * sl2; \
            _Pragma("unroll") for (int r = 0; r < 16; ++r) { const float c = (float)((r & 3) + 8 * (r >> 2)); \
                S0[r] = __builtin_fmaf(m2, fmaxf(dq0 + c, 0.f), S0[r]); S1[r] = __builtin_fmaf(m2, fmaxf(dq0 + 32.0f + c, 0.f), S1[r]); } } } while (0)
#define B3_EXP(S0, S1, PW) do { float ls = 0.f; \
            _Pragma("unroll") for (int r = 0; r < 16; ++r) { S0[r] = __builtin_amdgcn_exp2f(S0[r]); S1[r] = __builtin_amdgcn_exp2f(S1[r]); ls += S0[r] + S1[r]; } \
            l += ls; \
            PW[0] = (u32x4){pk2(S0[0], S0[1]), pk2(S0[2], S0[3]), pk2(S0[4], S0[5]), pk2(S0[6], S0[7])}; \
            PW[1] = (u32x4){pk2(S0[8], S0[9]), pk2(S0[10], S0[11]), pk2(S0[12], S0[13]), pk2(S0[14], S0[15])}; \
            PW[2] = (u32x4){pk2(S1[0], S1[1]), pk2(S1[2], S1[3]), pk2(S1[4], S1[5]), pk2(S1[6], S1[7])}; \
            PW[3] = (u32x4){pk2(S1[8], S1[9]), pk2(S1[10], S1[11]), pk2(S1[12], S1[13]), pk2(S1[14], S1[15])}; } while (0)
#define B3_PV(PW, JJ) do { const LAS unsigned char* vb = st + 32768 + (JJ) * 4096 + vl; \
            _Pragma("unroll") for (int ks = 0; ks < 4; ++ks) { _Pragma("unroll") for (int dq = 0; dq < 4; ++dq) { \
                const f16x4 lo = vtr(vb + dq * B3_VQ + ks * 1024), hh = vtr(vb + dq * B3_VQ + ks * 1024 + 512); \
                const f16x8 vf = (f16x8){lo[0], lo[1], lo[2], lo[3], hh[0], hh[1], hh[2], hh[3]}; \
                o[dq] = MFMA32(__builtin_bit_cast(f16x8, PW[ks]), vf, o[dq]); } } } while (0)
#pragma unroll 1
        for (int pp = 0; pp < U; ++pp) {
            if (pp + 1 < U) B3_ISSUE(pp + 1);
#ifdef B3_SKEW
            if (grp) __builtin_amdgcn_s_sleep(B3_SKEW);
#endif
            const LAS unsigned char* st = lds + (pp & 1) * B3_STG;
            const int T2 = B3_SEQ(pp), TA = 2 * T2, TB = 2 * T2 + 1;
            f32x16 a0s, a1s, b0s, b1s; u32x4 pwA[4], pwB[4];
            B3_QK(a0s, a1s, TA, 0);
            __builtin_amdgcn_sched_group_barrier(0x100, 4, 0); __builtin_amdgcn_sched_group_barrier(0x8, 2, 0);
            __builtin_amdgcn_sched_group_barrier(0x8, 2, 0); __builtin_amdgcn_sched_group_barrier(0x100, 2, 0);
            __builtin_amdgcn_sched_group_barrier(0x8, 2, 0); __builtin_amdgcn_sched_group_barrier(0x100, 2, 0);
            __builtin_amdgcn_sched_group_barrier(0x8, 4, 0);
            B3_FIX(a0s, a1s, TA);
            { const float mx = rowmax32(a0s, a1s);
              if (__any(mx > B2_THR)) {
                const float dl = fmaxf(mx, 0.f), al = __builtin_amdgcn_exp2f(-dl);
                m += dl; l *= al;
                if (hi == 0) wsf[r32] = al;
#pragma unroll
                for (int r = 0; r < 16; ++r) { const float f = wsf[crow(r, hi)];
#pragma unroll
                    for (int i = 0; i < 4; ++i) o[i][r] *= f;
                    a0s[r] -= dl; a1s[r] -= dl; }
              } }
            {
                const LAS unsigned char* kbse = st + grp * 16384 + 8192;
                const int side = TB <= dw ? 0 : 1;
                const float sq = sl2 * (float)qrel;
                const float mr = side == 0 ? -(m + sq) : -(m - sq);
                const f16 mH = (f16)mr, mL = (f16)(mr - (float)mH), one = (f16)1.0f;
                const f16 trel = (f16)(float)(TB - 2 * qb), l0 = (f16)(float)r32, l1 = (f16)(float)(32 + r32);
                const f16x8 kx0 = hi == 0 ? (f16x8){trel, trel, l0, l0, one, one, zz, zz} : (f16x8){zz, zz, zz, zz, zz, zz, zz, zz};
                const f16x8 kx1 = hi == 0 ? (f16x8){trel, trel, l1, l1, one, one, zz, zz} : (f16x8){zz, zz, zz, zz, zz, zz, zz, zz};
                u32x4 qxb = (u32x4){qx01, qx23, 0u, 0u}; if (side) { qxb.x ^= 0x80008000u; qxb.y ^= 0x80008000u; }
                if (hi == 0) qxb.z = __builtin_bit_cast(unsigned, (f16x2){mH, mL});
                const f16x8 qx = __builtin_bit_cast(f16x8, qxb);
                f16x8 kf0 = *(const LAS f16x8*)(kbse + KOFF(0)), kf1 = *(const LAS f16x8*)(kbse + 4096 + KOFF(0));
                f16x8 kf2 = *(const LAS f16x8*)(kbse + KOFF(1)), kf3 = *(const LAS f16x8*)(kbse + 4096 + KOFF(1));
                float ls = 0.f;
                SBAR();
#define EX3(S, i0) do { S[i0] = __builtin_amdgcn_exp2f(S[i0]); S[i0 + 1] = __builtin_amdgcn_exp2f(S[i0 + 1]); S[i0 + 2] = __builtin_amdgcn_exp2f(S[i0 + 2]); ls += S[i0]; ls += S[i0 + 1]; ls += S[i0 + 2]; PIN(ls); } while (0)
#define EX4(S, i0) do { S[i0] = __builtin_amdgcn_exp2f(S[i0]); S[i0 + 1] = __builtin_amdgcn_exp2f(S[i0 + 1]); S[i0 + 2] = __builtin_amdgcn_exp2f(S[i0 + 2]); S[i0 + 3] = __builtin_amdgcn_exp2f(S[i0 + 3]); ls += S[i0]; ls += S[i0 + 1]; ls += S[i0 + 2]; ls += S[i0 + 3]; PIN(ls); } while (0)
                b0s = MFMA32(kx0, qx, z16); EX3(a0s, 0); SBAR();
                b1s = MFMA32(kx1, qx, z16); EX3(a0s, 3); SBAR();
                b0s = MFMA32(kf0, qr[0], b0s); kf0 = *(const LAS f16x8*)(kbse + KOFF(2)); EX3(a0s, 6); SBAR();
                b1s = MFMA32(kf1, qr[0], b1s); kf1 = *(const LAS f16x8*)(kbse + 4096 + KOFF(2)); EX3(a0s, 9); SBAR();
                b0s = MFMA32(kf2, qr[1], b0s); kf2 = *(const LAS f16x8*)(kbse + KOFF(3)); EX4(a0s, 12); SBAR();
                b1s = MFMA32(kf3, qr[1], b1s); kf3 = *(const LAS f16x8*)(kbse + 4096 + KOFF(3)); EX4(a1s, 0); SBAR();
                b0s = MFMA32(kf0, qr[2], b0s); EX4(a1s, 4); SBAR();
                b1s = MFMA32(kf1, qr[2], b1s); EX4(a1s, 8); SBAR();
                b0s = MFMA32(kf2, qr[3], b0s); EX4(a1s, 12);
                pwA[0] = (u32x4){pk2(a0s[0], a0s[1]), pk2(a0s[2], a0s[3]), pk2(a0s[4], a0s[5]), pk2(a0s[6], a0s[7])};
                pwA[1] = (u32x4){pk2(a0s[8], a0s[9]), pk2(a0s[10], a0s[11]), pk2(a0s[12], a0s[13]), pk2(a0s[14], a0s[15])};
                SBAR();
                b1s = MFMA32(kf3, qr[3], b1s);
                pwA[2] = (u32x4){pk2(a1s[0], a1s[1]), pk2(a1s[2], a1s[3]), pk2(a1s[4], a1s[5]), pk2(a1s[6], a1s[7])};
                pwA[3] = (u32x4){pk2(a1s[8], a1s[9]), pk2(a1s[10], a1s[11]), pk2(a1s[12], a1s[13]), pk2(a1s[14], a1s[15])};
                SBAR();
                l += ls;
            }
            B3_FIX(b0s, b1s, TB);
            { const float mx = rowmax32(b0s, b1s);
              if (__any(mx > B2_THR)) {
                const float dl = fmaxf(mx, 0.f), al = __builtin_amdgcn_exp2f(-dl);
                m += dl; l *= al;
                if (hi == 0) wsf[r32] = al;
#pragma unroll
                for (int r = 0; r < 16; ++r) { const float f = wsf[crow(r, hi)];
#pragma unroll
                    for (int i = 0; i < 4; ++i) o[i][r] *= f;
                    b0s[r] -= dl; b1s[r] -= dl; a0s[r] *= al; a1s[r] *= al; }
                pwA[0] = (u32x4){pk2(a0s[0], a0s[1]), pk2(a0s[2], a0s[3]), pk2(a0s[4], a0s[5]), pk2(a0s[6], a0s[7])};
                pwA[1] = (u32x4){pk2(a0s[8], a0s[9]), pk2(a0s[10], a0s[11]), pk2(a0s[12], a0s[13]), pk2(a0s[14], a0s[15])};
                pwA[2] = (u32x4){pk2(a1s[0], a1s[1]), pk2(a1s[2], a1s[3]), pk2(a1s[4], a1s[5]), pk2(a1s[6], a1s[7])};
                pwA[3] = (u32x4){pk2(a1s[8], a1s[9]), pk2(a1s[10], a1s[11]), pk2(a1s[12], a1s[13]), pk2(a1s[14], a1s[15])};
              } }
            {
                const LAS unsigned char* vb = st + 32768 + vl;
                float ls = 0.f;
#define VFR_(ks, dq) do { const f16x4 lo_ = vtr(vb + (dq) * B3_VQ + (ks) * 1024), hh_ = vtr(vb + (dq) * B3_VQ + (ks) * 1024 + 512); vnx = (f16x8){lo_[0], lo_[1], lo_[2], lo_[3], hh_[0], hh_[1], hh_[2], hh_[3]}; } while (0)
#define EX2(S, i0) do { S[i0] = __builtin_amdgcn_exp2f(S[i0]); S[i0 + 1] = __builtin_amdgcn_exp2f(S[i0 + 1]); ls += S[i0]; ls += S[i0 + 1]; PIN(ls); } while (0)
                f16x8 vcu, vnx;
                VFR_(0, 0); vcu = vnx; SBAR();
#define PVG(ks, dq, nks, ndq, S, i0) do { VFR_(nks, ndq); o[dq] = MFMA32(__builtin_bit_cast(f16x8, pwA[ks]), vcu, o[dq]); EX2(S, i0); vcu = vnx; SBAR(); } while (0)
                PVG(0, 0, 0, 1, b0s, 0);  PVG(0, 1, 0, 2, b0s, 2);  PVG(0, 2, 0, 3, b0s, 4);  PVG(0, 3, 1, 0, b0s, 6);
                PVG(1, 0, 1, 1, b0s, 8);  PVG(1, 1, 1, 2, b0s, 10); PVG(1, 2, 1, 3, b0s, 12); PVG(1, 3, 2, 0, b0s, 14);
                PVG(2, 0, 2, 1, b1s, 0);  PVG(2, 1, 2, 2, b1s, 2);  PVG(2, 2, 2, 3, b1s, 4);  PVG(2, 3, 3, 0, b1s, 6);
                PVG(3, 0, 3, 1, b1s, 8);  PVG(3, 1, 3, 2, b1s, 10); PVG(3, 2, 3, 3, b1s, 12);
                o[3] = MFMA32(__builtin_bit_cast(f16x8, pwA[3]), vcu, o[3]); EX2(b1s, 14); SBAR();
#undef PVG
#undef VFR_
                l += ls;
                pwB[0] = (u32x4){pk2(b0s[0], b0s[1]), pk2(b0s[2], b0s[3]), pk2(b0s[4], b0s[5]), pk2(b0s[6], b0s[7])};
                pwB[1] = (u32x4){pk2(b0s[8], b0s[9]), pk2(b0s[10], b0s[11]), pk2(b0s[12], b0s[13]), pk2(b0s[14], b0s[15])};
                pwB[2] = (u32x4){pk2(b1s[0], b1s[1]), pk2(b1s[2], b1s[3]), pk2(b1s[4], b1s[5]), pk2(b1s[6], b1s[7])};
                pwB[3] = (u32x4){pk2(b1s[8], b1s[9]), pk2(b1s[10], b1s[11]), pk2(b1s[12], b1s[13]), pk2(b1s[14], b1s[15])};
            }
            B3_PV(pwB, 1);
            __builtin_amdgcn_sched_group_barrier(0x100, 4, 3);
#pragma unroll
            for (int i = 0; i < 14; ++i) { __builtin_amdgcn_sched_group_barrier(0x8, 1, 3); __builtin_amdgcn_sched_group_barrier(0x100, 2, 3); }
            __builtin_amdgcn_sched_group_barrier(0x8, 2, 3);
#if TIMEQ == 1
            { const long long tq0 = __builtin_readcyclecounter(); asm volatile("s_waitcnt vmcnt(0)" ::: "memory"); tacc += __builtin_readcyclecounter() - tq0; }
#endif
#if TIMEQ == 2
            asm volatile("s_waitcnt vmcnt(0)" ::: "memory");
            const long long tq0 = __builtin_readcyclecounter();
#endif
            asm volatile("s_waitcnt vmcnt(0) lgkmcnt(0)\n\ts_barrier" ::: "memory");
#if TIMEQ == 2
            tacc += __builtin_readcyclecounter() - tq0;
#endif
        }
#undef B3_QK
#undef SBAR
#undef PIN
#undef EX2
#undef EX3
#undef EX4
#undef B3_FIX
#undef B3_EXP
#undef B3_PV
#undef B3_ISSUE
#undef B3_SEQ
        l = half_sum(l);
        if (hi == 0) wsf[r32] = 1.0f / l;
        LAS float* ost = (LAS float*)lds + (size_t)grp * 128 * 128;
#pragma unroll
        for (int r = 0; r < 16; ++r) { const float il = wsf[crow(r, hi)]; const int row = qsub * 32 + crow(r, hi);
#pragma unroll
            for (int i = 0; i < 4; ++i) ost[row * 128 + i * 32 + r32] = o[i][r] * il; }
        __syncthreads();
        {
            const LAS float* o1 = (const LAS float*)lds; const LAS float* o2 = o1 + 128 * 128;
            int l2 = lane; asm volatile("" : "+v"(l2));
            const float g0s = subg[l2], g1s = subg[64 + l2];
            for (int rr = 0; rr < 16; ++rr) {
                const int row = wave * 16 + rr;
                const float v0 = o1[row * 128 + l2] - lam * o2[row * 128 + l2], v1 = o1[row * 128 + 64 + l2] - lam * o2[row * 128 + 64 + l2];
                float ss = v0 * v0 + v1 * v1;
                for (int of = 32; of >= 1; of >>= 1) ss += shx(ss, of, lane);
                const float rs = rsqrtf(ss * (1.0f / 128.0f) + 1e-5f) * (1.0f - LAMBDA_INIT);
                f16* op = ob + ((size_t)b * SEQ + qb * 128 + row) * 512 + h * 128;
                op[l2] = (f16)(v0 * rs * g0s); op[64 + l2] = (f16)(v1 * rs * g1s);
            }
        }
        __syncthreads();
    }
#if TIMEQ
    { const long long t0 = __builtin_readcyclecounter(); while (__builtin_readcyclecounter() - t0 < tacc) __builtin_amdgcn_s_sleep(1); }
    __syncthreads();
#endif
#undef KOFF
}
#define XB_TMO      128
#define XB_XCNT(j)  (256  + 64 * (j))
#define XB_XSUB(j)  (1280 + 64 * (j))
#define XB_XGEN(j)  (2304 + 64 * (j))
#define XB_TOP      3328
#define XB_TOPGEN   3392
#define XCD_BAR_WORDS 3456
#define XB_SPIN_CAP (1u << 20)
__device__ __forceinline__ unsigned xb_ld(unsigned* p)              { return __hip_atomic_load(p, __ATOMIC_RELAXED, __HIP_MEMORY_SCOPE_AGENT); }
__device__ __forceinline__ unsigned xb_add(unsigned* p, unsigned v) { return __hip_atomic_fetch_add(p, v, __ATOMIC_RELAXED, __HIP_MEMORY_SCOPE_AGENT); }
__device__ __forceinline__ unsigned xb_xcc_id() { return (unsigned)__builtin_amdgcn_s_getreg((3 << 11) | 20) & 0xFu; }
#define XB_SPIN(cond, bar) do { unsigned _sp = 0; while (cond) { __builtin_amdgcn_s_sleep(1); \
    if ((++_sp & 255u) == 0u) { if (xb_ld(&(bar)[XB_TMO])) break; if (_sp > XB_SPIN_CAP) { atomicAdd(&(bar)[XB_TMO], 1u); break; } } } } while (0)
__device__ __forceinline__ void xcd_barrier_post(unsigned* bar, int tid) { if (tid == 0) (void)xb_add(&bar[XB_XCNT(xb_xcc_id())], 1u); }
__device__ __forceinline__ void xcd_barrier_complete(unsigned* bar, unsigned x, unsigned& nloc, unsigned& nx) {
    const unsigned G = gridDim.x;
    unsigned sum, cnt, mine, sp = 0u;
    for (;;) {
        sum = 0u; cnt = 0u; mine = 0u;
#pragma unroll
        for (unsigned j = 0; j < 16; ++j) { const unsigned c = xb_ld(&bar[XB_XCNT(j)]); sum += c; cnt += (c > 0u) ? 1u : 0u; mine = (j == x) ? c : mine; }
        if (sum == G) break;
        __builtin_amdgcn_s_sleep(1);
        if ((++sp & 255u) == 0u) { if (xb_ld(&bar[XB_TMO])) break; if (sp > XB_SPIN_CAP) { atomicAdd(&bar[XB_TMO], 1u); break; } }
    }
    nloc = mine > 0u ? mine : 1u; nx = cnt > 0u ? cnt : 1u;
}
__device__ __forceinline__ void xcd_barrier(unsigned* bar, volatile LAS unsigned* st, LAS unsigned char* lds) {
    const int tid = get_tid(lds);
    asm volatile("s_waitcnt vmcnt(0)" ::: "memory");
    __syncthreads();
    if (tid == 0) {
        const unsigned x = xb_xcc_id();
        __builtin_amdgcn_s_waitcnt(0);
        unsigned nloc = st[0], nx = st[1];
        if (nloc == 0u) { xcd_barrier_complete(bar, x, nloc, nx); st[0] = nloc; st[1] = nx; }
        const unsigned old = xb_add(&bar[XB_XSUB(x)], 1u);
        const unsigned gen = old / nloc;
        if (old + 1u == (gen + 1u) * nloc) {
            __builtin_amdgcn_fence(__ATOMIC_RELEASE, "agent");
            asm volatile("s_waitcnt vmcnt(0)" ::: "memory");
            const unsigned og = xb_add(&bar[XB_TOP], 1u);
            const unsigned tg = og / nx;
            if (og + 1u == (tg + 1u) * nx) xb_add(&bar[XB_TOPGEN], 1u);
            else XB_SPIN(xb_ld(&bar[XB_TOPGEN]) == tg, bar);
            __builtin_amdgcn_fence(__ATOMIC_ACQUIRE, "agent");
            xb_add(&bar[XB_XGEN(x)], 1u);
            asm volatile("s_waitcnt vmcnt(0)" ::: "memory");
        } else {
            XB_SPIN(xb_ld(&bar[XB_XGEN(x)]) == gen, bar);
            __builtin_amdgcn_fence(__ATOMIC_ACQUIRE, "agent");
            asm volatile("s_waitcnt vmcnt(0)" ::: "memory");
        }
    }
    __syncthreads();
}
constexpr int LDS_BARST = LDS_TOTAL - 16;
constexpr size_t SM_BAR = 1024;
__global__ void __launch_bounds__(NTHR, 2) k_mega(Params p) {
    extern __shared__ __attribute__((aligned(16))) unsigned char smem[];
    LAS unsigned char* lds = (LAS unsigned char*)smem;
    const int wg = blockIdx.x, nwg = gridDim.x;
    volatile LAS unsigned* st = (volatile LAS unsigned*)(lds + LDS_BARST);
    { const unsigned hw = (unsigned)__builtin_amdgcn_s_getreg((5 << 11) | 4) & 63u; if ((threadIdx.x & 63) == 0) ((LAS int*)(lds + LDS_WTAB))[hw] = (int)(threadIdx.x >> 6); }
    if (threadIdx.x == 0) { st[0] = 0u; st[1] = 0u; put_params(p, lds); }
    __syncthreads();
    xcd_barrier_post((unsigned*)(get_params(lds).ws + WS_SMALL + SM_BAR), get_tid(lds));
#define GRID_SYNC() xcd_barrier((unsigned*)(get_params(lds).ws + WS_SMALL + SM_BAR), st, lds)
#ifndef TIMEPH
#define TIMEPH 0
#endif
    long long tph = 0;
#define TPH2(n, call) do { if (TIMEPH == (n) || TIMEPH == 11) { const long long t0_ = __builtin_readcyclecounter(); call; tph += __builtin_readcyclecounter() - t0_; } else { call; } } while (0)
#define TPH(n, call) do { if (TIMEPH == (n)) { const long long t0_ = __builtin_readcyclecounter(); call; tph += __builtin_readcyclecounter() - t0_; } else { call; } } while (0)
    TPH(1, phase_prep(get_params(lds), lds, wg, nwg));      TPH2(21, GRID_SYNC());
    TPH(2, phase_inproj(get_params(lds), lds, wg, nwg));    TPH2(22, GRID_SYNC());
    TPH(10, phase_knorm(get_params(lds), lds, wg, nwg));
    TPH(3, phase_attnA(get_params(lds), lds, wg, nwg));
    TPH(4, phase_attnB3(get_params(lds), lds, wg, nwg));
    TPH2(23, GRID_SYNC());
#ifdef EXTRA_SYNC
    GRID_SYNC(); GRID_SYNC(); GRID_SYNC(); GRID_SYNC();
#endif
    TPH(5, phase_merge(get_params(lds), lds, wg, nwg));     TPH2(24, GRID_SYNC());
    TPH(6, phase_outproj(get_params(lds), lds, wg, nwg));   TPH2(25, GRID_SYNC());
    TPH(12, phase_router(get_params(lds), lds, wg, nwg));   TPH2(26, GRID_SYNC());
    TPH(7, phase_up(get_params(lds), lds, wg, nwg));        TPH2(27, GRID_SYNC());
    TPH(8, phase_down(get_params(lds), lds, wg, nwg));      TPH2(28, GRID_SYNC());
    TPH(9, phase_final(get_params(lds), lds, wg, nwg));
    if (TIMEPH) { const long long t0_ = __builtin_readcyclecounter(); while (__builtin_readcyclecounter() - t0_ < tph) __builtin_amdgcn_s_sleep(1); }
#undef TPH
#undef GRID_SYNC
}
}

extern "C" void kernel_launch(void* const* d_in, const int* in_sizes, int n_in, void* d_out, int out_size, void* d_ws, size_t ws_size,
                              hipStream_t stream) {
    static int grid_blocks = 0;
    if (grid_blocks == 0) {
        int dev = 0, cus = 0, per_cu = 0;
        if (hipGetDevice(&dev) != hipSuccess || hipDeviceGetAttribute(&cus, hipDeviceAttributeMultiprocessorCount, dev) != hipSuccess) { fprintf(stderr, "kernel_launch: device query failed\n"); grid_blocks = -1; return; }
        if (hipFuncSetAttribute((const void*)k_mega, hipFuncAttributeMaxDynamicSharedMemorySize, LDS_TOTAL) != hipSuccess) { fprintf(stderr, "kernel_launch: hipFuncSetAttribute failed\n"); grid_blocks = -1; return; }
        if (hipOccupancyMaxActiveBlocksPerMultiprocessor(&per_cu, (const void*)k_mega, NTHR, LDS_TOTAL) != hipSuccess || per_cu < 1) { fprintf(stderr, "kernel_launch: occupancy query says %d blocks/CU\n", per_cu); grid_blocks = -1; return; }
        grid_blocks = cus * per_cu;
        if (grid_blocks > NWG) grid_blocks = NWG;
        if (grid_blocks != NWG) { fprintf(stderr, "kernel_launch: need %d co-resident workgroups, device offers %d\n", NWG, grid_blocks); grid_blocks = -1; return; }
        if (ws_size < WS_END) { fprintf(stderr, "kernel_launch: workspace too small (%zu < %zu)\n", ws_size, (size_t)WS_END); grid_blocks = -1; return; }
    }
    if (grid_blocks < 0) return;
    Params p{};
    for (int i = 0; i < 22; ++i) p.in[i] = (const float*)d_in[i];
    p.out = (float*)d_out; p.ws = (unsigned char*)d_ws;
    if (hipMemsetAsync((char*)d_ws + WS_SMALL, 0, 16384, stream) != hipSuccess) { fprintf(stderr, "kernel_launch: memset failed\n"); return; }
    void* args[] = {&p};
    hipError_t e = hipLaunchCooperativeKernel((const void*)k_mega, dim3(grid_blocks), dim3(NTHR), args, LDS_TOTAL, stream);
    if (e != hipSuccess) fprintf(stderr, "kernel_launch: cooperative launch failed: %s (grid %d)\n", hipGetErrorString(e), grid_blocks);
}
```

```cpp
#include <hip/hip_runtime.h>
#include <hip/hip_cooperative_groups.h>
#include <stdint.h>
#include <stdio.h>

namespace {
constexpr int NB = 8, SEQ = 4096, DM = 1024, TOK = NB * SEQ;
constexpr int INW = 5120;
constexpr int C_QA = 0, C_KA = 512, C_VA = 1024, C_QB = 1536, C_KB = 2048, C_VB = 2560, C_GA = 3072, C_GB = 4096;
constexpr int NEXP = 32, TOPK = 4, NASG = TOK * TOPK;
constexpr float ALPHA = 1.189207115002721f;
constexpr float LAMBDA_INIT = 0.2f;
constexpr float LOG2E = 1.4426950408889634f;
constexpr size_t MiB = 1048576;

__device__ __forceinline__ float sigmoidf_(float x) { return 1.0f / (1.0f + __expf(-x)); }
__device__ __forceinline__ float slope_of(int idx) { return exp2f(-8.0f * (float)(idx + 1) / 12.0f); }
#define LAS __attribute__((address_space(3)))
typedef _Float16 f16;
typedef _Float16 f16x8 __attribute__((ext_vector_type(8)));
typedef _Float16 f16x4 __attribute__((ext_vector_type(4)));
typedef _Float16 f16x2 __attribute__((ext_vector_type(2)));
typedef float f32x4 __attribute__((ext_vector_type(4)));
typedef float f32x16 __attribute__((ext_vector_type(16)));
typedef unsigned u32x4 __attribute__((ext_vector_type(4)));
typedef unsigned u32x2 __attribute__((ext_vector_type(2)));

constexpr int NTHR = 512, NWG = 256;
constexpr int BM = 256, BK = 64, HALF = 128, HTB = HALF * BK * 2, STAGE_BYTES = 8 * HTB;
constexpr int LDS_MISC = STAGE_BYTES;
constexpr int LDS_TOTAL = 155648;
constexpr float QSCALE = 0.125f * 1.4426950408889634f;
constexpr int ROWPAD = 256;
constexpr int MOE_ROWS = NASG + NEXP * ROWPAD;
constexpr int LISTCAP = TOK;


constexpr int LDS_WTAB = LDS_TOTAL - 16 - 256;
__device__ __forceinline__ int get_tid(LAS unsigned char* lds) {
    const unsigned hw = (unsigned)__builtin_amdgcn_s_getreg((5 << 11) | 4) & 63u;
    const int wave = __builtin_amdgcn_readfirstlane(((LAS int*)(lds + LDS_WTAB))[hw]);
    int lane; asm volatile("v_mbcnt_lo_u32_b32 %0, -1, 0\n\tv_mbcnt_hi_u32_b32 %0, -1, %0" : "=v"(lane));
    int t = wave * 64 + lane; asm volatile("" : "+v"(t));
    return t;
}
__device__ __forceinline__ float shx(float v, int mask, int lane) { return __int_as_float(__builtin_amdgcn_ds_bpermute((lane ^ mask) << 2, __float_as_int(v))); }
__device__ __forceinline__ unsigned pk2(float a, float b) { f16x2 v; v.x = (f16)a; v.y = (f16)b; return __builtin_bit_cast(unsigned, v); }
__device__ __forceinline__ int lds_byte(int r, int c) { const int st = (r >> 4) * 2 + (c >> 5), rr = r & 15, cc = c & 31, ob = rr * 64 + cc * 2; return st * 1024 + (ob ^ (((ob >> 9) & 1) << 5)); }
__device__ __forceinline__ void stage_rc(int b, int& R, int& C) { const int st = b / 1024, sb = b % 1024, swz = sb ^ (((sb >> 9) & 1) << 5); R = (st >> 1) * 16 + swz / 64; C = (st & 1) * 32 + (swz % 64) / 2; }
__device__ __forceinline__ int perm32(int rho) { const int n = rho >> 4, i = rho & 15; return 8 * (i >> 2) + 4 * n + (i & 3); }

struct Unit { int pm, pn, e, row0, nrows; };

template <int K_>
struct DenseSched {
    static constexpr int K = K_;
    const char* A; const char* Bt; int nM, nN, nwg, G, c;
    __device__ void init(const void* A_, const void* Bt_, int M, int N, int G_, int c_) { A = (const char*)A_; Bt = (const char*)Bt_; nM = M / BM; nN = N / BM; nwg = nM * nN; G = G_; c = c_; }
    __device__ __forceinline__ bool next(int i, Unit& u) const {
        const long L = (long)i * G + c; if (L >= nwg) return false;
        int wgid = (int)L; { const int q = nwg / 8, r = nwg % 8, xcd = wgid % 8, off = wgid / 8; wgid = (xcd < r ? xcd * (q + 1) : r * (q + 1) + (xcd - r) * q) + off; }
        const int nig = 8 * nN, gid = wgid / nig, fm = gid * 8, gsz = (nM - fm) < 8 ? (nM - fm) : 8;
        u.pm = fm + ((wgid % nig) % gsz); u.pn = (wgid % nig) / gsz; u.e = 0; u.row0 = u.pm * BM; u.nrows = BM; return true;
    }
    static constexpr int LDB = K_, MID = -1;
    static __device__ __forceinline__ unsigned ka(int kt) { return (unsigned)kt * 128u; }
    static __device__ __forceinline__ unsigned kb(int kt) { return (unsigned)kt * 128u; }
    static __device__ __forceinline__ unsigned make_rc(int R, int C) { return (unsigned)(R * K + C) * 2u; }
    __device__ __forceinline__ void a_desc(const Unit& u, const unsigned (&rc)[2], unsigned (&ad)[2]) const { ad[0] = rc[0] + (unsigned)u.pm * (unsigned)(BM * K * 2); ad[1] = rc[1] + (unsigned)u.pm * (unsigned)(BM * K * 2); }
    static __device__ __forceinline__ unsigned aoff(unsigned ad, unsigned rc, int h) { return ad + (unsigned)h * (unsigned)(HALF * K * 2); }
    __device__ __forceinline__ const char* b_base(const Unit& u) const { return Bt + (size_t)u.pn * BM * K * 2; }
};

template <class Sched, class Epi>
__device__ __forceinline__ void gemm_phase(LAS unsigned char* lds, const Sched& S, const Epi& E) {
    constexpr int K = Sched::K, nt = K / BK;
    const int tid = get_tid(lds);
    const int wid = __builtin_amdgcn_readfirstlane(tid >> 6), lane = tid & 63, wr = wid >> 2, wc = wid & 3, fr = lane & 15, fq = lane >> 4;
    unsigned rc[2], voffB[2];
#pragma unroll
    for (int i = 0; i < 2; ++i) { int R, C; stage_rc(tid * 16 + i * 8192, R, C); const int Rb = Epi::PERM ? ((R & ~31) + perm32(R & 31)) : R; voffB[i] = (unsigned)(Rb * Sched::LDB + C) * 2u; rc[i] = Sched::make_rc(R, C); }
    constexpr unsigned hstepB = HALF * Sched::LDB * 2;
    const unsigned ldsw = (unsigned)wid * 1024u;
    const int aoff = lds_byte(wr * 64 + fr, fq * 8), boff = lds_byte(wc * 32 + fr, fq * 8);
#define G_SA(b, h) (((b) * 2 + (h)) * HTB)
#define G_SB(b, h) ((4 + (b) * 2 + (h)) * HTB)
#define G_STAGE_A(bufoff, ad, h, kb) do { \
        __builtin_amdgcn_global_load_lds((const unsigned*)(Abase + (size_t)Sched::aoff((ad)[0], rc[0], h) + (kb)), (LAS unsigned*)(lds + (bufoff) + ldsw), 16, 0, 0); \
        __builtin_amdgcn_global_load_lds((const unsigned*)(Abase + (size_t)Sched::aoff((ad)[1], rc[1], h) + (kb)), (LAS unsigned*)(lds + (bufoff) + ldsw + 8192), 16, 0, 0); } while (0)
#define G_STAGE_B(bufoff, gbase) do { _Pragma("unroll") for (int _i = 0; _i < 2; ++_i) \
        __builtin_amdgcn_global_load_lds((const unsigned*)((const char*)(gbase) + voffB[_i]), (LAS unsigned*)(lds + (bufoff) + ldsw + _i * 8192), 16, 0, 0); } while (0)
#define G_LDA(dst, b, h) do { _Pragma("unroll") for (int m = 0; m < 4; ++m) _Pragma("unroll") for (int k = 0; k < 2; ++k) dst[m][k] = *(const LAS f16x8*)(lds + G_SA(b, h) + aoff + m * 2048 + k * 1024); } while (0)
#define G_LDB(dst, b, h) do { _Pragma("unroll") for (int n = 0; n < 2; ++n) _Pragma("unroll") for (int k = 0; k < 2; ++k) dst[n][k] = *(const LAS f16x8*)(lds + G_SB(b, h) + boff + n * 2048 + k * 1024); } while (0)
#define G_MMA(ai, bj, At, Bt) do { __builtin_amdgcn_s_setprio(1); _Pragma("unroll") for (int m = 0; m < 4; ++m) _Pragma("unroll") for (int n = 0; n < 2; ++n) _Pragma("unroll") for (int k = 0; k < 2; ++k) \
        acc[ai][bj][m][n] = __builtin_amdgcn_mfma_f32_16x16x32_f16(Bt[n][k], At[m][k], acc[ai][bj][m][n], 0, 0, 0); __builtin_amdgcn_s_setprio(0); } while (0)
#define G_WAIT_V(n) asm volatile("s_waitcnt vmcnt(" #n ")" ::: "memory")
#define G_WAIT_L(n) asm volatile("s_waitcnt lgkmcnt(" #n ")" ::: "memory")
#define G_BAR __builtin_amdgcn_s_barrier()
#define G_SCHED __builtin_amdgcn_sched_barrier(0)
    Unit cur, nxt; int ui = 0;
    if (!S.next(0, cur)) return;
    f32x4 acc[2][2][4][2];
#pragma unroll
    for (int a = 0; a < 2; ++a)
#pragma unroll
        for (int b = 0; b < 2; ++b)
#pragma unroll
            for (int m = 0; m < 4; ++m)
#pragma unroll
                for (int n = 0; n < 2; ++n) acc[a][b][m][n] = (f32x4){0.f, 0.f, 0.f, 0.f};
    f16x8 At[4][2], B0[2][2], B1[2][2];
    const char* const Abase = S.A;
    unsigned cad[2], nad[2];
    S.a_desc(cur, rc, cad);
    const char* cB = S.b_base(cur);
    G_STAGE_B(G_SB(0, 0), cB); G_STAGE_B(G_SB(0, 1), cB + hstepB); G_STAGE_A(G_SA(0, 0), cad, 0, 0u); G_STAGE_A(G_SA(0, 1), cad, 1, 0u);
    if (wr == 1) G_BAR;
    G_WAIT_V(2); G_BAR;
    G_STAGE_B(G_SB(1, 0), cB + Sched::kb(1)); G_STAGE_A(G_SA(1, 0), cad, 0, Sched::ka(1)); G_STAGE_B(G_SB(1, 1), cB + hstepB + Sched::kb(1));
    G_WAIT_V(6); G_BAR;
    for (;;) {
        const bool has_next = S.next(ui + 1, nxt);
        const char* nB = cB;
        if (has_next) { S.a_desc(nxt, rc, nad); nB = S.b_base(nxt); }
        else { nad[0] = cad[0]; nad[1] = cad[1]; }
        for (int t = 0; t < nt; t += 2) {
            const bool last = (t == nt - 2);
            const unsigned k1 = Sched::ka(t + 1);
            const unsigned k2 = last ? Sched::ka(0) : Sched::ka(t + 2), k3 = last ? Sched::ka(1) : Sched::ka(t + 3);
            const unsigned a2[2] = {last ? nad[0] : cad[0], last ? nad[1] : cad[1]};
            const char* b2 = (last ? nB + Sched::kb(0) : cB + Sched::kb(t + 2)); const char* b3 = (last ? nB + Sched::kb(1) : cB + Sched::kb(t + 3));
            if constexpr (Sched::MID >= 0) { if (t == Sched::MID) E.mid(acc, cur, wr, wc, fr, fq); }
            G_LDB(B0, 0, 0); G_LDB(B1, 0, 1); G_SCHED; G_LDA(At, 0, 0); G_STAGE_A(G_SA(1, 1), cad, 1, k1);
            G_WAIT_V(8); G_WAIT_L(0); G_BAR; G_MMA(0, 0, At, B0); G_MMA(0, 1, At, B1); G_BAR; G_SCHED;
            G_LDA(At, 0, 1); G_STAGE_B(G_SB(0, 0), b2); G_STAGE_B(G_SB(0, 1), b2 + hstepB); G_STAGE_A(G_SA(0, 0), a2, 0, k2);
            G_WAIT_V(8); G_WAIT_L(0); G_BAR; G_MMA(1, 0, At, B0); G_MMA(1, 1, At, B1); G_BAR; G_SCHED;
            G_LDB(B0, 1, 0); G_LDB(B1, 1, 1); G_SCHED; G_LDA(At, 1, 0); G_STAGE_A(G_SA(0, 1), a2, 1, k2);
            G_WAIT_V(8); G_WAIT_L(0); G_BAR; G_MMA(0, 0, At, B0); G_MMA(0, 1, At, B1); G_BAR; G_SCHED;
            G_LDA(At, 1, 1); G_STAGE_B(G_SB(1, 0), b3); G_STAGE_B(G_SB(1, 1), b3 + hstepB); G_STAGE_A(G_SA(1, 0), a2, 0, k3);
            G_WAIT_V(8); G_WAIT_L(0); G_BAR; G_MMA(1, 0, At, B0); G_MMA(1, 1, At, B1); G_BAR; G_SCHED;
        }
        if (wr == 0) G_BAR;
        E(acc, cur, wr, wc, fr, fq);
        if (!has_next) break;
#pragma unroll
        for (int a = 0; a < 2; ++a)
#pragma unroll
            for (int b = 0; b < 2; ++b)
#pragma unroll
                for (int m = 0; m < 4; ++m)
#pragma unroll
                    for (int n = 0; n < 2; ++n) acc[a][b][m][n] = (f32x4){0.f, 0.f, 0.f, 0.f};
        cur = nxt; cB = nB; ++ui; cad[0] = nad[0]; cad[1] = nad[1];
        if (wr == 1) G_BAR;
    }
    G_WAIT_V(0);
    G_BAR;
#undef G_SA
#undef G_SB
#undef G_STAGE_A
#undef G_STAGE_B
#undef G_LDA
#undef G_LDB
#undef G_MMA
#undef G_WAIT_V
#undef G_WAIT_L
#undef G_BAR
#undef G_SCHED
}
constexpr size_t WS_WIN = 0;
constexpr size_t WS_WPA = WS_WIN + (size_t)INW * DM * 2;
constexpr size_t WS_WPB = WS_WPA + (size_t)DM * 512 * 2;
constexpr size_t WS_WOUT = WS_WPB + (size_t)DM * 512 * 2;
constexpr size_t WS_WUP = WS_WOUT + (size_t)DM * DM * 2;
constexpr size_t WS_WDN = WS_WUP + (size_t)NEXP * 2048 * DM * 2;
constexpr size_t WS_XH = WS_WDN + (size_t)NEXP * DM * DM * 2;
constexpr size_t WS_PROJ = WS_XH + (size_t)TOK * DM * 2;
constexpr size_t WS_OAB = WS_PROJ + (size_t)TOK * INW * 2;
constexpr size_t WS_MERGED = WS_OAB + (size_t)TOK * DM * 2;
constexpr size_t WS_H1 = WS_MERGED + (size_t)TOK * DM * 2;
constexpr size_t WS_SMALL = WS_H1 + (size_t)TOK * DM * 4 + 16 * MiB;
constexpr size_t WS_YS = WS_OAB;
constexpr size_t SM_PQ = 16064;
constexpr size_t SM_CNT = 0, SM_TK = 16384, SM_LIST = SM_TK + (size_t)NASG * 4;
constexpr size_t WS_END = WS_SMALL + SM_LIST + (size_t)NEXP * LISTCAP * 8;
static_assert(WS_YS + (size_t)MOE_ROWS * DM * 2 <= WS_SMALL, "ys overlaps bookkeeping");
static_assert((size_t)MOE_ROWS * DM * 2 <= (size_t)TOK * INW * 2, "act does not fit over proj");
static_assert(WS_END <= 1024 * MiB, "workspace");

struct Params {
    const float* in[22]; float* out; unsigned char* ws;
};

constexpr int LDS_PARAMS = LDS_WTAB - 256;
__device__ __forceinline__ unsigned long long rfl64(unsigned long long v) {
    const unsigned lo = (unsigned)__builtin_amdgcn_readfirstlane((int)(unsigned)v), hi = (unsigned)__builtin_amdgcn_readfirstlane((int)(unsigned)(v >> 32));
    return ((unsigned long long)hi << 32) | lo; }
__device__ __forceinline__ Params get_params(LAS unsigned char* lds) {
    unsigned off = LDS_PARAMS; asm volatile("" : "+v"(off));
    const LAS unsigned long long* q = (const LAS unsigned long long*)(lds + off);
    Params p;
#pragma unroll
    for (int i = 0; i < 22; ++i) p.in[i] = (const float*)rfl64(q[i]);
    p.out = (float*)rfl64(q[22]); p.ws = (unsigned char*)rfl64(q[23]);
    return p;
}
__device__ __forceinline__ void put_params(const Params& p, LAS unsigned char* lds) {
    LAS unsigned long long* q = (LAS unsigned long long*)(lds + LDS_PARAMS);
#pragma unroll
    for (int i = 0; i < 22; ++i) q[i] = (unsigned long long)p.in[i];
    q[22] = (unsigned long long)p.out; q[23] = (unsigned long long)p.ws;
}


struct PrepTile { const float* src; int ldsrc; f16* dst; int K; int n0; };
__device__ __forceinline__ PrepTile prep_desc(const Params& p, int t) {
    unsigned char* ws = p.ws;
    constexpr int T_IN = (INW / 64) * (DM / 128), T_PA = (DM / 64) * (512 / 128), T_OUT = (DM / 64) * (DM / 128);
    constexpr int T_UP1 = (2048 / 64) * (DM / 128), T_DN1 = (DM / 64) * (DM / 128);
    constexpr int T0 = T_IN, T1 = T0 + T_PA, T2 = T1 + T_PA, T3 = T2 + T_OUT, T4 = T3 + NEXP * T_UP1;
    PrepTile d;
    if (t < T0) { const int tn = t / 8, tk = t % 8; d.src = p.in[1] + (size_t)(tk * 128) * INW + tn * 64; d.ldsrc = INW; d.dst = (f16*)(ws + WS_WIN) + tk * 128; d.K = DM; d.n0 = tn * 64; }
    else if (t < T1) { const int q = t - T0, tn = q / 4, tk = q % 4; d.src = p.in[8] + (size_t)(tk * 128) * DM + tn * 64; d.ldsrc = DM; d.dst = (f16*)(ws + WS_WPA) + tk * 128; d.K = 512; d.n0 = tn * 64; }
    else if (t < T2) { const int q = t - T1, tn = q / 4, tk = q % 4; d.src = p.in[9] + (size_t)(tk * 128) * DM + tn * 64; d.ldsrc = DM; d.dst = (f16*)(ws + WS_WPB) + tk * 128; d.K = 512; d.n0 = tn * 64; }
    else if (t < T3) { const int q = t - T2, tn = q / 8, tk = q % 8; d.src = p.in[10] + (size_t)(tk * 128) * DM + tn * 64; d.ldsrc = DM; d.dst = (f16*)(ws + WS_WOUT) + tk * 128; d.K = DM; d.n0 = tn * 64; }
    else if (t < T4) { const int q = t - T3, e = q / T_UP1, r = q % T_UP1, tn = r / 8, tk = r % 8;
        const int np = tn * 64, pn = np >> 8, jj = np & 255;
        const int sc = jj < 128 ? pn * 128 + jj : 1024 + pn * 128 + (jj - 128);
        d.src = p.in[16] + (size_t)e * DM * 2048 + (size_t)(tk * 128) * 2048 + sc; d.ldsrc = 2048; d.dst = (f16*)(ws + WS_WUP) + (size_t)e * 2048 * DM + tk * 128; d.K = DM; d.n0 = np; }
    else { const int q = t - T4, e = q / T_DN1, r = q % T_DN1, tn = r / 8, tk = r % 8;
        d.src = p.in[18] + (size_t)e * DM * DM + (size_t)(tk * 128) * DM + tn * 64; d.ldsrc = DM; d.dst = (f16*)(ws + WS_WDN) + (size_t)e * DM * DM + tk * 128; d.K = DM; d.n0 = tn * 64; }
    return d;
}
constexpr int PREP_NT = (INW / 64) * (DM / 128) + 2 * (DM / 64) * (512 / 128) + (DM / 64) * (DM / 128) + NEXP * ((2048 / 64) * (DM / 128) + (DM / 64) * (DM / 128));
__device__ __forceinline__ void phase_prep(const Params& p, LAS unsigned char* lds, int wg, int nwg) {
    const int tid = get_tid(lds);
    unsigned char* ws = p.ws;
    {
        const float4* src = (const float4*)p.in[0]; u32x4* dst = (u32x4*)(ws + WS_XH);
        constexpr size_t n8 = (size_t)TOK * DM / 8;
        const size_t stride = (size_t)nwg * NTHR;
        for (size_t i = (size_t)wg * NTHR + tid; i < n8; i += 4 * stride) {
            float4 a[4], c[4];
#pragma unroll
            for (int u = 0; u < 4; ++u) { { const f32x4 t0_ = __builtin_nontemporal_load((const f32x4*)(src + 2 * (i + u * stride))), t1_ = __builtin_nontemporal_load((const f32x4*)(src + 2 * (i + u * stride) + 1)); a[u] = make_float4(t0_[0], t0_[1], t0_[2], t0_[3]); c[u] = make_float4(t1_[0], t1_[1], t1_[2], t1_[3]); } }
#pragma unroll
            for (int u = 0; u < 4; ++u) { u32x4 w; w.x = pk2(a[u].x, a[u].y); w.y = pk2(a[u].z, a[u].w); w.z = pk2(c[u].x, c[u].y); w.w = pk2(c[u].z, c[u].w); dst[i + u * stride] = w; }
        }
    }
    LAS float* tile = (LAS float*)lds;
    const int lk = tid >> 4, ln4 = (tid & 15) * 4;
    float4 va[4], vb[4];
#define PREP_LOAD(V, tt) do { if ((tt) < PREP_NT) { const PrepTile d_ = prep_desc(p, (tt)); \
        _Pragma("unroll") for (int j = 0; j < 4; ++j) { const f32x4 t_ = __builtin_nontemporal_load((const f32x4*)(d_.src + (size_t)(lk + 32 * j) * d_.ldsrc + ln4)); V[j] = make_float4(t_[0], t_[1], t_[2], t_[3]); } } } while (0)
#define PREP_DO2(V, tt, tnext) do { if ((tt) < PREP_NT) { const PrepTile d = prep_desc(p, (tt)); \
        _Pragma("unroll") for (int j = 0; j < 4; ++j) { LAS float* r = tile + (lk + 32 * j) * 65 + ln4; r[0] = V[j].x; r[1] = V[j].y; r[2] = V[j].z; r[3] = V[j].w; } \
        PREP_LOAD(V, (tnext)); \
        __syncthreads(); \
        { const int n = tid >> 3, kc = (tid & 7) * 16; u32x4 w0, w1; \
          w0.x = pk2(tile[(kc + 0) * 65 + n], tile[(kc + 1) * 65 + n]); w0.y = pk2(tile[(kc + 2) * 65 + n], tile[(kc + 3) * 65 + n]); \
          w0.z = pk2(tile[(kc + 4) * 65 + n], tile[(kc + 5) * 65 + n]); w0.w = pk2(tile[(kc + 6) * 65 + n], tile[(kc + 7) * 65 + n]); \
          w1.x = pk2(tile[(kc + 8) * 65 + n], tile[(kc + 9) * 65 + n]); w1.y = pk2(tile[(kc + 10) * 65 + n], tile[(kc + 11) * 65 + n]); \
          w1.z = pk2(tile[(kc + 12) * 65 + n], tile[(kc + 13) * 65 + n]); w1.w = pk2(tile[(kc + 14) * 65 + n], tile[(kc + 15) * 65 + n]); \
          f16* o = d.dst + (size_t)(d.n0 + n) * d.K + kc; *(u32x4*)o = w0; *(u32x4*)(o + 8) = w1; } \
        __syncthreads(); } } while (0)
    unsigned* pq = (unsigned*)(ws + WS_SMALL + SM_PQ);
    LAS int* qslot = (LAS int*)(lds + 36864);
    int ta, tb;
    if (tid == 0) { qslot[0] = (int)__hip_atomic_fetch_add(pq, 1u, __ATOMIC_RELAXED, __HIP_MEMORY_SCOPE_AGENT); qslot[1] = (int)__hip_atomic_fetch_add(pq, 1u, __ATOMIC_RELAXED, __HIP_MEMORY_SCOPE_AGENT); }
    __syncthreads();
    ta = qslot[0]; tb = qslot[1];
    PREP_LOAD(va, ta); PREP_LOAD(vb, tb);
#define PREP_DRAW(tv) do { __syncthreads(); if (tid == 0) qslot[0] = (int)__hip_atomic_fetch_add(pq, 1u, __ATOMIC_RELAXED, __HIP_MEMORY_SCOPE_AGENT); __syncthreads(); tv = qslot[0]; } while (0)
#pragma unroll 1
    for (;;) {
        if (ta >= PREP_NT && tb >= PREP_NT) break;
        int tn;
        if (ta < PREP_NT) { PREP_DRAW(tn); PREP_DO2(va, ta, tn); ta = tn; }
        if (tb < PREP_NT) { PREP_DRAW(tn); PREP_DO2(vb, tb, tn); tb = tn; }
    }
#undef PREP_DRAW
#undef PREP_LOAD
#undef PREP_DO2
}

struct EpiInProj {
    static constexpr bool PERM = true;
    f16* O; const float* bias;
    __device__ __forceinline__ void operator()(const f32x4 (&acc)[2][2][4][2], const Unit& u, int wr, int wc, int fr, int fq) const {
        const int row0 = u.pm * BM + wr * 64 + fr, col0 = u.pn * BM + wc * 32 + 8 * fq;
        const int cls = u.pn;
        const float scl = (cls < 2 || cls == 6 || cls == 7) ? QSCALE : 1.0f;
        const bool sig = cls >= 12;
        f32x4 bv[2][2];
#pragma unroll
        for (int bj = 0; bj < 2; ++bj)
#pragma unroll
            for (int n = 0; n < 2; ++n) bv[bj][n] = *(const f32x4*)(bias + col0 + bj * HALF + 4 * n);
#pragma unroll
        for (int ai = 0; ai < 2; ++ai)
#pragma unroll
            for (int m = 0; m < 4; ++m) {
                f16* rowp = O + (size_t)(row0 + ai * HALF + m * 16) * INW + col0;
#pragma unroll
                for (int bj = 0; bj < 2; ++bj) {
                    f32x4 v0 = acc[ai][bj][m][0] + bv[bj][0], v1 = acc[ai][bj][m][1] + bv[bj][1];
                    if (sig) {
#pragma unroll
                        for (int j = 0; j < 4; ++j) { v0[j] = __builtin_amdgcn_rcpf(1.0f + __expf(-v0[j])); v1[j] = __builtin_amdgcn_rcpf(1.0f + __expf(-v1[j])); }
                    } else { v0 *= scl; v1 *= scl; }
                    u32x4 w; w.x = pk2(v0[0], v0[1]); w.y = pk2(v0[2], v0[3]); w.z = pk2(v1[0], v1[1]); w.w = pk2(v1[2], v1[3]);
                    *(u32x4*)(rowp + bj * HALF) = w;
                }
            }
    }
};
__device__ __forceinline__ void phase_inproj(const Params& p, LAS unsigned char* lds, int wg, int nwg) {
    DenseSched<DM> S; S.init(p.ws + WS_XH, p.ws + WS_WIN, TOK, INW, nwg, wg);
    EpiInProj E{(f16*)(p.ws + WS_PROJ), p.in[2]};
    gemm_phase(lds, S, E);
}
constexpr int RT_LOG = 131072, RT_HIST = RT_LOG + 16384;
__device__ __forceinline__ void phase_router(const Params& p, LAS unsigned char* lds, int wg, int nwg) {
    const int tid = get_tid(lds);
    const int lane = tid & 63, wave = tid >> 6;
    const float* h1 = (const float*)(p.ws + WS_H1);
    f16* x1h = (f16*)(p.ws + WS_XH);
    const float* lng = p.in[12]; const float* lnb = p.in[13];
    const float* wr = p.in[14]; const float* br = p.in[15];
    int* cnt = (int*)(p.ws + WS_SMALL + SM_CNT);
    int* tk = (int*)(p.ws + WS_SMALL + SM_TK);
    int2* list = (int2*)(p.ws + WS_SMALL + SM_LIST);
    LAS float* wl = (LAS float*)lds;
    LAS float* slog = (LAS float*)(lds + RT_LOG);
    LAS int* hist = (LAS int*)(lds + RT_HIST);
    LAS int* hbase = hist + 32;
    for (int i = tid; i < DM * 8; i += NTHR) {
        const int col = i >> 3, k = i & 7;
        const float4 v = *(const float4*)(wr + (size_t)col * NEXP + k * 4);
        LAS float* d = wl + col * 32 + ((k ^ ((col >> 1) & 7)) << 2);
        d[0] = v.x; d[1] = v.y; d[2] = v.z; d[3] = v.w;
    }
    if (tid < 32) hist[tid] = 0;
    __syncthreads();
    const int tpw = TOK / (nwg * 8);
    const int tok0 = wg * (TOK / nwg) + wave * tpw;
    float gam[16], bet[16];
#pragma unroll
    for (int r = 0; r < 16; ++r) { gam[r] = lng[r * 64 + lane]; bet[r] = lnb[r * 64 + lane]; }
    float xa[16], xb[16];
#pragma unroll
    for (int r = 0; r < 16; ++r) { xa[r] = h1[(size_t)tok0 * DM + r * 64 + lane]; xb[r] = h1[(size_t)(tok0 + 1) * DM + r * 64 + lane]; }
#pragma unroll 1
    for (int j = 0; j < tpw; j += 2) {
        const int t = tok0 + j;
        float na[16], nb[16];
        if (j + 2 < tpw) {
#pragma unroll
            for (int r = 0; r < 16; ++r) { na[r] = h1[(size_t)(t + 2) * DM + r * 64 + lane]; nb[r] = h1[(size_t)(t + 3) * DM + r * 64 + lane]; }
        } else {
#pragma unroll
            for (int r = 0; r < 16; ++r) { na[r] = 0.f; nb[r] = 0.f; }
        }
        float sa = 0.f, sb = 0.f;
#pragma unroll
        for (int r = 0; r < 16; ++r) { sa += xa[r]; sb += xb[r]; }
        for (int o = 32; o >= 1; o >>= 1) { sa += shx(sa, o, lane); sb += shx(sb, o, lane); }
        const float mua = sa * (1.0f / DM), mub = sb * (1.0f / DM);
        float qa = 0.f, qb = 0.f;
#pragma unroll
        for (int r = 0; r < 16; ++r) { const float da = xa[r] - mua, db = xb[r] - mub; qa += da * da; qb += db * db; }
        for (int o = 32; o >= 1; o >>= 1) { qa += shx(qa, o, lane); qb += shx(qb, o, lane); }
        const float rsa = rsqrtf(qa * (1.0f / DM) + 1e-5f), rsb = rsqrtf(qb * (1.0f / DM) + 1e-5f);
#pragma unroll
        for (int r = 0; r < 16; ++r) {
            xa[r] = (xa[r] - mua) * rsa * gam[r] + bet[r]; xb[r] = (xb[r] - mub) * rsb * gam[r] + bet[r];
            x1h[(size_t)t * DM + r * 64 + lane] = (f16)xa[r]; x1h[(size_t)(t + 1) * DM + r * 64 + lane] = (f16)xb[r];
        }
        float acc[32], acd[32];
#pragma unroll
        for (int e = 0; e < 32; ++e) { acc[e] = 0.f; acd[e] = 0.f; }
#pragma unroll
        for (int r = 0; r < 16; ++r) {
            const int col = r * 64 + lane;
            const LAS float* wrow = wl + col * 32;
            const int sw = (col >> 1) & 7;
#pragma unroll
            for (int k = 0; k < 8; ++k) {
                const f32x4 w4 = *(const LAS f32x4*)(wrow + ((k ^ sw) << 2));
#pragma unroll
                for (int c = 0; c < 4; ++c) { acc[k * 4 + c] = fmaf(xa[r], w4[c], acc[k * 4 + c]); acd[k * 4 + c] = fmaf(xb[r], w4[c], acd[k * 4 + c]); }
            }
        }
#define RT_REDUCE(AC, OUT) do { float a16[16], a8[8], a4[4], a2[2]; \
        { const bool hi_ = (lane & 32) != 0; _Pragma("unroll") for (int k = 0; k < 16; ++k) { const float snd = hi_ ? AC[k] : AC[16 + k]; const float rcv = shx(snd, 32, lane); a16[k] = (hi_ ? AC[16 + k] : AC[k]) + rcv; } } \
        { const bool hi_ = (lane & 16) != 0; _Pragma("unroll") for (int k = 0; k < 8; ++k) { const float snd = hi_ ? a16[k] : a16[8 + k]; const float rcv = shx(snd, 16, lane); a8[k] = (hi_ ? a16[8 + k] : a16[k]) + rcv; } } \
        { const bool hi_ = (lane & 8) != 0; _Pragma("unroll") for (int k = 0; k < 4; ++k) { const float snd = hi_ ? a8[k] : a8[4 + k]; const float rcv = shx(snd, 8, lane); a4[k] = (hi_ ? a8[4 + k] : a8[k]) + rcv; } } \
        { const bool hi_ = (lane & 4) != 0; _Pragma("unroll") for (int k = 0; k < 2; ++k) { const float snd = hi_ ? a4[k] : a4[2 + k]; const float rcv = shx(snd, 4, lane); a2[k] = (hi_ ? a4[2 + k] : a4[k]) + rcv; } } \
        { const bool hi_ = (lane & 2) != 0; const float snd = hi_ ? a2[0] : a2[1]; const float rcv = shx(snd, 2, lane); OUT = (hi_ ? a2[1] : a2[0]) + rcv; } \
        OUT += shx(OUT, 1, lane); } while (0)
        float l0, l1;
        RT_REDUCE(acc, l0); RT_REDUCE(acd, l1);
#undef RT_REDUCE
        if ((lane & 1) == 0) { const float bb = br[lane >> 1]; slog[(wave * tpw + j) * 32 + (lane >> 1)] = l0 + bb; slog[(wave * tpw + j + 1) * 32 + (lane >> 1)] = l1 + bb; }
#pragma unroll
        for (int r = 0; r < 16; ++r) { xa[r] = na[r]; xb[r] = nb[r]; }
    }
    __syncthreads();
    int my_e[4]; float my_g[4]; int my_loc[4];
    const bool act = lane < tpw;
    const int tl = wave * tpw + lane;
    if (act) {
        float v[32];
#pragma unroll
        for (int k = 0; k < 8; ++k) { const f32x4 t4 = *(const LAS f32x4*)(slog + tl * 32 + k * 4); v[k * 4] = t4[0]; v[k * 4 + 1] = t4[1]; v[k * 4 + 2] = t4[2]; v[k * 4 + 3] = t4[3]; }
        float tv[4];
#pragma unroll
        for (int k = 0; k < 4; ++k) {
            float bv = -3.0e38f; int bi = 0;
#pragma unroll
            for (int e = 0; e < 32; ++e) { if (v[e] > bv) { bv = v[e]; bi = e; } }
            tv[k] = bv; my_e[k] = bi;
#pragma unroll
            for (int e = 0; e < 32; ++e) v[e] = (e == bi) ? -3.0e38f : v[e];
        }
        const float e1 = __expf(tv[1] - tv[0]), e2 = __expf(tv[2] - tv[0]), e3 = __expf(tv[3] - tv[0]);
        const float inv = 1.0f / (1.0f + e1 + e2 + e3);
        my_g[0] = inv; my_g[1] = e1 * inv; my_g[2] = e2 * inv; my_g[3] = e3 * inv;
#pragma unroll
        for (int k = 0; k < 4; ++k) my_loc[k] = __hip_atomic_fetch_add(hist + my_e[k], 1, __ATOMIC_RELAXED, __HIP_MEMORY_SCOPE_WORKGROUP);
    }
    __syncthreads();
    if (tid < 32) hbase[tid] = atomicAdd(&cnt[tid], hist[tid]);
    __syncthreads();
    if (act) {
        const int t = tok0 + lane;
#pragma unroll
        for (int k = 0; k < 4; ++k) {
            const int slot = hbase[my_e[k]] + my_loc[k];
            tk[t * 4 + k] = (my_e[k] << 20) | slot;
            list[(size_t)my_e[k] * LISTCAP + slot] = make_int2(t, __float_as_int(my_g[k]));
        }
    }
    __syncthreads();
}

__device__ __forceinline__ void phase_final(const Params& p, LAS unsigned char* lds, int wg, int nwg) {
    const int tid = get_tid(lds);
    const int lane = tid & 63, wave = tid >> 6;
    const f16* x1h = (const f16*)(p.ws + WS_XH);
    const f16* ys = (const f16*)(p.ws + WS_YS);
    const int* cnt = (const int*)(p.ws + WS_SMALL + SM_CNT);
    const int* tk = (const int*)(p.ws + WS_SMALL + SM_TK);
    const float* lng = p.in[20]; const float* lnb = p.in[21];
    LAS int* ps = (LAS int*)lds;
    if (tid == 0) { int a = 0; for (int e = 0; e < NEXP; ++e) { ps[e] = a; a += (cnt[e] + ROWPAD - 1) / ROWPAD * ROWPAD; } }
    __syncthreads();
    const int tpw = TOK / (nwg * 8);
    const int tok0 = wg * (TOK / nwg) + wave * tpw;
    float gm[16], bt[16];
#pragma unroll
    for (int hh = 0; hh < 2; ++hh) { const int c0 = hh * 512 + 8 * lane;
        const float4 g0 = *(const float4*)(lng + c0), g1 = *(const float4*)(lng + c0 + 4), b0 = *(const float4*)(lnb + c0), b1 = *(const float4*)(lnb + c0 + 4);
        gm[hh * 8 + 0] = g0.x; gm[hh * 8 + 1] = g0.y; gm[hh * 8 + 2] = g0.z; gm[hh * 8 + 3] = g0.w; gm[hh * 8 + 4] = g1.x; gm[hh * 8 + 5] = g1.y; gm[hh * 8 + 6] = g1.z; gm[hh * 8 + 7] = g1.w;
        bt[hh * 8 + 0] = b0.x; bt[hh * 8 + 1] = b0.y; bt[hh * 8 + 2] = b0.z; bt[hh * 8 + 3] = b0.w; bt[hh * 8 + 4] = b1.x; bt[hh * 8 + 5] = b1.y; bt[hh * 8 + 6] = b1.z; bt[hh * 8 + 7] = b1.w; }
    f16x8 ra[5], rb[5];
#define FN_LOAD(t_) do { ra[0] = *(const f16x8*)(x1h + (size_t)(t_) * DM + 8 * lane); rb[0] = *(const f16x8*)(x1h + (size_t)(t_) * DM + 512 + 8 * lane); \
        _Pragma("unroll") for (int k = 0; k < 4; ++k) { const int c = tk[(t_) * 4 + k]; const int row = ps[c >> 20] + (c & 0xFFFFF); \
            ra[1 + k] = *(const f16x8*)(ys + (size_t)row * DM + 8 * lane); rb[1 + k] = *(const f16x8*)(ys + (size_t)row * DM + 512 + 8 * lane); } } while (0)
    FN_LOAD(tok0);
#pragma unroll 1
    for (int j = 0; j < tpw; ++j) {
        const int t = tok0 + j;
        float v[16];
#pragma unroll
        for (int i = 0; i < 8; ++i) { v[i] = ALPHA * (float)ra[0][i]; v[8 + i] = ALPHA * (float)rb[0][i]; }
#pragma unroll
        for (int k = 1; k < 5; ++k)
#pragma unroll
            for (int i = 0; i < 8; ++i) { v[i] += (float)ra[k][i]; v[8 + i] += (float)rb[k][i]; }
        if (j + 1 < tpw) FN_LOAD(t + 1);
        float s = 0.f;
#pragma unroll
        for (int i = 0; i < 16; ++i) s += v[i];
        for (int o = 32; o >= 1; o >>= 1) s += shx(s, o, lane);
        const float mu = s * (1.0f / DM);
        float q = 0.f;
#pragma unroll
        for (int i = 0; i < 16; ++i) { const float d = v[i] - mu; q += d * d; }
        for (int o = 32; o >= 1; o >>= 1) q += shx(q, o, lane);
        const float rs = rsqrtf(q * (1.0f / DM) + 1e-5f);
        float* op = p.out + (size_t)t * DM;
#pragma unroll
        for (int hh = 0; hh < 2; ++hh) {
            const int c0 = hh * 512 + 8 * lane;
            float4 o0, o1;
            o0.x = (v[hh * 8 + 0] - mu) * rs * gm[hh * 8 + 0] + bt[hh * 8 + 0]; o0.y = (v[hh * 8 + 1] - mu) * rs * gm[hh * 8 + 1] + bt[hh * 8 + 1];
            o0.z = (v[hh * 8 + 2] - mu) * rs * gm[hh * 8 + 2] + bt[hh * 8 + 2]; o0.w = (v[hh * 8 + 3] - mu) * rs * gm[hh * 8 + 3] + bt[hh * 8 + 3];
            o1.x = (v[hh * 8 + 4] - mu) * rs * gm[hh * 8 + 4] + bt[hh * 8 + 4]; o1.y = (v[hh * 8 + 5] - mu) * rs * gm[hh * 8 + 5] + bt[hh * 8 + 5];
            o1.z = (v[hh * 8 + 6] - mu) * rs * gm[hh * 8 + 6] + bt[hh * 8 + 6]; o1.w = (v[hh * 8 + 7] - mu) * rs * gm[hh * 8 + 7] + bt[hh * 8 + 7];
            *(float4*)(op + c0) = o0; *(float4*)(op + c0 + 4) = o1;
        }
    }
#undef FN_LOAD
    __syncthreads();
}
struct MergeSched {
    static constexpr int K = 1024, LDB = 512, MID = 8;
    static constexpr unsigned OB_JUMP = (unsigned)(TOK * 512 * 2) - 1024u, WB_JUMP = (unsigned)(DM * 512 * 2) - 1024u;
    const char* A; const char* Bt; DenseSched<512> D;
    __device__ void init(const void* oa, const void* wpa_t, int G, int c) { A = (const char*)oa; Bt = (const char*)wpa_t; D.init(oa, wpa_t, TOK, DM, G, c); }
    __device__ __forceinline__ bool next(int i, Unit& u) const { return D.next(i, u); }
    static __device__ __forceinline__ unsigned ka(int kt) { return (unsigned)kt * 128u + (kt >= 8 ? OB_JUMP : 0u); }
    static __device__ __forceinline__ unsigned kb(int kt) { return (unsigned)kt * 128u + (kt >= 8 ? WB_JUMP : 0u); }
    static __device__ __forceinline__ unsigned make_rc(int R, int C) { return (unsigned)(R * 512 + C) * 2u; }
    __device__ __forceinline__ void a_desc(const Unit& u, const unsigned (&rc)[2], unsigned (&ad)[2]) const { const unsigned o = (unsigned)u.pm * (unsigned)(BM * 512 * 2); ad[0] = rc[0] + o; ad[1] = rc[1] + o; }
    static __device__ __forceinline__ unsigned aoff(unsigned ad, unsigned rc, int h) { return ad + (unsigned)h * (unsigned)(HALF * 512 * 2); }
    __device__ __forceinline__ const char* b_base(const Unit& u) const { return Bt + (size_t)u.pn * BM * 512 * 2; }
};
struct EpiMerge {
    static constexpr bool PERM = true;
    const f16* proj; f16* merged;
    __device__ __forceinline__ void mid(f32x4 (&acc)[2][2][4][2], const Unit& u, int wr, int wc, int fr, int fq) const {
        asm volatile("" : "+v"(fr), "+v"(fq));
        const int row0 = u.pm * BM + wr * 64 + fr, col0 = u.pn * BM + wc * 32 + 8 * fq;
#pragma unroll
        for (int ai = 0; ai < 2; ++ai)
#pragma unroll
            for (int m = 0; m < 4; ++m) {
                const size_t row = (size_t)(row0 + ai * HALF + m * 16);
#pragma unroll
                for (int bj = 0; bj < 2; ++bj) {
                    const f16x8 ga = *(const f16x8*)(proj + row * INW + C_GA + col0 + bj * HALF), gb = *(const f16x8*)(proj + row * INW + C_GB + col0 + bj * HALF);
#pragma unroll
                    for (int j = 0; j < 4; ++j) {
                        acc[ai][bj][m][0][j] *= (float)ga[j] * __builtin_amdgcn_rcpf(fmaxf((float)gb[j], 5.9604645e-8f));
                        acc[ai][bj][m][1][j] *= (float)ga[4 + j] * __builtin_amdgcn_rcpf(fmaxf((float)gb[4 + j], 5.9604645e-8f));
                    }
                }
                asm volatile("" ::: "memory");
            }
    }
    __device__ __forceinline__ void operator()(const f32x4 (&acc)[2][2][4][2], const Unit& u, int wr, int wc, int fr, int fq) const {
        const int row0 = u.pm * BM + wr * 64 + fr, col0 = u.pn * BM + wc * 32 + 8 * fq;
#pragma unroll
        for (int ai = 0; ai < 2; ++ai)
#pragma unroll
            for (int m = 0; m < 4; ++m) {
                const size_t row = (size_t)(row0 + ai * HALF + m * 16);
#pragma unroll
                for (int bj = 0; bj < 2; ++bj) {
                    const f16x8 gb = *(const f16x8*)(proj + row * INW + C_GB + col0 + bj * HALF);
                    float v[8];
#pragma unroll
                    for (int j = 0; j < 4; ++j) { v[j] = fmaxf((float)gb[j], 5.9604645e-8f) * acc[ai][bj][m][0][j]; v[4 + j] = fmaxf((float)gb[4 + j], 5.9604645e-8f) * acc[ai][bj][m][1][j]; }
                    u32x4 w; w.x = pk2(v[0], v[1]); w.y = pk2(v[2], v[3]); w.z = pk2(v[4], v[5]); w.w = pk2(v[6], v[7]);
                    *(u32x4*)(merged + row * DM + col0 + bj * HALF) = w;
                }
            }
    }
};
__device__ __forceinline__ void phase_merge(const Params& p, LAS unsigned char* lds, int wg, int nwg) {
    MergeSched S; S.init(p.ws + WS_OAB, p.ws + WS_WPA, nwg, wg);
    EpiMerge E{(const f16*)(p.ws + WS_PROJ), (f16*)(p.ws + WS_MERGED)};
    gemm_phase(lds, S, E);
}
struct EpiOutProj {
    static constexpr bool PERM = false;
    const float* x; const float* bias; float* h1;
    __device__ __forceinline__ void operator()(const f32x4 (&acc)[2][2][4][2], const Unit& u, int wr, int wc, int fr, int fq) const {
        const int row0 = u.pm * BM + wr * 64 + fr, col0 = u.pn * BM + wc * 32 + 4 * fq;
        f32x4 bv[2][2];
#pragma unroll
        for (int bj = 0; bj < 2; ++bj)
#pragma unroll
            for (int n = 0; n < 2; ++n) bv[bj][n] = *(const f32x4*)(bias + col0 + bj * HALF + n * 16);
#pragma unroll
        for (int ai = 0; ai < 2; ++ai)
#pragma unroll
            for (int m = 0; m < 4; ++m) {
                const size_t off = (size_t)(row0 + ai * HALF + m * 16) * DM + col0;
#pragma unroll
                for (int bj = 0; bj < 2; ++bj)
#pragma unroll
                    for (int n = 0; n < 2; ++n) {
                        const f32x4 xv = *(const f32x4*)(x + off + bj * HALF + n * 16);
                        *(f32x4*)(h1 + off + bj * HALF + n * 16) = ALPHA * xv + acc[ai][bj][m][n] + bv[bj][n];
                    }
            }
    }
};
__device__ __forceinline__ void phase_outproj(const Params& p, LAS unsigned char* lds, int wg, int nwg) {
    DenseSched<DM> S; S.init(p.ws + WS_MERGED, p.ws + WS_WOUT, TOK, DM, nwg, wg);
    EpiOutProj E{p.in[0], p.in[11], (float*)(p.ws + WS_H1)};
    gemm_phase(lds, S, E);
}

constexpr int MOE_MISC = STAGE_BYTES;
__device__ __forceinline__ void moe_prefix(const Params& p, LAS unsigned char* lds) {
    LAS int* tpre = (LAS int*)(lds + MOE_MISC); LAS int* ecnt = tpre + 64;
    const int* cnt = (const int*)(p.ws + WS_SMALL + SM_CNT);
    if (get_tid(lds) == 0) { int a = 0; for (int e = 0; e < NEXP; ++e) { const int c = cnt[e]; ecnt[e] = c; tpre[e] = a; a += (c + ROWPAD - 1) / ROWPAD; } tpre[NEXP] = a; }
    __syncthreads();
}
template <int NPN, bool GATHER>
struct MoeSched {
    static constexpr int K = DM;
    const char* A; const char* Bt; const int2* list; LAS int* tpre; LAS int* ecnt; int c;
    __device__ __forceinline__ bool next(int i, Unit& u) const {
        constexpr int MPR = 256 / NPN, MPX = 32 / NPN;
        const int xcd = c & 7, j = c >> 3;
        const int M = i * MPR + xcd * MPX + j / NPN;
        if (M >= tpre[NEXP]) return false;
        int e = 0;
        for (int k = 1; k < NEXP; ++k) e += (tpre[k] <= M) ? 1 : 0;
        u.e = e; u.pm = M - tpre[e]; u.pn = j % NPN; u.row0 = M * ROWPAD; u.nrows = ecnt[e] - u.pm * ROWPAD;
        return true;
    }
    static constexpr int LDB = DM, MID = -1;
    static __device__ __forceinline__ unsigned ka(int kt) { return (unsigned)kt * 128u; }
    static __device__ __forceinline__ unsigned kb(int kt) { return (unsigned)kt * 128u; }
    static __device__ __forceinline__ unsigned make_rc(int R, int C) { return GATHER ? ((unsigned)R | ((unsigned)(2 * C) << 8)) : (unsigned)(R * K + C) * 2u; }
    __device__ __forceinline__ void a_desc(const Unit& u, const unsigned (&rc)[2], unsigned (&ad)[2]) const {
        if (GATHER) {
#pragma unroll
            for (int i = 0; i < 2; ++i) {
                const int R = (int)(rc[i] & 0xFFu);
                const int2* lp = list + (size_t)u.e * LISTCAP + u.pm * ROWPAD + R;
                int t0 = lp[0].x, t1 = lp[HALF].x;
                t0 = R < u.nrows ? t0 : 0; t1 = (R + HALF) < u.nrows ? t1 : 0;
                ad[i] = (unsigned)t0 | ((unsigned)t1 << 16);
            }
            asm volatile("" : "+v"(ad[0]), "+v"(ad[1]));
        } else { ad[0] = rc[0] + (unsigned)u.row0 * (unsigned)(K * 2); ad[1] = rc[1] + (unsigned)u.row0 * (unsigned)(K * 2); }
    }
    static __device__ __forceinline__ unsigned aoff(unsigned ad, unsigned rc, int h) {
        return GATHER ? (((ad >> (16 * h)) & 0xFFFFu) * (unsigned)(K * 2) + (rc >> 8)) : (ad + (unsigned)h * (unsigned)(HALF * K * 2)); }
    __device__ __forceinline__ const char* b_base(const Unit& u) const { return Bt + ((size_t)u.e * (NPN * BM) + (size_t)u.pn * BM) * K * 2; }
};
struct EpiUp {
    static constexpr bool PERM = true;
    const float* bup; f16* act;
    __device__ __forceinline__ void operator()(const f32x4 (&acc)[2][2][4][2], const Unit& u, int wr, int wc, int fr, int fq) const {
        const int col0 = u.pn * HALF + wc * 32 + 8 * fq;
        const float* bg = bup + (size_t)u.e * 2048 + col0; const float* bu = bg + 1024;
        const f32x4 bg0 = *(const f32x4*)bg, bg1 = *(const f32x4*)(bg + 4), bu0 = *(const f32x4*)bu, bu1 = *(const f32x4*)(bu + 4);
#pragma unroll
        for (int ai = 0; ai < 2; ++ai)
#pragma unroll
            for (int m = 0; m < 4; ++m) {
                const size_t row = (size_t)(u.row0 + ai * HALF + wr * 64 + m * 16 + fr);
                float v[8];
#pragma unroll
                for (int n = 0; n < 2; ++n)
#pragma unroll
                    for (int j = 0; j < 4; ++j) {
                        const float hg = acc[ai][0][m][n][j] + (n == 0 ? bg0[j] : bg1[j]), hu = acc[ai][1][m][n][j] + (n == 0 ? bu0[j] : bu1[j]);
                        const float gate = fminf(hg, 7.0f), up = fminf(fmaxf(hu, -7.0f), 7.0f);
                        v[n * 4 + j] = gate * __builtin_amdgcn_rcpf(1.0f + __expf(-1.702f * gate)) * (up + 1.0f);
                    }
                u32x4 w; w.x = pk2(v[0], v[1]); w.y = pk2(v[2], v[3]); w.z = pk2(v[4], v[5]); w.w = pk2(v[6], v[7]);
                *(u32x4*)(act + row * DM + col0) = w;
            }
    }
};
struct EpiDown {
    static constexpr bool PERM = true;
    const float* bdn; const int2* list; f16* ys;
    __device__ __forceinline__ void operator()(const f32x4 (&acc)[2][2][4][2], const Unit& u, int wr, int wc, int fr, int fq) const {
        const int col0 = u.pn * BM + wc * 32 + 8 * fq;
        f32x4 bv[2][2];
#pragma unroll
        for (int bj = 0; bj < 2; ++bj)
#pragma unroll
            for (int n = 0; n < 2; ++n) bv[bj][n] = *(const f32x4*)(bdn + (size_t)u.e * DM + col0 + bj * HALF + 4 * n);
#pragma unroll
        for (int ai = 0; ai < 2; ++ai)
#pragma unroll
            for (int m = 0; m < 4; ++m) {
                const int lr = ai * HALF + wr * 64 + m * 16 + fr;
                float wgt = __int_as_float(list[(size_t)u.e * LISTCAP + u.pm * ROWPAD + lr].y); wgt = lr < u.nrows ? wgt : 0.f;
                f16* rowp = ys + (size_t)(u.row0 + lr) * DM + col0;
#pragma unroll
                for (int bj = 0; bj < 2; ++bj) {
                    const f32x4 v0 = (acc[ai][bj][m][0] + bv[bj][0]) * wgt, v1 = (acc[ai][bj][m][1] + bv[bj][1]) * wgt;
                    u32x4 w; w.x = pk2(v0[0], v0[1]); w.y = pk2(v0[2], v0[3]); w.z = pk2(v1[0], v1[1]); w.w = pk2(v1[2], v1[3]);
                    *(u32x4*)(rowp + bj * HALF) = w;
                }
            }
    }
};
__device__ __forceinline__ void phase_up(const Params& p, LAS unsigned char* lds, int wg, int nwg) {
    moe_prefix(p, lds);
    MoeSched<8, true> S{(const char*)(p.ws + WS_XH), (const char*)(p.ws + WS_WUP), (const int2*)(p.ws + WS_SMALL + SM_LIST), (LAS int*)(lds + MOE_MISC), (LAS int*)(lds + MOE_MISC) + 64, wg};
    EpiUp E{p.in[17], (f16*)(p.ws + WS_PROJ)};
    gemm_phase(lds, S, E);
}
__device__ __forceinline__ void phase_down(const Params& p, LAS unsigned char* lds, int wg, int nwg) {
    moe_prefix(p, lds);
    MoeSched<4, false> S{(const char*)(p.ws + WS_PROJ), (const char*)(p.ws + WS_WDN), (const int2*)(p.ws + WS_SMALL + SM_LIST), (LAS int*)(lds + MOE_MISC), (LAS int*)(lds + MOE_MISC) + 64, wg};
    EpiDown E{p.in[19], (const int2*)(p.ws + WS_SMALL + SM_LIST), (f16*)(p.ws + WS_YS)};
    gemm_phase(lds, S, E);
}
__device__ __forceinline__ float lambda_full(const float* lq1, const float* lk1, const float* lq2, const float* lk2, int lane) {
    float a = lq1[lane] * lk1[lane], c = lq2[lane] * lk2[lane];
    for (int o = 32; o >= 1; o >>= 1) { a += shx(a, o, lane); c += shx(c, o, lane); }
    return __expf(a) - __expf(c) + LAMBDA_INIT;
}
typedef short s16x4 __attribute__((ext_vector_type(4)));
__device__ __forceinline__ int crow(int r, int hi) { return (r & 3) + 8 * (r >> 2) + 4 * hi; }
__device__ __forceinline__ f16x4 vtr(const LAS unsigned char* p) { return __builtin_bit_cast(f16x4, __builtin_amdgcn_ds_read_tr16_b64_v4i16((LAS s16x4*)p)); }
#define MFMA32(a, b, c) __builtin_amdgcn_mfma_f32_32x32x16_f16(a, b, c, 0, 0, 0)
__device__ __forceinline__ float rowmax32(const f32x16& p0, const f32x16& p1) {
    float a = fmaxf(fmaxf(p0[0], p0[1]), p1[0]), b = fmaxf(fmaxf(p0[2], p0[3]), p1[1]); a = fmaxf(fmaxf(a, p1[2]), p1[3]);
#pragma unroll
    for (int r = 4; r < 16; r += 4) { a = fmaxf(fmaxf(a, p0[r]), p0[r + 1]); b = fmaxf(fmaxf(b, p0[r + 2]), p0[r + 3]); a = fmaxf(fmaxf(a, p1[r]), p1[r + 1]); b = fmaxf(fmaxf(b, p1[r + 2]), p1[r + 3]); }
    float m = fmaxf(a, b); auto rr = __builtin_amdgcn_permlane32_swap(__float_as_uint(m), __float_as_uint(m), false, false);
    return fmaxf(__uint_as_float(rr[0]), __uint_as_float(rr[1]));
}
__device__ __forceinline__ float half_sum(float v) { auto rr = __builtin_amdgcn_permlane32_swap(__float_as_uint(v), __float_as_uint(v), false, false); return __uint_as_float(rr[0]) + __uint_as_float(rr[1]); }

constexpr int AB_QSTR = 4160;
constexpr int AB_STG = 16384 + 4 * AB_QSTR;
constexpr int AB_STGS = 33280;
constexpr int AB_WSF = 131072;
constexpr float AB_THR = 8.0f;

constexpr int AA_HSTR = 2112;
constexpr int AA_BUF = 2 * AA_HSTR;
constexpr int AA_KBUF = 4096;
constexpr int AA_WAVE = 2 * AA_BUF + 2 * AA_KBUF + 128;
constexpr float AA_THR = 8.0f;
__device__ __forceinline__ float rowmax16(const f32x16& p0) {
    float a = fmaxf(fmaxf(p0[0], p0[1]), p0[2]), b = fmaxf(fmaxf(p0[3], p0[4]), p0[5]);
    a = fmaxf(fmaxf(a, p0[6]), p0[7]); b = fmaxf(fmaxf(b, p0[8]), p0[9]); a = fmaxf(fmaxf(a, p0[10]), p0[11]); b = fmaxf(fmaxf(b, p0[12]), p0[13]);
    a = fmaxf(fmaxf(a, p0[14]), p0[15]);
    float m = fmaxf(a, b); auto rr = __builtin_amdgcn_permlane32_swap(__float_as_uint(m), __float_as_uint(m), false, false);
    return fmaxf(__uint_as_float(rr[0]), __uint_as_float(rr[1]));
}
__device__ __forceinline__ void phase_attnA(const Params& p, LAS unsigned char* lds, int wg, int nwg) {
    const int tid = get_tid(lds);
    const int lane = tid & 63, r32 = lane & 31, hi = lane >> 5;
    const int wave = __builtin_amdgcn_readfirstlane(tid >> 6);
    const f16* proj = (const f16*)(p.ws + WS_PROJ);
    f16* oa = (f16*)(p.ws + WS_OAB);
    LAS unsigned char* wl = lds + wave * AA_WAVE;
    LAS float* wsf = (LAS float*)(wl + 2 * AA_BUF + 2 * AA_KBUF);
    const int kw0 = (lane >> 3) * 128 + (((lane & 7) ^ (((lane >> 3) >> 1) & 7)) << 4);
    const int kr0 = r32 * 128, kx = (hi ^ ((r32 >> 1) & 7)) << 4;
    const int vl = ((lane >> 4) & 1) * 32 + (lane & 3) * 8 + (4 * hi + ((lane & 15) >> 2)) * 64;
    const int vrow0 = lane >> 3, vch0 = lane & 7, vw0 = (vch0 >> 2) * AA_HSTR + vrow0 * 64 + (vch0 & 3) * 16;
#if defined(AA_TIMEQ)
#define AA_TQ0 const long long tq0_ = __builtin_readcyclecounter();
#define AA_TQ1 tacc += __builtin_readcyclecounter() - tq0_;
#else
#define AA_TQ0
#define AA_TQ1
#endif
    long long tacc = 0;
    constexpr int NTILE = 33;
#pragma unroll 1
    for (int ui = 0; ui < 4; ++ui) {
        const int j = wg >> 3, bh = ui * 16 + (wg & 7) * 2 + (j >> 4), r16 = j & 15;
        const int b = bh >> 3, h = bh & 7;
        const float sl2 = slope_of(h + (h >> 1)) * LOG2E;
        const f16* base = proj + (size_t)b * SEQ * INW;
        const int P0 = r16 + 512 * wave, qpos = P0 + 16 * r32;
        f16x8 qr[4];
#pragma unroll
        for (int d0 = 0; d0 < 4; ++d0) qr[d0] = *(const f16x8*)(base + (size_t)qpos * INW + C_QA + h * 64 + 16 * d0 + 8 * hi);
        f32x16 o[2];
        o[0] = (f32x16){0.f, 0.f, 0.f, 0.f, 0.f, 0.f, 0.f, 0.f, 0.f, 0.f, 0.f, 0.f, 0.f, 0.f, 0.f, 0.f}; o[1] = o[0];
        float m = -1.0e30f, l = 0.f;
        u32x4 kS[4], vA[4];
#define AA_PARAMS(tt, d, n) const int d = (tt) < 5 ? 16 : ((tt) < 13 ? 4 : 1), n = (tt) < 5 ? (tt) : ((tt) < 13 ? (tt) - 5 : (tt) - 13)
#define AA_LOADKV(tt) do { AA_PARAMS(tt, d_, n_); const int kb_ = P0 - 64 * d_ + 32 * d_ * n_; \
            if (kb_ >= 0 && kb_ + 31 * d_ < SEQ) { \
                const f16* r0_ = base + (size_t)(kb_ + d_ * vrow0) * INW + h * 64 + vch0 * 8; const size_t st_ = (size_t)(8 * d_) * INW; \
                _Pragma("unroll") for (int jj = 0; jj < 4; ++jj) { kS[jj] = *(const u32x4*)(r0_ + C_KA + jj * st_); vA[jj] = *(const u32x4*)(r0_ + C_VA + jj * st_); } \
            } else { \
                _Pragma("unroll") for (int jj = 0; jj < 4; ++jj) { int kp = kb_ + d_ * (vrow0 + 8 * jj); kp = kp < 0 ? 0 : (kp > SEQ - 1 ? SEQ - 1 : kp); \
                  const f16* r_ = base + (size_t)kp * INW + h * 64 + vch0 * 8; kS[jj] = *(const u32x4*)(r_ + C_KA); vA[jj] = *(const u32x4*)(r_ + C_VA); } } } while (0)
#define AA_STEP(tt) do { \
            AA_TQ0 asm volatile("s_waitcnt vmcnt(0)" ::: "memory"); AA_TQ1 \
            LAS unsigned char* vbuf = wl + ((tt) & 1) * AA_BUF; \
            LAS unsigned char* kbuf = wl + 2 * AA_BUF + ((tt) & 1) * AA_KBUF; \
            _Pragma("unroll") for (int jj = 0; jj < 4; ++jj) { *(LAS u32x4*)(vbuf + vw0 + jj * 512) = vA[jj]; *(LAS u32x4*)(kbuf + ((kw0 + jj * 1024) ^ ((jj & 1) << 6))) = kS[jj]; } \
            if ((tt) + 1 < NTILE) { AA_LOADKV((tt) + 1); } \
            AA_PARAMS(tt, d, n); \
            const int kb = P0 - 64 * d + 32 * d * n; \
            f32x16 s = (f32x16){0.f, 0.f, 0.f, 0.f, 0.f, 0.f, 0.f, 0.f, 0.f, 0.f, 0.f, 0.f, 0.f, 0.f, 0.f, 0.f}; \
            _Pragma("unroll") for (int d0 = 0; d0 < 4; ++d0) { const f16x8 kf = *(const LAS f16x8*)(kbuf + kr0 + ((d0 << 5) ^ kx)); s = MFMA32(kf, qr[d0], s); } \
            const float df = (float)d, basef = (float)(d * (32 * n + 4 * hi - 64) - 16 * r32), lim = 64.0f * df; \
            const bool need_range = (kb < 0) || (kb + 31 * d >= SEQ); \
            const float kpf0 = (float)(kb + 4 * hi * d); \
            if (need_range) { \
                _Pragma("unroll") for (int r = 0; r < 16; ++r) { \
                    const float c = (float)((r & 3) + 8 * (r >> 2)); \
                    const float ad = __builtin_fabsf(__builtin_fmaf(df, c, basef)), kpf = __builtin_fmaf(df, c, kpf0); \
                    const bool valid = (ad <= lim) && (kpf >= 0.0f) && (kpf < (float)SEQ); \
                    s[r] = valid ? __builtin_fmaf(-sl2, ad, s[r]) : -INFINITY; } \
            } else { \
                _Pragma("unroll") for (int r = 0; r < 16; ++r) { \
                    const float c = (float)((r & 3) + 8 * (r >> 2)); \
                    const float ad = __builtin_fabsf(__builtin_fmaf(df, c, basef)); \
                    s[r] = (ad <= lim) ? __builtin_fmaf(-sl2, ad, s[r]) : -INFINITY; } \
            } \
            const float mx = rowmax16(s); \
            if (__any(mx > m + AA_THR)) { \
                const float mn = fmaxf(m, mx), al = __builtin_amdgcn_exp2f(m - mn); \
                l *= al; m = mn; \
                if (hi == 0) wsf[r32] = al; \
                _Pragma("unroll") for (int r = 0; r < 16; ++r) { const float f = wsf[crow(r, hi)]; o[0][r] *= f; o[1][r] *= f; } } \
            float ls = 0.f; \
            _Pragma("unroll") for (int r = 0; r < 16; ++r) { s[r] = __builtin_amdgcn_exp2f(s[r] - m); ls += s[r]; } \
            l += ls; \
            u32x4 pw[2]; \
            pw[0] = (u32x4){pk2(s[0], s[1]), pk2(s[2], s[3]), pk2(s[4], s[5]), pk2(s[6], s[7])}; \
            pw[1] = (u32x4){pk2(s[8], s[9]), pk2(s[10], s[11]), pk2(s[12], s[13]), pk2(s[14], s[15])}; \
            const LAS unsigned char* vb = vbuf + vl; \
            _Pragma("unroll") for (int ks = 0; ks < 2; ++ks) _Pragma("unroll") for (int dh = 0; dh < 2; ++dh) { \
                    const f16x4 lo = vtr(vb + dh * AA_HSTR + ks * 1024), hh = vtr(vb + dh * AA_HSTR + ks * 1024 + 512); \
                    const f16x8 vf = (f16x8){lo[0], lo[1], lo[2], lo[3], hh[0], hh[1], hh[2], hh[3]}; \
                    o[dh] = MFMA32(__builtin_bit_cast(f16x8, pw[ks]), vf, o[dh]); } \
        } while (0)
        AA_LOADKV(0);
#pragma unroll 1
        for (int tt = 0; tt < NTILE - 1; tt += 2) { AA_STEP(tt); AA_STEP(tt + 1); }
        AA_STEP(NTILE - 1);
#undef AA_STEP
#undef AA_LOADKV
#undef AA_PARAMS
        l = half_sum(l);
        if (hi == 0) wsf[r32] = 1.0f / l;
#pragma unroll
        for (int r = 0; r < 16; ++r) {
            const float il = wsf[crow(r, hi)];
            f16* op = oa + ((size_t)b * SEQ + P0 + 16 * crow(r, hi)) * 512 + h * 64 + r32;
            op[0] = (f16)(o[0][r] * il); op[32] = (f16)(o[1][r] * il);
        }
    }
#if defined(AA_TIMEQ)
    { const long long t0 = __builtin_readcyclecounter(); while (__builtin_readcyclecounter() - t0 < tacc) __builtin_amdgcn_s_sleep(1); }
#endif
    __syncthreads();
}
constexpr int B2_STGS = 33280, B2_WSF = 4 * B2_STGS, B2_CMX = B2_WSF + 1024;
constexpr float B2_THR = 8.0f, B2_SKIP_T = 40.0f;
constexpr size_t SM_KMAX = 15360, SM_KDONE = 15872, SM_AQ = 16000;

__device__ __forceinline__ void glds16_asm(const void* gsrc, unsigned lds_dst) {
    unsigned keep;
    asm volatile("s_mov_b32 %0, m0\n\ts_mov_b32 m0, %2\n\ts_nop 0\n\tglobal_load_lds_dwordx4 %1, off\n\ts_mov_b32 m0, %0" : "=&s"(keep) : "v"(gsrc), "s"(lds_dst) : "memory");
}
__device__ __forceinline__ void phase_knorm(const Params& p, LAS unsigned char* lds, int wg, int nwg) {
    const int tid = get_tid(lds);
    const int lane = tid & 63;
    const f16* proj = (const f16*)(p.ws + WS_PROJ);
    unsigned* kmax2 = (unsigned*)(p.ws + WS_SMALL + SM_KMAX);
    unsigned* kdone = (unsigned*)(p.ws + WS_SMALL + SM_KDONE);
    const int tpw = TOK / nwg;
    const int t = wg * tpw + (tid >> 2), part = tid & 3;
    float n2[2];
#pragma unroll
    for (int g = 0; g < 2; ++g) {
        const f16* kr = proj + (size_t)t * INW + C_KB + (part * 2 + g) * 64;
        float s = 0.f;
#pragma unroll
        for (int c = 0; c < 8; ++c) { const f16x8 v = *(const f16x8*)(kr + c * 8);
#pragma unroll
            for (int j = 0; j < 8; ++j) s = fmaf((float)v[j], (float)v[j], s); }
        n2[g] = s;
    }
#pragma unroll
    for (int g = 0; g < 2; ++g) { for (int o = 4; o <= 32; o <<= 1) n2[g] = fmaxf(n2[g], shx(n2[g], o, lane)); }
    if (lane < 4) {
        const int b = (wg * tpw) / SEQ;
#pragma unroll
        for (int g = 0; g < 2; ++g) { const int hm = part * 2 + g;
            __hip_atomic_fetch_max(kmax2 + b * 8 + hm, __float_as_uint(n2[g]), __ATOMIC_RELAXED, __HIP_MEMORY_SCOPE_AGENT); }
    }
    asm volatile("s_waitcnt vmcnt(0)" ::: "memory");
    __syncthreads();
    if (tid == 0) __hip_atomic_fetch_add(kdone, 1u, __ATOMIC_RELAXED, __HIP_MEMORY_SCOPE_AGENT);
}

__device__ __forceinline__ void dma8(const void* sbase, const unsigned (&vo)[8], unsigned ldk, unsigned ldv) {
    unsigned keep;
    asm volatile(
        "s_mov_b32 %0, m0\n\t"
        "s_mov_b32 m0, %10\n\ts_nop 0\n\tglobal_load_lds_dwordx4 %2, %1\n\t"
        "s_add_i32 m0, %10, 0x400\n\ts_nop 0\n\tglobal_load_lds_dwordx4 %3, %1\n\t"
        "s_add_i32 m0, %10, 0x4000\n\ts_nop 0\n\tglobal_load_lds_dwordx4 %4, %1\n\t"
        "s_add_i32 m0, %10, 0x4400\n\ts_nop 0\n\tglobal_load_lds_dwordx4 %5, %1\n\t"
        "s_mov_b32 m0, %11\n\ts_nop 0\n\tglobal_load_lds_dwordx4 %6, %1\n\t"
        "s_add_i32 m0, %11, 0x400\n\ts_nop 0\n\tglobal_load_lds_dwordx4 %7, %1\n\t"
        "s_add_i32 m0, %11, 0x800\n\ts_nop 0\n\tglobal_load_lds_dwordx4 %8, %1\n\t"
        "s_add_i32 m0, %11, 0xc00\n\ts_nop 0\n\tglobal_load_lds_dwordx4 %9, %1\n\t"
        "s_mov_b32 m0, %0"
        : "=&s"(keep)
        : "s"(sbase), "v"(vo[0]), "v"(vo[1]), "v"(vo[2]), "v"(vo[3]), "v"(vo[4]), "v"(vo[5]), "v"(vo[6]), "v"(vo[7]), "s"(ldk), "s"(ldv)
        : "memory", "scc");
}

constexpr int B3_VQ = 8256;
constexpr int B3_STG = 32768 + 4 * B3_VQ;
constexpr int B3_WSF = 2 * B3_STG, B3_CMX = B3_WSF + 1024;
__device__ __forceinline__ void phase_attnB3(const Params& p, LAS unsigned char* lds, int wg, int nwg) {
    const int tid = get_tid(lds);
    const int lane = tid & 63, r32 = lane & 31, hi = lane >> 5;
    const int wave = __builtin_amdgcn_readfirstlane(tid >> 6), grp = wave >> 2, qsub = wave & 3;
    const f16* proj = (const f16*)(p.ws + WS_PROJ);
    f16* ob = (f16*)(p.ws + WS_OAB) + (size_t)TOK * 512;
    const float lam = lambda_full(p.in[3], p.in[4], p.in[5], p.in[6], lane);
    const float* subg = p.in[7];
    LAS float* wsf = (LAS float*)(lds + B3_WSF) + wave * 32;
    LAS float* cmx = (LAS float*)(lds + B3_CMX);
    if (tid == 0) { unsigned* kdone = (unsigned*)(p.ws + WS_SMALL + SM_KDONE); unsigned sp = 0;
        while (__hip_atomic_load(kdone, __ATOMIC_RELAXED, __HIP_MEMORY_SCOPE_AGENT) < (unsigned)nwg) { __builtin_amdgcn_s_sleep(2); if (++sp > (1u << 22)) break; } }
    __syncthreads();
    const unsigned* kmax2 = (const unsigned*)(p.ws + WS_SMALL + SM_KMAX);
    const int kx4 = (hi ^ ((r32 >> 1) & 7)) << 4, krow = r32 * 128;
#define KOFF(d0) (krow + (((d0) << 5) ^ kx4))
    const int vl = ((lane >> 4) & 1) * 32 + (lane & 3) * 8 + (4 * hi + ((lane & 15) >> 2)) * 64;
    const unsigned vo_k = (unsigned)((16 * wave + (lane >> 3)) * INW + ((lane & 7) ^ (((16 * wave + (lane >> 3)) >> 1) & 7)) * 8) * 2u;
    const unsigned vo_v = (unsigned)((16 * ((4 * wave) & 7) + (lane >> 2)) * INW + (C_VB - C_KB) + (wave >> 1) * 32 + (lane & 3) * 8) * 2u;
    const unsigned ldk_w = (unsigned)wave * 2048u, ldv_w = 32768u + (unsigned)(wave >> 1) * B3_VQ + (unsigned)(wave & 1) * 4096u;
#ifndef TIMEQ
#define TIMEQ 0
#endif
    long long tacc = 0;
    const unsigned lds0 = (unsigned)(size_t)lds;
    const f32x16 z16 = (f32x16){0.f, 0.f, 0.f, 0.f, 0.f, 0.f, 0.f, 0.f, 0.f, 0.f, 0.f, 0.f, 0.f, 0.f, 0.f, 0.f};

    unsigned* aq = (unsigned*)(p.ws + WS_SMALL + SM_AQ) + (wg & 7);
#pragma unroll 1
    for (;;) {
        if (tid == 0) cmx[8] = __uint_as_float(__hip_atomic_fetch_add(aq, 1u, __ATOMIC_RELAXED, __HIP_MEMORY_SCOPE_AGENT));
        __syncthreads();
        const int u = __builtin_amdgcn_readfirstlane((int)__float_as_uint(cmx[8]));
        if (u >= 128) break;
        const int g8 = wg & 7, h = 3 - (u >> 5), ui = (h - (g8 & 3)) & 3, qb = u & 31;
        const int b = 2 * ui + (g8 >> 2);
        const float sl2 = slope_of(3 * h + 2) * LOG2E;
        const f16* base = proj + (size_t)b * SEQ * INW;
        const int dw = 2 * qb + (qsub >> 1);
        const int qrel = qsub * 32 + r32, qpos = qb * 128 + qrel;
        f16x8 qr[4], ks4[4];
        { int lu = lane; asm volatile("" : "+v"(lu));
          const unsigned qo = (unsigned)((qb * 128 + qsub * 32 + (lu & 31)) * INW + h * 128 + grp * 64 + 8 * (lu >> 5));
#pragma unroll
          for (int d0 = 0; d0 < 4; ++d0) { qr[d0] = *(const f16x8*)(base + qo + C_QB + 16 * d0); ks4[d0] = *(const f16x8*)(base + qo + C_KB + 16 * d0); } }
        float qn2 = 0.f, sii = 0.f;
#pragma unroll
        for (int d0 = 0; d0 < 4; ++d0)
#pragma unroll
            for (int j = 0; j < 8; ++j) { const float qv = (float)qr[d0][j]; qn2 = fmaf(qv, qv, qn2); sii = fmaf(qv, (float)ks4[d0][j], sii); }
        qn2 = half_sum(qn2); sii = half_sum(sii);
        const float kmx = sqrtf(__uint_as_float(__hip_atomic_load(kmax2 + b * 8 + h * 2 + grp, __ATOMIC_RELAXED, __HIP_MEMORY_SCOPE_AGENT)));
        float cb = sqrtf(qn2) * kmx * 1.001f - sii;
        for (int of = 16; of >= 1; of >>= 1) cb = fmaxf(cb, shx(cb, of, lane));
        if (lane == 0) cmx[wave] = cb;
        const float a64 = 64.0f * sl2; const f16 aH = (f16)a64, aL = (f16)(a64 - (float)aH), bH = (f16)sl2, bL = (f16)(sl2 - (float)bH);
        const f16 zz = (f16)0.f;
        const unsigned qx01 = hi == 0 ? __builtin_bit_cast(unsigned, (f16x2){aH, aL}) : 0u, qx23 = hi == 0 ? __builtin_bit_cast(unsigned, (f16x2){bH, bL}) : 0u;
        asm volatile("s_waitcnt lgkmcnt(0)" ::: "memory"); __syncthreads();
        float cmax = cmx[0];
#pragma unroll
        for (int w = 1; w < 8; ++w) cmax = fmaxf(cmax, cmx[w]);
        const float Dm = (cmax + B2_SKIP_T + 1.0f) / sl2;
        int t_lo, t_hi;
        { const float lo = ((float)(qb * 128 - 127) - Dm) * (1.0f / 128.0f), hh = ((float)(qb * 128 + 127) + Dm) * (1.0f / 128.0f);
          t_lo = lo <= 0.f ? 0 : (int)lo; t_hi = hh >= 31.f ? 31 : (int)hh; if (t_lo > qb) t_lo = qb; if (t_hi < qb) t_hi = qb; }
        t_lo = __builtin_amdgcn_readfirstlane(t_lo); t_hi = __builtin_amdgcn_readfirstlane(t_hi);
        const int nL = qb - t_lo, U = 1 + nL + (t_hi - qb);
#define B3_SEQ(pp) ((pp) == 0 ? qb : ((pp) - 1 < nL ? qb - 1 - ((pp) - 1) : qb + 1 + ((pp) - 1 - nL)))
        const f16* gk = base + C_KB + h * 128;
#define B3_ISSUE(pp) do { const int T2_ = B3_SEQ(pp); const unsigned st_ = lds0 + (unsigned)((pp) & 1) * (unsigned)B3_STG; \
            const unsigned vo_[8] = {vo_k, (vo_k + 8u * INW * 2u) ^ 64u, vo_k + 128u, ((vo_k + 8u * INW * 2u) ^ 64u) + 128u,     \
                 vo_v, vo_v + 16u * INW * 2u, vo_v + 32u * INW * 2u, vo_v + 48u * INW * 2u}; \
            dma8(gk + (size_t)T2_ * 128 * INW, vo_, (unsigned)__builtin_amdgcn_readfirstlane(st_ + ldk_w), (unsigned)__builtin_amdgcn_readfirstlane(st_ + ldv_w)); } while (0)
        B3_ISSUE(0);
        f32x16 o[4]; o[0] = z16; o[1] = z16; o[2] = z16; o[3] = z16;
        float m = sii, l = 0.f;
        asm volatile("s_waitcnt vmcnt(0) lgkmcnt(0)\n\ts_barrier" ::: "memory");
#define SBAR() __builtin_amdgcn_sched_barrier(0)
#define PIN(x) asm volatile("" : "+v"(x))
#define B3_QK(S0, S1, T, JJ) do { \
            const LAS unsigned char* kbse = st + grp * 16384 + (JJ) * 8192; \
            const int side = (T) <= dw ? 0 : 1; \
            const float sq = sl2 * (float)qrel; \
            const float mr = side == 0 ? -(m + sq) : -(m - sq); \
            const f16 mH = (f16)mr, mL = (f16)(mr - (float)mH), one = (f16)1.0f; \
            const f16 trel = (f16)(float)((T) - 2 * qb), l0 = (f16)(float)r32, l1 = (f16)(float)(32 + r32); \
            const f16x8 kx0 = hi == 0 ? (f16x8){trel, trel, l0, l0, one, one, zz, zz} : (f16x8){zz, zz, zz, zz, zz, zz, zz, zz}; \
            const f16x8 kx1 = hi == 0 ? (f16x8){trel, trel, l1, l1, one, one, zz, zz} : (f16x8){zz, zz, zz, zz, zz, zz, zz, zz}; \
            u32x4 qxb = (u32x4){qx01, qx23, 0u, 0u}; if (side) { qxb.x ^= 0x80008000u; qxb.y ^= 0x80008000u; } \
            if (hi == 0) qxb.z = __builtin_bit_cast(unsigned, (f16x2){mH, mL}); \
            const f16x8 qx = __builtin_bit_cast(f16x8, qxb); \
            S0 = MFMA32(kx0, qx, z16); S1 = MFMA32(kx1, qx, z16); \
            _Pragma("unroll") for (int d0 = 0; d0 < 4; ++d0) { \
                const f16x8 a0 = *(const LAS f16x8*)(kbse + KOFF(d0)), a1 = *(const LAS f16x8*)(kbse + 4096 + KOFF(d0)); \
                S0 = MFMA32(a0, qr[d0], S0); S1 = MFMA32(a1, qr[d0], S1); } } while (0)
#define B3_FIX(S0, S1, T) do { if ((T) == dw) { const float dq0 = (float)(64 * ((T) - 2 * qb) + 4 * hi - qrel), m2 = -2.0f * sl2; \
            _Pragma("unroll") for (int r = 0; r < 16; ++r) { const float c = (float)((r & 3) + 8 * (r >> 2)); \
                S0[r] = __builtin_fmaf(m2, fmaxf(dq0 + c, 0.f), S0[r]); S1[r] = __builtin_fmaf(m2, fmaxf(dq0 + 32.0f + c, 0.f), S1[r]); } } } while (0)
#define B3_EXP(S0, S1, PW) do { float ls = 0.f; \
            _Pragma("unroll") for (int r = 0; r < 16; ++r) { S0[r] = __builtin_amdgcn_exp2f(S0[r]); S1[r] = __builtin_amdgcn_exp2f(S1[r]); ls += S0[r] + S1[r]; } \
            l += ls; \
            PW[0] = (u32x4){pk2(S0[0], S0[1]), pk2(S0[2], S0[3]), pk2(S0[4], S0[5]), pk2(S0[6], S0[7])}; \
            PW[1] = (u32x4){pk2(S0[8], S0[9]), pk2(S0[10], S0[11]), pk2(S0[12], S0[13]), pk2(S0[14], S0[15])}; \
            PW[2] = (u32x4){pk2(S1[0], S1[1]), pk2(S1[2], S1[3]), pk2(S1[4], S1[5]), pk2(S1[6], S1[7])}; \
            PW[3] = (u32x4){pk2(S1[8], S1[9]), pk2(S1[10], S1[11]), pk2(S1[12], S1[13]), pk2(S1[14], S1[15])}; } while (0)
#define B3_PV(PW, JJ) do { const LAS unsigned char* vb = st + 32768 + (JJ) * 4096 + vl; \
            _Pragma("unroll") for (int ks = 0; ks < 4; ++ks) { _Pragma("unroll") for (int dq = 0; dq < 4; ++dq) { \
                const f16x4 lo = vtr(vb + dq * B3_VQ + ks * 1024), hh = vtr(vb + dq * B3_VQ + ks * 1024 + 512); \
                const f16x8 vf = (f16x8){lo[0], lo[1], lo[2], lo[3], hh[0], hh[1], hh[2], hh[3]}; \
                o[dq] = MFMA32(__builtin_bit_cast(f16x8, PW[ks]), vf, o[dq]); } } } while (0)
#pragma unroll 1
        for (int pp = 0; pp < U; ++pp) {
            if (pp + 1 < U) B3_ISSUE(pp + 1);
#ifdef B3_SKEW
            if (grp) __builtin_amdgcn_s_sleep(B3_SKEW);
#endif
            const LAS unsigned char* st = lds + (pp & 1) * B3_STG;
            const int T2 = B3_SEQ(pp), TA = 2 * T2, TB = 2 * T2 + 1;
            f32x16 a0s, a1s, b0s, b1s; u32x4 pwA[4], pwB[4];
            B3_QK(a0s, a1s, TA, 0);
            __builtin_amdgcn_sched_group_barrier(0x100, 4, 0); __builtin_amdgcn_sched_group_barrier(0x8, 2, 0);
            __builtin_amdgcn_sched_group_barrier(0x8, 2, 0); __builtin_amdgcn_sched_group_barrier(0x100, 2, 0);
            __builtin_amdgcn_sched_group_barrier(0x8, 2, 0); __builtin_amdgcn_sched_group_barrier(0x100, 2, 0);
            __builtin_amdgcn_sched_group_barrier(0x8, 4, 0);
            B3_FIX(a0s, a1s, TA);
            { const float mx = rowmax32(a0s, a1s);
              if (__any(mx > B2_THR)) {
                const float dl = fmaxf(mx, 0.f), al = __builtin_amdgcn_exp2f(-dl);
                m += dl; l *= al;
                if (hi == 0) wsf[r32] = al;
#pragma unroll
                for (int r = 0; r < 16; ++r) { const float f = wsf[crow(r, hi)];
#pragma unroll
                    for (int i = 0; i < 4; ++i) o[i][r] *= f;
                    a0s[r] -= dl; a1s[r] -= dl; }
              } }
            {
                const LAS unsigned char* kbse = st + grp * 16384 + 8192;
                const int side = TB <= dw ? 0 : 1;
                const float sq = sl2 * (float)qrel;
                const float mr = side == 0 ? -(m + sq) : -(m - sq);
                const f16 mH = (f16)mr, mL = (f16)(mr - (float)mH), one = (f16)1.0f;
                const f16 trel = (f16)(float)(TB - 2 * qb), l0 = (f16)(float)r32, l1 = (f16)(float)(32 + r32);
                const f16x8 kx0 = hi == 0 ? (f16x8){trel, trel, l0, l0, one, one, zz, zz} : (f16x8){zz, zz, zz, zz, zz, zz, zz, zz};
                const f16x8 kx1 = hi == 0 ? (f16x8){trel, trel, l1, l1, one, one, zz, zz} : (f16x8){zz, zz, zz, zz, zz, zz, zz, zz};
                u32x4 qxb = (u32x4){qx01, qx23, 0u, 0u}; if (side) { qxb.x ^= 0x80008000u; qxb.y ^= 0x80008000u; }
                if (hi == 0) qxb.z = __builtin_bit_cast(unsigned, (f16x2){mH, mL});
                const f16x8 qx = __builtin_bit_cast(f16x8, qxb);
                f16x8 kf0 = *(const LAS f16x8*)(kbse + KOFF(0)), kf1 = *(const LAS f16x8*)(kbse + 4096 + KOFF(0));
                f16x8 kf2 = *(const LAS f16x8*)(kbse + KOFF(1)), kf3 = *(const LAS f16x8*)(kbse + 4096 + KOFF(1));
                float ls = 0.f;
                SBAR();
#define EX3(S, i0) do { S[i0] = __builtin_amdgcn_exp2f(S[i0]); S[i0 + 1] = __builtin_amdgcn_exp2f(S[i0 + 1]); S[i0 + 2] = __builtin_amdgcn_exp2f(S[i0 + 2]); ls += S[i0]; ls += S[i0 + 1]; ls += S[i0 + 2]; PIN(ls); } while (0)
#define EX4(S, i0) do { S[i0] = __builtin_amdgcn_exp2f(S[i0]); S[i0 + 1] = __builtin_amdgcn_exp2f(S[i0 + 1]); S[i0 + 2] = __builtin_amdgcn_exp2f(S[i0 + 2]); S[i0 + 3] = __builtin_amdgcn_exp2f(S[i0 + 3]); ls += S[i0]; ls += S[i0 + 1]; ls += S[i0 + 2]; ls += S[i0 + 3]; PIN(ls); } while (0)
                b0s = MFMA32(kx0, qx, z16); EX3(a0s, 0); SBAR();
                b1s = MFMA32(kx1, qx, z16); EX3(a0s, 3); SBAR();
                b0s = MFMA32(kf0, qr[0], b0s); kf0 = *(const LAS f16x8*)(kbse + KOFF(2)); EX3(a0s, 6); SBAR();
                b1s = MFMA32(kf1, qr[0], b1s); kf1 = *(const LAS f16x8*)(kbse + 4096 + KOFF(2)); EX3(a0s, 9); SBAR();
                b0s = MFMA32(kf2, qr[1], b0s); kf2 = *(const LAS f16x8*)(kbse + KOFF(3)); EX4(a0s, 12); SBAR();
                b1s = MFMA32(kf3, qr[1], b1s); kf3 = *(const LAS f16x8*)(kbse + 4096 + KOFF(3)); EX4(a1s, 0); SBAR();
                b0s = MFMA32(kf0, qr[2], b0s); EX4(a1s, 4); SBAR();
                b1s = MFMA32(kf1, qr[2], b1s); EX4(a1s, 8); SBAR();
                b0s = MFMA32(kf2, qr[3], b0s); EX4(a1s, 12);
                pwA[0] = (u32x4){pk2(a0s[0], a0s[1]), pk2(a0s[2], a0s[3]), pk2(a0s[4], a0s[5]), pk2(a0s[6], a0s[7])};
                pwA[1] = (u32x4){pk2(a0s[8], a0s[9]), pk2(a0s[10], a0s[11]), pk2(a0s[12], a0s[13]), pk2(a0s[14], a0s[15])};
                SBAR();
                b1s = MFMA32(kf3, qr[3], b1s);
                pwA[2] = (u32x4){pk2(a1s[0], a1s[1]), pk2(a1s[2], a1s[3]), pk2(a1s[4], a1s[5]), pk2(a1s[6], a1s[7])};
                pwA[3] = (u32x4){pk2(a1s[8], a1s[9]), pk2(a1s[10], a1s[11]), pk2(a1s[12], a1s[13]), pk2(a1s[14], a1s[15])};
                SBAR();
                l += ls;
            }
            B3_FIX(b0s, b1s, TB);
            { const float mx = rowmax32(b0s, b1s);
              if (__any(mx > B2_THR)) {
                const float dl = fmaxf(mx, 0.f), al = __builtin_amdgcn_exp2f(-dl);
                m += dl; l *= al;
                if (hi == 0) wsf[r32] = al;
#pragma unroll
                for (int r = 0; r < 16; ++r) { const float f = wsf[crow(r, hi)];
#pragma unroll
                    for (int i = 0; i < 4; ++i) o[i][r] *= f;
                    b0s[r] -= dl; b1s[r] -= dl; a0s[r] *= al; a1s[r] *= al; }
                pwA[0] = (u32x4){pk2(a0s[0], a0s[1]), pk2(a0s[2], a0s[3]), pk2(a0s[4], a0s[5]), pk2(a0s[6], a0s[7])};
                pwA[1] = (u32x4){pk2(a0s[8], a0s[9]), pk2(a0s[10], a0s[11]), pk2(a0s[12], a0s[13]), pk2(a0s[14], a0s[15])};
                pwA[2] = (u32x4){pk2(a1s[0], a1s[1]), pk2(a1s[2], a1s[3]), pk2(a1s[4], a1s[5]), pk2(a1s[6], a1s[7])};
                pwA[3] = (u32x4){pk2(a1s[8], a1s[9]), pk2(a1s[10], a1s[11]), pk2(a1s[12], a1s[13]), pk2(a1s[14], a1s[15])};
              } }
            {
                const LAS unsigned char* vb = st + 32768 + vl;
                float ls = 0.f;
#define VFR_(ks, dq) do { const f16x4 lo_ = vtr(vb + (dq) * B3_VQ + (ks) * 1024), hh_ = vtr(vb + (dq) * B3_VQ + (ks) * 1024 + 512); vnx = (f16x8){lo_[0], lo_[1], lo_[2], lo_[3], hh_[0], hh_[1], hh_[2], hh_[3]}; } while (0)
#define EX2(S, i0) do { S[i0] = __builtin_amdgcn_exp2f(S[i0]); S[i0 + 1] = __builtin_amdgcn_exp2f(S[i0 + 1]); ls += S[i0]; ls += S[i0 + 1]; PIN(ls); } while (0)
                f16x8 vcu, vnx;
                VFR_(0, 0); vcu = vnx; SBAR();
#define PVG(ks, dq, nks, ndq, S, i0) do { VFR_(nks, ndq); o[dq] = MFMA32(__builtin_bit_cast(f16x8, pwA[ks]), vcu, o[dq]); EX2(S, i0); vcu = vnx; SBAR(); } while (0)
                PVG(0, 0, 0, 1, b0s, 0);  PVG(0, 1, 0, 2, b0s, 2);  PVG(0, 2, 0, 3, b0s, 4);  PVG(0, 3, 1, 0, b0s, 6);
                PVG(1, 0, 1, 1, b0s, 8);  PVG(1, 1, 1, 2, b0s, 10); PVG(1, 2, 1, 3, b0s, 12); PVG(1, 3, 2, 0, b0s, 14);
                PVG(2, 0, 2, 1, b1s, 0);  PVG(2, 1, 2, 2, b1s, 2);  PVG(2, 2, 2, 3, b1s, 4);  PVG(2, 3, 3, 0, b1s, 6);
                PVG(3, 0, 3, 1, b1s, 8);  PVG(3, 1, 3, 2, b1s, 10); PVG(3, 2, 3, 3, b1s, 12);
                o[3] = MFMA32(__builtin_bit_cast(f16x8, pwA[3]), vcu, o[3]); EX2(b1s, 14); SBAR();
#undef PVG
#undef VFR_
                l += ls;
                pwB[0] = (u32x4){pk2(b0s[0], b0s[1]), pk2(b0s[2], b0s[3]), pk2(b0s[4], b0s[5]), pk2(b0s[6], b0s[7])};
                pwB[1] = (u32x4){pk2(b0s[8], b0s[9]), pk2(b0s[10], b0s[11]), pk2(b0s[12], b0s[13]), pk2(b0s[14], b0s[15])};
                pwB[2] = (u32x4){pk2(b1s[0], b1s[1]), pk2(b1s[2], b1s[3]), pk2(b1s[4], b1s[5]), pk2(b1s[6], b1s[7])};
                pwB[3] = (u32x4){pk2(b1s[8], b1s[9]), pk2(b1s[10], b1s[11]), pk2(b1s[12], b1s[13]), pk2(b1s[14], b1s[15])};
            }
            B3_PV(pwB, 1);
            __builtin_amdgcn_sched_group_barrier(0x100, 4, 3);
#pragma unroll
            for (int i = 0; i < 14; ++i) { __builtin_amdgcn_sched_group_barrier(0x8, 1, 3); __builtin_amdgcn_sched_group_barrier(0x100, 2, 3); }
            __builtin_amdgcn_sched_group_barrier(0x8, 2, 3);
#if TIMEQ == 1
            { const long long tq0 = __builtin_readcyclecounter(); asm volatile("s_waitcnt vmcnt(0)" ::: "memory"); tacc += __builtin_readcyclecounter() - tq0; }
#endif
#if TIMEQ == 2
            asm volatile("s_waitcnt vmcnt(0)" ::: "memory");
            const long long tq0 = __builtin_readcyclecounter();
#endif
            asm volatile("s_waitcnt vmcnt(0) lgkmcnt(0)\n\ts_barrier" ::: "memory");
#if TIMEQ == 2
            tacc += __builtin_readcyclecounter() - tq0;
#endif
        }
#undef B3_QK
#undef SBAR
#undef PIN
#undef EX2
#undef EX3
#undef EX4
#undef B3_FIX
#undef B3_EXP
#undef B3_PV
#undef B3_ISSUE
#undef B3_SEQ
        l = half_sum(l);
        if (hi == 0) wsf[r32] = 1.0f / l;
        LAS float* ost = (LAS float*)lds + (size_t)grp * 128 * 128;
#pragma unroll
        for (int r = 0; r < 16; ++r) { const float il = wsf[crow(r, hi)]; const int row = qsub * 32 + crow(r, hi);
#pragma unroll
            for (int i = 0; i < 4; ++i) ost[row * 128 + i * 32 + r32] = o[i][r] * il; }
        __syncthreads();
        {
            const LAS float* o1 = (const LAS float*)lds; const LAS float* o2 = o1 + 128 * 128;
            int l2 = lane; asm volatile("" : "+v"(l2));
            const float g0s = subg[l2], g1s = subg[64 + l2];
            for (int rr = 0; rr < 16; ++rr) {
                const int row = wave * 16 + rr;
                const float v0 = o1[row * 128 + l2] - lam * o2[row * 128 + l2], v1 = o1[row * 128 + 64 + l2] - lam * o2[row * 128 + 64 + l2];
                float ss = v0 * v0 + v1 * v1;
                for (int of = 32; of >= 1; of >>= 1) ss += shx(ss, of, lane);
                const float rs = rsqrtf(ss * (1.0f / 128.0f) + 1e-5f) * (1.0f - LAMBDA_INIT);
                f16* op = ob + ((size_t)b * SEQ + qb * 128 + row) * 512 + h * 128;
                op[l2] = (f16)(v0 * rs * g0s); op[64 + l2] = (f16)(v1 * rs * g1s);
            }
        }
        __syncthreads();
    }
#if TIMEQ
    { const long long t0 = __builtin_readcyclecounter(); while (__builtin_readcyclecounter() - t0 < tacc) __builtin_amdgcn_s_sleep(1); }
    __syncthreads();
#endif
#undef KOFF
}
#define XB_TMO      128
#define XB_XCNT(j)  (256  + 64 * (j))
#define XB_XSUB(j)  (1280 + 64 * (j))
#define XB_XGEN(j)  (2304 + 64 * (j))
#define XB_TOP      3328
#define XB_TOPGEN   3392
#define XCD_BAR_WORDS 3456
#define XB_SPIN_CAP (1u << 20)
__device__ __forceinline__ unsigned xb_ld(unsigned* p)              { return __hip_atomic_load(p, __ATOMIC_RELAXED, __HIP_MEMORY_SCOPE_AGENT); }
__device__ __forceinline__ unsigned xb_add(unsigned* p, unsigned v) { return __hip_atomic_fetch_add(p, v, __ATOMIC_RELAXED, __HIP_MEMORY_SCOPE_AGENT); }
__device__ __forceinline__ unsigned xb_xcc_id() { return (unsigned)__builtin_amdgcn_s_getreg((3 << 11) | 20) & 0xFu; }
#define XB_SPIN(cond, bar) do { unsigned _sp = 0; while (cond) { __builtin_amdgcn_s_sleep(1); \
    if ((++_sp & 255u) == 0u) { if (xb_ld(&(bar)[XB_TMO])) break; if (_sp > XB_SPIN_CAP) { atomicAdd(&(bar)[XB_TMO], 1u); break; } } } } while (0)
__device__ __forceinline__ void xcd_barrier_post(unsigned* bar, int tid) { if (tid == 0) (void)xb_add(&bar[XB_XCNT(xb_xcc_id())], 1u); }
__device__ __forceinline__ void xcd_barrier_complete(unsigned* bar, unsigned x, unsigned& nloc, unsigned& nx) {
    const unsigned G = gridDim.x;
    unsigned sum, cnt, mine, sp = 0u;
    for (;;) {
        sum = 0u; cnt = 0u; mine = 0u;
#pragma unroll
        for (unsigned j = 0; j < 16; ++j) { const unsigned c = xb_ld(&bar[XB_XCNT(j)]); sum += c; cnt += (c > 0u) ? 1u : 0u; mine = (j == x) ? c : mine; }
        if (sum == G) break;
        __builtin_amdgcn_s_sleep(1);
        if ((++sp & 255u) == 0u) { if (xb_ld(&bar[XB_TMO])) break; if (sp > XB_SPIN_CAP) { atomicAdd(&bar[XB_TMO], 1u); break; } }
    }
    nloc = mine > 0u ? mine : 1u; nx = cnt > 0u ? cnt : 1u;
}
__device__ __forceinline__ void xcd_barrier(unsigned* bar, volatile LAS unsigned* st, LAS unsigned char* lds) {
    const int tid = get_tid(lds);
    asm volatile("s_waitcnt vmcnt(0)" ::: "memory");
    __syncthreads();
    if (tid == 0) {
        const unsigned x = xb_xcc_id();
        __builtin_amdgcn_s_waitcnt(0);
        unsigned nloc = st[0], nx = st[1];
        if (nloc == 0u) { xcd_barrier_complete(bar, x, nloc, nx); st[0] = nloc; st[1] = nx; }
        const unsigned old = xb_add(&bar[XB_XSUB(x)], 1u);
        const unsigned gen = old / nloc;
        if (old + 1u == (gen + 1u) * nloc) {
            __builtin_amdgcn_fence(__ATOMIC_RELEASE, "agent");
            asm volatile("s_waitcnt vmcnt(0)" ::: "memory");
            const unsigned og = xb_add(&bar[XB_TOP], 1u);
            const unsigned tg = og / nx;
            if (og + 1u == (tg + 1u) * nx) xb_add(&bar[XB_TOPGEN], 1u);
            else XB_SPIN(xb_ld(&bar[XB_TOPGEN]) == tg, bar);
            __builtin_amdgcn_fence(__ATOMIC_ACQUIRE, "agent");
            xb_add(&bar[XB_XGEN(x)], 1u);
            asm volatile("s_waitcnt vmcnt(0)" ::: "memory");
        } else {
            XB_SPIN(xb_ld(&bar[XB_XGEN(x)]) == gen, bar);
            __builtin_amdgcn_fence(__ATOMIC_ACQUIRE, "agent");
            asm volatile("s_waitcnt vmcnt(0)" ::: "memory");
        }
    }
    __syncthreads();
}
constexpr int LDS_BARST = LDS_TOTAL - 16;
constexpr size_t SM_BAR = 1024;
__global__ void __launch_bounds__(NTHR, 2) k_mega(Params p) {
    extern __shared__ __attribute__((aligned(16))) unsigned char smem[];
    LAS unsigned char* lds = (LAS unsigned char*)smem;
    const int wg = blockIdx.x, nwg = gridDim.x;
    volatile LAS unsigned* st = (volatile LAS unsigned*)(lds + LDS_BARST);
    { const unsigned hw = (unsigned)__builtin_amdgcn_s_getreg((5 << 11) | 4) & 63u; if ((threadIdx.x & 63) == 0) ((LAS int*)(lds + LDS_WTAB))[hw] = (int)(threadIdx.x >> 6); }
    if (threadIdx.x == 0) { st[0] = 0u; st[1] = 0u; put_params(p, lds); }
    __syncthreads();
    xcd_barrier_post((unsigned*)(get_params(lds).ws + WS_SMALL + SM_BAR), get_tid(lds));
#define GRID_SYNC() xcd_barrier((unsigned*)(get_params(lds).ws + WS_SMALL + SM_BAR), st, lds)
#ifndef TIMEPH
#define TIMEPH 0
#endif
    long long tph = 0;
#define TPH2(n, call) do { if (TIMEPH == (n) || TIMEPH == 11) { const long long t0_ = __builtin_readcyclecounter(); call; tph += __builtin_readcyclecounter() - t0_; } else { call; } } while (0)
#define TPH(n, call) do { if (TIMEPH == (n)) { const long long t0_ = __builtin_readcyclecounter(); call; tph += __builtin_readcyclecounter() - t0_; } else { call; } } while (0)
    TPH(1, phase_prep(get_params(lds), lds, wg, nwg));      TPH2(21, GRID_SYNC());
    TPH(2, phase_inproj(get_params(lds), lds, wg, nwg));    TPH2(22, GRID_SYNC());
    TPH(10, phase_knorm(get_params(lds), lds, wg, nwg));
    TPH(3, phase_attnA(get_params(lds), lds, wg, nwg));
    TPH(4, phase_attnB3(get_params(lds), lds, wg, nwg));
    TPH2(23, GRID_SYNC());
#ifdef EXTRA_SYNC
    GRID_SYNC(); GRID_SYNC(); GRID_SYNC(); GRID_SYNC();
#endif
    TPH(5, phase_merge(get_params(lds), lds, wg, nwg));     TPH2(24, GRID_SYNC());
    TPH(6, phase_outproj(get_params(lds), lds, wg, nwg));   TPH2(25, GRID_SYNC());
    TPH(12, phase_router(get_params(lds), lds, wg, nwg));   TPH2(26, GRID_SYNC());
    TPH(7, phase_up(get_params(lds), lds, wg, nwg));        TPH2(27, GRID_SYNC());
    TPH(8, phase_down(get_params(lds), lds, wg, nwg));      TPH2(28, GRID_SYNC());
    TPH(9, phase_final(get_params(lds), lds, wg, nwg));
    if (TIMEPH) { const long long t0_ = __builtin_readcyclecounter(); while (__builtin_readcyclecounter() - t0_ < tph) __builtin_amdgcn_s_sleep(1); }
#undef TPH
#undef GRID_SYNC
}
}

extern "C" void kernel_launch(void* const* d_in, const int* in_sizes, int n_in, void* d_out, int out_size, void* d_ws, size_t ws_size,
                              hipStream_t stream) {
    static int grid_blocks = 0;
    if (grid_blocks == 0) {
        int dev = 0, cus = 0, per_cu = 0;
        if (hipGetDevice(&dev) != hipSuccess || hipDeviceGetAttribute(&cus, hipDeviceAttributeMultiprocessorCount, dev) != hipSuccess) { fprintf(stderr, "kernel_launch: device query failed\n"); grid_blocks = -1; return; }
        if (hipFuncSetAttribute((const void*)k_mega, hipFuncAttributeMaxDynamicSharedMemorySize, LDS_TOTAL) != hipSuccess) { fprintf(stderr, "kernel_launch: hipFuncSetAttribute failed\n"); grid_blocks = -1; return; }
        if (hipOccupancyMaxActiveBlocksPerMultiprocessor(&per_cu, (const void*)k_mega, NTHR, LDS_TOTAL) != hipSuccess || per_cu < 1) { fprintf(stderr, "kernel_launch: occupancy query says %d blocks/CU\n", per_cu); grid_blocks = -1; return; }
        grid_blocks = cus * per_cu;
        if (grid_blocks > NWG) grid_blocks = NWG;
        if (grid_blocks != NWG) { fprintf(stderr, "kernel_launch: need %d co-resident workgroups, device offers %d\n", NWG, grid_blocks); grid_blocks = -1; return; }
        if (ws_size < WS_END) { fprintf(stderr, "kernel_launch: workspace too small (%zu < %zu)\n", ws_size, (size_t)WS_END); grid_blocks = -1; return; }
    }
    if (grid_blocks < 0) return;
    Params p{};
    for (int i = 0; i < 22; ++i) p.in[i] = (const float*)d_in[i];
    p.out = (float*)d_out; p.ws = (unsigned char*)d_ws;
    if (hipMemsetAsync((char*)d_ws + WS_SMALL, 0, 16384, stream) != hipSuccess) { fprintf(stderr, "kernel_launch: memset failed\n"); return; }
    void* args[] = {&p};
    hipError_t e = hipLaunchCooperativeKernel((const void*)k_mega, dim3(grid_blocks), dim3(NTHR), args, LDS_TOTAL, stream);
    if (e != hipSuccess) fprintf(stderr, "kernel_launch: cooperative launch failed: %s (grid %d)\n", hipGetErrorString(e), grid_blocks);
}
```

```cpp
#include <hip/hip_runtime.h>
#include <hip/hip_cooperative_groups.h>
#include <stdint.h>
#include <stdio.h>

namespace {
constexpr int NB = 8, SEQ = 4096, DM = 1024, TOK = NB * SEQ;
constexpr int INW = 5120;
constexpr int C_QA = 0, C_KA = 512, C_VA = 1024, C_QB = 1536, C_KB = 2048, C_VB = 2560, C_GA = 3072, C_GB = 4096;
constexpr int NEXP = 32, TOPK = 4, NASG = TOK * TOPK;
constexpr float ALPHA = 1.189207115002721f;
constexpr float LAMBDA_INIT = 0.2f;
constexpr float LOG2E = 1.4426950408889634f;
constexpr size_t MiB = 1048576;

__device__ __forceinline__ float sigmoidf_(float x) { return 1.0f / (1.0f + __expf(-x)); }
__device__ __forceinline__ float slope_of(int idx) { return exp2f(-8.0f * (float)(idx + 1) / 12.0f); }
#define LAS __attribute__((address_space(3)))
typedef _Float16 f16;
typedef _Float16 f16x8 __attribute__((ext_vector_type(8)));
typedef _Float16 f16x4 __attribute__((ext_vector_type(4)));
typedef _Float16 f16x2 __attribute__((ext_vector_type(2)));
typedef float f32x4 __attribute__((ext_vector_type(4)));
typedef float f32x16 __attribute__((ext_vector_type(16)));
typedef unsigned u32x4 __attribute__((ext_vector_type(4)));
typedef unsigned u32x2 __attribute__((ext_vector_type(2)));

constexpr int NTHR = 512, NWG = 256;
constexpr int BM = 256, BK = 64, HALF = 128, HTB = HALF * BK * 2, STAGE_BYTES = 8 * HTB;
constexpr int LDS_MISC = STAGE_BYTES;
constexpr int LDS_TOTAL = 155648;
constexpr float QSCALE = 0.125f * 1.4426950408889634f;
constexpr int ROWPAD = 256;
constexpr int MOE_ROWS = NASG + NEXP * ROWPAD;
constexpr int LISTCAP = TOK;


constexpr int LDS_WTAB = LDS_TOTAL - 16 - 256;
__device__ __forceinline__ int get_tid(LAS unsigned char* lds) {
    const unsigned hw = (unsigned)__builtin_amdgcn_s_getreg((5 << 11) | 4) & 63u;
    const int wave = __builtin_amdgcn_readfirstlane(((LAS int*)(lds + LDS_WTAB))[hw]);
    int lane; asm volatile("v_mbcnt_lo_u32_b32 %0, -1, 0\n\tv_mbcnt_hi_u32_b32 %0, -1, %0" : "=v"(lane));
    int t = wave * 64 + lane; asm volatile("" : "+v"(t));
    return t;
}
__device__ __forceinline__ float shx(float v, int mask, int lane) { return __int_as_float(__builtin_amdgcn_ds_bpermute((lane ^ mask) << 2, __float_as_int(v))); }
__device__ __forceinline__ unsigned pk2(float a, float b) { f16x2 v; v.x = (f16)a; v.y = (f16)b; return __builtin_bit_cast(unsigned, v); }
__device__ __forceinline__ int lds_byte(int r, int c) { const int st = (r >> 4) * 2 + (c >> 5), rr = r & 15, cc = c & 31, ob = rr * 64 + cc * 2; return st * 1024 + (ob ^ (((ob >> 9) & 1) << 5)); }
__device__ __forceinline__ void stage_rc(int b, int& R, int& C) { const int st = b / 1024, sb = b % 1024, swz = sb ^ (((sb >> 9) & 1) << 5); R = (st >> 1) * 16 + swz / 64; C = (st & 1) * 32 + (swz % 64) / 2; }
__device__ __forceinline__ int perm32(int rho) { const int n = rho >> 4, i = rho & 15; return 8 * (i >> 2) + 4 * n + (i & 3); }

struct Unit { int pm, pn, e, row0, nrows; };

template <int K_>
struct DenseSched {
    static constexpr int K = K_;
    const char* A; const char* Bt; int nM, nN, nwg, G, c;
    __device__ void init(const void* A_, const void* Bt_, int M, int N, int G_, int c_) { A = (const char*)A_; Bt = (const char*)Bt_; nM = M / BM; nN = N / BM; nwg = nM * nN; G = G_; c = c_; }
    __device__ __forceinline__ bool next(int i, Unit& u) const {
        const long L = (long)i * G + c; if (L >= nwg) return false;
        int wgid = (int)L; { const int q = nwg / 8, r = nwg % 8, xcd = wgid % 8, off = wgid / 8; wgid = (xcd < r ? xcd * (q + 1) : r * (q + 1) + (xcd - r) * q) + off; }
        const int nig = 8 * nN, gid = wgid / nig, fm = gid * 8, gsz = (nM - fm) < 8 ? (nM - fm) : 8;
        u.pm = fm + ((wgid % nig) % gsz); u.pn = (wgid % nig) / gsz; u.e = 0; u.row0 = u.pm * BM; u.nrows = BM; return true;
    }
    static constexpr int LDB = K_, MID = -1;
    static __device__ __forceinline__ unsigned ka(int kt) { return (unsigned)kt * 128u; }
    static __device__ __forceinline__ unsigned kb(int kt) { return (unsigned)kt * 128u; }
    static __device__ __forceinline__ unsigned make_rc(int R, int C) { return (unsigned)(R * K + C) * 2u; }
    __device__ __forceinline__ void a_desc(const Unit& u, const unsigned (&rc)[2], unsigned (&ad)[2]) const { ad[0] = rc[0] + (unsigned)u.pm * (unsigned)(BM * K * 2); ad[1] = rc[1] + (unsigned)u.pm * (unsigned)(BM * K * 2); }
    static __device__ __forceinline__ unsigned aoff(unsigned ad, unsigned rc, int h) { return ad + (unsigned)h * (unsigned)(HALF * K * 2); }
    __device__ __forceinline__ const char* b_base(const Unit& u) const { return Bt + (size_t)u.pn * BM * K * 2; }
};

template <class Sched, class Epi>
__device__ __forceinline__ void gemm_phase(LAS unsigned char* lds, const Sched& S, const Epi& E) {
    constexpr int K = Sched::K, nt = K / BK;
    const int tid = get_tid(lds);
    const int wid = __builtin_amdgcn_readfirstlane(tid >> 6), lane = tid & 63, wr = wid >> 2, wc = wid & 3, fr = lane & 15, fq = lane >> 4;
    unsigned rc[2], voffB[2];
#pragma unroll
    for (int i = 0; i < 2; ++i) { int R, C; stage_rc(tid * 16 + i * 8192, R, C); const int Rb = Epi::PERM ? ((R & ~31) + perm32(R & 31)) : R; voffB[i] = (unsigned)(Rb * Sched::LDB + C) * 2u; rc[i] = Sched::make_rc(R, C); }
    constexpr unsigned hstepB = HALF * Sched::LDB * 2;
    const unsigned ldsw = (unsigned)wid * 1024u;
    const int aoff = lds_byte(wr * 64 + fr, fq * 8), boff = lds_byte(wc * 32 + fr, fq * 8);
#define G_SA(b, h) (((b) * 2 + (h)) * HTB)
#define G_SB(b, h) ((4 + (b) * 2 + (h)) * HTB)
#define G_STAGE_A(bufoff, ad, h, kb) do { \
        __builtin_amdgcn_global_load_lds((const unsigned*)(Abase + (size_t)Sched::aoff((ad)[0], rc[0], h) + (kb)), (LAS unsigned*)(lds + (bufoff) + ldsw), 16, 0, 0); \
        __builtin_amdgcn_global_load_lds((const unsigned*)(Abase + (size_t)Sched::aoff((ad)[1], rc[1], h) + (kb)), (LAS unsigned*)(lds + (bufoff) + ldsw + 8192), 16, 0, 0); } while (0)
#define G_STAGE_B(bufoff, gbase) do { _Pragma("unroll") for (int _i = 0; _i < 2; ++_i) \
        __builtin_amdgcn_global_load_lds((const unsigned*)((const char*)(gbase) + voffB[_i]), (LAS unsigned*)(lds + (bufoff) + ldsw + _i * 8192), 16, 0, 0); } while (0)
#define G_LDA(dst, b, h) do { _Pragma("unroll") for (int m = 0; m < 4; ++m) _Pragma("unroll") for (int k = 0; k < 2; ++k) dst[m][k] = *(const LAS f16x8*)(lds + G_SA(b, h) + aoff + m * 2048 + k * 1024); } while (0)
#define G_LDB(dst, b, h) do { _Pragma("unroll") for (int n = 0; n < 2; ++n) _Pragma("unroll") for (int k = 0; k < 2; ++k) dst[n][k] = *(const LAS f16x8*)(lds + G_SB(b, h) + boff + n * 2048 + k * 1024); } while (0)
#define G_MMA(ai, bj, At, Bt) do { __builtin_amdgcn_s_setprio(1); _Pragma("unroll") for (int m = 0; m < 4; ++m) _Pragma("unroll") for (int n = 0; n < 2; ++n) _Pragma("unroll") for (int k = 0; k < 2; ++k) \
        acc[ai][bj][m][n] = __builtin_amdgcn_mfma_f32_16x16x32_f16(Bt[n][k], At[m][k], acc[ai][bj][m][n], 0, 0, 0); __builtin_amdgcn_s_setprio(0); } while (0)
#define G_WAIT_V(n) asm volatile("s_waitcnt vmcnt(" #n ")" ::: "memory")
#define G_WAIT_L(n) asm volatile("s_waitcnt lgkmcnt(" #n ")" ::: "memory")
#define G_BAR __builtin_amdgcn_s_barrier()
#define G_SCHED __builtin_amdgcn_sched_barrier(0)
    Unit cur, nxt; int ui = 0;
    if (!S.next(0, cur)) return;
    f32x4 acc[2][2][4][2];
#pragma unroll
    for (int a = 0; a < 2; ++a)
#pragma unroll
        for (int b = 0; b < 2; ++b)
#pragma unroll
            for (int m = 0; m < 4; ++m)
#pragma unroll
                for (int n = 0; n < 2; ++n) acc[a][b][m][n] = (f32x4){0.f, 0.f, 0.f, 0.f};
    f16x8 At[4][2], B0[2][2], B1[2][2];
    const char* const Abase = S.A;
    unsigned cad[2], nad[2];
    S.a_desc(cur, rc, cad);
    const char* cB = S.b_base(cur);
    G_STAGE_B(G_SB(0, 0), cB); G_STAGE_B(G_SB(0, 1), cB + hstepB); G_STAGE_A(G_SA(0, 0), cad, 0, 0u); G_STAGE_A(G_SA(0, 1), cad, 1, 0u);
    if (wr == 1) G_BAR;
    G_WAIT_V(2); G_BAR;
    G_STAGE_B(G_SB(1, 0), cB + Sched::kb(1)); G_STAGE_A(G_SA(1, 0), cad, 0, Sched::ka(1)); G_STAGE_B(G_SB(1, 1), cB + hstepB + Sched::kb(1));
    G_WAIT_V(6); G_BAR;
    for (;;) {
        const bool has_next = S.next(ui + 1, nxt);
        const char* nB = cB;
        if (has_next) { S.a_desc(nxt, rc, nad); nB = S.b_base(nxt); }
        else { nad[0] = cad[0]; nad[1] = cad[1]; }
        for (int t = 0; t < nt; t += 2) {
            const bool last = (t == nt - 2);
            const unsigned k1 = Sched::ka(t + 1);
            const unsigned k2 = last ? Sched::ka(0) : Sched::ka(t + 2), k3 = last ? Sched::ka(1) : Sched::ka(t + 3);
            const unsigned a2[2] = {last ? nad[0] : cad[0], last ? nad[1] : cad[1]};
            const char* b2 = (last ? nB + Sched::kb(0) : cB + Sched::kb(t + 2)); const char* b3 = (last ? nB + Sched::kb(1) : cB + Sched::kb(t + 3));
            if constexpr (Sched::MID >= 0) { if (t == Sched::MID) E.mid(acc, cur, wr, wc, fr, fq); }
            G_LDB(B0, 0, 0); G_LDB(B1, 0, 1); G_SCHED; G_LDA(At, 0, 0); G_STAGE_A(G_SA(1, 1), cad, 1, k1);
            G_WAIT_V(8); G_WAIT_L(0); G_BAR; G_MMA(0, 0, At, B0); G_MMA(0, 1, At, B1); G_BAR; G_SCHED;
            G_LDA(At, 0, 1); G_STAGE_B(G_SB(0, 0), b2); G_STAGE_B(G_SB(0, 1), b2 + hstepB); G_STAGE_A(G_SA(0, 0), a2, 0, k2);
            G_WAIT_V(8); G_WAIT_L(0); G_BAR; G_MMA(1, 0, At, B0); G_MMA(1, 1, At, B1); G_BAR; G_SCHED;
            G_LDB(B0, 1, 0); G_LDB(B1, 1, 1); G_SCHED; G_LDA(At, 1, 0); G_STAGE_A(G_SA(0, 1), a2, 1, k2);
            G_WAIT_V(8); G_WAIT_L(0); G_BAR; G_MMA(0, 0, At, B0); G_MMA(0, 1, At, B1); G_BAR; G_SCHED;
            G_LDA(At, 1, 1); G_STAGE_B(G_SB(1, 0), b3); G_STAGE_B(G_SB(1, 1), b3 + hstepB); G_STAGE_A(G_SA(1, 0), a2, 0, k3);
            G_WAIT_V(8); G_WAIT_L(0); G_BAR; G_MMA(1, 0, At, B0); G_MMA(1, 1, At, B1); G_BAR; G_SCHED;
        }
        if (wr == 0) G_BAR;
        E(acc, cur, wr, wc, fr, fq);
        if (!has_next) break;
#pragma unroll
        for (int a = 0; a < 2; ++a)
#pragma unroll
            for (int b = 0; b < 2; ++b)
#pragma unroll
                for (int m = 0; m < 4; ++m)
#pragma unroll
                    for (int n = 0; n < 2; ++n) acc[a][b][m][n] = (f32x4){0.f, 0.f, 0.f, 0.f};
        cur = nxt; cB = nB; ++ui; cad[0] = nad[0]; cad[1] = nad[1];
        if (wr == 1) G_BAR;
    }
    G_WAIT_V(0);
    G_BAR;
#undef G_SA
#undef G_SB
#undef G_STAGE_A
#undef G_STAGE_B
#undef G_LDA
#undef G_LDB
#undef G_MMA
#undef G_WAIT_V
#undef G_WAIT_L
#undef G_BAR
#undef G_SCHED
}
constexpr size_t WS_WIN = 0;
constexpr size_t WS_WPA = WS_WIN + (size_t)INW * DM * 2;
constexpr size_t WS_WPB = WS_WPA + (size_t)DM * 512 * 2;
constexpr size_t WS_WOUT = WS_WPB + (size_t)DM * 512 * 2;
constexpr size_t WS_WUP = WS_WOUT + (size_t)DM * DM * 2;
constexpr size_t WS_WDN = WS_WUP + (size_t)NEXP * 2048 * DM * 2;
constexpr size_t WS_XH = WS_WDN + (size_t)NEXP * DM * DM * 2;
constexpr size_t WS_PROJ = WS_XH + (size_t)TOK * DM * 2;
constexpr size_t WS_OAB = WS_PROJ + (size_t)TOK * INW * 2;
constexpr size_t WS_MERGED = WS_OAB + (size_t)TOK * DM * 2;
constexpr size_t WS_H1 = WS_MERGED + (size_t)TOK * DM * 2;
constexpr size_t WS_SMALL = WS_H1 + (size_t)TOK * DM * 4 + 16 * MiB;
constexpr size_t WS_YS = WS_OAB;
constexpr size_t SM_PQ = 16064;
constexpr size_t SM_CNT = 0, SM_TK = 16384, SM_LIST = SM_TK + (size_t)NASG * 4;
constexpr size_t WS_END = WS_SMALL + SM_LIST + (size_t)NEXP * LISTCAP * 8;
static_assert(WS_YS + (size_t)MOE_ROWS * DM * 2 <= WS_SMALL, "ys overlaps bookkeeping");
static_assert((size_t)MOE_ROWS * DM * 2 <= (size_t)TOK * INW * 2, "act does not fit over proj");
static_assert(WS_END <= 1024 * MiB, "workspace");

struct Params {
    const float* in[22]; float* out; unsigned char* ws;
};

constexpr int LDS_PARAMS = LDS_WTAB - 256;
__device__ __forceinline__ unsigned long long rfl64(unsigned long long v) {
    const unsigned lo = (unsigned)__builtin_amdgcn_readfirstlane((int)(unsigned)v), hi = (unsigned)__builtin_amdgcn_readfirstlane((int)(unsigned)(v >> 32));
    return ((unsigned long long)hi << 32) | lo; }
__device__ __forceinline__ Params get_params(LAS unsigned char* lds) {
    unsigned off = LDS_PARAMS; asm volatile("" : "+v"(off));
    const LAS unsigned long long* q = (const LAS unsigned long long*)(lds + off);
    Params p;
#pragma unroll
    for (int i = 0; i < 22; ++i) p.in[i] = (const float*)rfl64(q[i]);
    p.out = (float*)rfl64(q[22]); p.ws = (unsigned char*)rfl64(q[23]);
    return p;
}
__device__ __forceinline__ void put_params(const Params& p, LAS unsigned char* lds) {
    LAS unsigned long long* q = (LAS unsigned long long*)(lds + LDS_PARAMS);
#pragma unroll
    for (int i = 0; i < 22; ++i) q[i] = (unsigned long long)p.in[i];
    q[22] = (unsigned long long)p.out; q[23] = (unsigned long long)p.ws;
}


struct PrepTile { const float* src; int ldsrc; f16* dst; int K; int n0; };
__device__ __forceinline__ PrepTile prep_desc(const Params& p, int t) {
    unsigned char* ws = p.ws;
    constexpr int T_IN = (INW / 64) * (DM / 128), T_PA = (DM / 64) * (512 / 128), T_OUT = (DM / 64) * (DM / 128);
    constexpr int T_UP1 = (2048 / 64) * (DM / 128), T_DN1 = (DM / 64) * (DM / 128);
    constexpr int T0 = T_IN, T1 = T0 + T_PA, T2 = T1 + T_PA, T3 = T2 + T_OUT, T4 = T3 + NEXP * T_UP1;
    PrepTile d;
    if (t < T0) { const int tn = t / 8, tk = t % 8; d.src = p.in[1] + (size_t)(tk * 128) * INW + tn * 64; d.ldsrc = INW; d.dst = (f16*)(ws + WS_WIN) + tk * 128; d.K = DM; d.n0 = tn * 64; }
    else if (t < T1) { const int q = t - T0, tn = q / 4, tk = q % 4; d.src = p.in[8] + (size_t)(tk * 128) * DM + tn * 64; d.ldsrc = DM; d.dst = (f16*)(ws + WS_WPA) + tk * 128; d.K = 512; d.n0 = tn * 64; }
    else if (t < T2) { const int q = t - T1, tn = q / 4, tk = q % 4; d.src = p.in[9] + (size_t)(tk * 128) * DM + tn * 64; d.ldsrc = DM; d.dst = (f16*)(ws + WS_WPB) + tk * 128; d.K = 512; d.n0 = tn * 64; }
    else if (t < T3) { const int q = t - T2, tn = q / 8, tk = q % 8; d.src = p.in[10] + (size_t)(tk * 128) * DM + tn * 64; d.ldsrc = DM; d.dst = (f16*)(ws + WS_WOUT) + tk * 128; d.K = DM; d.n0 = tn * 64; }
    else if (t < T4) { const int q = t - T3, e = q / T_UP1, r = q % T_UP1, tn = r / 8, tk = r % 8;
        const int np = tn * 64, pn = np >> 8, jj = np & 255;
        const int sc = jj < 128 ? pn * 128 + jj : 1024 + pn * 128 + (jj - 128);
        d.src = p.in[16] + (size_t)e * DM * 2048 + (size_t)(tk * 128) * 2048 + sc; d.ldsrc = 2048; d.dst = (f16*)(ws + WS_WUP) + (size_t)e * 2048 * DM + tk * 128; d.K = DM; d.n0 = np; }
    else { const int q = t - T4, e = q / T_DN1, r = q % T_DN1, tn = r / 8, tk = r % 8;
        d.src = p.in[18] + (size_t)e * DM * DM + (size_t)(tk * 128) * DM + tn * 64; d.ldsrc = DM; d.dst = (f16*)(ws + WS_WDN) + (size_t)e * DM * DM + tk * 128; d.K = DM; d.n0 = tn * 64; }
    return d;
}
constexpr int PREP_NT = (INW / 64) * (DM / 128) + 2 * (DM / 64) * (512 / 128) + (DM / 64) * (DM / 128) + NEXP * ((2048 / 64) * (DM / 128) + (DM / 64) * (DM / 128));
__device__ __forceinline__ void phase_prep(const Params& p, LAS unsigned char* lds, int wg, int nwg) {
    const int tid = get_tid(lds);
    unsigned char* ws = p.ws;
    {
        const float4* src = (const float4*)p.in[0]; u32x4* dst = (u32x4*)(ws + WS_XH);
        constexpr size_t n8 = (size_t)TOK * DM / 8;
        const size_t stride = (size_t)nwg * NTHR;
        for (size_t i = (size_t)wg * NTHR + tid; i < n8; i += 4 * stride) {
            float4 a[4], c[4];
#pragma unroll
            for (int u = 0; u < 4; ++u) { { const f32x4 t0_ = __builtin_nontemporal_load((const f32x4*)(src + 2 * (i + u * stride))), t1_ = __builtin_nontemporal_load((const f32x4*)(src + 2 * (i + u * stride) + 1)); a[u] = make_float4(t0_[0], t0_[1], t0_[2], t0_[3]); c[u] = make_float4(t1_[0], t1_[1], t1_[2], t1_[3]); } }
#pragma unroll
            for (int u = 0; u < 4; ++u) { u32x4 w; w.x = pk2(a[u].x, a[u].y); w.y = pk2(a[u].z, a[u].w); w.z = pk2(c[u].x, c[u].y); w.w = pk2(c[u].z, c[u].w); dst[i + u * stride] = w; }
        }
    }
    LAS float* tile = (LAS float*)lds;
    const int lk = tid >> 4, ln4 = (tid & 15) * 4;
    float4 va[4], vb[4];
#define PREP_LOAD(V, tt) do { if ((tt) < PREP_NT) { const PrepTile d_ = prep_desc(p, (tt)); \
        _Pragma("unroll") for (int j = 0; j < 4; ++j) { const f32x4 t_ = __builtin_nontemporal_load((const f32x4*)(d_.src + (size_t)(lk + 32 * j) * d_.ldsrc + ln4)); V[j] = make_float4(t_[0], t_[1], t_[2], t_[3]); } } } while (0)
#define PREP_DO2(V, tt, tnext) do { if ((tt) < PREP_NT) { const PrepTile d = prep_desc(p, (tt)); \
        _Pragma("unroll") for (int j = 0; j < 4; ++j) { LAS float* r = tile + (lk + 32 * j) * 65 + ln4; r[0] = V[j].x; r[1] = V[j].y; r[2] = V[j].z; r[3] = V[j].w; } \
        PREP_LOAD(V, (tnext)); \
        __syncthreads(); \
        { const int n = tid >> 3, kc = (tid & 7) * 16; u32x4 w0, w1; \
          w0.x = pk2(tile[(kc + 0) * 65 + n], tile[(kc + 1) * 65 + n]); w0.y = pk2(tile[(kc + 2) * 65 + n], tile[(kc + 3) * 65 + n]); \
          w0.z = pk2(tile[(kc + 4) * 65 + n], tile[(kc + 5) * 65 + n]); w0.w = pk2(tile[(kc + 6) * 65 + n], tile[(kc + 7) * 65 + n]); \
          w1.x = pk2(tile[(kc + 8) * 65 + n], tile[(kc + 9) * 65 + n]); w1.y = pk2(tile[(kc + 10) * 65 + n], tile[(kc + 11) * 65 + n]); \
          w1.z = pk2(tile[(kc + 12) * 65 + n], tile[(kc + 13) * 65 + n]); w1.w = pk2(tile[(kc + 14) * 65 + n], tile[(kc + 15) * 65 + n]); \
          f16* o = d.dst + (size_t)(d.n0 + n) * d.K + kc; *(u32x4*)o = w0; *(u32x4*)(o + 8) = w1; } \
        __syncthreads(); } } while (0)
    unsigned* pq = (unsigned*)(ws + WS_SMALL + SM_PQ);
    LAS int* qslot = (LAS int*)(lds + 36864);
    int ta, tb;
    if (tid == 0) { qslot[0] = (int)__hip_atomic_fetch_add(pq, 1u, __ATOMIC_RELAXED, __HIP_MEMORY_SCOPE_AGENT); qslot[1] = (int)__hip_atomic_fetch_add(pq, 1u, __ATOMIC_RELAXED, __HIP_MEMORY_SCOPE_AGENT); }
    __syncthreads();
    ta = qslot[0]; tb = qslot[1];
    PREP_LOAD(va, ta); PREP_LOAD(vb, tb);
#define PREP_DRAW(tv) do { __syncthreads(); if (tid == 0) qslot[0] = (int)__hip_atomic_fetch_add(pq, 1u, __ATOMIC_RELAXED, __HIP_MEMORY_SCOPE_AGENT); __syncthreads(); tv = qslot[0]; } while (0)
#pragma unroll 1
    for (;;) {
        if (ta >= PREP_NT && tb >= PREP_NT) break;
        int tn;
        if (ta < PREP_NT) { PREP_DRAW(tn); PREP_DO2(va, ta, tn); ta = tn; }
        if (tb < PREP_NT) { PREP_DRAW(tn); PREP_DO2(vb, tb, tn); tb = tn; }
    }
#undef PREP_DRAW
#undef PREP_LOAD
#undef PREP_DO2
}

struct EpiInProj {
    static constexpr bool PERM = true;
    f16* O; const float* bias;
    __device__ __forceinline__ void operator()(const f32x4 (&acc)[2][2][4][2], const Unit& u, int wr, int wc, int fr, int fq) const {
        const int row0 = u.pm * BM + wr * 64 + fr, col0 = u.pn * BM + wc * 32 + 8 * fq;
        const int cls = u.pn;
        const float scl = (cls < 2 || cls == 6 || cls == 7) ? QSCALE : 1.0f;
        const bool sig = cls >= 12;
        f32x4 bv[2][2];
#pragma unroll
        for (int bj = 0; bj < 2; ++bj)
#pragma unroll
            for (int n = 0; n < 2; ++n) bv[bj][n] = *(const f32x4*)(bias + col0 + bj * HALF + 4 * n);
#pragma unroll
        for (int ai = 0; ai < 2; ++ai)
#pragma unroll
            for (int m = 0; m < 4; ++m) {
                f16* rowp = O + (size_t)(row0 + ai * HALF + m * 16) * INW + col0;
#pragma unroll
                for (int bj = 0; bj < 2; ++bj) {
                    f32x4 v0 = acc[ai][bj][m][0] + bv[bj][0], v1 = acc[ai][bj][m][1] + bv[bj][1];
                    if (sig) {
#pragma unroll
                        for (int j = 0; j < 4; ++j) { v0[j] = __builtin_amdgcn_rcpf(1.0f + __expf(-v0[j])); v1[j] = __builtin_amdgcn_rcpf(1.0f + __expf(-v1[j])); }
                    } else { v0 *= scl; v1 *= scl; }
                    u32x4 w; w.x = pk2(v0[0], v0[1]); w.y = pk2(v0[2], v0[3]); w.z = pk2(v1[0], v1[1]); w.w = pk2(v1[2], v1[3]);
                    *(u32x4*)(rowp + bj * HALF) = w;
                }
            }
    }
};
__device__ __forceinline__ void phase_inproj(const Params& p, LAS unsigned char* lds, int wg, int nwg) {
    DenseSched<DM> S; S.init(p.ws + WS_XH, p.ws + WS_WIN, TOK, INW, nwg, wg);
    EpiInProj E{(f16*)(p.ws + WS_PROJ), p.in[2]};
    gemm_phase(lds, S, E);
}
constexpr int RT_LOG = 131072, RT_HIST = RT_LOG + 16384;
__device__ __forceinline__ void phase_router(const Params& p, LAS unsigned char* lds, int wg, int nwg) {
    const int tid = get_tid(lds);
    const int lane = tid & 63, wave = tid >> 6;
    const float* h1 = (const float*)(p.ws + WS_H1);
    f16* x1h = (f16*)(p.ws + WS_XH);
    const float* lng = p.in[12]; const float* lnb = p.in[13];
    const float* wr = p.in[14]; const float* br = p.in[15];
    int* cnt = (int*)(p.ws + WS_SMALL + SM_CNT);
    int* tk = (int*)(p.ws + WS_SMALL + SM_TK);
    int2* list = (int2*)(p.ws + WS_SMALL + SM_LIST);
    LAS float* wl = (LAS float*)lds;
    LAS float* slog = (LAS float*)(lds + RT_LOG);
    LAS int* hist = (LAS int*)(lds + RT_HIST);
    LAS int* hbase = hist + 32;
    for (int i = tid; i < DM * 8; i += NTHR) {
        const int col = i >> 3, k = i & 7;
        const float4 v = *(const float4*)(wr + (size_t)col * NEXP + k * 4);
        LAS float* d = wl + col * 32 + ((k ^ ((col >> 1) & 7)) << 2);
        d[0] = v.x; d[1] = v.y; d[2] = v.z; d[3] = v.w;
    }
    if (tid < 32) hist[tid] = 0;
    __syncthreads();
    const int tpw = TOK / (nwg * 8);
    const int tok0 = wg * (TOK / nwg) + wave * tpw;
    float gam[16], bet[16];
#pragma unroll
    for (int r = 0; r < 16; ++r) { gam[r] = lng[r * 64 + lane]; bet[r] = lnb[r * 64 + lane]; }
    float xa[16], xb[16];
#pragma unroll
    for (int r = 0; r < 16; ++r) { xa[r] = h1[(size_t)tok0 * DM + r * 64 + lane]; xb[r] = h1[(size_t)(tok0 + 1) * DM + r * 64 + lane]; }
#pragma unroll 1
    for (int j = 0; j < tpw; j += 2) {
        const int t = tok0 + j;
        float na[16], nb[16];
        if (j + 2 < tpw) {
#pragma unroll
            for (int r = 0; r < 16; ++r) { na[r] = h1[(size_t)(t + 2) * DM + r * 64 + lane]; nb[r] = h1[(size_t)(t + 3) * DM + r * 64 + lane]; }
        } else {
#pragma unroll
            for (int r = 0; r < 16; ++r) { na[r] = 0.f; nb[r] = 0.f; }
        }
        float sa = 0.f, sb = 0.f;
#pragma unroll
        for (int r = 0; r < 16; ++r) { sa += xa[r]; sb += xb[r]; }
        for (int o = 32; o >= 1; o >>= 1) { sa += shx(sa, o, lane); sb += shx(sb, o, lane); }
        const float mua = sa * (1.0f / DM), mub = sb * (1.0f / DM);
        float qa = 0.f, qb = 0.f;
#pragma unroll
        for (int r = 0; r < 16; ++r) { const float da = xa[r] - mua, db = xb[r] - mub; qa += da * da; qb += db * db; }
        for (int o = 32; o >= 1; o >>= 1) { qa += shx(qa, o, lane); qb += shx(qb, o, lane); }
        const float rsa = rsqrtf(qa * (1.0f / DM) + 1e-5f), rsb = rsqrtf(qb * (1.0f / DM) + 1e-5f);
#pragma unroll
        for (int r = 0; r < 16; ++r) {
            xa[r] = (xa[r] - mua) * rsa * gam[r] + bet[r]; xb[r] = (xb[r] - mub) * rsb * gam[r] + bet[r];
            x1h[(size_t)t * DM + r * 64 + lane] = (f16)xa[r]; x1h[(size_t)(t + 1) * DM + r * 64 + lane] = (f16)xb[r];
        }
        typedef float f32x2 __attribute__((ext_vector_type(2)));
        f32x2 ac2[16], ad2[16];
#pragma unroll
        for (int e = 0; e < 16; ++e) { ac2[e] = (f32x2){0.f, 0.f}; ad2[e] = (f32x2){0.f, 0.f}; }
#pragma unroll
        for (int r = 0; r < 16; ++r) {
            const int col = r * 64 + lane;
            const LAS float* wrow = wl + col * 32;
            const int sw = (col >> 1) & 7;
            const f32x2 xa2 = (f32x2){xa[r], xa[r]}, xb2 = (f32x2){xb[r], xb[r]};
#pragma unroll
            for (int k = 0; k < 8; ++k) {
                const f32x4 w4 = *(const LAS f32x4*)(wrow + ((k ^ sw) << 2));
                const f32x2 wlo = (f32x2){w4[0], w4[1]}, whi = (f32x2){w4[2], w4[3]};
                ac2[2 * k] = __builtin_elementwise_fma(xa2, wlo, ac2[2 * k]); ac2[2 * k + 1] = __builtin_elementwise_fma(xa2, whi, ac2[2 * k + 1]);
                ad2[2 * k] = __builtin_elementwise_fma(xb2, wlo, ad2[2 * k]); ad2[2 * k + 1] = __builtin_elementwise_fma(xb2, whi, ad2[2 * k + 1]);
            }
        }
        float acc[32], acd[32];
#pragma unroll
        for (int e = 0; e < 16; ++e) { acc[2 * e] = ac2[e][0]; acc[2 * e + 1] = ac2[e][1]; acd[2 * e] = ad2[e][0]; acd[2 * e + 1] = ad2[e][1]; }
#define RT_REDUCE(AC, OUT) do { float a16[16], a8[8], a4[4], a2[2]; \
        { const bool hi_ = (lane & 32) != 0; _Pragma("unroll") for (int k = 0; k < 16; ++k) { const float snd = hi_ ? AC[k] : AC[16 + k]; const float rcv = shx(snd, 32, lane); a16[k] = (hi_ ? AC[16 + k] : AC[k]) + rcv; } } \
        { const bool hi_ = (lane & 16) != 0; _Pragma("unroll") for (int k = 0; k < 8; ++k) { const float snd = hi_ ? a16[k] : a16[8 + k]; const float rcv = shx(snd, 16, lane); a8[k] = (hi_ ? a16[8 + k] : a16[k]) + rcv; } } \
        { const bool hi_ = (lane & 8) != 0; _Pragma("unroll") for (int k = 0; k < 4; ++k) { const float snd = hi_ ? a8[k] : a8[4 + k]; const float rcv = shx(snd, 8, lane); a4[k] = (hi_ ? a8[4 + k] : a8[k]) + rcv; } } \
        { const bool hi_ = (lane & 4) != 0; _Pragma("unroll") for (int k = 0; k < 2; ++k) { const float snd = hi_ ? a4[k] : a4[2 + k]; const float rcv = shx(snd, 4, lane); a2[k] = (hi_ ? a4[2 + k] : a4[k]) + rcv; } } \
        { const bool hi_ = (lane & 2) != 0; const float snd = hi_ ? a2[0] : a2[1]; const float rcv = shx(snd, 2, lane); OUT = (hi_ ? a2[1] : a2[0]) + rcv; } \
        OUT += shx(OUT, 1, lane); } while (0)
        float l0, l1;
        RT_REDUCE(acc, l0); RT_REDUCE(acd, l1);
#undef RT_REDUCE
        if ((lane & 1) == 0) { const float bb = br[lane >> 1]; slog[(wave * tpw + j) * 32 + (lane >> 1)] = l0 + bb; slog[(wave * tpw + j + 1) * 32 + (lane >> 1)] = l1 + bb; }
#pragma unroll
        for (int r = 0; r < 16; ++r) { xa[r] = na[r]; xb[r] = nb[r]; }
    }
    __syncthreads();
    int my_e[4]; float my_g[4]; int my_loc[4];
    const bool act = lane < tpw;
    const int tl = wave * tpw + lane;
    if (act) {
        float v[32];
#pragma unroll
        for (int k = 0; k < 8; ++k) { const f32x4 t4 = *(const LAS f32x4*)(slog + tl * 32 + k * 4); v[k * 4] = t4[0]; v[k * 4 + 1] = t4[1]; v[k * 4 + 2] = t4[2]; v[k * 4 + 3] = t4[3]; }
        float tv[4];
#pragma unroll
        for (int k = 0; k < 4; ++k) {
            float bv = -3.0e38f; int bi = 0;
#pragma unroll
            for (int e = 0; e < 32; ++e) { if (v[e] > bv) { bv = v[e]; bi = e; } }
            tv[k] = bv; my_e[k] = bi;
#pragma unroll
            for (int e = 0; e < 32; ++e) v[e] = (e == bi) ? -3.0e38f : v[e];
        }
        const float e1 = __expf(tv[1] - tv[0]), e2 = __expf(tv[2] - tv[0]), e3 = __expf(tv[3] - tv[0]);
        const float inv = 1.0f / (1.0f + e1 + e2 + e3);
        my_g[0] = inv; my_g[1] = e1 * inv; my_g[2] = e2 * inv; my_g[3] = e3 * inv;
#pragma unroll
        for (int k = 0; k < 4; ++k) my_loc[k] = __hip_atomic_fetch_add(hist + my_e[k], 1, __ATOMIC_RELAXED, __HIP_MEMORY_SCOPE_WORKGROUP);
    }
    __syncthreads();
    if (tid < 32) hbase[tid] = atomicAdd(&cnt[tid], hist[tid]);
    __syncthreads();
    if (act) {
        const int t = tok0 + lane;
#pragma unroll
        for (int k = 0; k < 4; ++k) {
            const int slot = hbase[my_e[k]] + my_loc[k];
            tk[t * 4 + k] = (my_e[k] << 20) | slot;
            list[(size_t)my_e[k] * LISTCAP + slot] = make_int2(t, __float_as_int(my_g[k]));
        }
    }
    __syncthreads();
}

__device__ __forceinline__ void phase_final(const Params& p, LAS unsigned char* lds, int wg, int nwg) {
    const int tid = get_tid(lds);
    const int lane = tid & 63, wave = tid >> 6;
    const f16* x1h = (const f16*)(p.ws + WS_XH);
    const f16* ys = (const f16*)(p.ws + WS_YS);
    const int* cnt = (const int*)(p.ws + WS_SMALL + SM_CNT);
    const int* tk = (const int*)(p.ws + WS_SMALL + SM_TK);
    const float* lng = p.in[20]; const float* lnb = p.in[21];
    LAS int* ps = (LAS int*)lds;
    if (tid == 0) { int a = 0; for (int e = 0; e < NEXP; ++e) { ps[e] = a; a += (cnt[e] + ROWPAD - 1) / ROWPAD * ROWPAD; } }
    __syncthreads();
    const int tpw = TOK / (nwg * 8);
    const int tok0 = wg * (TOK / nwg) + wave * tpw;
    float gm[16], bt[16];
#pragma unroll
    for (int hh = 0; hh < 2; ++hh) { const int c0 = hh * 512 + 8 * lane;
        const float4 g0 = *(const float4*)(lng + c0), g1 = *(const float4*)(lng + c0 + 4), b0 = *(const float4*)(lnb + c0), b1 = *(const float4*)(lnb + c0 + 4);
        gm[hh * 8 + 0] = g0.x; gm[hh * 8 + 1] = g0.y; gm[hh * 8 + 2] = g0.z; gm[hh * 8 + 3] = g0.w; gm[hh * 8 + 4] = g1.x; gm[hh * 8 + 5] = g1.y; gm[hh * 8 + 6] = g1.z; gm[hh * 8 + 7] = g1.w;
        bt[hh * 8 + 0] = b0.x; bt[hh * 8 + 1] = b0.y; bt[hh * 8 + 2] = b0.z; bt[hh * 8 + 3] = b0.w; bt[hh * 8 + 4] = b1.x; bt[hh * 8 + 5] = b1.y; bt[hh * 8 + 6] = b1.z; bt[hh * 8 + 7] = b1.w; }
    f16x8 ra[5], rb[5];
#define FN_LOAD(t_) do { ra[0] = *(const f16x8*)(x1h + (size_t)(t_) * DM + 8 * lane); rb[0] = *(const f16x8*)(x1h + (size_t)(t_) * DM + 512 + 8 * lane); \
        _Pragma("unroll") for (int k = 0; k < 4; ++k) { const int c = tk[(t_) * 4 + k]; const int row = ps[c >> 20] + (c & 0xFFFFF); \
            ra[1 + k] = *(const f16x8*)(ys + (size_t)row * DM + 8 * lane); rb[1 + k] = *(const f16x8*)(ys + (size_t)row * DM + 512 + 8 * lane); } } while (0)
    FN_LOAD(tok0);
#pragma unroll 1
    for (int j = 0; j < tpw; ++j) {
        const int t = tok0 + j;
        float v[16];
#pragma unroll
        for (int i = 0; i < 8; ++i) { v[i] = ALPHA * (float)ra[0][i]; v[8 + i] = ALPHA * (float)rb[0][i]; }
#pragma unroll
        for (int k = 1; k < 5; ++k)
#pragma unroll
            for (int i = 0; i < 8; ++i) { v[i] += (float)ra[k][i]; v[8 + i] += (float)rb[k][i]; }
        if (j + 1 < tpw) FN_LOAD(t + 1);
        float s = 0.f;
#pragma unroll
        for (int i = 0; i < 16; ++i) s += v[i];
        for (int o = 32; o >= 1; o >>= 1) s += shx(s, o, lane);
        const float mu = s * (1.0f / DM);
        float q = 0.f;
#pragma unroll
        for (int i = 0; i < 16; ++i) { const float d = v[i] - mu; q += d * d; }
        for (int o = 32; o >= 1; o >>= 1) q += shx(q, o, lane);
        const float rs = rsqrtf(q * (1.0f / DM) + 1e-5f);
        float* op = p.out + (size_t)t * DM;
#pragma unroll
        for (int hh = 0; hh < 2; ++hh) {
            const int c0 = hh * 512 + 8 * lane;
            float4 o0, o1;
            o0.x = (v[hh * 8 + 0] - mu) * rs * gm[hh * 8 + 0] + bt[hh * 8 + 0]; o0.y = (v[hh * 8 + 1] - mu) * rs * gm[hh * 8 + 1] + bt[hh * 8 + 1];
            o0.z = (v[hh * 8 + 2] - mu) * rs * gm[hh * 8 + 2] + bt[hh * 8 + 2]; o0.w = (v[hh * 8 + 3] - mu) * rs * gm[hh * 8 + 3] + bt[hh * 8 + 3];
            o1.x = (v[hh * 8 + 4] - mu) * rs * gm[hh * 8 + 4] + bt[hh * 8 + 4]; o1.y = (v[hh * 8 + 5] - mu) * rs * gm[hh * 8 + 5] + bt[hh * 8 + 5];
            o1.z = (v[hh * 8 + 6] - mu) * rs * gm[hh * 8 + 6] + bt[hh * 8 + 6]; o1.w = (v[hh * 8 + 7] - mu) * rs * gm[hh * 8 + 7] + bt[hh * 8 + 7];
            *(float4*)(op + c0) = o0; *(float4*)(op + c0 + 4) = o1;
        }
    }
#undef FN_LOAD
    __syncthreads();
}
struct MergeSched {
    static constexpr int K = 1024, LDB = 512, MID = 8;
    static constexpr unsigned OB_JUMP = (unsigned)(TOK * 512 * 2) - 1024u, WB_JUMP = (unsigned)(DM * 512 * 2) - 1024u;
    const char* A; const char* Bt; DenseSched<512> D;
    __device__ void init(const void* oa, const void* wpa_t, int G, int c) { A = (const char*)oa; Bt = (const char*)wpa_t; D.init(oa, wpa_t, TOK, DM, G, c); }
    __device__ __forceinline__ bool next(int i, Unit& u) const { return D.next(i, u); }
    static __device__ __forceinline__ unsigned ka(int kt) { return (unsigned)kt * 128u + (kt >= 8 ? OB_JUMP : 0u); }
    static __device__ __forceinline__ unsigned kb(int kt) { return (unsigned)kt * 128u + (kt >= 8 ? WB_JUMP : 0u); }
    static __device__ __forceinline__ unsigned make_rc(int R, int C) { return (unsigned)(R * 512 + C) * 2u; }
    __device__ __forceinline__ void a_desc(const Unit& u, const unsigned (&rc)[2], unsigned (&ad)[2]) const { const unsigned o = (unsigned)u.pm * (unsigned)(BM * 512 * 2); ad[0] = rc[0] + o; ad[1] = rc[1] + o; }
    static __device__ __forceinline__ unsigned aoff(unsigned ad, unsigned rc, int h) { return ad + (unsigned)h * (unsigned)(HALF * 512 * 2); }
    __device__ __forceinline__ const char* b_base(const Unit& u) const { return Bt + (size_t)u.pn * BM * 512 * 2; }
};
struct EpiMerge {
    static constexpr bool PERM = true;
    const f16* proj; f16* merged;
    __device__ __forceinline__ void mid(f32x4 (&acc)[2][2][4][2], const Unit& u, int wr, int wc, int fr, int fq) const {
        asm volatile("" : "+v"(fr), "+v"(fq));
        const int row0 = u.pm * BM + wr * 64 + fr, col0 = u.pn * BM + wc * 32 + 8 * fq;
#pragma unroll
        for (int ai = 0; ai < 2; ++ai)
#pragma unroll
            for (int m = 0; m < 4; ++m) {
                const size_t row = (size_t)(row0 + ai * HALF + m * 16);
#pragma unroll
                for (int bj = 0; bj < 2; ++bj) {
                    const f16x8 ga = *(const f16x8*)(proj + row * INW + C_GA + col0 + bj * HALF), gb = *(const f16x8*)(proj + row * INW + C_GB + col0 + bj * HALF);
#pragma unroll
                    for (int j = 0; j < 4; ++j) {
                        acc[ai][bj][m][0][j] *= (float)ga[j] * __builtin_amdgcn_rcpf(fmaxf((float)gb[j], 5.9604645e-8f));
                        acc[ai][bj][m][1][j] *= (float)ga[4 + j] * __builtin_amdgcn_rcpf(fmaxf((float)gb[4 + j], 5.9604645e-8f));
                    }
                }
                asm volatile("" ::: "memory");
            }
    }
    __device__ __forceinline__ void operator()(const f32x4 (&acc)[2][2][4][2], const Unit& u, int wr, int wc, int fr, int fq) const {
        const int row0 = u.pm * BM + wr * 64 + fr, col0 = u.pn * BM + wc * 32 + 8 * fq;
#pragma unroll
        for (int ai = 0; ai < 2; ++ai)
#pragma unroll
            for (int m = 0; m < 4; ++m) {
                const size_t row = (size_t)(row0 + ai * HALF + m * 16);
#pragma unroll
                for (int bj = 0; bj < 2; ++bj) {
                    const f16x8 gb = *(const f16x8*)(proj + row * INW + C_GB + col0 + bj * HALF);
                    float v[8];
#pragma unroll
                    for (int j = 0; j < 4; ++j) { v[j] = fmaxf((float)gb[j], 5.9604645e-8f) * acc[ai][bj][m][0][j]; v[4 + j] = fmaxf((float)gb[4 + j], 5.9604645e-8f) * acc[ai][bj][m][1][j]; }
                    u32x4 w; w.x = pk2(v[0], v[1]); w.y = pk2(v[2], v[3]); w.z = pk2(v[4], v[5]); w.w = pk2(v[6], v[7]);
                    *(u32x4*)(merged + row * DM + col0 + bj * HALF) = w;
                }
            }
    }
};
__device__ __forceinline__ void phase_merge(const Params& p, LAS unsigned char* lds, int wg, int nwg) {
    MergeSched S; S.init(p.ws + WS_OAB, p.ws + WS_WPA, nwg, wg);
    EpiMerge E{(const f16*)(p.ws + WS_PROJ), (f16*)(p.ws + WS_MERGED)};
    gemm_phase(lds, S, E);
}
struct EpiOutProj {
    static constexpr bool PERM = false;
    const float* x; const float* bias; float* h1;
    __device__ __forceinline__ void operator()(const f32x4 (&acc)[2][2][4][2], const Unit& u, int wr, int wc, int fr, int fq) const {
        const int row0 = u.pm * BM + wr * 64 + fr, col0 = u.pn * BM + wc * 32 + 4 * fq;
        f32x4 bv[2][2];
#pragma unroll
        for (int bj = 0; bj < 2; ++bj)
#pragma unroll
            for (int n = 0; n < 2; ++n) bv[bj][n] = *(const f32x4*)(bias + col0 + bj * HALF + n * 16);
#pragma unroll
        for (int ai = 0; ai < 2; ++ai)
#pragma unroll
            for (int m = 0; m < 4; ++m) {
                const size_t off = (size_t)(row0 + ai * HALF + m * 16) * DM + col0;
#pragma unroll
                for (int bj = 0; bj < 2; ++bj)
#pragma unroll
                    for (int n = 0; n < 2; ++n) {
                        const f32x4 xv = *(const f32x4*)(x + off + bj * HALF + n * 16);
                        *(f32x4*)(h1 + off + bj * HALF + n * 16) = ALPHA * xv + acc[ai][bj][m][n] + bv[bj][n];
                    }
            }
    }
};
__device__ __forceinline__ void phase_outproj(const Params& p, LAS unsigned char* lds, int wg, int nwg) {
    DenseSched<DM> S; S.init(p.ws + WS_MERGED, p.ws + WS_WOUT, TOK, DM, nwg, wg);
    EpiOutProj E{p.in[0], p.in[11], (float*)(p.ws + WS_H1)};
    gemm_phase(lds, S, E);
}

constexpr int MOE_MISC = STAGE_BYTES;
__device__ __forceinline__ void moe_prefix(const Params& p, LAS unsigned char* lds) {
    LAS int* tpre = (LAS int*)(lds + MOE_MISC); LAS int* ecnt = tpre + 64;
    const int* cnt = (const int*)(p.ws + WS_SMALL + SM_CNT);
    if (get_tid(lds) == 0) { int a = 0; for (int e = 0; e < NEXP; ++e) { const int c = cnt[e]; ecnt[e] = c; tpre[e] = a; a += (c + ROWPAD - 1) / ROWPAD; } tpre[NEXP] = a; }
    __syncthreads();
}
template <int NPN, bool GATHER>
struct MoeSched {
    static constexpr int K = DM;
    const char* A; const char* Bt; const int2* list; LAS int* tpre; LAS int* ecnt; int c;
    __device__ __forceinline__ bool next(int i, Unit& u) const {
        constexpr int MPR = 256 / NPN, MPX = 32 / NPN;
        const int xcd = c & 7, j = c >> 3;
        const int M = i * MPR + xcd * MPX + j / NPN;
        if (M >= tpre[NEXP]) return false;
        int e = 0;
        for (int k = 1; k < NEXP; ++k) e += (tpre[k] <= M) ? 1 : 0;
        u.e = e; u.pm = M - tpre[e]; u.pn = j % NPN; u.row0 = M * ROWPAD; u.nrows = ecnt[e] - u.pm * ROWPAD;
        return true;
    }
    static constexpr int LDB = DM, MID = -1;
    static __device__ __forceinline__ unsigned ka(int kt) { return (unsigned)kt * 128u; }
    static __device__ __forceinline__ unsigned kb(int kt) { return (unsigned)kt * 128u; }
    static __device__ __forceinline__ unsigned make_rc(int R, int C) { return GATHER ? ((unsigned)R | ((unsigned)(2 * C) << 8)) : (unsigned)(R * K + C) * 2u; }
    __device__ __forceinline__ void a_desc(const Unit& u, const unsigned (&rc)[2], unsigned (&ad)[2]) const {
        if (GATHER) {
#pragma unroll
            for (int i = 0; i < 2; ++i) {
                const int R = (int)(rc[i] & 0xFFu);
                const int2* lp = list + (size_t)u.e * LISTCAP + u.pm * ROWPAD + R;
                int t0 = lp[0].x, t1 = lp[HALF].x;
                t0 = R < u.nrows ? t0 : 0; t1 = (R + HALF) < u.nrows ? t1 : 0;
                ad[i] = (unsigned)t0 | ((unsigned)t1 << 16);
            }
            asm volatile("" : "+v"(ad[0]), "+v"(ad[1]));
        } else { ad[0] = rc[0] + (unsigned)u.row0 * (unsigned)(K * 2); ad[1] = rc[1] + (unsigned)u.row0 * (unsigned)(K * 2); }
    }
    static __device__ __forceinline__ unsigned aoff(unsigned ad, unsigned rc, int h) {
        return GATHER ? (((ad >> (16 * h)) & 0xFFFFu) * (unsigned)(K * 2) + (rc >> 8)) : (ad + (unsigned)h * (unsigned)(HALF * K * 2)); }
    __device__ __forceinline__ const char* b_base(const Unit& u) const { return Bt + ((size_t)u.e * (NPN * BM) + (size_t)u.pn * BM) * K * 2; }
};
struct EpiUp {
    static constexpr bool PERM = true;
    const float* bup; f16* act;
    __device__ __forceinline__ void operator()(const f32x4 (&acc)[2][2][4][2], const Unit& u, int wr, int wc, int fr, int fq) const {
        const int col0 = u.pn * HALF + wc * 32 + 8 * fq;
        const float* bg = bup + (size_t)u.e * 2048 + col0; const float* bu = bg + 1024;
        const f32x4 bg0 = *(const f32x4*)bg, bg1 = *(const f32x4*)(bg + 4), bu0 = *(const f32x4*)bu, bu1 = *(const f32x4*)(bu + 4);
#pragma unroll
        for (int ai = 0; ai < 2; ++ai)
#pragma unroll
            for (int m = 0; m < 4; ++m) {
                const size_t row = (size_t)(u.row0 + ai * HALF + wr * 64 + m * 16 + fr);
                float v[8];
#pragma unroll
                for (int n = 0; n < 2; ++n)
#pragma unroll
                    for (int j = 0; j < 4; ++j) {
                        const float hg = acc[ai][0][m][n][j] + (n == 0 ? bg0[j] : bg1[j]), hu = acc[ai][1][m][n][j] + (n == 0 ? bu0[j] : bu1[j]);
                        const float gate = fminf(hg, 7.0f), up = fminf(fmaxf(hu, -7.0f), 7.0f);
                        v[n * 4 + j] = gate * __builtin_amdgcn_rcpf(1.0f + __expf(-1.702f * gate)) * (up + 1.0f);
                    }
                u32x4 w; w.x = pk2(v[0], v[1]); w.y = pk2(v[2], v[3]); w.z = pk2(v[4], v[5]); w.w = pk2(v[6], v[7]);
                *(u32x4*)(act + row * DM + col0) = w;
            }
    }
};
struct EpiDown {
    static constexpr bool PERM = true;
    const float* bdn; const int2* list; f16* ys;
    __device__ __forceinline__ void operator()(const f32x4 (&acc)[2][2][4][2], const Unit& u, int wr, int wc, int fr, int fq) const {
        const int col0 = u.pn * BM + wc * 32 + 8 * fq;
        f32x4 bv[2][2];
#pragma unroll
        for (int bj = 0; bj < 2; ++bj)
#pragma unroll
            for (int n = 0; n < 2; ++n) bv[bj][n] = *(const f32x4*)(bdn + (size_t)u.e * DM + col0 + bj * HALF + 4 * n);
#pragma unroll
        for (int ai = 0; ai < 2; ++ai)
#pragma unroll
            for (int m = 0; m < 4; ++m) {
                const int lr = ai * HALF + wr * 64 + m * 16 + fr;
                float wgt = __int_as_float(list[(size_t)u.e * LISTCAP + u.pm * ROWPAD + lr].y); wgt = lr < u.nrows ? wgt : 0.f;
                f16* rowp = ys + (size_t)(u.row0 + lr) * DM + col0;
#pragma unroll
                for (int bj = 0; bj < 2; ++bj) {
                    const f32x4 v0 = (acc[ai][bj][m][0] + bv[bj][0]) * wgt, v1 = (acc[ai][bj][m][1] + bv[bj][1]) * wgt;
                    u32x4 w; w.x = pk2(v0[0], v0[1]); w.y = pk2(v0[2], v0[3]); w.z = pk2(v1[0], v1[1]); w.w = pk2(v1[2], v1[3]);
                    *(u32x4*)(rowp + bj * HALF) = w;
                }
            }
    }
};
__device__ __forceinline__ void phase_up(const Params& p, LAS unsigned char* lds, int wg, int nwg) {
    moe_prefix(p, lds);
    MoeSched<8, true> S{(const char*)(p.ws + WS_XH), (const char*)(p.ws + WS_WUP), (const int2*)(p.ws + WS_SMALL + SM_LIST), (LAS int*)(lds + MOE_MISC), (LAS int*)(lds + MOE_MISC) + 64, wg};
    EpiUp E{p.in[17], (f16*)(p.ws + WS_PROJ)};
    gemm_phase(lds, S, E);
}
__device__ __forceinline__ void phase_down(const Params& p, LAS unsigned char* lds, int wg, int nwg) {
    moe_prefix(p, lds);
    MoeSched<4, false> S{(const char*)(p.ws + WS_PROJ), (const char*)(p.ws + WS_WDN), (const int2*)(p.ws + WS_SMALL + SM_LIST), (LAS int*)(lds + MOE_MISC), (LAS int*)(lds + MOE_MISC) + 64, wg};
    EpiDown E{p.in[19], (const int2*)(p.ws + WS_SMALL + SM_LIST), (f16*)(p.ws + WS_YS)};
    gemm_phase(lds, S, E);
}
__device__ __forceinline__ float lambda_full(const float* lq1, const float* lk1, const float* lq2, const float* lk2, int lane) {
    float a = lq1[lane] * lk1[lane], c = lq2[lane] * lk2[lane];
    for (int o = 32; o >= 1; o >>= 1) { a += shx(a, o, lane); c += shx(c, o, lane); }
    return __expf(a) - __expf(c) + LAMBDA_INIT;
}
typedef short s16x4 __attribute__((ext_vector_type(4)));
__device__ __forceinline__ int crow(int r, int hi) { return (r & 3) + 8 * (r >> 2) + 4 * hi; }
__device__ __forceinline__ f16x4 vtr(const LAS unsigned char* p) { return __builtin_bit_cast(f16x4, __builtin_amdgcn_ds_read_tr16_b64_v4i16((LAS s16x4*)p)); }
#define MFMA32(a, b, c) __builtin_amdgcn_mfma_f32_32x32x16_f16(a, b, c, 0, 0, 0)
__device__ __forceinline__ float rowmax32(const f32x16& p0, const f32x16& p1) {
    float a = fmaxf(fmaxf(p0[0], p0[1]), p1[0]), b = fmaxf(fmaxf(p0[2], p0[3]), p1[1]); a = fmaxf(fmaxf(a, p1[2]), p1[3]);
#pragma unroll
    for (int r = 4; r < 16; r += 4) { a = fmaxf(fmaxf(a, p0[r]), p0[r + 1]); b = fmaxf(fmaxf(b, p0[r + 2]), p0[r + 3]); a = fmaxf(fmaxf(a, p1[r]), p1[r + 1]); b = fmaxf(fmaxf(b, p1[r + 2]), p1[r + 3]); }
    float m = fmaxf(a, b); auto rr = __builtin_amdgcn_permlane32_swap(__float_as_uint(m), __float_as_uint(m), false, false);
    return fmaxf(__uint_as_float(rr[0]), __uint_as_float(rr[1]));
}
__device__ __forceinline__ float half_sum(float v) { auto rr = __builtin_amdgcn_permlane32_swap(__float_as_uint(v), __float_as_uint(v), false, false); return __uint_as_float(rr[0]) + __uint_as_float(rr[1]); }

constexpr int AB_QSTR = 4160;
constexpr int AB_STG = 16384 + 4 * AB_QSTR;
constexpr int AB_STGS = 33280;
constexpr int AB_WSF = 131072;
constexpr float AB_THR = 8.0f;

constexpr int AA_HSTR = 2112;
constexpr int AA_BUF = 2 * AA_HSTR;
constexpr int AA_KBUF = 4096;
constexpr int AA_WAVE = 2 * AA_BUF + 2 * AA_KBUF + 128;
constexpr float AA_THR = 8.0f;
__device__ __forceinline__ float rowmax16(const f32x16& p0) {
    float a = fmaxf(fmaxf(p0[0], p0[1]), p0[2]), b = fmaxf(fmaxf(p0[3], p0[4]), p0[5]);
    a = fmaxf(fmaxf(a, p0[6]), p0[7]); b = fmaxf(fmaxf(b, p0[8]), p0[9]); a = fmaxf(fmaxf(a, p0[10]), p0[11]); b = fmaxf(fmaxf(b, p0[12]), p0[13]);
    a = fmaxf(fmaxf(a, p0[14]), p0[15]);
    float m = fmaxf(a, b); auto rr = __builtin_amdgcn_permlane32_swap(__float_as_uint(m), __float_as_uint(m), false, false);
    return fmaxf(__uint_as_float(rr[0]), __uint_as_float(rr[1]));
}
__device__ __forceinline__ void phase_attnA(const Params& p, LAS unsigned char* lds, int wg, int nwg) {
    const int tid = get_tid(lds);
    const int lane = tid & 63, r32 = lane & 31, hi = lane >> 5;
    const int wave = __builtin_amdgcn_readfirstlane(tid >> 6);
    const f16* proj = (const f16*)(p.ws + WS_PROJ);
    f16* oa = (f16*)(p.ws + WS_OAB);
    LAS unsigned char* wl = lds + wave * AA_WAVE;
    LAS float* wsf = (LAS float*)(wl + 2 * AA_BUF + 2 * AA_KBUF);
    const int kw0 = (lane >> 3) * 128 + (((lane & 7) ^ (((lane >> 3) >> 1) & 7)) << 4);
    const int kr0 = r32 * 128, kx = (hi ^ ((r32 >> 1) & 7)) << 4;
    const int vl = ((lane >> 4) & 1) * 32 + (lane & 3) * 8 + (4 * hi + ((lane & 15) >> 2)) * 64;
    const int vrow0 = lane >> 3, vch0 = lane & 7, vw0 = (vch0 >> 2) * AA_HSTR + vrow0 * 64 + (vch0 & 3) * 16;
#if defined(AA_TIMEQ)
#define AA_TQ0 const long long tq0_ = __builtin_readcyclecounter();
#define AA_TQ1 tacc += __builtin_readcyclecounter() - tq0_;
#else
#define AA_TQ0
#define AA_TQ1
#endif
    long long tacc = 0;
    constexpr int NTILE = 33;
#pragma unroll 1
    for (int ui = 0; ui < 4; ++ui) {
        const int j = wg >> 3, bh = ui * 16 + (wg & 7) * 2 + (j >> 4), r16 = j & 15;
        const int b = bh >> 3, h = bh & 7;
        const float sl2 = slope_of(h + (h >> 1)) * LOG2E;
        const f16* base = proj + (size_t)b * SEQ * INW;
        const int P0 = r16 + 512 * wave, qpos = P0 + 16 * r32;
        f16x8 qr[4];
#pragma unroll
        for (int d0 = 0; d0 < 4; ++d0) qr[d0] = *(const f16x8*)(base + (size_t)qpos * INW + C_QA + h * 64 + 16 * d0 + 8 * hi);
        f32x16 o[2];
        o[0] = (f32x16){0.f, 0.f, 0.f, 0.f, 0.f, 0.f, 0.f, 0.f, 0.f, 0.f, 0.f, 0.f, 0.f, 0.f, 0.f, 0.f}; o[1] = o[0];
        float m = -1.0e30f, l = 0.f;
        u32x4 kS[4], vA[4];
#define AA_PARAMS(tt, d, n) const int d = (tt) < 5 ? 16 : ((tt) < 13 ? 4 : 1), n = (tt) < 5 ? (tt) : ((tt) < 13 ? (tt) - 5 : (tt) - 13)
#define AA_LOADKV(tt) do { AA_PARAMS(tt, d_, n_); const int kb_ = P0 - 64 * d_ + 32 * d_ * n_; \
            if (kb_ >= 0 && kb_ + 31 * d_ < SEQ) { \
                const f16* r0_ = base + (size_t)(kb_ + d_ * vrow0) * INW + h * 64 + vch0 * 8; const size_t st_ = (size_t)(8 * d_) * INW; \
                _Pragma("unroll") for (int jj = 0; jj < 4; ++jj) { kS[jj] = *(const u32x4*)(r0_ + C_KA + jj * st_); vA[jj] = *(const u32x4*)(r0_ + C_VA + jj * st_); } \
            } else { \
                _Pragma("unroll") for (int jj = 0; jj < 4; ++jj) { int kp = kb_ + d_ * (vrow0 + 8 * jj); kp = kp < 0 ? 0 : (kp > SEQ - 1 ? SEQ - 1 : kp); \
                  const f16* r_ = base + (size_t)kp * INW + h * 64 + vch0 * 8; kS[jj] = *(const u32x4*)(r_ + C_KA); vA[jj] = *(const u32x4*)(r_ + C_VA); } } } while (0)
#define AA_STEP(tt) do { \
            AA_TQ0 asm volatile("s_waitcnt vmcnt(0)" ::: "memory"); AA_TQ1 \
            LAS unsigned char* vbuf = wl + ((tt) & 1) * AA_BUF; \
            LAS unsigned char* kbuf = wl + 2 * AA_BUF + ((tt) & 1) * AA_KBUF; \
            _Pragma("unroll") for (int jj = 0; jj < 4; ++jj) { *(LAS u32x4*)(vbuf + vw0 + jj * 512) = vA[jj]; *(LAS u32x4*)(kbuf + ((kw0 + jj * 1024) ^ ((jj & 1) << 6))) = kS[jj]; } \
            if ((tt) + 1 < NTILE) { AA_LOADKV((tt) + 1); } \
            AA_PARAMS(tt, d, n); \
            const int kb = P0 - 64 * d + 32 * d * n; \
            f32x16 s = (f32x16){0.f, 0.f, 0.f, 0.f, 0.f, 0.f, 0.f, 0.f, 0.f, 0.f, 0.f, 0.f, 0.f, 0.f, 0.f, 0.f}; \
            _Pragma("unroll") for (int d0 = 0; d0 < 4; ++d0) { const f16x8 kf = *(const LAS f16x8*)(kbuf + kr0 + ((d0 << 5) ^ kx)); s = MFMA32(kf, qr[d0], s); } \
            const float df = (float)d, basef = (float)(d * (32 * n + 4 * hi - 64) - 16 * r32), lim = 64.0f * df; \
            const bool need_range = (kb < 0) || (kb + 31 * d >= SEQ); \
            const float kpf0 = (float)(kb + 4 * hi * d); \
            if (need_range) { \
                _Pragma("unroll") for (int r = 0; r < 16; ++r) { \
                    const float c = (float)((r & 3) + 8 * (r >> 2)); \
                    const float ad = __builtin_fabsf(__builtin_fmaf(df, c, basef)), kpf = __builtin_fmaf(df, c, kpf0); \
                    const bool valid = (ad <= lim) && (kpf >= 0.0f) && (kpf < (float)SEQ); \
                    s[r] = valid ? __builtin_fmaf(-sl2, ad, s[r]) : -INFINITY; } \
            } else { \
                _Pragma("unroll") for (int r = 0; r < 16; ++r) { \
                    const float c = (float)((r & 3) + 8 * (r >> 2)); \
                    const float ad = __builtin_fabsf(__builtin_fmaf(df, c, basef)); \
                    s[r] = (ad <= lim) ? __builtin_fmaf(-sl2, ad, s[r]) : -INFINITY; } \
            } \
            const float mx = rowmax16(s); \
            if (__any(mx > m + AA_THR)) { \
                const float mn = fmaxf(m, mx), al = __builtin_amdgcn_exp2f(m - mn); \
                l *= al; m = mn; \
                if (hi == 0) wsf[r32] = al; \
                _Pragma("unroll") for (int r = 0; r < 16; ++r) { const float f = wsf[crow(r, hi)]; o[0][r] *= f; o[1][r] *= f; } } \
            float ls = 0.f; \
            _Pragma("unroll") for (int r = 0; r < 16; ++r) { s[r] = __builtin_amdgcn_exp2f(s[r] - m); ls += s[r]; } \
            l += ls; \
            u32x4 pw[2]; \
            pw[0] = (u32x4){pk2(s[0], s[1]), pk2(s[2], s[3]), pk2(s[4], s[5]), pk2(s[6], s[7])}; \
            pw[1] = (u32x4){pk2(s[8], s[9]), pk2(s[10], s[11]), pk2(s[12], s[13]), pk2(s[14], s[15])}; \
            const LAS unsigned char* vb = vbuf + vl; \
            _Pragma("unroll") for (int ks = 0; ks < 2; ++ks) _Pragma("unroll") for (int dh = 0; dh < 2; ++dh) { \
                    const f16x4 lo = vtr(vb + dh * AA_HSTR + ks * 1024), hh = vtr(vb + dh * AA_HSTR + ks * 1024 + 512); \
                    const f16x8 vf = (f16x8){lo[0], lo[1], lo[2], lo[3], hh[0], hh[1], hh[2], hh[3]}; \
                    o[dh] = MFMA32(__builtin_bit_cast(f16x8, pw[ks]), vf, o[dh]); } \
        } while (0)
        AA_LOADKV(0);
#pragma unroll 1
        for (int tt = 0; tt < NTILE - 1; tt += 2) { AA_STEP(tt); AA_STEP(tt + 1); }
        AA_STEP(NTILE - 1);
#undef AA_STEP
#undef AA_LOADKV
#undef AA_PARAMS
        l = half_sum(l);
        if (hi == 0) wsf[r32] = 1.0f / l;
#pragma unroll
        for (int r = 0; r < 16; ++r) {
            const float il = wsf[crow(r, hi)];
            f16* op = oa + ((size_t)b * SEQ + P0 + 16 * crow(r, hi)) * 512 + h * 64 + r32;
            op[0] = (f16)(o[0][r] * il); op[32] = (f16)(o[1][r] * il);
        }
    }
#if defined(AA_TIMEQ)
    { const long long t0 = __builtin_readcyclecounter(); while (__builtin_readcyclecounter() - t0 < tacc) __builtin_amdgcn_s_sleep(1); }
#endif
    __syncthreads();
}
constexpr int B2_STGS = 33280, B2_WSF = 4 * B2_STGS, B2_CMX = B2_WSF + 1024;
constexpr float B2_THR = 8.0f, B2_SKIP_T = 40.0f;
constexpr size_t SM_KMAX = 15360, SM_KDONE = 15872, SM_AQ = 16000;

__device__ __forceinline__ void glds16_asm(const void* gsrc, unsigned lds_dst) {
    unsigned keep;
    asm volatile("s_mov_b32 %0, m0\n\ts_mov_b32 m0, %2\n\ts_nop 0\n\tglobal_load_lds_dwordx4 %1, off\n\ts_mov_b32 m0, %0" : "=&s"(keep) : "v"(gsrc), "s"(lds_dst) : "memory");
}
__device__ __forceinline__ void phase_knorm(const Params& p, LAS unsigned char* lds, int wg, int nwg) {
    const int tid = get_tid(lds);
    const int lane = tid & 63;
    const f16* proj = (const f16*)(p.ws + WS_PROJ);
    unsigned* kmax2 = (unsigned*)(p.ws + WS_SMALL + SM_KMAX);
    unsigned* kdone = (unsigned*)(p.ws + WS_SMALL + SM_KDONE);
    const int tpw = TOK / nwg;
    const int t = wg * tpw + (tid >> 2), part = tid & 3;
    float n2[2];
#pragma unroll
    for (int g = 0; g < 2; ++g) {
        const f16* kr = proj + (size_t)t * INW + C_KB + (part * 2 + g) * 64;
        float s = 0.f;
#pragma unroll
        for (int c = 0; c < 8; ++c) { const f16x8 v = *(const f16x8*)(kr + c * 8);
#pragma unroll
            for (int j = 0; j < 8; ++j) s = fmaf((float)v[j], (float)v[j], s); }
        n2[g] = s;
    }
#pragma unroll
    for (int g = 0; g < 2; ++g) { for (int o = 4; o <= 32; o <<= 1) n2[g] = fmaxf(n2[g], shx(n2[g], o, lane)); }
    if (lane < 4) {
        const int b = (wg * tpw) / SEQ;
#pragma unroll
        for (int g = 0; g < 2; ++g) { const int hm = part * 2 + g;
            __hip_atomic_fetch_max(kmax2 + b * 8 + hm, __float_as_uint(n2[g]), __ATOMIC_RELAXED, __HIP_MEMORY_SCOPE_AGENT); }
    }
    asm volatile("s_waitcnt vmcnt(0)" ::: "memory");
    __syncthreads();
    if (tid == 0) __hip_atomic_fetch_add(kdone, 1u, __ATOMIC_RELAXED, __HIP_MEMORY_SCOPE_AGENT);
}

__device__ __forceinline__ void dma8(const void* sbase, const unsigned (&vo)[8], unsigned ldk, unsigned ldv) {
    unsigned keep;
    asm volatile(
        "s_mov_b32 %0, m0\n\t"
        "s_mov_b32 m0, %10\n\ts_nop 0\n\tglobal_load_lds_dwordx4 %2, %1\n\t"
        "s_add_i32 m0, %10, 0x400\n\ts_nop 0\n\tglobal_load_lds_dwordx4 %3, %1\n\t"
        "s_add_i32 m0, %10, 0x4000\n\ts_nop 0\n\tglobal_load_lds_dwordx4 %4, %1\n\t"
        "s_add_i32 m0, %10, 0x4400\n\ts_nop 0\n\tglobal_load_lds_dwordx4 %5, %1\n\t"
        "s_mov_b32 m0, %11\n\ts_nop 0\n\tglobal_load_lds_dwordx4 %6, %1\n\t"
        "s_add_i32 m0, %11, 0x400\n\ts_nop 0\n\tglobal_load_lds_dwordx4 %7, %1\n\t"
        "s_add_i32 m0, %11, 0x800\n\ts_nop 0\n\tglobal_load_lds_dwordx4 %8, %1\n\t"
        "s_add_i32 m0, %11, 0xc00\n\ts_nop 0\n\tglobal_load_lds_dwordx4 %9, %1\n\t"
        "s_mov_b32 m0, %0"
        : "=&s"(keep)
        : "s"(sbase), "v"(vo[0]), "v"(vo[1]), "v"(vo[2]), "v"(vo[3]), "v"(vo[4]), "v"(vo[5]), "v"(vo[6]), "v"(vo[7]), "s"(ldk), "s"(ldv)
        : "memory", "scc");
}

constexpr int B3_VQ = 8256;
constexpr int B3_STG = 32768 + 4 * B3_VQ;
constexpr int B3_WSF = 2 * B3_STG, B3_CMX = B3_WSF + 1024;
__device__ __forceinline__ void phase_attnB3(const Params& p, LAS unsigned char* lds, int wg, int nwg) {
    const int tid = get_tid(lds);
    const int lane = tid & 63, r32 = lane & 31, hi = lane >> 5;
    const int wave = __builtin_amdgcn_readfirstlane(tid >> 6), grp = wave >> 2, qsub = wave & 3;
    const f16* proj = (const f16*)(p.ws + WS_PROJ);
    f16* ob = (f16*)(p.ws + WS_OAB) + (size_t)TOK * 512;
    const float lam = lambda_full(p.in[3], p.in[4], p.in[5], p.in[6], lane);
    const float* subg = p.in[7];
    LAS float* wsf = (LAS float*)(lds + B3_WSF) + wave * 32;
    LAS float* cmx = (LAS float*)(lds + B3_CMX);
    if (tid == 0) { unsigned* kdone = (unsigned*)(p.ws + WS_SMALL + SM_KDONE); unsigned sp = 0;
        while (__hip_atomic_load(kdone, __ATOMIC_RELAXED, __HIP_MEMORY_SCOPE_AGENT) < (unsigned)nwg) { __builtin_amdgcn_s_sleep(2); if (++sp > (1u << 22)) break; } }
    __syncthreads();
    const unsigned* kmax2 = (const unsigned*)(p.ws + WS_SMALL + SM_KMAX);
    const int kx4 = (hi ^ ((r32 >> 1) & 7)) << 4, krow = r32 * 128;
#define KOFF(d0) (krow + (((d0) << 5) ^ kx4))
    const int vl = ((lane >> 4) & 1) * 32 + (lane & 3) * 8 + (4 * hi + ((lane & 15) >> 2)) * 64;
    const unsigned vo_k = (unsigned)((16 * wave + (lane >> 3)) * INW + ((lane & 7) ^ (((16 * wave + (lane >> 3)) >> 1) & 7)) * 8) * 2u;
    const unsigned vo_v = (unsigned)((16 * ((4 * wave) & 7) + (lane >> 2)) * INW + (C_VB - C_KB) + (wave >> 1) * 32 + (lane & 3) * 8) * 2u;
    const unsigned ldk_w = (unsigned)wave * 2048u, ldv_w = 32768u + (unsigned)(wave >> 1) * B3_VQ + (unsigned)(wave & 1) * 4096u;
#ifdef B3_PRIO
    if (grp) __builtin_amdgcn_s_setprio(1);
#endif
#ifndef TIMEQ
#define TIMEQ 0
#endif
    long long tacc = 0;
    const unsigned lds0 = (unsigned)(size_t)lds;
    const f32x16 z16 = (f32x16){0.f, 0.f, 0.f, 0.f, 0.f, 0.f, 0.f, 0.f, 0.f, 0.f, 0.f, 0.f, 0.f, 0.f, 0.f, 0.f};

    unsigned* aq = (unsigned*)(p.ws + WS_SMALL + SM_AQ) + (wg & 7);
#pragma unroll 1
    for (;;) {
        if (tid == 0) cmx[8] = __uint_as_float(__hip_atomic_fetch_add(aq, 1u, __ATOMIC_RELAXED, __HIP_MEMORY_SCOPE_AGENT));
        __syncthreads();
        const int u = __builtin_amdgcn_readfirstlane((int)__float_as_uint(cmx[8]));
        if (u >= 128) break;
        const int g8 = wg & 7, h = 3 - (u >> 5), ui = (h - (g8 & 3)) & 3, qb = u & 31;
        const int b = 2 * ui + (g8 >> 2);
        const float sl2 = slope_of(3 * h + 2) * LOG2E;
        const f16* base = proj + (size_t)b * SEQ * INW;
        const int dw = 2 * qb + (qsub >> 1);
        const int qrel = qsub * 32 + r32, qpos = qb * 128 + qrel;
        f16x8 qr[4], ks4[4];
        { int lu = lane; asm volatile("" : "+v"(lu));
          const unsigned qo = (unsigned)((qb * 128 + qsub * 32 + (lu & 31)) * INW + h * 128 + grp * 64 + 8 * (lu >> 5));
#pragma unroll
          for (int d0 = 0; d0 < 4; ++d0) { qr[d0] = *(const f16x8*)(base + qo + C_QB + 16 * d0); ks4[d0] = *(const f16x8*)(base + qo + C_KB + 16 * d0); } }
        float qn2 = 0.f, sii = 0.f;
#pragma unroll
        for (int d0 = 0; d0 < 4; ++d0)
#pragma unroll
            for (int j = 0; j < 8; ++j) { const float qv = (float)qr[d0][j]; qn2 = fmaf(qv, qv, qn2); sii = fmaf(qv, (float)ks4[d0][j], sii); }
        qn2 = half_sum(qn2); sii = half_sum(sii);
        const float kmx = sqrtf(__uint_as_float(__hip_atomic_load(kmax2 + b * 8 + h * 2 + grp, __ATOMIC_RELAXED, __HIP_MEMORY_SCOPE_AGENT)));
        float cb = sqrtf(qn2) * kmx * 1.001f - sii;
        for (int of = 16; of >= 1; of >>= 1) cb = fmaxf(cb, shx(cb, of, lane));
        if (lane == 0) cmx[wave] = cb;
        const float a64 = 64.0f * sl2; const f16 aH = (f16)a64, aL = (f16)(a64 - (float)aH), bH = (f16)sl2, bL = (f16)(sl2 - (float)bH);
        const f16 zz = (f16)0.f;
        const unsigned qx01 = hi == 0 ? __builtin_bit_cast(unsigned, (f16x2){aH, aL}) : 0u, qx23 = hi == 0 ? __builtin_bit_cast(unsigned, (f16x2){bH, bL}) : 0u;
        asm volatile("s_waitcnt lgkmcnt(0)" ::: "memory"); __syncthreads();
        float cmax = cmx[0];
#pragma unroll
        for (int w = 1; w < 8; ++w) cmax = fmaxf(cmax, cmx[w]);
        const float Dm = (cmax + B2_SKIP_T + 1.0f) / sl2;
        int t_lo, t_hi;
        { const float lo = ((float)(qb * 128 - 127) - Dm) * (1.0f / 128.0f), hh = ((float)(qb * 128 + 127) + Dm) * (1.0f / 128.0f);
          t_lo = lo <= 0.f ? 0 : (int)lo; t_hi = hh >= 31.f ? 31 : (int)hh; if (t_lo > qb) t_lo = qb; if (t_hi < qb) t_hi = qb; }
        t_lo = __builtin_amdgcn_readfirstlane(t_lo); t_hi = __builtin_amdgcn_readfirstlane(t_hi);
        const int nL = qb - t_lo, U = 1 + nL + (t_hi - qb);
#define B3_SEQ(pp) ((pp) == 0 ? qb : ((pp) - 1 < nL ? qb - 1 - ((pp) - 1) : qb + 1 + ((pp) - 1 - nL)))
        const f16* gk = base + C_KB + h * 128;
#define B3_ISSUE(pp) do { const int T2_ = B3_SEQ(pp); const unsigned st_ = lds0 + (unsigned)((pp) & 1) * (unsigned)B3_STG; \
            const unsigned vo_[8] = {vo_k, (vo_k + 8u * INW * 2u) ^ 64u, vo_k + 128u, ((vo_k + 8u * INW * 2u) ^ 64u) + 128u,     \
                 vo_v, vo_v + 16u * INW * 2u, vo_v + 32u * INW * 2u, vo_v + 48u * INW * 2u}; \
            dma8(gk + (size_t)T2_ * 128 * INW, vo_, (unsigned)__builtin_amdgcn_readfirstlane(st_ + ldk_w), (unsigned)__builtin_amdgcn_readfirstlane(st_ + ldv_w)); } while (0)
        B3_ISSUE(0);
        f32x16 o[4]; o[0] = z16; o[1] = z16; o[2] = z16; o[3] = z16;
        float m = sii, l = 0.f;
        asm volatile("s_waitcnt vmcnt(0) lgkmcnt(0)\n\ts_barrier" ::: "memory");
#define SBAR() __builtin_amdgcn_sched_barrier(0)
#define PIN(x) asm volatile("" : "+v"(x))
#define B3_QK(S0, S1, T, JJ) do { \
            const LAS unsigned char* kbse = st + grp * 16384 + (JJ) * 8192; \
            const int side = (T) <= dw ? 0 : 1; \
            const float sq = sl2 * (float)qrel; \
            const float mr = side == 0 ? -(m + sq) : -(m - sq); \
            const f16 mH = (f16)mr, mL = (f16)(mr - (float)mH), one = (f16)1.0f; \
            const f16 trel = (f16)(float)((T) - 2 * qb), l0 = (f16)(float)r32, l1 = (f16)(float)(32 + r32); \
            const f16x8 kx0 = hi == 0 ? (f16x8){trel, trel, l0, l0, one, one, zz, zz} : (f16x8){zz, zz, zz, zz, zz, zz, zz, zz}; \
            const f16x8 kx1 = hi == 0 ? (f16x8){trel, trel, l1, l1, one, one, zz, zz} : (f16x8){zz, zz, zz, zz, zz, zz, zz, zz}; \
            u32x4 qxb = (u32x4){qx01, qx23, 0u, 0u}; if (side) { qxb.x ^= 0x80008000u; qxb.y ^= 0x80008000u; } \
            if (hi == 0) qxb.z = __builtin_bit_cast(unsigned, (f16x2){mH, mL}); \
            const f16x8 qx = __builtin_bit_cast(f16x8, qxb); \
            S0 = MFMA32(kx0, qx, z16); S1 = MFMA32(kx1, qx, z16); \
            _Pragma("unroll") for (int d0 = 0; d0 < 4; ++d0) { \
                const f16x8 a0 = *(const LAS f16x8*)(kbse + KOFF(d0)), a1 = *(const LAS f16x8*)(kbse + 4096 + KOFF(d0)); \
                S0 = MFMA32(a0, qr[d0], S0); S1 = MFMA32(a1, qr[d0], S1); } } while (0)
#define B3_FIX(S0, S1, T) do { if ((T) == dw) { const float dq0 = (float)(64 * ((T) - 2 * qb) + 4 * hi - qrel), m2 = -2.0f * sl2; \
            _Pragma("unroll") for (int r = 0; r < 16; ++r) { const float c = (float)((r & 3) + 8 * (r >> 2)); \
                S0[r] = __builtin_fmaf(m2, fmaxf(dq0 + c, 0.f), S0[r]); S1[r] = __builtin_fmaf(m2, fmaxf(dq0 + 32.0f + c, 0.f), S1[r]); } } } while (0)
#define B3_EXP(S0, S1, PW) do { float ls = 0.f; \
            _Pragma("unroll") for (int r = 0; r < 16; ++r) { S0[r] = __builtin_amdgcn_exp2f(S0[r]); S1[r] = __builtin_amdgcn_exp2f(S1[r]); ls += S0[r] + S1[r]; } \
            l += ls; \
            PW[0] = (u32x4){pk2(S0[0], S0[1]), pk2(S0[2], S0[3]), pk2(S0[4], S0[5]), pk2(S0[6], S0[7])}; \
            PW[1] = (u32x4){pk2(S0[8], S0[9]), pk2(S0[10], S0[11]), pk2(S0[12], S0[13]), pk2(S0[14], S0[15])}; \
            PW[2] = (u32x4){pk2(S1[0], S1[1]), pk2(S1[2], S1[3]), pk2(S1[4], S1[5]), pk2(S1[6], S1[7])}; \
            PW[3] = (u32x4){pk2(S1[8], S1[9]), pk2(S1[10], S1[11]), pk2(S1[12], S1[13]), pk2(S1[14], S1[15])}; } while (0)
#define B3_PV(PW, JJ) do { const LAS unsigned char* vb = st + 32768 + (JJ) * 4096 + vl; \
            _Pragma("unroll") for (int ks = 0; ks < 4; ++ks) { _Pragma("unroll") for (int dq = 0; dq < 4; ++dq) { \
                const f16x4 lo = vtr(vb + dq * B3_VQ + ks * 1024), hh = vtr(vb + dq * B3_VQ + ks * 1024 + 512); \
                const f16x8 vf = (f16x8){lo[0], lo[1], lo[2], lo[3], hh[0], hh[1], hh[2], hh[3]}; \
                o[dq] = MFMA32(__builtin_bit_cast(f16x8, PW[ks]), vf, o[dq]); } } } while (0)
#pragma unroll 1
        for (int pp = 0; pp < U; ++pp) {
            if (pp + 1 < U) B3_ISSUE(pp + 1);
#ifdef B3_SKEW
            if (grp) __builtin_amdgcn_s_sleep(B3_SKEW);
#endif
            const LAS unsigned char* st = lds + (pp & 1) * B3_STG;
            const int T2 = B3_SEQ(pp), TA = 2 * T2, TB = 2 * T2 + 1;
            f32x16 a0s, a1s, b0s, b1s; u32x4 pwA[4], pwB[4];
            B3_QK(a0s, a1s, TA, 0);
            __builtin_amdgcn_sched_group_barrier(0x100, 4, 0); __builtin_amdgcn_sched_group_barrier(0x8, 2, 0);
            __builtin_amdgcn_sched_group_barrier(0x8, 2, 0); __builtin_amdgcn_sched_group_barrier(0x100, 2, 0);
            __builtin_amdgcn_sched_group_barrier(0x8, 2, 0); __builtin_amdgcn_sched_group_barrier(0x100, 2, 0);
            __builtin_amdgcn_sched_group_barrier(0x8, 4, 0);
            B3_FIX(a0s, a1s, TA);
            { const float mx = rowmax32(a0s, a1s);
              if (__any(mx > B2_THR)) {
                const float dl = fmaxf(mx, 0.f), al = __builtin_amdgcn_exp2f(-dl);
                m += dl; l *= al;
                if (hi == 0) wsf[r32] = al;
#pragma unroll
                for (int r = 0; r < 16; ++r) { const float f = wsf[crow(r, hi)];
#pragma unroll
                    for (int i = 0; i < 4; ++i) o[i][r] *= f;
                    a0s[r] -= dl; a1s[r] -= dl; }
              } }
            {
                const LAS unsigned char* kbse = st + grp * 16384 + 8192;
                const int side = TB <= dw ? 0 : 1;
                const float sq = sl2 * (float)qrel;
                const float mr = side == 0 ? -(m + sq) : -(m - sq);
                const f16 mH = (f16)mr, mL = (f16)(mr - (float)mH), one = (f16)1.0f;
                const f16 trel = (f16)(float)(TB - 2 * qb), l0 = (f16)(float)r32, l1 = (f16)(float)(32 + r32);
                const f16x8 kx0 = hi == 0 ? (f16x8){trel, trel, l0, l0, one, one, zz, zz} : (f16x8){zz, zz, zz, zz, zz, zz, zz, zz};
                const f16x8 kx1 = hi == 0 ? (f16x8){trel, trel, l1, l1, one, one, zz, zz} : (f16x8){zz, zz, zz, zz, zz, zz, zz, zz};
                u32x4 qxb = (u32x4){qx01, qx23, 0u, 0u}; if (side) { qxb.x ^= 0x80008000u; qxb.y ^= 0x80008000u; }
                if (hi == 0) qxb.z = __builtin_bit_cast(unsigned, (f16x2){mH, mL});
                const f16x8 qx = __builtin_bit_cast(f16x8, qxb);
                f16x8 kf0 = *(const LAS f16x8*)(kbse + KOFF(0)), kf1 = *(const LAS f16x8*)(kbse + 4096 + KOFF(0));
                f16x8 kf2 = *(const LAS f16x8*)(kbse + KOFF(1)), kf3 = *(const LAS f16x8*)(kbse + 4096 + KOFF(1));
                float ls = 0.f;
                SBAR();
#define EX3(S, i0) do { S[i0] = __builtin_amdgcn_exp2f(S[i0]); S[i0 + 1] = __builtin_amdgcn_exp2f(S[i0 + 1]); S[i0 + 2] = __builtin_amdgcn_exp2f(S[i0 + 2]); ls += S[i0]; ls += S[i0 + 1]; ls += S[i0 + 2]; PIN(ls); } while (0)
#define EX4(S, i0) do { S[i0] = __builtin_amdgcn_exp2f(S[i0]); S[i0 + 1] = __builtin_amdgcn_exp2f(S[i0 + 1]); S[i0 + 2] = __builtin_amdgcn_exp2f(S[i0 + 2]); S[i0 + 3] = __builtin_amdgcn_exp2f(S[i0 + 3]); ls += S[i0]; ls += S[i0 + 1]; ls += S[i0 + 2]; ls += S[i0 + 3]; PIN(ls); } while (0)
                b0s = MFMA32(kx0, qx, z16); EX3(a0s, 0); SBAR();
                b1s = MFMA32(kx1, qx, z16); EX3(a0s, 3); SBAR();
                b0s = MFMA32(kf0, qr[0], b0s); kf0 = *(const LAS f16x8*)(kbse + KOFF(2)); EX3(a0s, 6); SBAR();
                b1s = MFMA32(kf1, qr[0], b1s); kf1 = *(const LAS f16x8*)(kbse + 4096 + KOFF(2)); EX3(a0s, 9); SBAR();
                b0s = MFMA32(kf2, qr[1], b0s); kf2 = *(const LAS f16x8*)(kbse + KOFF(3)); EX4(a0s, 12); SBAR();
                b1s = MFMA32(kf3, qr[1], b1s); kf3 = *(const LAS f16x8*)(kbse + 4096 + KOFF(3)); EX4(a1s, 0); SBAR();
                b0s = MFMA32(kf0, qr[2], b0s); EX4(a1s, 4); SBAR();
                b1s = MFMA32(kf1, qr[2], b1s); EX4(a1s, 8); SBAR();
                b0s = MFMA32(kf2, qr[3], b0s); EX4(a1s, 12);
                pwA[0] = (u32x4){pk2(a0s[0], a0s[1]), pk2(a0s[2], a0s[3]), pk2(a0s[4], a0s[5]), pk2(a0s[6], a0s[7])};
                pwA[1] = (u32x4){pk2(a0s[8], a0s[9]), pk2(a0s[10], a0s[11]), pk2(a0s[12], a0s[13]), pk2(a0s[14], a0s[15])};
                SBAR();
                b1s = MFMA32(kf3, qr[3], b1s);
                pwA[2] = (u32x4){pk2(a1s[0], a1s[1]), pk2(a1s[2], a1s[3]), pk2(a1s[4], a1s[5]), pk2(a1s[6], a1s[7])};
                pwA[3] = (u32x4){pk2(a1s[8], a1s[9]), pk2(a1s[10], a1s[11]), pk2(a1s[12], a1s[13]), pk2(a1s[14], a1s[15])};
                SBAR();
                l += ls;
            }
            B3_FIX(b0s, b1s, TB);
            { const float mx = rowmax32(b0s, b1s);
              if (__any(mx > B2_THR)) {
                const float dl = fmaxf(mx, 0.f), al = __builtin_amdgcn_exp2f(-dl);
                m += dl; l *= al;
                if (hi == 0) wsf[r32] = al;
#pragma unroll
                for (int r = 0; r < 16; ++r) { const float f = wsf[crow(r, hi)];
#pragma unroll
                    for (int i = 0; i < 4; ++i) o[i][r] *= f;
                    b0s[r] -= dl; b1s[r] -= dl; a0s[r] *= al; a1s[r] *= al; }
                pwA[0] = (u32x4){pk2(a0s[0], a0s[1]), pk2(a0s[2], a0s[3]), pk2(a0s[4], a0s[5]), pk2(a0s[6], a0s[7])};
                pwA[1] = (u32x4){pk2(a0s[8], a0s[9]), pk2(a0s[10], a0s[11]), pk2(a0s[12], a0s[13]), pk2(a0s[14], a0s[15])};
                pwA[2] = (u32x4){pk2(a1s[0], a1s[1]), pk2(a1s[2], a1s[3]), pk2(a1s[4], a1s[5]), pk2(a1s[6], a1s[7])};
                pwA[3] = (u32x4){pk2(a1s[8], a1s[9]), pk2(a1s[10], a1s[11]), pk2(a1s[12], a1s[13]), pk2(a1s[14], a1s[15])};
              } }
            {
                const LAS unsigned char* vb = st + 32768 + vl;
                float ls = 0.f;
#define VFR_(ks, dq) do { const f16x4 lo_ = vtr(vb + (dq) * B3_VQ + (ks) * 1024), hh_ = vtr(vb + (dq) * B3_VQ + (ks) * 1024 + 512); vnx = (f16x8){lo_[0], lo_[1], lo_[2], lo_[3], hh_[0], hh_[1], hh_[2], hh_[3]}; } while (0)
#define EX2(S, i0) do { S[i0] = __builtin_amdgcn_exp2f(S[i0]); S[i0 + 1] = __builtin_amdgcn_exp2f(S[i0 + 1]); ls += S[i0]; ls += S[i0 + 1]; PIN(ls); } while (0)
                f16x8 vcu, vnx;
                VFR_(0, 0); vcu = vnx; SBAR();
#define PVG(ks, dq, nks, ndq, S, i0) do { VFR_(nks, ndq); o[dq] = MFMA32(__builtin_bit_cast(f16x8, pwA[ks]), vcu, o[dq]); EX2(S, i0); vcu = vnx; SBAR(); } while (0)
                PVG(0, 0, 0, 1, b0s, 0);  PVG(0, 1, 0, 2, b0s, 2);  PVG(0, 2, 0, 3, b0s, 4);  PVG(0, 3, 1, 0, b0s, 6);
                PVG(1, 0, 1, 1, b0s, 8);  PVG(1, 1, 1, 2, b0s, 10); PVG(1, 2, 1, 3, b0s, 12); PVG(1, 3, 2, 0, b0s, 14);
                PVG(2, 0, 2, 1, b1s, 0);  PVG(2, 1, 2, 2, b1s, 2);  PVG(2, 2, 2, 3, b1s, 4);  PVG(2, 3, 3, 0, b1s, 6);
                PVG(3, 0, 3, 1, b1s, 8);  PVG(3, 1, 3, 2, b1s, 10); PVG(3, 2, 3, 3, b1s, 12);
                o[3] = MFMA32(__builtin_bit_cast(f16x8, pwA[3]), vcu, o[3]); EX2(b1s, 14); SBAR();
#undef PVG
#undef VFR_
                l += ls;
                pwB[0] = (u32x4){pk2(b0s[0], b0s[1]), pk2(b0s[2], b0s[3]), pk2(b0s[4], b0s[5]), pk2(b0s[6], b0s[7])};
                pwB[1] = (u32x4){pk2(b0s[8], b0s[9]), pk2(b0s[10], b0s[11]), pk2(b0s[12], b0s[13]), pk2(b0s[14], b0s[15])};
                pwB[2] = (u32x4){pk2(b1s[0], b1s[1]), pk2(b1s[2], b1s[3]), pk2(b1s[4], b1s[5]), pk2(b1s[6], b1s[7])};
                pwB[3] = (u32x4){pk2(b1s[8], b1s[9]), pk2(b1s[10], b1s[11]), pk2(b1s[12], b1s[13]), pk2(b1s[14], b1s[15])};
            }
            B3_PV(pwB, 1);
            __builtin_amdgcn_sched_group_barrier(0x100, 4, 3);
#pragma unroll
            for (int i = 0; i < 14; ++i) { __builtin_amdgcn_sched_group_barrier(0x8, 1, 3); __builtin_amdgcn_sched_group_barrier(0x100, 2, 3); }
            __builtin_amdgcn_sched_group_barrier(0x8, 2, 3);
#if TIMEQ == 1
            { const long long tq0 = __builtin_readcyclecounter(); asm volatile("s_waitcnt vmcnt(0)" ::: "memory"); tacc += __builtin_readcyclecounter() - tq0; }
#endif
#if TIMEQ == 2
            asm volatile("s_waitcnt vmcnt(0)" ::: "memory");
            const long long tq0 = __builtin_readcyclecounter();
#endif
            asm volatile("s_waitcnt vmcnt(0) lgkmcnt(0)\n\ts_barrier" ::: "memory");
#if TIMEQ == 2
            tacc += __builtin_readcyclecounter() - tq0;
#endif
        }
#undef B3_QK
#undef SBAR
#undef PIN
#undef EX2
#undef EX3
#undef EX4
#undef B3_FIX
#undef B3_EXP
#undef B3_PV
#undef B3_ISSUE
#undef B3_SEQ
        l = half_sum(l);
        if (hi == 0) wsf[r32] = 1.0f / l;
        LAS float* ost = (LAS float*)lds + (size_t)grp * 128 * 128;
#pragma unroll
        for (int r = 0; r < 16; ++r) { const float il = wsf[crow(r, hi)]; const int row = qsub * 32 + crow(r, hi);
#pragma unroll
            for (int i = 0; i < 4; ++i) ost[row * 128 + i * 32 + r32] = o[i][r] * il; }
        __syncthreads();
        {
            const LAS float* o1 = (const LAS float*)lds; const LAS float* o2 = o1 + 128 * 128;
            int l2 = lane; asm volatile("" : "+v"(l2));
            const float g0s = subg[l2], g1s = subg[64 + l2];
            for (int rr = 0; rr < 16; ++rr) {
                const int row = wave * 16 + rr;
                const float v0 = o1[row * 128 + l2] - lam * o2[row * 128 + l2], v1 = o1[row * 128 + 64 + l2] - lam * o2[row * 128 + 64 + l2];
                float ss = v0 * v0 + v1 * v1;
                for (int of = 32; of >= 1; of >>= 1) ss += shx(ss, of, lane);
                const float rs = rsqrtf(ss * (1.0f / 128.0f) + 1e-5f) * (1.0f - LAMBDA_INIT);
                f16* op = ob + ((size_t)b * SEQ + qb * 128 + row) * 512 + h * 128;
                op[l2] = (f16)(v0 * rs * g0s); op[64 + l2] = (f16)(v1 * rs * g1s);
            }
        }
        __syncthreads();
    }
#if TIMEQ
    { const long long t0 = __builtin_readcyclecounter(); while (__builtin_readcyclecounter() - t0 < tacc) __builtin_amdgcn_s_sleep(1); }
    __syncthreads();
#endif
#ifdef B3_PRIO
    __builtin_amdgcn_s_setprio(0);
#endif
#undef KOFF
}
#define XB_TMO      128
#define XB_XCNT(j)  (256  + 64 * (j))
#define XB_XSUB(j)  (1280 + 64 * (j))
#define XB_XGEN(j)  (2304 + 64 * (j))
#define XB_TOP      3328
#define XB_TOPGEN   3392
#define XCD_BAR_WORDS 3456
#define XB_SPIN_CAP (1u << 20)
__device__ __forceinline__ unsigned xb_ld(unsigned* p)              { return __hip_atomic_load(p, __ATOMIC_RELAXED, __HIP_MEMORY_SCOPE_AGENT); }
__device__ __forceinline__ unsigned xb_add(unsigned* p, unsigned v) { return __hip_atomic_fetch_add(p, v, __ATOMIC_RELAXED, __HIP_MEMORY_SCOPE_AGENT); }
__device__ __forceinline__ unsigned xb_xcc_id() { return (unsigned)__builtin_amdgcn_s_getreg((3 << 11) | 20) & 0xFu; }
#define XB_SPIN(cond, bar) do { unsigned _sp = 0; while (cond) { __builtin_amdgcn_s_sleep(1); \
    if ((++_sp & 255u) == 0u) { if (xb_ld(&(bar)[XB_TMO])) break; if (_sp > XB_SPIN_CAP) { atomicAdd(&(bar)[XB_TMO], 1u); break; } } } } while (0)
__device__ __forceinline__ void xcd_barrier_post(unsigned* bar, int tid) { if (tid == 0) (void)xb_add(&bar[XB_XCNT(xb_xcc_id())], 1u); }
__device__ __forceinline__ void xcd_barrier_complete(unsigned* bar, unsigned x, unsigned& nloc, unsigned& nx) {
    const unsigned G = gridDim.x;
    unsigned sum, cnt, mine, sp = 0u;
    for (;;) {
        sum = 0u; cnt = 0u; mine = 0u;
#pragma unroll
        for (unsigned j = 0; j < 16; ++j) { const unsigned c = xb_ld(&bar[XB_XCNT(j)]); sum += c; cnt += (c > 0u) ? 1u : 0u; mine = (j == x) ? c : mine; }
        if (sum == G) break;
        __builtin_amdgcn_s_sleep(1);
        if ((++sp & 255u) == 0u) { if (xb_ld(&bar[XB_TMO])) break; if (sp > XB_SPIN_CAP) { atomicAdd(&bar[XB_TMO], 1u); break; } }
    }
    nloc = mine > 0u ? mine : 1u; nx = cnt > 0u ? cnt : 1u;
}
__device__ __forceinline__ void xcd_barrier(unsigned* bar, volatile LAS unsigned* st, LAS unsigned char* lds) {
    const int tid = get_tid(lds);
    asm volatile("s_waitcnt vmcnt(0)" ::: "memory");
    __syncthreads();
    if (tid == 0) {
        const unsigned x = xb_xcc_id();
        __builtin_amdgcn_s_waitcnt(0);
        unsigned nloc = st[0], nx = st[1];
        if (nloc == 0u) { xcd_barrier_complete(bar, x, nloc, nx); st[0] = nloc; st[1] = nx; }
        const unsigned old = xb_add(&bar[XB_XSUB(x)], 1u);
        const unsigned gen = old / nloc;
        if (old + 1u == (gen + 1u) * nloc) {
            __builtin_amdgcn_fence(__ATOMIC_RELEASE, "agent");
            asm volatile("s_waitcnt vmcnt(0)" ::: "memory");
            const unsigned og = xb_add(&bar[XB_TOP], 1u);
            const unsigned tg = og / nx;
            if (og + 1u == (tg + 1u) * nx) xb_add(&bar[XB_TOPGEN], 1u);
            else XB_SPIN(xb_ld(&bar[XB_TOPGEN]) == tg, bar);
            __builtin_amdgcn_fence(__ATOMIC_ACQUIRE, "agent");
            xb_add(&bar[XB_XGEN(x)], 1u);
            asm volatile("s_waitcnt vmcnt(0)" ::: "memory");
        } else {
            XB_SPIN(xb_ld(&bar[XB_XGEN(x)]) == gen, bar);
            __builtin_amdgcn_fence(__ATOMIC_ACQUIRE, "agent");
            asm volatile("s_waitcnt vmcnt(0)" ::: "memory");
        }
    }
    __syncthreads();
}
constexpr int LDS_BARST = LDS_TOTAL - 16;
constexpr size_t SM_BAR = 1024;
__global__ void __launch_bounds__(NTHR, 2) k_mega(Params p) {
    extern __shared__ __attribute__((aligned(16))) unsigned char smem[];
    LAS unsigned char* lds = (LAS unsigned char*)smem;
    const int wg = blockIdx.x, nwg = gridDim.x;
    volatile LAS unsigned* st = (volatile LAS unsigned*)(lds + LDS_BARST);
    { const unsigned hw = (unsigned)__builtin_amdgcn_s_getreg((5 << 11) | 4) & 63u; if ((threadIdx.x & 63) == 0) ((LAS int*)(lds + LDS_WTAB))[hw] = (int)(threadIdx.x >> 6); }
    if (threadIdx.x == 0) { st[0] = 0u; st[1] = 0u; put_params(p, lds); }
    __syncthreads();
    xcd_barrier_post((unsigned*)(get_params(lds).ws + WS_SMALL + SM_BAR), get_tid(lds));
#define GRID_SYNC() xcd_barrier((unsigned*)(get_params(lds).ws + WS_SMALL + SM_BAR), st, lds)
#ifndef TIMEPH
#define TIMEPH 0
#endif
    long long tph = 0;
#define TPH2(n, call) do { if (TIMEPH == (n) || TIMEPH == 11) { const long long t0_ = __builtin_readcyclecounter(); call; tph += __builtin_readcyclecounter() - t0_; } else { call; } } while (0)
#define TPH(n, call) do { if (TIMEPH == (n)) { const long long t0_ = __builtin_readcyclecounter(); call; tph += __builtin_readcyclecounter() - t0_; } else { call; } } while (0)
    TPH(1, phase_prep(get_params(lds), lds, wg, nwg));      TPH2(21, GRID_SYNC());
    TPH(2, phase_inproj(get_params(lds), lds, wg, nwg));    TPH2(22, GRID_SYNC());
    TPH(10, phase_knorm(get_params(lds), lds, wg, nwg));
    TPH(3, phase_attnA(get_params(lds), lds, wg, nwg));
    TPH(4, phase_attnB3(get_params(lds), lds, wg, nwg));
    TPH2(23, GRID_SYNC());
#ifdef EXTRA_SYNC
    GRID_SYNC(); GRID_SYNC(); GRID_SYNC(); GRID_SYNC();
#endif
    TPH(5, phase_merge(get_params(lds), lds, wg, nwg));     TPH2(24, GRID_SYNC());
    TPH(6, phase_outproj(get_params(lds), lds, wg, nwg));   TPH2(25, GRID_SYNC());
    TPH(12, phase_router(get_params(lds), lds, wg, nwg));   TPH2(26, GRID_SYNC());
    TPH(7, phase_up(get_params(lds), lds, wg, nwg));        TPH2(27, GRID_SYNC());
    TPH(8, phase_down(get_params(lds), lds, wg, nwg));      TPH2(28, GRID_SYNC());
    TPH(9, phase_final(get_params(lds), lds, wg, nwg));
    if (TIMEPH) { const long long t0_ = __builtin_readcyclecounter(); while (__builtin_readcyclecounter() - t0_ < tph) __builtin_amdgcn_s_sleep(1); }
#undef TPH
#undef GRID_SYNC
}
}

extern "C" void kernel_launch(void* const* d_in, const int* in_sizes, int n_in, void* d_out, int out_size, void* d_ws, size_t ws_size,
                              hipStream_t stream) {
    static int grid_blocks = 0;
    if (grid_blocks == 0) {
        int dev = 0, cus = 0, per_cu = 0;
        if (hipGetDevice(&dev) != hipSuccess || hipDeviceGetAttribute(&cus, hipDeviceAttributeMultiprocessorCount, dev) != hipSuccess) { fprintf(stderr, "kernel_launch: device query failed\n"); grid_blocks = -1; return; }
        if (hipFuncSetAttribute((const void*)k_mega, hipFuncAttributeMaxDynamicSharedMemorySize, LDS_TOTAL) != hipSuccess) { fprintf(stderr, "kernel_launch: hipFuncSetAttribute failed\n"); grid_blocks = -1; return; }
        if (hipOccupancyMaxActiveBlocksPerMultiprocessor(&per_cu, (const void*)k_mega, NTHR, LDS_TOTAL) != hipSuccess || per_cu < 1) { fprintf(stderr, "kernel_launch: occupancy query says %d blocks/CU\n", per_cu); grid_blocks = -1; return; }
        grid_blocks = cus * per_cu;
        if (grid_blocks > NWG) grid_blocks = NWG;
        if (grid_blocks != NWG) { fprintf(stderr, "kernel_launch: need %d co-resident workgroups, device offers %d\n", NWG, grid_blocks); grid_blocks = -1; return; }
        if (ws_size < WS_END) { fprintf(stderr, "kernel_launch: workspace too small (%zu < %zu)\n", ws_size, (size_t)WS_END); grid_blocks = -1; return; }
    }
    if (grid_blocks < 0) return;
    Params p{};
    for (int i = 0; i < 22; ++i) p.in[i] = (const float*)d_in[i];
    p.out = (float*)d_out; p.ws = (unsigned char*)d_ws;
    if (hipMemsetAsync((char*)d_ws + WS_SMALL, 0, 16384, stream) != hipSuccess) { fprintf(stderr, "kernel_launch: memset failed\n"); return; }
    void* args[] = {&p};
    hipError_t e = hipLaunchCooperativeKernel((const void*)k_mega, dim3(grid_blocks), dim3(NTHR), args, LDS_TOTAL, stream);
    if (e != hipSuccess) fprintf(stderr, "kernel_launch: cooperative launch failed: %s (grid %d)\n", hipGetErrorString(e), grid_blocks);
}
```

```cpp
#include <hip/hip_runtime.h>
#include <hip/hip_cooperative_groups.h>
#include <stdint.h>
#include <stdio.h>

namespace {
constexpr int NB = 8, SEQ = 4096, DM = 1024, TOK = NB * SEQ;
constexpr int INW = 5120;
constexpr int C_QA = 0, C_KA = 512, C_VA = 1024, C_QB = 1536, C_KB = 2048, C_VB = 2560, C_GA = 3072, C_GB = 4096;
constexpr int NEXP = 32, TOPK = 4, NASG = TOK * TOPK;
constexpr float ALPHA = 1.189207115002721f;
constexpr float LAMBDA_INIT = 0.2f;
constexpr float LOG2E = 1.4426950408889634f;
constexpr size_t MiB = 1048576;

__device__ __forceinline__ float sigmoidf_(float x) { return 1.0f / (1.0f + __expf(-x)); }
__device__ __forceinline__ float slope_of(int idx) { return exp2f(-8.0f * (float)(idx + 1) / 12.0f); }
#define LAS __attribute__((address_space(3)))
typedef _Float16 f16;
typedef _Float16 f16x8 __attribute__((ext_vector_type(8)));
typedef _Float16 f16x4 __attribute__((ext_vector_type(4)));
typedef _Float16 f16x2 __attribute__((ext_vector_type(2)));
typedef float f32x4 __attribute__((ext_vector_type(4)));
typedef float f32x16 __attribute__((ext_vector_type(16)));
typedef unsigned u32x4 __attribute__((ext_vector_type(4)));
typedef unsigned u32x2 __attribute__((ext_vector_type(2)));

constexpr int NTHR = 512, NWG = 256;
constexpr int BM = 256, BK = 64, HALF = 128, HTB = HALF * BK * 2, STAGE_BYTES = 8 * HTB;
constexpr int LDS_MISC = STAGE_BYTES;
constexpr int LDS_TOTAL = 155648;
constexpr float QSCALE = 0.125f * 1.4426950408889634f;
constexpr int ROWPAD = 256;
constexpr int MOE_ROWS = NASG + NEXP * ROWPAD;
constexpr int LISTCAP = TOK;


constexpr int LDS_WTAB = LDS_TOTAL - 16 - 256;
__device__ __forceinline__ int get_tid(LAS unsigned char* lds) {
    const unsigned hw = (unsigned)__builtin_amdgcn_s_getreg((5 << 11) | 4) & 63u;
    const int wave = __builtin_amdgcn_readfirstlane(((LAS int*)(lds + LDS_WTAB))[hw]);
    int lane; asm volatile("v_mbcnt_lo_u32_b32 %0, -1, 0\n\tv_mbcnt_hi_u32_b32 %0, -1, %0" : "=v"(lane));
    int t = wave * 64 + lane; asm volatile("" : "+v"(t));
    return t;
}
__device__ __forceinline__ float shx(float v, int mask, int lane) { return __int_as_float(__builtin_amdgcn_ds_bpermute((lane ^ mask) << 2, __float_as_int(v))); }
__device__ __forceinline__ unsigned pk2(float a, float b) { f16x2 v; v.x = (f16)a; v.y = (f16)b; return __builtin_bit_cast(unsigned, v); }
__device__ __forceinline__ int lds_byte(int r, int c) { const int st = (r >> 4) * 2 + (c >> 5), rr = r & 15, cc = c & 31, ob = rr * 64 + cc * 2; return st * 1024 + (ob ^ (((ob >> 9) & 1) << 5)); }
__device__ __forceinline__ void stage_rc(int b, int& R, int& C) { const int st = b / 1024, sb = b % 1024, swz = sb ^ (((sb >> 9) & 1) << 5); R = (st >> 1) * 16 + swz / 64; C = (st & 1) * 32 + (swz % 64) / 2; }
__device__ __forceinline__ int perm32(int rho) { const int n = rho >> 4, i = rho & 15; return 8 * (i >> 2) + 4 * n + (i & 3); }

struct Unit { int pm, pn, e, row0, nrows; };

template <int K_>
struct DenseSched {
    static constexpr int K = K_;
    const char* A; const char* Bt; int nM, nN, nwg, G, c;
    __device__ void init(const void* A_, const void* Bt_, int M, int N, int G_, int c_) { A = (const char*)A_; Bt = (const char*)Bt_; nM = M / BM; nN = N / BM; nwg = nM * nN; G = G_; c = c_; }
    __device__ __forceinline__ bool next(int i, Unit& u) const {
        const long L = (long)i * G + c; if (L >= nwg) return false;
        int wgid = (int)L; { const int q = nwg / 8, r = nwg % 8, xcd = wgid % 8, off = wgid / 8; wgid = (xcd < r ? xcd * (q + 1) : r * (q + 1) + (xcd - r) * q) + off; }
        const int nig = 8 * nN, gid = wgid / nig, fm = gid * 8, gsz = (nM - fm) < 8 ? (nM - fm) : 8;
        u.pm = fm + ((wgid % nig) % gsz); u.pn = (wgid % nig) / gsz; u.e = 0; u.row0 = u.pm * BM; u.nrows = BM; return true;
    }
    static constexpr int LDB = K_, MID = -1;
    static __device__ __forceinline__ unsigned ka(int kt) { return (unsigned)kt * 128u; }
    static __device__ __forceinline__ unsigned kb(int kt) { return (unsigned)kt * 128u; }
    static __device__ __forceinline__ unsigned make_rc(int R, int C) { return (unsigned)(R * K + C) * 2u; }
    __device__ __forceinline__ void a_desc(const Unit& u, const unsigned (&rc)[2], unsigned (&ad)[2]) const { ad[0] = rc[0] + (unsigned)u.pm * (unsigned)(BM * K * 2); ad[1] = rc[1] + (unsigned)u.pm * (unsigned)(BM * K * 2); }
    static __device__ __forceinline__ unsigned aoff(unsigned ad, unsigned rc, int h) { return ad + (unsigned)h * (unsigned)(HALF * K * 2); }
    __device__ __forceinline__ const char* b_base(const Unit& u) const { return Bt + (size_t)u.pn * BM * K * 2; }
};

template <class Sched, class Epi>
__device__ __forceinline__ void gemm_phase(LAS unsigned char* lds, const Sched& S, const Epi& E) {
    constexpr int K = Sched::K, nt = K / BK;
    const int tid = get_tid(lds);
    const int wid = __builtin_amdgcn_readfirstlane(tid >> 6), lane = tid & 63, wr = wid >> 2, wc = wid & 3, fr = lane & 15, fq = lane >> 4;
    unsigned rc[2], voffB[2];
#pragma unroll
    for (int i = 0; i < 2; ++i) { int R, C; stage_rc(tid * 16 + i * 8192, R, C); const int Rb = Epi::PERM ? ((R & ~31) + perm32(R & 31)) : R; voffB[i] = (unsigned)(Rb * Sched::LDB + C) * 2u; rc[i] = Sched::make_rc(R, C); }
    constexpr unsigned hstepB = HALF * Sched::LDB * 2;
    const unsigned ldsw = (unsigned)wid * 1024u;
    const int aoff = lds_byte(wr * 64 + fr, fq * 8), boff = lds_byte(wc * 32 + fr, fq * 8);
#define G_SA(b, h) (((b) * 2 + (h)) * HTB)
#define G_SB(b, h) ((4 + (b) * 2 + (h)) * HTB)
#define G_STAGE_A(bufoff, ad, h, kb) do { \
        __builtin_amdgcn_global_load_lds((const unsigned*)(Abase + (size_t)Sched::aoff((ad)[0], rc[0], h) + (kb)), (LAS unsigned*)(lds + (bufoff) + ldsw), 16, 0, 0); \
        __builtin_amdgcn_global_load_lds((const unsigned*)(Abase + (size_t)Sched::aoff((ad)[1], rc[1], h) + (kb)), (LAS unsigned*)(lds + (bufoff) + ldsw + 8192), 16, 0, 0); } while (0)
#define G_STAGE_B(bufoff, gbase) do { _Pragma("unroll") for (int _i = 0; _i < 2; ++_i) \
        __builtin_amdgcn_global_load_lds((const unsigned*)((const char*)(gbase) + voffB[_i]), (LAS unsigned*)(lds + (bufoff) + ldsw + _i * 8192), 16, 0, 0); } while (0)
#define G_LDA(dst, b, h) do { _Pragma("unroll") for (int m = 0; m < 4; ++m) _Pragma("unroll") for (int k = 0; k < 2; ++k) dst[m][k] = *(const LAS f16x8*)(lds + G_SA(b, h) + aoff + m * 2048 + k * 1024); } while (0)
#define G_LDB(dst, b, h) do { _Pragma("unroll") for (int n = 0; n < 2; ++n) _Pragma("unroll") for (int k = 0; k < 2; ++k) dst[n][k] = *(const LAS f16x8*)(lds + G_SB(b, h) + boff + n * 2048 + k * 1024); } while (0)
#define G_MMA(ai, bj, At, Bt) do { __builtin_amdgcn_s_setprio(1); _Pragma("unroll") for (int m = 0; m < 4; ++m) _Pragma("unroll") for (int n = 0; n < 2; ++n) _Pragma("unroll") for (int k = 0; k < 2; ++k) \
        acc[ai][bj][m][n] = __builtin_amdgcn_mfma_f32_16x16x32_f16(Bt[n][k], At[m][k], acc[ai][bj][m][n], 0, 0, 0); __builtin_amdgcn_s_setprio(0); } while (0)
#define G_WAIT_V(n) asm volatile("s_waitcnt vmcnt(" #n ")" ::: "memory")
#define G_WAIT_L(n) asm volatile("s_waitcnt lgkmcnt(" #n ")" ::: "memory")
#define G_BAR __builtin_amdgcn_s_barrier()
#define G_SCHED __builtin_amdgcn_sched_barrier(0)
    Unit cur, nxt; int ui = 0;
    if (!S.next(0, cur)) return;
    f32x4 acc[2][2][4][2];
#pragma unroll
    for (int a = 0; a < 2; ++a)
#pragma unroll
        for (int b = 0; b < 2; ++b)
#pragma unroll
            for (int m = 0; m < 4; ++m)
#pragma unroll
                for (int n = 0; n < 2; ++n) acc[a][b][m][n] = (f32x4){0.f, 0.f, 0.f, 0.f};
    f16x8 At[4][2], B0[2][2], B1[2][2];
    const char* const Abase = S.A;
    unsigned cad[2], nad[2];
    S.a_desc(cur, rc, cad);
    const char* cB = S.b_base(cur);
    G_STAGE_B(G_SB(0, 0), cB); G_STAGE_B(G_SB(0, 1), cB + hstepB); G_STAGE_A(G_SA(0, 0), cad, 0, 0u); G_STAGE_A(G_SA(0, 1), cad, 1, 0u);
    if (wr == 1) G_BAR;
    G_WAIT_V(2); G_BAR;
    G_STAGE_B(G_SB(1, 0), cB + Sched::kb(1)); G_STAGE_A(G_SA(1, 0), cad, 0, Sched::ka(1)); G_STAGE_B(G_SB(1, 1), cB + hstepB + Sched::kb(1));
    G_WAIT_V(6); G_BAR;
    for (;;) {
        const bool has_next = S.next(ui + 1, nxt);
        const char* nB = cB;
        if (has_next) { S.a_desc(nxt, rc, nad); nB = S.b_base(nxt); }
        else { nad[0] = cad[0]; nad[1] = cad[1]; }
        for (int t = 0; t < nt; t += 2) {
            const bool last = (t == nt - 2);
            const unsigned k1 = Sched::ka(t + 1);
            const unsigned k2 = last ? Sched::ka(0) : Sched::ka(t + 2), k3 = last ? Sched::ka(1) : Sched::ka(t + 3);
            const unsigned a2[2] = {last ? nad[0] : cad[0], last ? nad[1] : cad[1]};
            const char* b2 = (last ? nB + Sched::kb(0) : cB + Sched::kb(t + 2)); const char* b3 = (last ? nB + Sched::kb(1) : cB + Sched::kb(t + 3));
            if constexpr (Sched::MID >= 0) { if (t == Sched::MID) E.mid(acc, cur, wr, wc, fr, fq); }
            G_LDB(B0, 0, 0); G_LDB(B1, 0, 1); G_SCHED; G_LDA(At, 0, 0); G_STAGE_A(G_SA(1, 1), cad, 1, k1);
            G_WAIT_V(8); G_WAIT_L(0); G_BAR; G_MMA(0, 0, At, B0); G_MMA(0, 1, At, B1); G_BAR; G_SCHED;
            G_LDA(At, 0, 1); G_STAGE_B(G_SB(0, 0), b2); G_STAGE_B(G_SB(0, 1), b2 + hstepB); G_STAGE_A(G_SA(0, 0), a2, 0, k2);
            G_WAIT_V(8); G_WAIT_L(0); G_BAR; G_MMA(1, 0, At, B0); G_MMA(1, 1, At, B1); G_BAR; G_SCHED;
            G_LDB(B0, 1, 0); G_LDB(B1, 1, 1); G_SCHED; G_LDA(At, 1, 0); G_STAGE_A(G_SA(0, 1), a2, 1, k2);
            G_WAIT_V(8); G_WAIT_L(0); G_BAR; G_MMA(0, 0, At, B0); G_MMA(0, 1, At, B1); G_BAR; G_SCHED;
            G_LDA(At, 1, 1); G_STAGE_B(G_SB(1, 0), b3); G_STAGE_B(G_SB(1, 1), b3 + hstepB); G_STAGE_A(G_SA(1, 0), a2, 0, k3);
            G_WAIT_V(8); G_WAIT_L(0); G_BAR; G_MMA(1, 0, At, B0); G_MMA(1, 1, At, B1); G_BAR; G_SCHED;
        }
        if (wr == 0) G_BAR;
        E(acc, cur, wr, wc, fr, fq);
        if (!has_next) break;
#pragma unroll
        for (int a = 0; a < 2; ++a)
#pragma unroll
            for (int b = 0; b < 2; ++b)
#pragma unroll
                for (int m = 0; m < 4; ++m)
#pragma unroll
                    for (int n = 0; n < 2; ++n) acc[a][b][m][n] = (f32x4){0.f, 0.f, 0.f, 0.f};
        cur = nxt; cB = nB; ++ui; cad[0] = nad[0]; cad[1] = nad[1];
        if (wr == 1) G_BAR;
    }
    G_WAIT_V(0);
    G_BAR;
#undef G_SA
#undef G_SB
#undef G_STAGE_A
#undef G_STAGE_B
#undef G_LDA
#undef G_LDB
#undef G_MMA
#undef G_WAIT_V
#undef G_WAIT_L
#undef G_BAR
#undef G_SCHED
}
constexpr size_t WS_WIN = 0;
constexpr size_t WS_WPA = WS_WIN + (size_t)INW * DM * 2;
constexpr size_t WS_WPB = WS_WPA + (size_t)DM * 512 * 2;
constexpr size_t WS_WOUT = WS_WPB + (size_t)DM * 512 * 2;
constexpr size_t WS_WUP = WS_WOUT + (size_t)DM * DM * 2;
constexpr size_t WS_WDN = WS_WUP + (size_t)NEXP * 2048 * DM * 2;
constexpr size_t WS_XH = WS_WDN + (size_t)NEXP * DM * DM * 2;
constexpr size_t WS_PROJ = WS_XH + (size_t)TOK * DM * 2;
constexpr size_t WS_OAB = WS_PROJ + (size_t)TOK * INW * 2;
constexpr size_t WS_MERGED = WS_OAB + (size_t)TOK * DM * 2;
constexpr size_t WS_H1 = WS_MERGED + (size_t)TOK * DM * 2;
constexpr size_t WS_SMALL = WS_H1 + (size_t)TOK * DM * 4 + 16 * MiB;
constexpr size_t WS_YS = WS_OAB;
constexpr size_t SM_PQ = 16064;
constexpr size_t SM_CNT = 0, SM_TK = 16384, SM_LIST = SM_TK + (size_t)NASG * 4;
constexpr size_t WS_END = WS_SMALL + SM_LIST + (size_t)NEXP * LISTCAP * 8;
static_assert(WS_YS + (size_t)MOE_ROWS * DM * 2 <= WS_SMALL, "ys overlaps bookkeeping");
static_assert((size_t)MOE_ROWS * DM * 2 <= (size_t)TOK * INW * 2, "act does not fit over proj");
static_assert(WS_END <= 1024 * MiB, "workspace");

struct Params {
    const float* in[22]; float* out; unsigned char* ws;
};

constexpr int LDS_PARAMS = LDS_WTAB - 256;
__device__ __forceinline__ unsigned long long rfl64(unsigned long long v) {
    const unsigned lo = (unsigned)__builtin_amdgcn_readfirstlane((int)(unsigned)v), hi = (unsigned)__builtin_amdgcn_readfirstlane((int)(unsigned)(v >> 32));
    return ((unsigned long long)hi << 32) | lo; }
__device__ __forceinline__ Params get_params(LAS unsigned char* lds) {
    unsigned off = LDS_PARAMS; asm volatile("" : "+v"(off));
    const LAS unsigned long long* q = (const LAS unsigned long long*)(lds + off);
    Params p;
#pragma unroll
    for (int i = 0; i < 22; ++i) p.in[i] = (const float*)rfl64(q[i]);
    p.out = (float*)rfl64(q[22]); p.ws = (unsigned char*)rfl64(q[23]);
    return p;
}
__device__ __forceinline__ void put_params(const Params& p, LAS unsigned char* lds) {
    LAS unsigned long long* q = (LAS unsigned long long*)(lds + LDS_PARAMS);
#pragma unroll
    for (int i = 0; i < 22; ++i) q[i] = (unsigned long long)p.in[i];
    q[22] = (unsigned long long)p.out; q[23] = (unsigned long long)p.ws;
}


struct PrepTile { const float* src; int ldsrc; f16* dst; int K; int n0; };
__device__ __forceinline__ PrepTile prep_desc(const Params& p, int t) {
    unsigned char* ws = p.ws;
    constexpr int T_IN = (INW / 64) * (DM / 128), T_PA = (DM / 64) * (512 / 128), T_OUT = (DM / 64) * (DM / 128);
    constexpr int T_UP1 = (2048 / 64) * (DM / 128), T_DN1 = (DM / 64) * (DM / 128);
    constexpr int T0 = T_IN, T1 = T0 + T_PA, T2 = T1 + T_PA, T3 = T2 + T_OUT, T4 = T3 + NEXP * T_UP1;
    PrepTile d;
    if (t < T0) { const int tn = t / 8, tk = t % 8; d.src = p.in[1] + (size_t)(tk * 128) * INW + tn * 64; d.ldsrc = INW; d.dst = (f16*)(ws + WS_WIN) + tk * 128; d.K = DM; d.n0 = tn * 64; }
    else if (t < T1) { const int q = t - T0, tn = q / 4, tk = q % 4; d.src = p.in[8] + (size_t)(tk * 128) * DM + tn * 64; d.ldsrc = DM; d.dst = (f16*)(ws + WS_WPA) + tk * 128; d.K = 512; d.n0 = tn * 64; }
    else if (t < T2) { const int q = t - T1, tn = q / 4, tk = q % 4; d.src = p.in[9] + (size_t)(tk * 128) * DM + tn * 64; d.ldsrc = DM; d.dst = (f16*)(ws + WS_WPB) + tk * 128; d.K = 512; d.n0 = tn * 64; }
    else if (t < T3) { const int q = t - T2, tn = q / 8, tk = q % 8; d.src = p.in[10] + (size_t)(tk * 128) * DM + tn * 64; d.ldsrc = DM; d.dst = (f16*)(ws + WS_WOUT) + tk * 128; d.K = DM; d.n0 = tn * 64; }
    else if (t < T4) { const int q = t - T3, e = q / T_UP1, r = q % T_UP1, tn = r / 8, tk = r % 8;
        const int np = tn * 64, pn = np >> 8, jj = np & 255;
        const int sc = jj < 128 ? pn * 128 + jj : 1024 + pn * 128 + (jj - 128);
        d.src = p.in[16] + (size_t)e * DM * 2048 + (size_t)(tk * 128) * 2048 + sc; d.ldsrc = 2048; d.dst = (f16*)(ws + WS_WUP) + (size_t)e * 2048 * DM + tk * 128; d.K = DM; d.n0 = np; }
    else { const int q = t - T4, e = q / T_DN1, r = q % T_DN1, tn = r / 8, tk = r % 8;
        d.src = p.in[18] + (size_t)e * DM * DM + (size_t)(tk * 128) * DM + tn * 64; d.ldsrc = DM; d.dst = (f16*)(ws + WS_WDN) + (size_t)e * DM * DM + tk * 128; d.K = DM; d.n0 = tn * 64; }
    return d;
}
constexpr int PREP_NT = (INW / 64) * (DM / 128) + 2 * (DM / 64) * (512 / 128) + (DM / 64) * (DM / 128) + NEXP * ((2048 / 64) * (DM / 128) + (DM / 64) * (DM / 128));
__device__ __forceinline__ void phase_prep(const Params& p, LAS unsigned char* lds, int wg, int nwg) {
    const int tid = get_tid(lds);
    unsigned char* ws = p.ws;
    {
        const float4* src = (const float4*)p.in[0]; u32x4* dst = (u32x4*)(ws + WS_XH);
        constexpr size_t n8 = (size_t)TOK * DM / 8;
        const size_t stride = (size_t)nwg * NTHR;
        for (size_t i = (size_t)wg * NTHR + tid; i < n8; i += 4 * stride) {
            float4 a[4], c[4];
#pragma unroll
            for (int u = 0; u < 4; ++u) { { const f32x4 t0_ = __builtin_nontemporal_load((const f32x4*)(src + 2 * (i + u * stride))), t1_ = __builtin_nontemporal_load((const f32x4*)(src + 2 * (i + u * stride) + 1)); a[u] = make_float4(t0_[0], t0_[1], t0_[2], t0_[3]); c[u] = make_float4(t1_[0], t1_[1], t1_[2], t1_[3]); } }
#pragma unroll
            for (int u = 0; u < 4; ++u) { u32x4 w; w.x = pk2(a[u].x, a[u].y); w.y = pk2(a[u].z, a[u].w); w.z = pk2(c[u].x, c[u].y); w.w = pk2(c[u].z, c[u].w); dst[i + u * stride] = w; }
        }
    }
    LAS float* tile = (LAS float*)lds;
    const int lk = tid >> 4, ln4 = (tid & 15) * 4;
    float4 va[4], vb[4];
#define PREP_LOAD(V, tt) do { if ((tt) < PREP_NT) { const PrepTile d_ = prep_desc(p, (tt)); \
        _Pragma("unroll") for (int j = 0; j < 4; ++j) { const f32x4 t_ = __builtin_nontemporal_load((const f32x4*)(d_.src + (size_t)(lk + 32 * j) * d_.ldsrc + ln4)); V[j] = make_float4(t_[0], t_[1], t_[2], t_[3]); } } } while (0)
#define PREP_DO2(V, tt, tnext) do { if ((tt) < PREP_NT) { const PrepTile d = prep_desc(p, (tt)); \
        _Pragma("unroll") for (int j = 0; j < 4; ++j) { LAS float* r = tile + (lk + 32 * j) * 65 + ln4; r[0] = V[j].x; r[1] = V[j].y; r[2] = V[j].z; r[3] = V[j].w; } \
        PREP_LOAD(V, (tnext)); \
        __syncthreads(); \
        { const int n = tid >> 3, kc = (tid & 7) * 16; u32x4 w0, w1; \
          w0.x = pk2(tile[(kc + 0) * 65 + n], tile[(kc + 1) * 65 + n]); w0.y = pk2(tile[(kc + 2) * 65 + n], tile[(kc + 3) * 65 + n]); \
          w0.z = pk2(tile[(kc + 4) * 65 + n], tile[(kc + 5) * 65 + n]); w0.w = pk2(tile[(kc + 6) * 65 + n], tile[(kc + 7) * 65 + n]); \
          w1.x = pk2(tile[(kc + 8) * 65 + n], tile[(kc + 9) * 65 + n]); w1.y = pk2(tile[(kc + 10) * 65 + n], tile[(kc + 11) * 65 + n]); \
          w1.z = pk2(tile[(kc + 12) * 65 + n], tile[(kc + 13) * 65 + n]); w1.w = pk2(tile[(kc + 14) * 65 + n], tile[(kc + 15) * 65 + n]); \
          f16* o = d.dst + (size_t)(d.n0 + n) * d.K + kc; *(u32x4*)o = w0; *(u32x4*)(o + 8) = w1; } \
        __syncthreads(); } } while (0)
    unsigned* pq = (unsigned*)(ws + WS_SMALL + SM_PQ);
    LAS int* qslot = (LAS int*)(lds + 36864);
    int ta, tb;
    if (tid == 0) { qslot[0] = (int)__hip_atomic_fetch_add(pq, 1u, __ATOMIC_RELAXED, __HIP_MEMORY_SCOPE_AGENT); qslot[1] = (int)__hip_atomic_fetch_add(pq, 1u, __ATOMIC_RELAXED, __HIP_MEMORY_SCOPE_AGENT); }
    __syncthreads();
    ta = qslot[0]; tb = qslot[1];
    PREP_LOAD(va, ta); PREP_LOAD(vb, tb);
#define PREP_DRAW(tv) do { __syncthreads(); if (tid == 0) qslot[0] = (int)__hip_atomic_fetch_add(pq, 1u, __ATOMIC_RELAXED, __HIP_MEMORY_SCOPE_AGENT); __syncthreads(); tv = qslot[0]; } while (0)
#pragma unroll 1
    for (;;) {
        if (ta >= PREP_NT && tb >= PREP_NT) break;
        int tn;
        if (ta < PREP_NT) { PREP_DRAW(tn); PREP_DO2(va, ta, tn); ta = tn; }
        if (tb < PREP_NT) { PREP_DRAW(tn); PREP_DO2(vb, tb, tn); tb = tn; }
    }
#undef PREP_DRAW
#undef PREP_LOAD
#undef PREP_DO2
}

struct EpiInProj {
    static constexpr bool PERM = true;
    f16* O; const float* bias;
    __device__ __forceinline__ void operator()(const f32x4 (&acc)[2][2][4][2], const Unit& u, int wr, int wc, int fr, int fq) const {
        const int row0 = u.pm * BM + wr * 64 + fr, col0 = u.pn * BM + wc * 32 + 8 * fq;
        const int cls = u.pn;
        const float scl = (cls < 2 || cls == 6 || cls == 7) ? QSCALE : 1.0f;
        const bool sig = cls >= 12;
        f32x4 bv[2][2];
#pragma unroll
        for (int bj = 0; bj < 2; ++bj)
#pragma unroll
            for (int n = 0; n < 2; ++n) bv[bj][n] = *(const f32x4*)(bias + col0 + bj * HALF + 4 * n);
#pragma unroll
        for (int ai = 0; ai < 2; ++ai)
#pragma unroll
            for (int m = 0; m < 4; ++m) {
                f16* rowp = O + (size_t)(row0 + ai * HALF + m * 16) * INW + col0;
#pragma unroll
                for (int bj = 0; bj < 2; ++bj) {
                    f32x4 v0 = acc[ai][bj][m][0] + bv[bj][0], v1 = acc[ai][bj][m][1] + bv[bj][1];
                    if (sig) {
#pragma unroll
                        for (int j = 0; j < 4; ++j) { v0[j] = __builtin_amdgcn_rcpf(1.0f + __expf(-v0[j])); v1[j] = __builtin_amdgcn_rcpf(1.0f + __expf(-v1[j])); }
                    } else { v0 *= scl; v1 *= scl; }
                    u32x4 w; w.x = pk2(v0[0], v0[1]); w.y = pk2(v0[2], v0[3]); w.z = pk2(v1[0], v1[1]); w.w = pk2(v1[2], v1[3]);
                    *(u32x4*)(rowp + bj * HALF) = w;
                }
            }
    }
};
__device__ __forceinline__ void phase_inproj(const Params& p, LAS unsigned char* lds, int wg, int nwg) {
    DenseSched<DM> S; S.init(p.ws + WS_XH, p.ws + WS_WIN, TOK, INW, nwg, wg);
    EpiInProj E{(f16*)(p.ws + WS_PROJ), p.in[2]};
    gemm_phase(lds, S, E);
}
constexpr int RT_LOG = 131072, RT_HIST = RT_LOG + 16384;
__device__ __forceinline__ void phase_router(const Params& p, LAS unsigned char* lds, int wg, int nwg) {
    const int tid = get_tid(lds);
    const int lane = tid & 63, wave = tid >> 6;
    const float* h1 = (const float*)(p.ws + WS_H1);
    f16* x1h = (f16*)(p.ws + WS_XH);
    const float* lng = p.in[12]; const float* lnb = p.in[13];
    const float* wr = p.in[14]; const float* br = p.in[15];
    int* cnt = (int*)(p.ws + WS_SMALL + SM_CNT);
    int* tk = (int*)(p.ws + WS_SMALL + SM_TK);
    int2* list = (int2*)(p.ws + WS_SMALL + SM_LIST);
    LAS float* wl = (LAS float*)lds;
    LAS float* slog = (LAS float*)(lds + RT_LOG);
    LAS int* hist = (LAS int*)(lds + RT_HIST);
    LAS int* hbase = hist + 32;
    for (int i = tid; i < DM * 8; i += NTHR) {
        const int col = i >> 3, k = i & 7;
        const float4 v = *(const float4*)(wr + (size_t)col * NEXP + k * 4);
        LAS float* d = wl + col * 32 + ((k ^ ((col >> 1) & 7)) << 2);
        d[0] = v.x; d[1] = v.y; d[2] = v.z; d[3] = v.w;
    }
    if (tid < 32) hist[tid] = 0;
    __syncthreads();
    const int tpw = TOK / (nwg * 8);
    const int tok0 = wg * (TOK / nwg) + wave * tpw;
    float gam[16], bet[16];
#pragma unroll
    for (int r = 0; r < 16; ++r) { gam[r] = lng[r * 64 + lane]; bet[r] = lnb[r * 64 + lane]; }
    float xa[16], xb[16];
#pragma unroll
    for (int r = 0; r < 16; ++r) { xa[r] = h1[(size_t)tok0 * DM + r * 64 + lane]; xb[r] = h1[(size_t)(tok0 + 1) * DM + r * 64 + lane]; }
#pragma unroll 1
    for (int j = 0; j < tpw; j += 2) {
        const int t = tok0 + j;
        float na[16], nb[16];
        if (j + 2 < tpw) {
#pragma unroll
            for (int r = 0; r < 16; ++r) { na[r] = h1[(size_t)(t + 2) * DM + r * 64 + lane]; nb[r] = h1[(size_t)(t + 3) * DM + r * 64 + lane]; }
        } else {
#pragma unroll
            for (int r = 0; r < 16; ++r) { na[r] = 0.f; nb[r] = 0.f; }
        }
        float sa = 0.f, sb = 0.f;
#pragma unroll
        for (int r = 0; r < 16; ++r) { sa += xa[r]; sb += xb[r]; }
        for (int o = 32; o >= 1; o >>= 1) { sa += shx(sa, o, lane); sb += shx(sb, o, lane); }
        const float mua = sa * (1.0f / DM), mub = sb * (1.0f / DM);
        float qa = 0.f, qb = 0.f;
#pragma unroll
        for (int r = 0; r < 16; ++r) { const float da = xa[r] - mua, db = xb[r] - mub; qa += da * da; qb += db * db; }
        for (int o = 32; o >= 1; o >>= 1) { qa += shx(qa, o, lane); qb += shx(qb, o, lane); }
        const float rsa = rsqrtf(qa * (1.0f / DM) + 1e-5f), rsb = rsqrtf(qb * (1.0f / DM) + 1e-5f);
#pragma unroll
        for (int r = 0; r < 16; ++r) {
            xa[r] = (xa[r] - mua) * rsa * gam[r] + bet[r]; xb[r] = (xb[r] - mub) * rsb * gam[r] + bet[r];
            x1h[(size_t)t * DM + r * 64 + lane] = (f16)xa[r]; x1h[(size_t)(t + 1) * DM + r * 64 + lane] = (f16)xb[r];
        }
        typedef float f32x2 __attribute__((ext_vector_type(2)));
        f32x2 ac2[16], ad2[16];
#pragma unroll
        for (int e = 0; e < 16; ++e) { ac2[e] = (f32x2){0.f, 0.f}; ad2[e] = (f32x2){0.f, 0.f}; }
#pragma unroll
        for (int r = 0; r < 16; ++r) {
            const int col = r * 64 + lane;
            const LAS float* wrow = wl + col * 32;
            const int sw = (col >> 1) & 7;
            const f32x2 xa2 = (f32x2){xa[r], xa[r]}, xb2 = (f32x2){xb[r], xb[r]};
#pragma unroll
            for (int k = 0; k < 8; ++k) {
                const f32x4 w4 = *(const LAS f32x4*)(wrow + ((k ^ sw) << 2));
                const f32x2 wlo = (f32x2){w4[0], w4[1]}, whi = (f32x2){w4[2], w4[3]};
                ac2[2 * k] = __builtin_elementwise_fma(xa2, wlo, ac2[2 * k]); ac2[2 * k + 1] = __builtin_elementwise_fma(xa2, whi, ac2[2 * k + 1]);
                ad2[2 * k] = __builtin_elementwise_fma(xb2, wlo, ad2[2 * k]); ad2[2 * k + 1] = __builtin_elementwise_fma(xb2, whi, ad2[2 * k + 1]);
            }
        }
        float acc[32], acd[32];
#pragma unroll
        for (int e = 0; e < 16; ++e) { acc[2 * e] = ac2[e][0]; acc[2 * e + 1] = ac2[e][1]; acd[2 * e] = ad2[e][0]; acd[2 * e + 1] = ad2[e][1]; }
#define RT_REDUCE(AC, OUT) do { float a16[16], a8[8], a4[4], a2[2]; \
        { const bool hi_ = (lane & 32) != 0; _Pragma("unroll") for (int k = 0; k < 16; ++k) { const float snd = hi_ ? AC[k] : AC[16 + k]; const float rcv = shx(snd, 32, lane); a16[k] = (hi_ ? AC[16 + k] : AC[k]) + rcv; } } \
        { const bool hi_ = (lane & 16) != 0; _Pragma("unroll") for (int k = 0; k < 8; ++k) { const float snd = hi_ ? a16[k] : a16[8 + k]; const float rcv = shx(snd, 16, lane); a8[k] = (hi_ ? a16[8 + k] : a16[k]) + rcv; } } \
        { const bool hi_ = (lane & 8) != 0; _Pragma("unroll") for (int k = 0; k < 4; ++k) { const float snd = hi_ ? a8[k] : a8[4 + k]; const float rcv = shx(snd, 8, lane); a4[k] = (hi_ ? a8[4 + k] : a8[k]) + rcv; } } \
        { const bool hi_ = (lane & 4) != 0; _Pragma("unroll") for (int k = 0; k < 2; ++k) { const float snd = hi_ ? a4[k] : a4[2 + k]; const float rcv = shx(snd, 4, lane); a2[k] = (hi_ ? a4[2 + k] : a4[k]) + rcv; } } \
        { const bool hi_ = (lane & 2) != 0; const float snd = hi_ ? a2[0] : a2[1]; const float rcv = shx(snd, 2, lane); OUT = (hi_ ? a2[1] : a2[0]) + rcv; } \
        OUT += shx(OUT, 1, lane); } while (0)
        float l0, l1;
        RT_REDUCE(acc, l0); RT_REDUCE(acd, l1);
#undef RT_REDUCE
        if ((lane & 1) == 0) { const float bb = br[lane >> 1]; slog[(wave * tpw + j) * 32 + (lane >> 1)] = l0 + bb; slog[(wave * tpw + j + 1) * 32 + (lane >> 1)] = l1 + bb; }
#pragma unroll
        for (int r = 0; r < 16; ++r) { xa[r] = na[r]; xb[r] = nb[r]; }
    }
    __syncthreads();
    int my_e[4]; float my_g[4]; int my_loc[4];
    const bool act = lane < tpw;
    const int tl = wave * tpw + lane;
    if (act) {
        float v[32];
#pragma unroll
        for (int k = 0; k < 8; ++k) { const f32x4 t4 = *(const LAS f32x4*)(slog + tl * 32 + k * 4); v[k * 4] = t4[0]; v[k * 4 + 1] = t4[1]; v[k * 4 + 2] = t4[2]; v[k * 4 + 3] = t4[3]; }
        float tv[4];
#pragma unroll
        for (int k = 0; k < 4; ++k) {
            float bv = -3.0e38f; int bi = 0;
#pragma unroll
            for (int e = 0; e < 32; ++e) { if (v[e] > bv) { bv = v[e]; bi = e; } }
            tv[k] = bv; my_e[k] = bi;
#pragma unroll
            for (int e = 0; e < 32; ++e) v[e] = (e == bi) ? -3.0e38f : v[e];
        }
        const float e1 = __expf(tv[1] - tv[0]), e2 = __expf(tv[2] - tv[0]), e3 = __expf(tv[3] - tv[0]);
        const float inv = 1.0f / (1.0f + e1 + e2 + e3);
        my_g[0] = inv; my_g[1] = e1 * inv; my_g[2] = e2 * inv; my_g[3] = e3 * inv;
#pragma unroll
        for (int k = 0; k < 4; ++k) my_loc[k] = __hip_atomic_fetch_add(hist + my_e[k], 1, __ATOMIC_RELAXED, __HIP_MEMORY_SCOPE_WORKGROUP);
    }
    __syncthreads();
    if (tid < 32) hbase[tid] = atomicAdd(&cnt[tid], hist[tid]);
    __syncthreads();
    if (act) {
        const int t = tok0 + lane;
#pragma unroll
        for (int k = 0; k < 4; ++k) {
            const int slot = hbase[my_e[k]] + my_loc[k];
            tk[t * 4 + k] = (my_e[k] << 20) | slot;
            list[(size_t)my_e[k] * LISTCAP + slot] = make_int2(t, __float_as_int(my_g[k]));
        }
    }
    __syncthreads();
}

__device__ __forceinline__ void phase_final(const Params& p, LAS unsigned char* lds, int wg, int nwg) {
    const int tid = get_tid(lds);
    const int lane = tid & 63, wave = tid >> 6;
    const f16* x1h = (const f16*)(p.ws + WS_XH);
    const f16* ys = (const f16*)(p.ws + WS_YS);
    const int* cnt = (const int*)(p.ws + WS_SMALL + SM_CNT);
    const int* tk = (const int*)(p.ws + WS_SMALL + SM_TK);
    const float* lng = p.in[20]; const float* lnb = p.in[21];
    LAS int* ps = (LAS int*)lds;
    if (tid == 0) { int a = 0; for (int e = 0; e < NEXP; ++e) { ps[e] = a; a += (cnt[e] + ROWPAD - 1) / ROWPAD * ROWPAD; } }
    __syncthreads();
    const int tpw = TOK / (nwg * 8);
    const int tok0 = wg * (TOK / nwg) + wave * tpw;
    float gm[16], bt[16];
#pragma unroll
    for (int hh = 0; hh < 2; ++hh) { const int c0 = hh * 512 + 8 * lane;
        const float4 g0 = *(const float4*)(lng + c0), g1 = *(const float4*)(lng + c0 + 4), b0 = *(const float4*)(lnb + c0), b1 = *(const float4*)(lnb + c0 + 4);
        gm[hh * 8 + 0] = g0.x; gm[hh * 8 + 1] = g0.y; gm[hh * 8 + 2] = g0.z; gm[hh * 8 + 3] = g0.w; gm[hh * 8 + 4] = g1.x; gm[hh * 8 + 5] = g1.y; gm[hh * 8 + 6] = g1.z; gm[hh * 8 + 7] = g1.w;
        bt[hh * 8 + 0] = b0.x; bt[hh * 8 + 1] = b0.y; bt[hh * 8 + 2] = b0.z; bt[hh * 8 + 3] = b0.w; bt[hh * 8 + 4] = b1.x; bt[hh * 8 + 5] = b1.y; bt[hh * 8 + 6] = b1.z; bt[hh * 8 + 7] = b1.w; }
    f16x8 ra[5], rb[5];
#define FN_LOAD(t_) do { ra[0] = *(const f16x8*)(x1h + (size_t)(t_) * DM + 8 * lane); rb[0] = *(const f16x8*)(x1h + (size_t)(t_) * DM + 512 + 8 * lane); \
        _Pragma("unroll") for (int k = 0; k < 4; ++k) { const int c = tk[(t_) * 4 + k]; const int row = ps[c >> 20] + (c & 0xFFFFF); \
            ra[1 + k] = *(const f16x8*)(ys + (size_t)row * DM + 8 * lane); rb[1 + k] = *(const f16x8*)(ys + (size_t)row * DM + 512 + 8 * lane); } } while (0)
    FN_LOAD(tok0);
#pragma unroll 1
    for (int j = 0; j < tpw; ++j) {
        const int t = tok0 + j;
        float v[16];
#pragma unroll
        for (int i = 0; i < 8; ++i) { v[i] = ALPHA * (float)ra[0][i]; v[8 + i] = ALPHA * (float)rb[0][i]; }
#pragma unroll
        for (int k = 1; k < 5; ++k)
#pragma unroll
            for (int i = 0; i < 8; ++i) { v[i] += (float)ra[k][i]; v[8 + i] += (float)rb[k][i]; }
        if (j + 1 < tpw) FN_LOAD(t + 1);
        float s = 0.f;
#pragma unroll
        for (int i = 0; i < 16; ++i) s += v[i];
        for (int o = 32; o >= 1; o >>= 1) s += shx(s, o, lane);
        const float mu = s * (1.0f / DM);
        float q = 0.f;
#pragma unroll
        for (int i = 0; i < 16; ++i) { const float d = v[i] - mu; q += d * d; }
        for (int o = 32; o >= 1; o >>= 1) q += shx(q, o, lane);
        const float rs = rsqrtf(q * (1.0f / DM) + 1e-5f);
        float* op = p.out + (size_t)t * DM;
#pragma unroll
        for (int hh = 0; hh < 2; ++hh) {
            const int c0 = hh * 512 + 8 * lane;
            float4 o0, o1;
            o0.x = (v[hh * 8 + 0] - mu) * rs * gm[hh * 8 + 0] + bt[hh * 8 + 0]; o0.y = (v[hh * 8 + 1] - mu) * rs * gm[hh * 8 + 1] + bt[hh * 8 + 1];
            o0.z = (v[hh * 8 + 2] - mu) * rs * gm[hh * 8 + 2] + bt[hh * 8 + 2]; o0.w = (v[hh * 8 + 3] - mu) * rs * gm[hh * 8 + 3] + bt[hh * 8 + 3];
            o1.x = (v[hh * 8 + 4] - mu) * rs * gm[hh * 8 + 4] + bt[hh * 8 + 4]; o1.y = (v[hh * 8 + 5] - mu) * rs * gm[hh * 8 + 5] + bt[hh * 8 + 5];
            o1.z = (v[hh * 8 + 6] - mu) * rs * gm[hh * 8 + 6] + bt[hh * 8 + 6]; o1.w = (v[hh * 8 + 7] - mu) * rs * gm[hh * 8 + 7] + bt[hh * 8 + 7];
            *(float4*)(op + c0) = o0; *(float4*)(op + c0 + 4) = o1;
        }
    }
#undef FN_LOAD
    __syncthreads();
}
struct MergeSched {
    static constexpr int K = 1024, LDB = 512, MID = 8;
    static constexpr unsigned OB_JUMP = (unsigned)(TOK * 512 * 2) - 1024u, WB_JUMP = (unsigned)(DM * 512 * 2) - 1024u;
    const char* A; const char* Bt; DenseSched<512> D;
    __device__ void init(const void* oa, const void* wpa_t, int G, int c) { A = (const char*)oa; Bt = (const char*)wpa_t; D.init(oa, wpa_t, TOK, DM, G, c); }
    __device__ __forceinline__ bool next(int i, Unit& u) const { return D.next(i, u); }
    static __device__ __forceinline__ unsigned ka(int kt) { return (unsigned)kt * 128u + (kt >= 8 ? OB_JUMP : 0u); }
    static __device__ __forceinline__ unsigned kb(int kt) { return (unsigned)kt * 128u + (kt >= 8 ? WB_JUMP : 0u); }
    static __device__ __forceinline__ unsigned make_rc(int R, int C) { return (unsigned)(R * 512 + C) * 2u; }
    __device__ __forceinline__ void a_desc(const Unit& u, const unsigned (&rc)[2], unsigned (&ad)[2]) const { const unsigned o = (unsigned)u.pm * (unsigned)(BM * 512 * 2); ad[0] = rc[0] + o; ad[1] = rc[1] + o; }
    static __device__ __forceinline__ unsigned aoff(unsigned ad, unsigned rc, int h) { return ad + (unsigned)h * (unsigned)(HALF * 512 * 2); }
    __device__ __forceinline__ const char* b_base(const Unit& u) const { return Bt + (size_t)u.pn * BM * 512 * 2; }
};
struct EpiMerge {
    static constexpr bool PERM = true;
    const f16* proj; f16* merged;
    __device__ __forceinline__ void mid(f32x4 (&acc)[2][2][4][2], const Unit& u, int wr, int wc, int fr, int fq) const {
        asm volatile("" : "+v"(fr), "+v"(fq));
        const int row0 = u.pm * BM + wr * 64 + fr, col0 = u.pn * BM + wc * 32 + 8 * fq;
#pragma unroll
        for (int ai = 0; ai < 2; ++ai)
#pragma unroll
            for (int m = 0; m < 4; ++m) {
                const size_t row = (size_t)(row0 + ai * HALF + m * 16);
#pragma unroll
                for (int bj = 0; bj < 2; ++bj) {
                    const f16x8 ga = *(const f16x8*)(proj + row * INW + C_GA + col0 + bj * HALF), gb = *(const f16x8*)(proj + row * INW + C_GB + col0 + bj * HALF);
#pragma unroll
                    for (int j = 0; j < 4; ++j) {
                        acc[ai][bj][m][0][j] *= (float)ga[j] * __builtin_amdgcn_rcpf(fmaxf((float)gb[j], 5.9604645e-8f));
                        acc[ai][bj][m][1][j] *= (float)ga[4 + j] * __builtin_amdgcn_rcpf(fmaxf((float)gb[4 + j], 5.9604645e-8f));
                    }
                }
                asm volatile("" ::: "memory");
            }
    }
    __device__ __forceinline__ void operator()(const f32x4 (&acc)[2][2][4][2], const Unit& u, int wr, int wc, int fr, int fq) const {
        const int row0 = u.pm * BM + wr * 64 + fr, col0 = u.pn * BM + wc * 32 + 8 * fq;
#pragma unroll
        for (int ai = 0; ai < 2; ++ai)
#pragma unroll
            for (int m = 0; m < 4; ++m) {
                const size_t row = (size_t)(row0 + ai * HALF + m * 16);
#pragma unroll
                for (int bj = 0; bj < 2; ++bj) {
                    const f16x8 gb = *(const f16x8*)(proj + row * INW + C_GB + col0 + bj * HALF);
                    float v[8];
#pragma unroll
                    for (int j = 0; j < 4; ++j) { v[j] = fmaxf((float)gb[j], 5.9604645e-8f) * acc[ai][bj][m][0][j]; v[4 + j] = fmaxf((float)gb[4 + j], 5.9604645e-8f) * acc[ai][bj][m][1][j]; }
                    u32x4 w; w.x = pk2(v[0], v[1]); w.y = pk2(v[2], v[3]); w.z = pk2(v[4], v[5]); w.w = pk2(v[6], v[7]);
                    *(u32x4*)(merged + row * DM + col0 + bj * HALF) = w;
                }
            }
    }
};
__device__ __forceinline__ void phase_merge(const Params& p, LAS unsigned char* lds, int wg, int nwg) {
    MergeSched S; S.init(p.ws + WS_OAB, p.ws + WS_WPA, nwg, wg);
    EpiMerge E{(const f16*)(p.ws + WS_PROJ), (f16*)(p.ws + WS_MERGED)};
    gemm_phase(lds, S, E);
}
struct EpiOutProj {
    static constexpr bool PERM = false;
    const float* x; const float* bias; float* h1;
    __device__ __forceinline__ void operator()(const f32x4 (&acc)[2][2][4][2], const Unit& u, int wr, int wc, int fr, int fq) const {
        const int row0 = u.pm * BM + wr * 64 + fr, col0 = u.pn * BM + wc * 32 + 4 * fq;
        f32x4 bv[2][2];
#pragma unroll
        for (int bj = 0; bj < 2; ++bj)
#pragma unroll
            for (int n = 0; n < 2; ++n) bv[bj][n] = *(const f32x4*)(bias + col0 + bj * HALF + n * 16);
#pragma unroll
        for (int ai = 0; ai < 2; ++ai)
#pragma unroll
            for (int m = 0; m < 4; ++m) {
                const size_t off = (size_t)(row0 + ai * HALF + m * 16) * DM + col0;
#pragma unroll
                for (int bj = 0; bj < 2; ++bj)
#pragma unroll
                    for (int n = 0; n < 2; ++n) {
                        const f32x4 xv = *(const f32x4*)(x + off + bj * HALF + n * 16);
                        *(f32x4*)(h1 + off + bj * HALF + n * 16) = ALPHA * xv + acc[ai][bj][m][n] + bv[bj][n];
                    }
            }
    }
};
__device__ __forceinline__ void phase_outproj(const Params& p, LAS unsigned char* lds, int wg, int nwg) {
    DenseSched<DM> S; S.init(p.ws + WS_MERGED, p.ws + WS_WOUT, TOK, DM, nwg, wg);
    EpiOutProj E{p.in[0], p.in[11], (float*)(p.ws + WS_H1)};
    gemm_phase(lds, S, E);
}

constexpr int MOE_MISC = STAGE_BYTES;
__device__ __forceinline__ void moe_prefix(const Params& p, LAS unsigned char* lds) {
    LAS int* tpre = (LAS int*)(lds + MOE_MISC); LAS int* ecnt = tpre + 64;
    const int* cnt = (const int*)(p.ws + WS_SMALL + SM_CNT);
    if (get_tid(lds) == 0) { int a = 0; for (int e = 0; e < NEXP; ++e) { const int c = cnt[e]; ecnt[e] = c; tpre[e] = a; a += (c + ROWPAD - 1) / ROWPAD; } tpre[NEXP] = a; }
    __syncthreads();
}
template <int NPN, bool GATHER>
struct MoeSched {
    static constexpr int K = DM;
    const char* A; const char* Bt; const int2* list; LAS int* tpre; LAS int* ecnt; int c;
    __device__ __forceinline__ bool next(int i, Unit& u) const {
        constexpr int MPR = 256 / NPN, MPX = 32 / NPN;
        const int xcd = c & 7, j = c >> 3;
        const int M = i * MPR + xcd * MPX + j / NPN;
        if (M >= tpre[NEXP]) return false;
        int e = 0;
        for (int k = 1; k < NEXP; ++k) e += (tpre[k] <= M) ? 1 : 0;
        u.e = e; u.pm = M - tpre[e]; u.pn = j % NPN; u.row0 = M * ROWPAD; u.nrows = ecnt[e] - u.pm * ROWPAD;
        return true;
    }
    static constexpr int LDB = DM, MID = -1;
    static __device__ __forceinline__ unsigned ka(int kt) { return (unsigned)kt * 128u; }
    static __device__ __forceinline__ unsigned kb(int kt) { return (unsigned)kt * 128u; }
    static __device__ __forceinline__ unsigned make_rc(int R, int C) { return GATHER ? ((unsigned)R | ((unsigned)(2 * C) << 8)) : (unsigned)(R * K + C) * 2u; }
    __device__ __forceinline__ void a_desc(const Unit& u, const unsigned (&rc)[2], unsigned (&ad)[2]) const {
        if (GATHER) {
#pragma unroll
            for (int i = 0; i < 2; ++i) {
                const int R = (int)(rc[i] & 0xFFu);
                const int2* lp = list + (size_t)u.e * LISTCAP + u.pm * ROWPAD + R;
                int t0 = lp[0].x, t1 = lp[HALF].x;
                t0 = R < u.nrows ? t0 : 0; t1 = (R + HALF) < u.nrows ? t1 : 0;
                ad[i] = (unsigned)t0 | ((unsigned)t1 << 16);
            }
            asm volatile("" : "+v"(ad[0]), "+v"(ad[1]));
        } else { ad[0] = rc[0] + (unsigned)u.row0 * (unsigned)(K * 2); ad[1] = rc[1] + (unsigned)u.row0 * (unsigned)(K * 2); }
    }
    static __device__ __forceinline__ unsigned aoff(unsigned ad, unsigned rc, int h) {
        return GATHER ? (((ad >> (16 * h)) & 0xFFFFu) * (unsigned)(K * 2) + (rc >> 8)) : (ad + (unsigned)h * (unsigned)(HALF * K * 2)); }
    __device__ __forceinline__ const char* b_base(const Unit& u) const { return Bt + ((size_t)u.e * (NPN * BM) + (size_t)u.pn * BM) * K * 2; }
};
struct EpiUp {
    static constexpr bool PERM = true;
    const float* bup; f16* act;
    __device__ __forceinline__ void operator()(const f32x4 (&acc)[2][2][4][2], const Unit& u, int wr, int wc, int fr, int fq) const {
        const int col0 = u.pn * HALF + wc * 32 + 8 * fq;
        const float* bg = bup + (size_t)u.e * 2048 + col0; const float* bu = bg + 1024;
        const f32x4 bg0 = *(const f32x4*)bg, bg1 = *(const f32x4*)(bg + 4), bu0 = *(const f32x4*)bu, bu1 = *(const f32x4*)(bu + 4);
#pragma unroll
        for (int ai = 0; ai < 2; ++ai)
#pragma unroll
            for (int m = 0; m < 4; ++m) {
                const size_t row = (size_t)(u.row0 + ai * HALF + wr * 64 + m * 16 + fr);
                float v[8];
#pragma unroll
                for (int n = 0; n < 2; ++n)
#pragma unroll
                    for (int j = 0; j < 4; ++j) {
                        const float hg = acc[ai][0][m][n][j] + (n == 0 ? bg0[j] : bg1[j]), hu = acc[ai][1][m][n][j] + (n == 0 ? bu0[j] : bu1[j]);
                        const float gate = fminf(hg, 7.0f), up = fminf(fmaxf(hu, -7.0f), 7.0f);
                        v[n * 4 + j] = gate * __builtin_amdgcn_rcpf(1.0f + __expf(-1.702f * gate)) * (up + 1.0f);
                    }
                u32x4 w; w.x = pk2(v[0], v[1]); w.y = pk2(v[2], v[3]); w.z = pk2(v[4], v[5]); w.w = pk2(v[6], v[7]);
                *(u32x4*)(act + row * DM + col0) = w;
            }
    }
};
struct EpiDown {
    static constexpr bool PERM = true;
    const float* bdn; const int2* list; f16* ys;
    __device__ __forceinline__ void operator()(const f32x4 (&acc)[2][2][4][2], const Unit& u, int wr, int wc, int fr, int fq) const {
        const int col0 = u.pn * BM + wc * 32 + 8 * fq;
        f32x4 bv[2][2];
#pragma unroll
        for (int bj = 0; bj < 2; ++bj)
#pragma unroll
            for (int n = 0; n < 2; ++n) bv[bj][n] = *(const f32x4*)(bdn + (size_t)u.e * DM + col0 + bj * HALF + 4 * n);
#pragma unroll
        for (int ai = 0; ai < 2; ++ai)
#pragma unroll
            for (int m = 0; m < 4; ++m) {
                const int lr = ai * HALF + wr * 64 + m * 16 + fr;
                float wgt = __int_as_float(list[(size_t)u.e * LISTCAP + u.pm * ROWPAD + lr].y); wgt = lr < u.nrows ? wgt : 0.f;
                f16* rowp = ys + (size_t)(u.row0 + lr) * DM + col0;
#pragma unroll
                for (int bj = 0; bj < 2; ++bj) {
                    const f32x4 v0 = (acc[ai][bj][m][0] + bv[bj][0]) * wgt, v1 = (acc[ai][bj][m][1] + bv[bj][1]) * wgt;
                    u32x4 w; w.x = pk2(v0[0], v0[1]); w.y = pk2(v0[2], v0[3]); w.z = pk2(v1[0], v1[1]); w.w = pk2(v1[2], v1[3]);
                    *(u32x4*)(rowp + bj * HALF) = w;
                }
            }
    }
};
__device__ __forceinline__ void phase_up(const Params& p, LAS unsigned char* lds, int wg, int nwg) {
    moe_prefix(p, lds);
    MoeSched<8, true> S{(const char*)(p.ws + WS_XH), (const char*)(p.ws + WS_WUP), (const int2*)(p.ws + WS_SMALL + SM_LIST), (LAS int*)(lds + MOE_MISC), (LAS int*)(lds + MOE_MISC) + 64, wg};
    EpiUp E{p.in[17], (f16*)(p.ws + WS_PROJ)};
    gemm_phase(lds, S, E);
}
__device__ __forceinline__ void phase_down(const Params& p, LAS unsigned char* lds, int wg, int nwg) {
    moe_prefix(p, lds);
    MoeSched<4, false> S{(const char*)(p.ws + WS_PROJ), (const char*)(p.ws + WS_WDN), (const int2*)(p.ws + WS_SMALL + SM_LIST), (LAS int*)(lds + MOE_MISC), (LAS int*)(lds + MOE_MISC) + 64, wg};
    EpiDown E{p.in[19], (const int2*)(p.ws + WS_SMALL + SM_LIST), (f16*)(p.ws + WS_YS)};
    gemm_phase(lds, S, E);
}
__device__ __forceinline__ float lambda_full(const float* lq1, const float* lk1, const float* lq2, const float* lk2, int lane) {
    float a = lq1[lane] * lk1[lane], c = lq2[lane] * lk2[lane];
    for (int o = 32; o >= 1; o >>= 1) { a += shx(a, o, lane); c += shx(c, o, lane); }
    return __expf(a) - __expf(c) + LAMBDA_INIT;
}
typedef short s16x4 __attribute__((ext_vector_type(4)));
__device__ __forceinline__ int crow(int r, int hi) { return (r & 3) + 8 * (r >> 2) + 4 * hi; }
__device__ __forceinline__ f16x4 vtr(const LAS unsigned char* p) { return __builtin_bit_cast(f16x4, __builtin_amdgcn_ds_read_tr16_b64_v4i16((LAS s16x4*)p)); }
#define MFMA32(a, b, c) __builtin_amdgcn_mfma_f32_32x32x16_f16(a, b, c, 0, 0, 0)
__device__ __forceinline__ float rowmax32(const f32x16& p0, const f32x16& p1) {
    float a = fmaxf(fmaxf(p0[0], p0[1]), p1[0]), b = fmaxf(fmaxf(p0[2], p0[3]), p1[1]); a = fmaxf(fmaxf(a, p1[2]), p1[3]);
#pragma unroll
    for (int r = 4; r < 16; r += 4) { a = fmaxf(fmaxf(a, p0[r]), p0[r + 1]); b = fmaxf(fmaxf(b, p0[r + 2]), p0[r + 3]); a = fmaxf(fmaxf(a, p1[r]), p1[r + 1]); b = fmaxf(fmaxf(b, p1[r + 2]), p1[r + 3]); }
    float m = fmaxf(a, b); auto rr = __builtin_amdgcn_permlane32_swap(__float_as_uint(m), __float_as_uint(m), false, false);
    return fmaxf(__uint_as_float(rr[0]), __uint_as_float(rr[1]));
}
__device__ __forceinline__ float half_sum(float v) { auto rr = __builtin_amdgcn_permlane32_swap(__float_as_uint(v), __float_as_uint(v), false, false); return __uint_as_float(rr[0]) + __uint_as_float(rr[1]); }

constexpr int AB_QSTR = 4160;
constexpr int AB_STG = 16384 + 4 * AB_QSTR;
constexpr int AB_STGS = 33280;
constexpr int AB_WSF = 131072;
constexpr float AB_THR = 8.0f;

constexpr int AA_HSTR = 2112;
constexpr int AA_BUF = 2 * AA_HSTR;
constexpr int AA_KBUF = 4096;
constexpr int AA_WAVE = 2 * AA_BUF + 2 * AA_KBUF + 128;
constexpr float AA_THR = 8.0f;
__device__ __forceinline__ float rowmax16(const f32x16& p0) {
    float a = fmaxf(fmaxf(p0[0], p0[1]), p0[2]), b = fmaxf(fmaxf(p0[3], p0[4]), p0[5]);
    a = fmaxf(fmaxf(a, p0[6]), p0[7]); b = fmaxf(fmaxf(b, p0[8]), p0[9]); a = fmaxf(fmaxf(a, p0[10]), p0[11]); b = fmaxf(fmaxf(b, p0[12]), p0[13]);
    a = fmaxf(fmaxf(a, p0[14]), p0[15]);
    float m = fmaxf(a, b); auto rr = __builtin_amdgcn_permlane32_swap(__float_as_uint(m), __float_as_uint(m), false, false);
    return fmaxf(__uint_as_float(rr[0]), __uint_as_float(rr[1]));
}
__device__ __forceinline__ void phase_attnA(const Params& p, LAS unsigned char* lds, int wg, int nwg) {
    const int tid = get_tid(lds);
    const int lane = tid & 63, r32 = lane & 31, hi = lane >> 5;
    const int wave = __builtin_amdgcn_readfirstlane(tid >> 6);
    const f16* proj = (const f16*)(p.ws + WS_PROJ);
    f16* oa = (f16*)(p.ws + WS_OAB);
    LAS unsigned char* wl = lds + wave * AA_WAVE;
    LAS float* wsf = (LAS float*)(wl + 2 * AA_BUF + 2 * AA_KBUF);
    const int kw0 = (lane >> 3) * 128 + (((lane & 7) ^ (((lane >> 3) >> 1) & 7)) << 4);
    const int kr0 = r32 * 128, kx = (hi ^ ((r32 >> 1) & 7)) << 4;
    const int vl = ((lane >> 4) & 1) * 32 + (lane & 3) * 8 + (4 * hi + ((lane & 15) >> 2)) * 64;
    const int vrow0 = lane >> 3, vch0 = lane & 7, vw0 = (vch0 >> 2) * AA_HSTR + vrow0 * 64 + (vch0 & 3) * 16;
#if defined(AA_TIMEQ)
#define AA_TQ0 const long long tq0_ = __builtin_readcyclecounter();
#define AA_TQ1 tacc += __builtin_readcyclecounter() - tq0_;
#else
#define AA_TQ0
#define AA_TQ1
#endif
    long long tacc = 0;
    constexpr int NTILE = 33;
#pragma unroll 1
    for (int ui = 0; ui < 4; ++ui) {
        const int j = wg >> 3, bh = ui * 16 + (wg & 7) * 2 + (j >> 4), r16 = j & 15;
        const int b = bh >> 3, h = bh & 7;
        const float sl2 = slope_of(h + (h >> 1)) * LOG2E;
        const f16* base = proj + (size_t)b * SEQ * INW;
        const int P0 = r16 + 512 * wave, qpos = P0 + 16 * r32;
        f16x8 qr[4];
#pragma unroll
        for (int d0 = 0; d0 < 4; ++d0) qr[d0] = *(const f16x8*)(base + (size_t)qpos * INW + C_QA + h * 64 + 16 * d0 + 8 * hi);
        f32x16 o[2];
        o[0] = (f32x16){0.f, 0.f, 0.f, 0.f, 0.f, 0.f, 0.f, 0.f, 0.f, 0.f, 0.f, 0.f, 0.f, 0.f, 0.f, 0.f}; o[1] = o[0];
        float m = -1.0e30f, l = 0.f;
        u32x4 kS[4], vA[4];
#define AA_PARAMS(tt, d, n) const int d = (tt) < 5 ? 16 : ((tt) < 13 ? 4 : 1), n = (tt) < 5 ? (tt) : ((tt) < 13 ? (tt) - 5 : (tt) - 13)
#define AA_LOADKV(tt) do { AA_PARAMS(tt, d_, n_); const int kb_ = P0 - 64 * d_ + 32 * d_ * n_; \
            if (kb_ >= 0 && kb_ + 31 * d_ < SEQ) { \
                const f16* r0_ = base + (size_t)(kb_ + d_ * vrow0) * INW + h * 64 + vch0 * 8; const size_t st_ = (size_t)(8 * d_) * INW; \
                _Pragma("unroll") for (int jj = 0; jj < 4; ++jj) { kS[jj] = *(const u32x4*)(r0_ + C_KA + jj * st_); vA[jj] = *(const u32x4*)(r0_ + C_VA + jj * st_); } \
            } else { \
                _Pragma("unroll") for (int jj = 0; jj < 4; ++jj) { int kp = kb_ + d_ * (vrow0 + 8 * jj); kp = kp < 0 ? 0 : (kp > SEQ - 1 ? SEQ - 1 : kp); \
                  const f16* r_ = base + (size_t)kp * INW + h * 64 + vch0 * 8; kS[jj] = *(const u32x4*)(r_ + C_KA); vA[jj] = *(const u32x4*)(r_ + C_VA); } } } while (0)
#define AA_STEP(tt) do { \
            AA_TQ0 asm volatile("s_waitcnt vmcnt(0)" ::: "memory"); AA_TQ1 \
            LAS unsigned char* vbuf = wl + ((tt) & 1) * AA_BUF; \
            LAS unsigned char* kbuf = wl + 2 * AA_BUF + ((tt) & 1) * AA_KBUF; \
            _Pragma("unroll") for (int jj = 0; jj < 4; ++jj) { *(LAS u32x4*)(vbuf + vw0 + jj * 512) = vA[jj]; *(LAS u32x4*)(kbuf + ((kw0 + jj * 1024) ^ ((jj & 1) << 6))) = kS[jj]; } \
            if ((tt) + 1 < NTILE) { AA_LOADKV((tt) + 1); } \
            AA_PARAMS(tt, d, n); \
            const int kb = P0 - 64 * d + 32 * d * n; \
            f32x16 s = (f32x16){0.f, 0.f, 0.f, 0.f, 0.f, 0.f, 0.f, 0.f, 0.f, 0.f, 0.f, 0.f, 0.f, 0.f, 0.f, 0.f}; \
            _Pragma("unroll") for (int d0 = 0; d0 < 4; ++d0) { const f16x8 kf = *(const LAS f16x8*)(kbuf + kr0 + ((d0 << 5) ^ kx)); s = MFMA32(kf, qr[d0], s); } \
            const float df = (float)d, basef = (float)(d * (32 * n + 4 * hi - 64) - 16 * r32), lim = 64.0f * df; \
            const bool need_range = (kb < 0) || (kb + 31 * d >= SEQ); \
            const float kpf0 = (float)(kb + 4 * hi * d); \
            if (need_range) { \
                _Pragma("unroll") for (int r = 0; r < 16; ++r) { \
                    const float c = (float)((r & 3) + 8 * (r >> 2)); \
                    const float ad = __builtin_fabsf(__builtin_fmaf(df, c, basef)), kpf = __builtin_fmaf(df, c, kpf0); \
                    const bool valid = (ad <= lim) && (kpf >= 0.0f) && (kpf < (float)SEQ); \
                    s[r] = valid ? __builtin_fmaf(-sl2, ad, s[r]) : -INFINITY; } \
            } else { \
                _Pragma("unroll") for (int r = 0; r < 16; ++r) { \
                    const float c = (float)((r & 3) + 8 * (r >> 2)); \
                    const float ad = __builtin_fabsf(__builtin_fmaf(df, c, basef)); \
                    s[r] = (ad <= lim) ? __builtin_fmaf(-sl2, ad, s[r]) : -INFINITY; } \
            } \
            const float mx = rowmax16(s); \
            if (__any(mx > m + AA_THR)) { \
                const float mn = fmaxf(m, mx), al = __builtin_amdgcn_exp2f(m - mn); \
                l *= al; m = mn; \
                if (hi == 0) wsf[r32] = al; \
                _Pragma("unroll") for (int r = 0; r < 16; ++r) { const float f = wsf[crow(r, hi)]; o[0][r] *= f; o[1][r] *= f; } } \
            float ls = 0.f; \
            _Pragma("unroll") for (int r = 0; r < 16; ++r) { s[r] = __builtin_amdgcn_exp2f(s[r] - m); ls += s[r]; } \
            l += ls; \
            u32x4 pw[2]; \
            pw[0] = (u32x4){pk2(s[0], s[1]), pk2(s[2], s[3]), pk2(s[4], s[5]), pk2(s[6], s[7])}; \
            pw[1] = (u32x4){pk2(s[8], s[9]), pk2(s[10], s[11]), pk2(s[12], s[13]), pk2(s[14], s[15])}; \
            const LAS unsigned char* vb = vbuf + vl; \
            _Pragma("unroll") for (int ks = 0; ks < 2; ++ks) _Pragma("unroll") for (int dh = 0; dh < 2; ++dh) { \
                    const f16x4 lo = vtr(vb + dh * AA_HSTR + ks * 1024), hh = vtr(vb + dh * AA_HSTR + ks * 1024 + 512); \
                    const f16x8 vf = (f16x8){lo[0], lo[1], lo[2], lo[3], hh[0], hh[1], hh[2], hh[3]}; \
                    o[dh] = MFMA32(__builtin_bit_cast(f16x8, pw[ks]), vf, o[dh]); } \
        } while (0)
        AA_LOADKV(0);
#pragma unroll 1
        for (int tt = 0; tt < NTILE - 1; tt += 2) { AA_STEP(tt); AA_STEP(tt + 1); }
        AA_STEP(NTILE - 1);
#undef AA_STEP
#undef AA_LOADKV
#undef AA_PARAMS
        l = half_sum(l);
        if (hi == 0) wsf[r32] = 1.0f / l;
#pragma unroll
        for (int r = 0; r < 16; ++r) {
            const float il = wsf[crow(r, hi)];
            f16* op = oa + ((size_t)b * SEQ + P0 + 16 * crow(r, hi)) * 512 + h * 64 + r32;
            op[0] = (f16)(o[0][r] * il); op[32] = (f16)(o[1][r] * il);
        }
    }
#if defined(AA_TIMEQ)
    { const long long t0 = __builtin_readcyclecounter(); while (__builtin_readcyclecounter() - t0 < tacc) __builtin_amdgcn_s_sleep(1); }
#endif
    __syncthreads();
}
constexpr int B2_STGS = 33280, B2_WSF = 4 * B2_STGS, B2_CMX = B2_WSF + 1024;
constexpr float B2_THR = 8.0f, B2_SKIP_T = 40.0f;
constexpr size_t SM_KMAX = 15360, SM_KDONE = 15872, SM_AQ = 16000;

__device__ __forceinline__ void glds16_asm(const void* gsrc, unsigned lds_dst) {
    unsigned keep;
    asm volatile("s_mov_b32 %0, m0\n\ts_mov_b32 m0, %2\n\ts_nop 0\n\tglobal_load_lds_dwordx4 %1, off\n\ts_mov_b32 m0, %0" : "=&s"(keep) : "v"(gsrc), "s"(lds_dst) : "memory");
}
__device__ __forceinline__ void phase_knorm(const Params& p, LAS unsigned char* lds, int wg, int nwg) {
    const int tid = get_tid(lds);
    const int lane = tid & 63;
    const f16* proj = (const f16*)(p.ws + WS_PROJ);
    unsigned* kmax2 = (unsigned*)(p.ws + WS_SMALL + SM_KMAX);
    unsigned* kdone = (unsigned*)(p.ws + WS_SMALL + SM_KDONE);
    const int tpw = TOK / nwg;
    const int t = wg * tpw + (tid >> 2), part = tid & 3;
    float n2[2];
#pragma unroll
    for (int g = 0; g < 2; ++g) {
        const f16* kr = proj + (size_t)t * INW + C_KB + (part * 2 + g) * 64;
        float s = 0.f;
#pragma unroll
        for (int c = 0; c < 8; ++c) { const f16x8 v = *(const f16x8*)(kr + c * 8);
#pragma unroll
            for (int j = 0; j < 8; ++j) s = fmaf((float)v[j], (float)v[j], s); }
        n2[g] = s;
    }
#pragma unroll
    for (int g = 0; g < 2; ++g) { for (int o = 4; o <= 32; o <<= 1) n2[g] = fmaxf(n2[g], shx(n2[g], o, lane)); }
    if (lane < 4) {
        const int b = (wg * tpw) / SEQ;
#pragma unroll
        for (int g = 0; g < 2; ++g) { const int hm = part * 2 + g;
            __hip_atomic_fetch_max(kmax2 + b * 8 + hm, __float_as_uint(n2[g]), __ATOMIC_RELAXED, __HIP_MEMORY_SCOPE_AGENT); }
    }
    asm volatile("s_waitcnt vmcnt(0)" ::: "memory");
    __syncthreads();
    if (tid == 0) __hip_atomic_fetch_add(kdone, 1u, __ATOMIC_RELAXED, __HIP_MEMORY_SCOPE_AGENT);
}

__device__ __forceinline__ void dma8(const void* sbase, const unsigned (&vo)[8], unsigned ldk, unsigned ldv) {
    unsigned keep;
    asm volatile(
        "s_mov_b32 %0, m0\n\t"
        "s_mov_b32 m0, %10\n\ts_nop 0\n\tglobal_load_lds_dwordx4 %2, %1\n\t"
        "s_add_i32 m0, %10, 0x400\n\ts_nop 0\n\tglobal_load_lds_dwordx4 %3, %1\n\t"
        "s_add_i32 m0, %10, 0x4000\n\ts_nop 0\n\tglobal_load_lds_dwordx4 %4, %1\n\t"
        "s_add_i32 m0, %10, 0x4400\n\ts_nop 0\n\tglobal_load_lds_dwordx4 %5, %1\n\t"
        "s_mov_b32 m0, %11\n\ts_nop 0\n\tglobal_load_lds_dwordx4 %6, %1\n\t"
        "s_add_i32 m0, %11, 0x400\n\ts_nop 0\n\tglobal_load_lds_dwordx4 %7, %1\n\t"
        "s_add_i32 m0, %11, 0x800\n\ts_nop 0\n\tglobal_load_lds_dwordx4 %8, %1\n\t"
        "s_add_i32 m0, %11, 0xc00\n\ts_nop 0\n\tglobal_load_lds_dwordx4 %9, %1\n\t"
        "s_mov_b32 m0, %0"
        : "=&s"(keep)
        : "s"(sbase), "v"(vo[0]), "v"(vo[1]), "v"(vo[2]), "v"(vo[3]), "v"(vo[4]), "v"(vo[5]), "v"(vo[6]), "v"(vo[7]), "s"(ldk), "s"(ldv)
        : "memory", "scc");
}

constexpr int B3_VQ = 8256;
constexpr int B3_STG = 32768 + 4 * B3_VQ;
constexpr int B3_WSF = 2 * B3_STG, B3_CMX = B3_WSF + 1024;
__device__ __forceinline__ void phase_attnB3(const Params& p, LAS unsigned char* lds, int wg, int nwg) {
    const int tid = get_tid(lds);
    const int lane = tid & 63, r32 = lane & 31, hi = lane >> 5;
    const int wave = __builtin_amdgcn_readfirstlane(tid >> 6), grp = wave >> 2, qsub = wave & 3;
    const f16* proj = (const f16*)(p.ws + WS_PROJ);
    f16* ob = (f16*)(p.ws + WS_OAB) + (size_t)TOK * 512;
    const float lam = lambda_full(p.in[3], p.in[4], p.in[5], p.in[6], lane);
    const float* subg = p.in[7];
    LAS float* wsf = (LAS float*)(lds + B3_WSF) + wave * 32;
    LAS float* cmx = (LAS float*)(lds + B3_CMX);
    if (tid == 0) { unsigned* kdone = (unsigned*)(p.ws + WS_SMALL + SM_KDONE); unsigned sp = 0;
        while (__hip_atomic_load(kdone, __ATOMIC_RELAXED, __HIP_MEMORY_SCOPE_AGENT) < (unsigned)nwg) { __builtin_amdgcn_s_sleep(2); if (++sp > (1u << 22)) break; } }
    __syncthreads();
    const unsigned* kmax2 = (const unsigned*)(p.ws + WS_SMALL + SM_KMAX);
    const int kx4 = (hi ^ ((r32 >> 1) & 7)) << 4, krow = r32 * 128;
#define KOFF(d0) (krow + (((d0) << 5) ^ kx4))
    const int vl = ((lane >> 4) & 1) * 32 + (lane & 3) * 8 + (4 * hi + ((lane & 15) >> 2)) * 64;
    const unsigned vo_k = (unsigned)((16 * wave + (lane >> 3)) * INW + ((lane & 7) ^ (((16 * wave + (lane >> 3)) >> 1) & 7)) * 8) * 2u;
    const unsigned vo_v = (unsigned)((16 * ((4 * wave) & 7) + (lane >> 2)) * INW + (C_VB - C_KB) + (wave >> 1) * 32 + (lane & 3) * 8) * 2u;
    const unsigned ldk_w = (unsigned)wave * 2048u, ldv_w = 32768u + (unsigned)(wave >> 1) * B3_VQ + (unsigned)(wave & 1) * 4096u;
#ifdef B3_PRIO
    if (grp) __builtin_amdgcn_s_setprio(1);
#endif
#ifndef TIMEQ
#define TIMEQ 0
#endif
    long long tacc = 0;
    const unsigned lds0 = (unsigned)(size_t)lds;
    const f32x16 z16 = (f32x16){0.f, 0.f, 0.f, 0.f, 0.f, 0.f, 0.f, 0.f, 0.f, 0.f, 0.f, 0.f, 0.f, 0.f, 0.f, 0.f};

    unsigned* aq = (unsigned*)(p.ws + WS_SMALL + SM_AQ) + (wg & 7);
#pragma unroll 1
    for (;;) {
        if (tid == 0) cmx[8] = __uint_as_float(__hip_atomic_fetch_add(aq, 1u, __ATOMIC_RELAXED, __HIP_MEMORY_SCOPE_AGENT));
        __syncthreads();
        const int u = __builtin_amdgcn_readfirstlane((int)__float_as_uint(cmx[8]));
        if (u >= 128) break;
        const int g8 = wg & 7, h = 3 - (u >> 5), ui = (h - (g8 & 3)) & 3, qb = u & 31;
        const int b = 2 * ui + (g8 >> 2);
        const float sl2 = slope_of(3 * h + 2) * LOG2E;
        const f16* base = proj + (size_t)b * SEQ * INW;
        const int dw = 2 * qb + (qsub >> 1);
        const int qrel = qsub * 32 + r32, qpos = qb * 128 + qrel;
        f16x8 qr[4], ks4[4];
        { int lu = lane; asm volatile("" : "+v"(lu));
          const unsigned qo = (unsigned)((qb * 128 + qsub * 32 + (lu & 31)) * INW + h * 128 + grp * 64 + 8 * (lu >> 5));
#pragma unroll
          for (int d0 = 0; d0 < 4; ++d0) { qr[d0] = *(const f16x8*)(base + qo + C_QB + 16 * d0); ks4[d0] = *(const f16x8*)(base + qo + C_KB + 16 * d0); } }
        float qn2 = 0.f, sii = 0.f;
#pragma unroll
        for (int d0 = 0; d0 < 4; ++d0)
#pragma unroll
            for (int j = 0; j < 8; ++j) { const float qv = (float)qr[d0][j]; qn2 = fmaf(qv, qv, qn2); sii = fmaf(qv, (float)ks4[d0][j], sii); }
        qn2 = half_sum(qn2); sii = half_sum(sii);
        const float kmx = sqrtf(__uint_as_float(__hip_atomic_load(kmax2 + b * 8 + h * 2 + grp, __ATOMIC_RELAXED, __HIP_MEMORY_SCOPE_AGENT)));
        float cb = sqrtf(qn2) * kmx * 1.001f - sii;
        for (int of = 16; of >= 1; of >>= 1) cb = fmaxf(cb, shx(cb, of, lane));
        if (lane == 0) cmx[wave] = cb;
        const float a64 = 64.0f * sl2; const f16 aH = (f16)a64, aL = (f16)(a64 - (float)aH), bH = (f16)sl2, bL = (f16)(sl2 - (float)bH);
        const f16 zz = (f16)0.f;
        const unsigned qx01 = hi == 0 ? __builtin_bit_cast(unsigned, (f16x2){aH, aL}) : 0u, qx23 = hi == 0 ? __builtin_bit_cast(unsigned, (f16x2){bH, bL}) : 0u;
        asm volatile("s_waitcnt lgkmcnt(0)" ::: "memory"); __syncthreads();
        float cmax = cmx[0];
#pragma unroll
        for (int w = 1; w < 8; ++w) cmax = fmaxf(cmax, cmx[w]);
        const float Dm = (cmax + B2_SKIP_T + 1.0f) / sl2;
        int t_lo, t_hi;
        { const float lo = ((float)(qb * 128 - 127) - Dm) * (1.0f / 128.0f), hh = ((float)(qb * 128 + 127) + Dm) * (1.0f / 128.0f);
          t_lo = lo <= 0.f ? 0 : (int)lo; t_hi = hh >= 31.f ? 31 : (int)hh; if (t_lo > qb) t_lo = qb; if (t_hi < qb) t_hi = qb; }
        t_lo = __builtin_amdgcn_readfirstlane(t_lo); t_hi = __builtin_amdgcn_readfirstlane(t_hi);
        const int nL = qb - t_lo, U = 1 + nL + (t_hi - qb);
#define B3_SEQ(pp) ((pp) == 0 ? qb : ((pp) - 1 < nL ? qb - 1 - ((pp) - 1) : qb + 1 + ((pp) - 1 - nL)))
        const f16* gk = base + C_KB + h * 128;
#define B3_ISSUE(pp) do { const int T2_ = B3_SEQ(pp); const unsigned st_ = lds0 + (unsigned)((pp) & 1) * (unsigned)B3_STG; \
            const unsigned vo_[8] = {vo_k, (vo_k + 8u * INW * 2u) ^ 64u, vo_k + 128u, ((vo_k + 8u * INW * 2u) ^ 64u) + 128u,     \
                 vo_v, vo_v + 16u * INW * 2u, vo_v + 32u * INW * 2u, vo_v + 48u * INW * 2u}; \
            dma8(gk + (size_t)T2_ * 128 * INW, vo_, (unsigned)__builtin_amdgcn_readfirstlane(st_ + ldk_w), (unsigned)__builtin_amdgcn_readfirstlane(st_ + ldv_w)); } while (0)
        B3_ISSUE(0);
        f32x16 o[4]; o[0] = z16; o[1] = z16; o[2] = z16; o[3] = z16;
        float m = sii, l = 0.f;
        asm volatile("s_waitcnt vmcnt(0) lgkmcnt(0)\n\ts_barrier" ::: "memory");
#define SBAR() __builtin_amdgcn_sched_barrier(0)
#define PIN(x) asm volatile("" : "+v"(x))
#define B3_QK(S0, S1, T, JJ) do { \
            const LAS unsigned char* kbse = st + grp * 16384 + (JJ) * 8192; \
            const int side = (T) <= dw ? 0 : 1; \
            const float sq = sl2 * (float)qrel; \
            const float mr = side == 0 ? -(m + sq) : -(m - sq); \
            const f16 mH = (f16)mr, mL = (f16)(mr - (float)mH), one = (f16)1.0f; \
            const f16 trel = (f16)(float)((T) - 2 * qb), l0 = (f16)(float)r32, l1 = (f16)(float)(32 + r32); \
            const f16x8 kx0 = hi == 0 ? (f16x8){trel, trel, l0, l0, one, one, zz, zz} : (f16x8){zz, zz, zz, zz, zz, zz, zz, zz}; \
            const f16x8 kx1 = hi == 0 ? (f16x8){trel, trel, l1, l1, one, one, zz, zz} : (f16x8){zz, zz, zz, zz, zz, zz, zz, zz}; \
            u32x4 qxb = (u32x4){qx01, qx23, 0u, 0u}; if (side) { qxb.x ^= 0x80008000u; qxb.y ^= 0x80008000u; } \
            if (hi == 0) qxb.z = __builtin_bit_cast(unsigned, (f16x2){mH, mL}); \
            const f16x8 qx = __builtin_bit_cast(f16x8, qxb); \
            S0 = MFMA32(kx0, qx, z16); S1 = MFMA32(kx1, qx, z16); \
            _Pragma("unroll") for (int d0 = 0; d0 < 4; ++d0) { \
                const f16x8 a0 = *(const LAS f16x8*)(kbse + KOFF(d0)), a1 = *(const LAS f16x8*)(kbse + 4096 + KOFF(d0)); \
                S0 = MFMA32(a0, qr[d0], S0); S1 = MFMA32(a1, qr[d0], S1); } } while (0)
#define B3_FIX(S0, S1, T) do { if ((T) == dw) { const float dq0 = (float)(64 * ((T) - 2 * qb) + 4 * hi - qrel), m2 = -2.0f * sl2; \
            _Pragma("unroll") for (int r = 0; r < 16; ++r) { const float c = (float)((r & 3) + 8 * (r >> 2)); \
                S0[r] = __builtin_fmaf(m2, fmaxf(dq0 + c, 0.f), S0[r]); S1[r] = __builtin_fmaf(m2, fmaxf(dq0 + 32.0f + c, 0.f), S1[r]); } } } while (0)
#define B3_EXP(S0, S1, PW) do { float ls = 0.f; \
            _Pragma("unroll") for (int r = 0; r < 16; ++r) { S0[r] = __builtin_amdgcn_exp2f(S0[r]); S1[r] = __builtin_amdgcn_exp2f(S1[r]); ls += S0[r] + S1[r]; } \
            l += ls; \
            PW[0] = (u32x4){pk2(S0[0], S0[1]), pk2(S0[2], S0[3]), pk2(S0[4], S0[5]), pk2(S0[6], S0[7])}; \
            PW[1] = (u32x4){pk2(S0[8], S0[9]), pk2(S0[10], S0[11]), pk2(S0[12], S0[13]), pk2(S0[14], S0[15])}; \
            PW[2] = (u32x4){pk2(S1[0], S1[1]), pk2(S1[2], S1[3]), pk2(S1[4], S1[5]), pk2(S1[6], S1[7])}; \
            PW[3] = (u32x4){pk2(S1[8], S1[9]), pk2(S1[10], S1[11]), pk2(S1[12], S1[13]), pk2(S1[14], S1[15])}; } while (0)
#define B3_PV(PW, JJ) do { const LAS unsigned char* vb = st + 32768 + (JJ) * 4096 + vl; \
            _Pragma("unroll") for (int ks = 0; ks < 4; ++ks) { _Pragma("unroll") for (int dq = 0; dq < 4; ++dq) { \
                const f16x4 lo = vtr(vb + dq * B3_VQ + ks * 1024), hh = vtr(vb + dq * B3_VQ + ks * 1024 + 512); \
                const f16x8 vf = (f16x8){lo[0], lo[1], lo[2], lo[3], hh[0], hh[1], hh[2], hh[3]}; \
                o[dq] = MFMA32(__builtin_bit_cast(f16x8, PW[ks]), vf, o[dq]); } } } while (0)
#pragma unroll 1
        for (int pp = 0; pp < U; ++pp) {
            if (pp + 1 < U) B3_ISSUE(pp + 1);
#ifdef B3_SKEW
            if (grp) __builtin_amdgcn_s_sleep(B3_SKEW);
#endif
            const LAS unsigned char* st = lds + (pp & 1) * B3_STG;
            const int T2 = B3_SEQ(pp), TA = 2 * T2, TB = 2 * T2 + 1;
            f32x16 a0s, a1s, b0s, b1s; u32x4 pwA[4], pwB[4];
            B3_QK(a0s, a1s, TA, 0);
            __builtin_amdgcn_sched_group_barrier(0x100, 4, 0); __builtin_amdgcn_sched_group_barrier(0x8, 2, 0);
            __builtin_amdgcn_sched_group_barrier(0x8, 2, 0); __builtin_amdgcn_sched_group_barrier(0x100, 2, 0);
            __builtin_amdgcn_sched_group_barrier(0x8, 2, 0); __builtin_amdgcn_sched_group_barrier(0x100, 2, 0);
            __builtin_amdgcn_sched_group_barrier(0x8, 4, 0);
            B3_FIX(a0s, a1s, TA);
            { const float mx = rowmax32(a0s, a1s);
              if (__any(mx > B2_THR)) {
                const float dl = fmaxf(mx, 0.f), al = __builtin_amdgcn_exp2f(-dl);
                m += dl; l *= al;
                if (hi == 0) wsf[r32] = al;
#pragma unroll
                for (int r = 0; r < 16; ++r) { const float f = wsf[crow(r, hi)];
#pragma unroll
                    for (int i = 0; i < 4; ++i) o[i][r] *= f;
                    a0s[r] -= dl; a1s[r] -= dl; }
              } }
            {
                const LAS unsigned char* kbse = st + grp * 16384 + 8192;
                const int side = TB <= dw ? 0 : 1;
                const float sq = sl2 * (float)qrel;
                const float mr = side == 0 ? -(m + sq) : -(m - sq);
                const f16 mH = (f16)mr, mL = (f16)(mr - (float)mH), one = (f16)1.0f;
                const f16 trel = (f16)(float)(TB - 2 * qb), l0 = (f16)(float)r32, l1 = (f16)(float)(32 + r32);
                const f16x8 kx0 = hi == 0 ? (f16x8){trel, trel, l0, l0, one, one, zz, zz} : (f16x8){zz, zz, zz, zz, zz, zz, zz, zz};
                const f16x8 kx1 = hi == 0 ? (f16x8){trel, trel, l1, l1, one, one, zz, zz} : (f16x8){zz, zz, zz, zz, zz, zz, zz, zz};
                u32x4 qxb = (u32x4){qx01, qx23, 0u, 0u}; if (side) { qxb.x ^= 0x80008000u; qxb.y ^= 0x80008000u; }
                if (hi == 0) qxb.z = __builtin_bit_cast(unsigned, (f16x2){mH, mL});
                const f16x8 qx = __builtin_bit_cast(f16x8, qxb);
                f16x8 kf0 = *(const LAS f16x8*)(kbse + KOFF(0)), kf1 = *(const LAS f16x8*)(kbse + 4096 + KOFF(0));
                f16x8 kf2 = *(const LAS f16x8*)(kbse + KOFF(1)), kf3 = *(const LAS f16x8*)(kbse + 4096 + KOFF(1));
                float ls = 0.f;
                SBAR();
#define EX3(S, i0) do { S[i0] = __builtin_amdgcn_exp2f(S[i0]); S[i0 + 1] = __builtin_amdgcn_exp2f(S[i0 + 1]); S[i0 + 2] = __builtin_amdgcn_exp2f(S[i0 + 2]); ls += S[i0]; ls += S[i0 + 1]; ls += S[i0 + 2]; PIN(ls); } while (0)
#define EX4(S, i0) do { S[i0] = __builtin_amdgcn_exp2f(S[i0]); S[i0 + 1] = __builtin_amdgcn_exp2f(S[i0 + 1]); S[i0 + 2] = __builtin_amdgcn_exp2f(S[i0 + 2]); S[i0 + 3] = __builtin_amdgcn_exp2f(S[i0 + 3]); ls += S[i0]; ls += S[i0 + 1]; ls += S[i0 + 2]; ls += S[i0 + 3]; PIN(ls); } while (0)
                b0s = MFMA32(kx0, qx, z16); EX3(a0s, 0); SBAR();
                b1s = MFMA32(kx1, qx, z16); EX3(a0s, 3); SBAR();
                b0s = MFMA32(kf0, qr[0], b0s); kf0 = *(const LAS f16x8*)(kbse + KOFF(2)); EX3(a0s, 6); SBAR();
                b1s = MFMA32(kf1, qr[0], b1s); kf1 = *(const LAS f16x8*)(kbse + 4096 + KOFF(2)); EX3(a0s, 9); SBAR();
                b0s = MFMA32(kf2, qr[1], b0s); kf2 = *(const LAS f16x8*)(kbse + KOFF(3)); EX4(a0s, 12); SBAR();
                b1s = MFMA32(kf3, qr[1], b1s); kf3 = *(const LAS f16x8*)(kbse + 4096 + KOFF(3)); EX4(a1s, 0); SBAR();
                b0s = MFMA32(kf0, qr[2], b0s); EX4(a1s, 4); SBAR();
                b1s = MFMA32(kf1, qr[2], b1s); EX4(a1s, 8); SBAR();
                b0s = MFMA32(kf2, qr[3], b0s); EX4(a1s, 12);
                pwA[0] = (u32x4){pk2(a0s[0], a0s[1]), pk2(a0s[2], a0s[3]), pk2(a0s[4], a0s[5]), pk2(a0s[6], a0s[7])};
                pwA[1] = (u32x4){pk2(a0s[8], a0s[9]), pk2(a0s[10], a0s[11]), pk2(a0s[12], a0s[13]), pk2(a0s[14], a0s[15])};
                SBAR();
                b1s = MFMA32(kf3, qr[3], b1s);
                pwA[2] = (u32x4){pk2(a1s[0], a1s[1]), pk2(a1s[2], a1s[3]), pk2(a1s[4], a1s[5]), pk2(a1s[6], a1s[7])};
                pwA[3] = (u32x4){pk2(a1s[8], a1s[9]), pk2(a1s[10], a1s[11]), pk2(a1s[12], a1s[13]), pk2(a1s[14], a1s[15])};
                SBAR();
                l += ls;
            }
            B3_FIX(b0s, b1s, TB);
            { const float mx = rowmax32(b0s, b1s);
              if (__any(mx > B2_THR)) {
                const float dl = fmaxf(mx, 0.f), al = __builtin_amdgcn_exp2f(-dl);
                m += dl; l *= al;
                if (hi == 0) wsf[r32] = al;
#pragma unroll
                for (int r = 0; r < 16; ++r) { const float f = wsf[crow(r, hi)];
#pragma unroll
                    for (int i = 0; i < 4; ++i) o[i][r] *= f;
                    b0s[r] -= dl; b1s[r] -= dl; a0s[r] *= al; a1s[r] *= al; }
                pwA[0] = (u32x4){pk2(a0s[0], a0s[1]), pk2(a0s[2], a0s[3]), pk2(a0s[4], a0s[5]), pk2(a0s[6], a0s[7])};
                pwA[1] = (u32x4){pk2(a0s[8], a0s[9]), pk2(a0s[10], a0s[11]), pk2(a0s[12], a0s[13]), pk2(a0s[14], a0s[15])};
                pwA[2] = (u32x4){pk2(a1s[0], a1s[1]), pk2(a1s[2], a1s[3]), pk2(a1s[4], a1s[5]), pk2(a1s[6], a1s[7])};
                pwA[3] = (u32x4){pk2(a1s[8], a1s[9]), pk2(a1s[10], a1s[11]), pk2(a1s[12], a1s[13]), pk2(a1s[14], a1s[15])};
              } }
            {
                const LAS unsigned char* vb = st + 32768 + vl;
                float ls = 0.f;
#define VFR_(ks, dq) do { const f16x4 lo_ = vtr(vb + (dq) * B3_VQ + (ks) * 1024), hh_ = vtr(vb + (dq) * B3_VQ + (ks) * 1024 + 512); vnx = (f16x8){lo_[0], lo_[1], lo_[2], lo_[3], hh_[0], hh_[1], hh_[2], hh_[3]}; } while (0)
#define EX2(S, i0) do { S[i0] = __builtin_amdgcn_exp2f(S[i0]); S[i0 + 1] = __builtin_amdgcn_exp2f(S[i0 + 1]); ls += S[i0]; ls += S[i0 + 1]; PIN(ls); } while (0)
                f16x8 vcu, vn1, vnx;
                VFR_(0, 0); vcu = vnx; VFR_(0, 1); vn1 = vnx; SBAR();
#define PVG(ks, dq, nks, ndq, S, i0) do { VFR_(nks, ndq); o[dq] = MFMA32(__builtin_bit_cast(f16x8, pwA[ks]), vcu, o[dq]); EX2(S, i0); vcu = vn1; vn1 = vnx; SBAR(); } while (0)
                PVG(0, 0, 0, 2, b0s, 0);  PVG(0, 1, 0, 3, b0s, 2);  PVG(0, 2, 1, 0, b0s, 4);  PVG(0, 3, 1, 1, b0s, 6);
                PVG(1, 0, 1, 2, b0s, 8);  PVG(1, 1, 1, 3, b0s, 10); PVG(1, 2, 2, 0, b0s, 12); PVG(1, 3, 2, 1, b0s, 14);
                PVG(2, 0, 2, 2, b1s, 0);  PVG(2, 1, 2, 3, b1s, 2);  PVG(2, 2, 3, 0, b1s, 4);  PVG(2, 3, 3, 1, b1s, 6);
                PVG(3, 0, 3, 2, b1s, 8);  PVG(3, 1, 3, 3, b1s, 10);
                o[2] = MFMA32(__builtin_bit_cast(f16x8, pwA[3]), vcu, o[2]); EX2(b1s, 12); vcu = vn1; SBAR();
                o[3] = MFMA32(__builtin_bit_cast(f16x8, pwA[3]), vcu, o[3]); EX2(b1s, 14); SBAR();
#undef PVG
#undef VFR_
                l += ls;
                pwB[0] = (u32x4){pk2(b0s[0], b0s[1]), pk2(b0s[2], b0s[3]), pk2(b0s[4], b0s[5]), pk2(b0s[6], b0s[7])};
                pwB[1] = (u32x4){pk2(b0s[8], b0s[9]), pk2(b0s[10], b0s[11]), pk2(b0s[12], b0s[13]), pk2(b0s[14], b0s[15])};
                pwB[2] = (u32x4){pk2(b1s[0], b1s[1]), pk2(b1s[2], b1s[3]), pk2(b1s[4], b1s[5]), pk2(b1s[6], b1s[7])};
                pwB[3] = (u32x4){pk2(b1s[8], b1s[9]), pk2(b1s[10], b1s[11]), pk2(b1s[12], b1s[13]), pk2(b1s[14], b1s[15])};
            }
            B3_PV(pwB, 1);
            __builtin_amdgcn_sched_group_barrier(0x100, 4, 3);
#pragma unroll
            for (int i = 0; i < 14; ++i) { __builtin_amdgcn_sched_group_barrier(0x8, 1, 3); __builtin_amdgcn_sched_group_barrier(0x100, 2, 3); }
            __builtin_amdgcn_sched_group_barrier(0x8, 2, 3);
#if TIMEQ == 1
            { const long long tq0 = __builtin_readcyclecounter(); asm volatile("s_waitcnt vmcnt(0)" ::: "memory"); tacc += __builtin_readcyclecounter() - tq0; }
#endif
#if TIMEQ == 2
            asm volatile("s_waitcnt vmcnt(0)" ::: "memory");
            const long long tq0 = __builtin_readcyclecounter();
#endif
            asm volatile("s_waitcnt vmcnt(0) lgkmcnt(0)\n\ts_barrier" ::: "memory");
#if TIMEQ == 2
            tacc += __builtin_readcyclecounter() - tq0;
#endif
        }
#undef B3_QK
#undef SBAR
#undef PIN
#undef EX2
#undef EX3
#undef EX4
#undef B3_FIX
#undef B3_EXP
#undef B3_PV
#undef B3_ISSUE
#undef B3_SEQ
        l = half_sum(l);
        if (hi == 0) wsf[r32] = 1.0f / l;
        LAS float* ost = (LAS float*)lds + (size_t)grp * 128 * 128;
#pragma unroll
        for (int r = 0; r < 16; ++r) { const float il = wsf[crow(r, hi)]; const int row = qsub * 32 + crow(r, hi);
#pragma unroll
            for (int i = 0; i < 4; ++i) ost[row * 128 + i * 32 + r32] = o[i][r] * il; }
        __syncthreads();
        {
            const LAS float* o1 = (const LAS float*)lds; const LAS float* o2 = o1 + 128 * 128;
            int l2 = lane; asm volatile("" : "+v"(l2));
            const float g0s = subg[l2], g1s = subg[64 + l2];
            for (int rr = 0; rr < 16; ++rr) {
                const int row = wave * 16 + rr;
                const float v0 = o1[row * 128 + l2] - lam * o2[row * 128 + l2], v1 = o1[row * 128 + 64 + l2] - lam * o2[row * 128 + 64 + l2];
                float ss = v0 * v0 + v1 * v1;
                for (int of = 32; of >= 1; of >>= 1) ss += shx(ss, of, lane);
                const float rs = rsqrtf(ss * (1.0f / 128.0f) + 1e-5f) * (1.0f - LAMBDA_INIT);
                f16* op = ob + ((size_t)b * SEQ + qb * 128 + row) * 512 + h * 128;
                op[l2] = (f16)(v0 * rs * g0s); op[64 + l2] = (f16)(v1 * rs * g1s);
            }
        }
        __syncthreads();
    }
#if TIMEQ
    { const long long t0 = __builtin_readcyclecounter(); while (__builtin_readcyclecounter() - t0 < tacc) __builtin_amdgcn_s_sleep(1); }
    __syncthreads();
#endif
#ifdef B3_PRIO
    __builtin_amdgcn_s_setprio(0);
#endif
#undef KOFF
}
#define XB_TMO      128
#define XB_XCNT(j)  (256  + 64 * (j))
#define XB_XSUB(j)  (1280 + 64 * (j))
#define XB_XGEN(j)  (2304 + 64 * (j))
#define XB_TOP      3328
#define XB_TOPGEN   3392
#define XCD_BAR_WORDS 3456
#define XB_SPIN_CAP (1u << 20)
__device__ __forceinline__ unsigned xb_ld(unsigned* p)              { return __hip_atomic_load(p, __ATOMIC_RELAXED, __HIP_MEMORY_SCOPE_AGENT); }
__device__ __forceinline__ unsigned xb_add(unsigned* p, unsigned v) { return __hip_atomic_fetch_add(p, v, __ATOMIC_RELAXED, __HIP_MEMORY_SCOPE_AGENT); }
__device__ __forceinline__ unsigned xb_xcc_id() { return (unsigned)__builtin_amdgcn_s_getreg((3 << 11) | 20) & 0xFu; }
#define XB_SPIN(cond, bar) do { unsigned _sp = 0; while (cond) { __builtin_amdgcn_s_sleep(1); \
    if ((++_sp & 255u) == 0u) { if (xb_ld(&(bar)[XB_TMO])) break; if (_sp > XB_SPIN_CAP) { atomicAdd(&(bar)[XB_TMO], 1u); break; } } } } while (0)
__device__ __forceinline__ void xcd_barrier_post(unsigned* bar, int tid) { if (tid == 0) (void)xb_add(&bar[XB_XCNT(xb_xcc_id())], 1u); }
__device__ __forceinline__ void xcd_barrier_complete(unsigned* bar, unsigned x, unsigned& nloc, unsigned& nx) {
    const unsigned G = gridDim.x;
    unsigned sum, cnt, mine, sp = 0u;
    for (;;) {
        sum = 0u; cnt = 0u; mine = 0u;
#pragma unroll
        for (unsigned j = 0; j < 16; ++j) { const unsigned c = xb_ld(&bar[XB_XCNT(j)]); sum += c; cnt += (c > 0u) ? 1u : 0u; mine = (j == x) ? c : mine; }
        if (sum == G) break;
        __builtin_amdgcn_s_sleep(1);
        if ((++sp & 255u) == 0u) { if (xb_ld(&bar[XB_TMO])) break; if (sp > XB_SPIN_CAP) { atomicAdd(&bar[XB_TMO], 1u); break; } }
    }
    nloc = mine > 0u ? mine : 1u; nx = cnt > 0u ? cnt : 1u;
}
__device__ __forceinline__ void xcd_barrier(unsigned* bar, volatile LAS unsigned* st, LAS unsigned char* lds) {
    const int tid = get_tid(lds);
    asm volatile("s_waitcnt vmcnt(0)" ::: "memory");
    __syncthreads();
    if (tid == 0) {
        const unsigned x = xb_xcc_id();
        __builtin_amdgcn_s_waitcnt(0);
        unsigned nloc = st[0], nx = st[1];
        if (nloc == 0u) { xcd_barrier_complete(bar, x, nloc, nx); st[0] = nloc; st[1] = nx; }
        const unsigned old = xb_add(&bar[XB_XSUB(x)], 1u);
        const unsigned gen = old / nloc;
        if (old + 1u == (gen + 1u) * nloc) {
            __builtin_amdgcn_fence(__ATOMIC_RELEASE, "agent");
            asm volatile("s_waitcnt vmcnt(0)" ::: "memory");
            const unsigned og = xb_add(&bar[XB_TOP], 1u);
            const unsigned tg = og / nx;
            if (og + 1u == (tg + 1u) * nx) xb_add(&bar[XB_TOPGEN], 1u);
            else XB_SPIN(xb_ld(&bar[XB_TOPGEN]) == tg, bar);
            __builtin_amdgcn_fence(__ATOMIC_ACQUIRE, "agent");
            xb_add(&bar[XB_XGEN(x)], 1u);
            asm volatile("s_waitcnt vmcnt(0)" ::: "memory");
        } else {
            XB_SPIN(xb_ld(&bar[XB_XGEN(x)]) == gen, bar);
            __builtin_amdgcn_fence(__ATOMIC_ACQUIRE, "agent");
            asm volatile("s_waitcnt vmcnt(0)" ::: "memory");
        }
    }
    __syncthreads();
}
constexpr int LDS_BARST = LDS_TOTAL - 16;
constexpr size_t SM_BAR = 1024;
__global__ void __launch_bounds__(NTHR, 2) k_mega(Params p) {
    extern __shared__ __attribute__((aligned(16))) unsigned char smem[];
    LAS unsigned char* lds = (LAS unsigned char*)smem;
    const int wg = blockIdx.x, nwg = gridDim.x;
    volatile LAS unsigned* st = (volatile LAS unsigned*)(lds + LDS_BARST);
    { const unsigned hw = (unsigned)__builtin_amdgcn_s_getreg((5 << 11) | 4) & 63u; if ((threadIdx.x & 63) == 0) ((LAS int*)(lds + LDS_WTAB))[hw] = (int)(threadIdx.x >> 6); }
    if (threadIdx.x == 0) { st[0] = 0u; st[1] = 0u; put_params(p, lds); }
    __syncthreads();
    xcd_barrier_post((unsigned*)(get_params(lds).ws + WS_SMALL + SM_BAR), get_tid(lds));
#define GRID_SYNC() xcd_barrier((unsigned*)(get_params(lds).ws + WS_SMALL + SM_BAR), st, lds)
#ifndef TIMEPH
#define TIMEPH 0
#endif
    long long tph = 0;
#define TPH2(n, call) do { if (TIMEPH == (n) || TIMEPH == 11) { const long long t0_ = __builtin_readcyclecounter(); call; tph += __builtin_readcyclecounter() - t0_; } else { call; } } while (0)
#define TPH(n, call) do { if (TIMEPH == (n)) { const long long t0_ = __builtin_readcyclecounter(); call; tph += __builtin_readcyclecounter() - t0_; } else { call; } } while (0)
    TPH(1, phase_prep(get_params(lds), lds, wg, nwg));      TPH2(21, GRID_SYNC());
    TPH(2, phase_inproj(get_params(lds), lds, wg, nwg));    TPH2(22, GRID_SYNC());
    TPH(10, phase_knorm(get_params(lds), lds, wg, nwg));
    TPH(3, phase_attnA(get_params(lds), lds, wg, nwg));
    TPH(4, phase_attnB3(get_params(lds), lds, wg, nwg));
    TPH2(23, GRID_SYNC());
#ifdef EXTRA_SYNC
    GRID_SYNC(); GRID_SYNC(); GRID_SYNC(); GRID_SYNC();
#endif
    TPH(5, phase_merge(get_params(lds), lds, wg, nwg));     TPH2(24, GRID_SYNC());
    TPH(6, phase_outproj(get_params(lds), lds, wg, nwg));   TPH2(25, GRID_SYNC());
    TPH(12, phase_router(get_params(lds), lds, wg, nwg));   TPH2(26, GRID_SYNC());
    TPH(7, phase_up(get_params(lds), lds, wg, nwg));        TPH2(27, GRID_SYNC());
    TPH(8, phase_down(get_params(lds), lds, wg, nwg));      TPH2(28, GRID_SYNC());
    TPH(9, phase_final(get_params(lds), lds, wg, nwg));
    if (TIMEPH) { const long long t0_ = __builtin_readcyclecounter(); while (__builtin_readcyclecounter() - t0_ < tph) __builtin_amdgcn_s_sleep(1); }
#undef TPH
#undef GRID_SYNC
}
}

extern "C" void kernel_launch(void* const* d_in, const int* in_sizes, int n_in, void* d_out, int out_size, void* d_ws, size_t ws_size,
                              hipStream_t stream) {
    static int grid_blocks = 0;
    if (grid_blocks == 0) {
        int dev = 0, cus = 0, per_cu = 0;
        if (hipGetDevice(&dev) != hipSuccess || hipDeviceGetAttribute(&cus, hipDeviceAttributeMultiprocessorCount, dev) != hipSuccess) { fprintf(stderr, "kernel_launch: device query failed\n"); grid_blocks = -1; return; }
        if (hipFuncSetAttribute((const void*)k_mega, hipFuncAttributeMaxDynamicSharedMemorySize, LDS_TOTAL) != hipSuccess) { fprintf(stderr, "kernel_launch: hipFuncSetAttribute failed\n"); grid_blocks = -1; return; }
        if (hipOccupancyMaxActiveBlocksPerMultiprocessor(&per_cu, (const void*)k_mega, NTHR, LDS_TOTAL) != hipSuccess || per_cu < 1) { fprintf(stderr, "kernel_launch: occupancy query says %d blocks/CU\n", per_cu); grid_blocks = -1; return; }
        grid_blocks = cus * per_cu;
        if (grid_blocks > NWG) grid_blocks = NWG;
        if (grid_blocks != NWG) { fprintf(stderr, "kernel_launch: need %d co-resident workgroups, device offers %d\n", NWG, grid_blocks); grid_blocks = -1; return; }
        if (ws_size < WS_END) { fprintf(stderr, "kernel_launch: workspace too small (%zu < %zu)\n", ws_size, (size_t)WS_END); grid_blocks = -1; return; }
    }
    if (grid_blocks < 0) return;
    Params p{};
    for (int i = 0; i < 22; ++i) p.in[i] = (const float*)d_in[i];
    p.out = (float*)d_out; p.ws = (unsigned char*)d_ws;
    if (hipMemsetAsync((char*)d_ws + WS_SMALL, 0, 16384, stream) != hipSuccess) { fprintf(stderr, "kernel_launch: memset failed\n"); return; }
    void* args[] = {&p};
    hipError_t e = hipLaunchCooperativeKernel((const void*)k_mega, dim3(grid_blocks), dim3(NTHR), args, LDS_TOTAL, stream);
    if (e != hipSuccess) fprintf(stderr, "kernel_launch: cooperative launch failed: %s (grid %d)\n", hipGetErrorString(e), grid_blocks);
}
```

```cpp
#include <hip/hip_runtime.h>
#include <hip/hip_cooperative_groups.h>
#include <stdint.h>
#include <stdio.h>

namespace {
constexpr int NB = 8, SEQ = 4096, DM = 1024, TOK = NB * SEQ;
constexpr int INW = 5120;
constexpr int C_QA = 0, C_KA = 512, C_VA = 1024, C_QB = 1536, C_KB = 2048, C_VB = 2560, C_GA = 3072, C_GB = 4096;
constexpr int NEXP = 32, TOPK = 4, NASG = TOK * TOPK;
constexpr float ALPHA = 1.189207115002721f;
constexpr float LAMBDA_INIT = 0.2f;
constexpr float LOG2E = 1.4426950408889634f;
constexpr size_t MiB = 1048576;

__device__ __forceinline__ float sigmoidf_(float x) { return 1.0f / (1.0f + __expf(-x)); }
__device__ __forceinline__ float slope_of(int idx) { return exp2f(-8.0f * (float)(idx + 1) / 12.0f); }
#define LAS __attribute__((address_space(3)))
#define GAS __attribute__((address_space(1)))
typedef _Float16 f16;
typedef _Float16 f16x8 __attribute__((ext_vector_type(8)));
typedef _Float16 f16x4 __attribute__((ext_vector_type(4)));
typedef _Float16 f16x2 __attribute__((ext_vector_type(2)));
typedef float f32x4 __attribute__((ext_vector_type(4)));
typedef float f32x16 __attribute__((ext_vector_type(16)));
typedef unsigned u32x4 __attribute__((ext_vector_type(4)));
typedef unsigned u32x2 __attribute__((ext_vector_type(2)));

constexpr int NTHR = 512, NWG = 256;
constexpr int BM = 256, BK = 64, HALF = 128, HTB = HALF * BK * 2, STAGE_BYTES = 8 * HTB;
constexpr int LDS_MISC = STAGE_BYTES;
constexpr int LDS_TOTAL = 155648;
constexpr float QSCALE = 0.125f * 1.4426950408889634f;
constexpr int ROWPAD = 256;
constexpr int MOE_ROWS = NASG + NEXP * ROWPAD;
constexpr int LISTCAP = TOK;


constexpr int LDS_WTAB = LDS_TOTAL - 16 - 256;
__device__ __forceinline__ int get_tid(LAS unsigned char* lds) {
    const unsigned hw = (unsigned)__builtin_amdgcn_s_getreg((5 << 11) | 4) & 63u;
    const int wave = __builtin_amdgcn_readfirstlane(((LAS int*)(lds + LDS_WTAB))[hw]);
    int lane; asm volatile("v_mbcnt_lo_u32_b32 %0, -1, 0\n\tv_mbcnt_hi_u32_b32 %0, -1, %0" : "=v"(lane));
    int t = wave * 64 + lane; asm volatile("" : "+v"(t));
    return t;
}
__device__ __forceinline__ float shx(float v, int mask, int lane) { return __int_as_float(__builtin_amdgcn_ds_bpermute((lane ^ mask) << 2, __float_as_int(v))); }
__device__ __forceinline__ unsigned pk2(float a, float b) { f16x2 v; v.x = (f16)a; v.y = (f16)b; return __builtin_bit_cast(unsigned, v); }
__device__ __forceinline__ int lds_byte(int r, int c) { const int st = (r >> 4) * 2 + (c >> 5), rr = r & 15, cc = c & 31, ob = rr * 64 + cc * 2; return st * 1024 + (ob ^ (((ob >> 9) & 1) << 5)); }
__device__ __forceinline__ void stage_rc(int b, int& R, int& C) { const int st = b / 1024, sb = b % 1024, swz = sb ^ (((sb >> 9) & 1) << 5); R = (st >> 1) * 16 + swz / 64; C = (st & 1) * 32 + (swz % 64) / 2; }
__device__ __forceinline__ int perm32(int rho) { const int n = rho >> 4, i = rho & 15; return 8 * (i >> 2) + 4 * n + (i & 3); }

constexpr int GEMM_PF = STAGE_BYTES + 1024, PF_BIAS = 1024, PF_ROWW = 1536;
__device__ __forceinline__ void glds4_asm(const void* gsrc, unsigned lds_dst) {
    unsigned keep;
    asm volatile("s_mov_b32 %0, m0\n\ts_mov_b32 m0, %2\n\ts_nop 0\n\tglobal_load_lds_dword %1, off\n\ts_mov_b32 m0, %0" : "=&s"(keep) : "v"(gsrc), "s"(lds_dst) : "memory");
}
struct Unit { int pm, pn, e, row0, nrows; };

template <int K_>
struct DenseSched {
    static constexpr int K = K_;
    const char* A; const char* Bt; int nM, nN, nwg, G, c;
    __device__ void init(const void* A_, const void* Bt_, int M, int N, int G_, int c_) { A = (const char*)A_; Bt = (const char*)Bt_; nM = M / BM; nN = N / BM; nwg = nM * nN; G = G_; c = c_; }
    __device__ __forceinline__ bool next(int i, Unit& u) const {
        const long L = (long)i * G + c; if (L >= nwg) return false;
        int wgid = (int)L; { const int q = nwg / 8, r = nwg % 8, xcd = wgid % 8, off = wgid / 8; wgid = (xcd < r ? xcd * (q + 1) : r * (q + 1) + (xcd - r) * q) + off; }
        const int nig = 8 * nN, gid = wgid / nig, fm = gid * 8, gsz = (nM - fm) < 8 ? (nM - fm) : 8;
        u.pm = fm + ((wgid % nig) % gsz); u.pn = (wgid % nig) / gsz; u.e = 0; u.row0 = u.pm * BM; u.nrows = BM; return true;
    }
    static constexpr int LDB = K_, MID = -1;
    static constexpr bool PFIDX = false;
    __device__ __forceinline__ void idx_issue(const Unit&, const unsigned (&)[2], unsigned) const {}
    __device__ __forceinline__ void idx_finish(const Unit&, const unsigned (&)[2], const LAS unsigned char*, int, unsigned (&)[2]) const {}
    static __device__ __forceinline__ unsigned ka(int kt) { return (unsigned)kt * 128u; }
    static __device__ __forceinline__ unsigned kb(int kt) { return (unsigned)kt * 128u; }
    static __device__ __forceinline__ unsigned make_rc(int R, int C) { return (unsigned)(R * K + C) * 2u; }
    __device__ __forceinline__ void a_desc(const Unit& u, const unsigned (&rc)[2], unsigned (&ad)[2]) const { ad[0] = rc[0] + (unsigned)u.pm * (unsigned)(BM * K * 2); ad[1] = rc[1] + (unsigned)u.pm * (unsigned)(BM * K * 2); }
    static __device__ __forceinline__ unsigned aoff(unsigned ad, unsigned rc, int h) { return ad + (unsigned)h * (unsigned)(HALF * K * 2); }
    __device__ __forceinline__ const char* b_base(const Unit& u) const { return Bt + (size_t)u.pn * BM * K * 2; }
};

template <class Sched, class Epi>
__device__ __forceinline__ void gemm_phase(LAS unsigned char* lds, const Sched& S, const Epi& E) {
    constexpr int K = Sched::K, nt = K / BK;
    const int tid = get_tid(lds);
    const int wid = __builtin_amdgcn_readfirstlane(tid >> 6), lane = tid & 63, wr = wid >> 2, wc = wid & 3, fr = lane & 15, fq = lane >> 4;
    unsigned rc[2], voffB[2];
#pragma unroll
    for (int i = 0; i < 2; ++i) { int R, C; stage_rc(tid * 16 + i * 8192, R, C); const int Rb = Epi::PERM ? ((R & ~31) + perm32(R & 31)) : R; voffB[i] = (unsigned)(Rb * Sched::LDB + C) * 2u; rc[i] = Sched::make_rc(R, C); }
    constexpr unsigned hstepB = HALF * Sched::LDB * 2;
    const unsigned ldsw = (unsigned)wid * 1024u;
    const LAS unsigned char* pfa = lds + GEMM_PF + wid * 2048;
    const unsigned pfa_u = (unsigned)__builtin_amdgcn_readfirstlane((int)((unsigned)(size_t)lds + (unsigned)(GEMM_PF + wid * 2048)));
    const int aoff = lds_byte(wr * 64 + fr, fq * 8), boff = lds_byte(wc * 32 + fr, fq * 8);
#define G_SA(b, h) (((b) * 2 + (h)) * HTB)
#define G_SB(b, h) ((4 + (b) * 2 + (h)) * HTB)
#define G_STAGE_A(bufoff, ad, h, kb) do { \
        __builtin_amdgcn_global_load_lds((const unsigned*)(Abase + (size_t)Sched::aoff((ad)[0], rc[0], h) + (kb)), (LAS unsigned*)(lds + (bufoff) + ldsw), 16, 0, 0); \
        __builtin_amdgcn_global_load_lds((const unsigned*)(Abase + (size_t)Sched::aoff((ad)[1], rc[1], h) + (kb)), (LAS unsigned*)(lds + (bufoff) + ldsw + 8192), 16, 0, 0); } while (0)
#define G_STAGE_B(bufoff, gbase) do { _Pragma("unroll") for (int _i = 0; _i < 2; ++_i) \
        __builtin_amdgcn_global_load_lds((const unsigned*)((const char*)(gbase) + voffB[_i]), (LAS unsigned*)(lds + (bufoff) + ldsw + _i * 8192), 16, 0, 0); } while (0)
#define G_LDA(dst, b, h) do { _Pragma("unroll") for (int m = 0; m < 4; ++m) _Pragma("unroll") for (int k = 0; k < 2; ++k) dst[m][k] = *(const LAS f16x8*)(lds + G_SA(b, h) + aoff + m * 2048 + k * 1024); } while (0)
#define G_LDB(dst, b, h) do { _Pragma("unroll") for (int n = 0; n < 2; ++n) _Pragma("unroll") for (int k = 0; k < 2; ++k) dst[n][k] = *(const LAS f16x8*)(lds + G_SB(b, h) + boff + n * 2048 + k * 1024); } while (0)
#define G_MMA(ai, bj, At, Bt) do { __builtin_amdgcn_s_setprio(1); _Pragma("unroll") for (int m = 0; m < 4; ++m) _Pragma("unroll") for (int n = 0; n < 2; ++n) _Pragma("unroll") for (int k = 0; k < 2; ++k) \
        acc[ai][bj][m][n] = __builtin_amdgcn_mfma_f32_16x16x32_f16(Bt[n][k], At[m][k], acc[ai][bj][m][n], 0, 0, 0); __builtin_amdgcn_s_setprio(0); } while (0)
#define G_WAIT_V(n) asm volatile("s_waitcnt vmcnt(" #n ")" ::: "memory")
#define G_WAIT_L(n) asm volatile("s_waitcnt lgkmcnt(" #n ")" ::: "memory")
#define G_BAR __builtin_amdgcn_s_barrier()
#define G_SCHED __builtin_amdgcn_sched_barrier(0)
    Unit cur, nxt; int ui = 0;
    if (!S.next(0, cur)) return;
    f32x4 acc[2][2][4][2];
#pragma unroll
    for (int a = 0; a < 2; ++a)
#pragma unroll
        for (int b = 0; b < 2; ++b)
#pragma unroll
            for (int m = 0; m < 4; ++m)
#pragma unroll
                for (int n = 0; n < 2; ++n) acc[a][b][m][n] = (f32x4){0.f, 0.f, 0.f, 0.f};
    f16x8 At[4][2], B0[2][2], B1[2][2];
    const char* const Abase = S.A;
    unsigned cad[2], nad[2];
    S.a_desc(cur, rc, cad);
    const char* cB = S.b_base(cur);
    G_STAGE_B(G_SB(0, 0), cB); G_STAGE_B(G_SB(0, 1), cB + hstepB); G_STAGE_A(G_SA(0, 0), cad, 0, 0u); G_STAGE_A(G_SA(0, 1), cad, 1, 0u);
    if (wr == 1) G_BAR;
    G_WAIT_V(2); G_BAR;
    G_STAGE_B(G_SB(1, 0), cB + Sched::kb(1)); G_STAGE_A(G_SA(1, 0), cad, 0, Sched::ka(1)); G_STAGE_B(G_SB(1, 1), cB + hstepB + Sched::kb(1));
    G_WAIT_V(6); G_BAR;
    for (;;) {
        const bool has_next = S.next(ui + 1, nxt);
        const char* nB = cB;
        E.prefetch(cur, pfa_u, wr, wc, lane);
        nad[0] = cad[0]; nad[1] = cad[1];
        if (has_next) { if constexpr (Sched::PFIDX) S.idx_issue(nxt, rc, pfa_u); else S.a_desc(nxt, rc, nad); nB = S.b_base(nxt); }
        for (int t = 0; t < nt; t += 2) {
            const bool last = (t == nt - 2);
            const unsigned k1 = Sched::ka(t + 1);
            const unsigned k2 = last ? Sched::ka(0) : Sched::ka(t + 2), k3 = last ? Sched::ka(1) : Sched::ka(t + 3);
            if constexpr (Sched::PFIDX) { if (last && has_next) S.idx_finish(nxt, rc, pfa, lane, nad); }
            const unsigned a2[2] = {last ? nad[0] : cad[0], last ? nad[1] : cad[1]};
            const char* b2 = (last ? nB + Sched::kb(0) : cB + Sched::kb(t + 2)); const char* b3 = (last ? nB + Sched::kb(1) : cB + Sched::kb(t + 3));
            if constexpr (Sched::MID >= 0) { if (t == Sched::MID) E.mid(acc, cur, wr, wc, fr, fq); }
            G_LDB(B0, 0, 0); G_LDB(B1, 0, 1); G_SCHED; G_LDA(At, 0, 0); G_STAGE_A(G_SA(1, 1), cad, 1, k1);
            G_WAIT_V(8); G_WAIT_L(0); G_BAR; G_MMA(0, 0, At, B0); G_MMA(0, 1, At, B1); G_BAR; G_SCHED;
            G_LDA(At, 0, 1); G_STAGE_B(G_SB(0, 0), b2); G_STAGE_B(G_SB(0, 1), b2 + hstepB); G_STAGE_A(G_SA(0, 0), a2, 0, k2);
            G_WAIT_V(8); G_WAIT_L(0); G_BAR; G_MMA(1, 0, At, B0); G_MMA(1, 1, At, B1); G_BAR; G_SCHED;
            G_LDB(B0, 1, 0); G_LDB(B1, 1, 1); G_SCHED; G_LDA(At, 1, 0); G_STAGE_A(G_SA(0, 1), a2, 1, k2);
            G_WAIT_V(8); G_WAIT_L(0); G_BAR; G_MMA(0, 0, At, B0); G_MMA(0, 1, At, B1); G_BAR; G_SCHED;
            G_LDA(At, 1, 1); G_STAGE_B(G_SB(1, 0), b3); G_STAGE_B(G_SB(1, 1), b3 + hstepB); G_STAGE_A(G_SA(1, 0), a2, 0, k3);
            G_WAIT_V(8); G_WAIT_L(0); G_BAR; G_MMA(1, 0, At, B0); G_MMA(1, 1, At, B1); G_BAR; G_SCHED;
        }
        if (wr == 0) G_BAR;
        E(acc, cur, wr, wc, fr, fq, pfa);
        if (!has_next) break;
#pragma unroll
        for (int a = 0; a < 2; ++a)
#pragma unroll
            for (int b = 0; b < 2; ++b)
#pragma unroll
                for (int m = 0; m < 4; ++m)
#pragma unroll
                    for (int n = 0; n < 2; ++n) acc[a][b][m][n] = (f32x4){0.f, 0.f, 0.f, 0.f};
        cur = nxt; cB = nB; ++ui; cad[0] = nad[0]; cad[1] = nad[1];
        if (wr == 1) G_BAR;
    }
    G_WAIT_V(0);
    G_BAR;
#undef G_SA
#undef G_SB
#undef G_STAGE_A
#undef G_STAGE_B
#undef G_LDA
#undef G_LDB
#undef G_MMA
#undef G_WAIT_V
#undef G_WAIT_L
#undef G_BAR
#undef G_SCHED
}
constexpr size_t WS_WIN = 0;
constexpr size_t WS_WPA = WS_WIN + (size_t)INW * DM * 2;
constexpr size_t WS_WPB = WS_WPA + (size_t)DM * 512 * 2;
constexpr size_t WS_WOUT = WS_WPB + (size_t)DM * 512 * 2;
constexpr size_t WS_WUP = WS_WOUT + (size_t)DM * DM * 2;
constexpr size_t WS_WDN = WS_WUP + (size_t)NEXP * 2048 * DM * 2;
constexpr size_t WS_XH = WS_WDN + (size_t)NEXP * DM * DM * 2;
constexpr size_t WS_PROJ = WS_XH + (size_t)TOK * DM * 2;
constexpr size_t WS_OAB = WS_PROJ + (size_t)TOK * INW * 2;
constexpr size_t WS_MERGED = WS_OAB + (size_t)TOK * DM * 2;
constexpr size_t WS_H1 = WS_MERGED + (size_t)TOK * DM * 2;
constexpr size_t WS_SMALL = WS_H1 + (size_t)TOK * DM * 4 + 16 * MiB;
constexpr size_t WS_KVB = WS_H1 + 72 * MiB;
constexpr size_t WS_YS = WS_OAB;
constexpr size_t SM_PQ = 16064;
constexpr size_t SM_CNT = 0, SM_TK = 16384, SM_LIST = SM_TK + (size_t)NASG * 4;
constexpr size_t WS_END = WS_SMALL + SM_LIST + (size_t)NEXP * LISTCAP * 8;
static_assert(WS_YS + (size_t)MOE_ROWS * DM * 2 <= WS_SMALL, "ys overlaps bookkeeping");
static_assert((size_t)MOE_ROWS * DM * 2 <= (size_t)TOK * INW * 2, "act does not fit over proj");
constexpr size_t WS_GATE = (WS_END + MiB - 1) / MiB * MiB;
constexpr size_t WS_TOTAL = WS_GATE + (size_t)TOK * 2048 * 2;
static_assert(WS_TOTAL <= 1024 * MiB, "workspace");

struct Params {
    const float* in[22]; float* out; unsigned char* ws;
};

constexpr int LDS_PARAMS = LDS_WTAB - 256;
__device__ __forceinline__ unsigned long long rfl64(unsigned long long v) {
    const unsigned lo = (unsigned)__builtin_amdgcn_readfirstlane((int)(unsigned)v), hi = (unsigned)__builtin_amdgcn_readfirstlane((int)(unsigned)(v >> 32));
    return ((unsigned long long)hi << 32) | lo; }
__device__ __forceinline__ Params get_params(LAS unsigned char* lds) {
    unsigned off = LDS_PARAMS; asm volatile("" : "+v"(off));
    const LAS unsigned long long* q = (const LAS unsigned long long*)(lds + off);
    Params p;
#pragma unroll
    for (int i = 0; i < 22; ++i) p.in[i] = (const float*)(const GAS float*)rfl64(q[i]);
    p.out = (float*)(GAS float*)rfl64(q[22]); p.ws = (unsigned char*)(GAS unsigned char*)rfl64(q[23]);
    return p;
}
__device__ __forceinline__ void put_params(const Params& p, LAS unsigned char* lds) {
    LAS unsigned long long* q = (LAS unsigned long long*)(lds + LDS_PARAMS);
#pragma unroll
    for (int i = 0; i < 22; ++i) q[i] = (unsigned long long)p.in[i];
    q[22] = (unsigned long long)p.out; q[23] = (unsigned long long)p.ws;
}


struct PrepTile { const float* src; int ldsrc; f16* dst; int K; int n0; };
__device__ __forceinline__ PrepTile prep_desc(const Params& p, int t) {
    unsigned char* ws = p.ws;
    constexpr int T_IN = (INW / 64) * (DM / 128), T_PA = (DM / 64) * (512 / 128), T_OUT = (DM / 64) * (DM / 128);
    constexpr int T_UP1 = (2048 / 64) * (DM / 128), T_DN1 = (DM / 64) * (DM / 128);
    constexpr int T0 = T_IN, T1 = T0 + T_PA, T2 = T1 + T_PA, T3 = T2 + T_OUT, T4 = T3 + NEXP * T_UP1;
    PrepTile d;
    if (t < T0) { const int tn = t / 8, tk = t % 8; d.src = p.in[1] + (size_t)(tk * 128) * INW + tn * 64; d.ldsrc = INW; d.dst = (f16*)(ws + WS_WIN) + tk * 128; d.K = DM; d.n0 = tn * 64; }
    else if (t < T1) { const int q = t - T0, tn = q / 4, tk = q % 4; d.src = p.in[8] + (size_t)(tk * 128) * DM + tn * 64; d.ldsrc = DM; d.dst = (f16*)(ws + WS_WPA) + tk * 128; d.K = 512; d.n0 = tn * 64; }
    else if (t < T2) { const int q = t - T1, tn = q / 4, tk = q % 4; d.src = p.in[9] + (size_t)(tk * 128) * DM + tn * 64; d.ldsrc = DM; d.dst = (f16*)(ws + WS_WPB) + tk * 128; d.K = 512; d.n0 = tn * 64; }
    else if (t < T3) { const int q = t - T2, tn = q / 8, tk = q % 8; d.src = p.in[10] + (size_t)(tk * 128) * DM + tn * 64; d.ldsrc = DM; d.dst = (f16*)(ws + WS_WOUT) + tk * 128; d.K = DM; d.n0 = tn * 64; }
    else if (t < T4) { const int q = t - T3, e = q / T_UP1, r = q % T_UP1, tn = r / 8, tk = r % 8;
        const int np = tn * 64, pn = np >> 8, jj = np & 255;
        const int sc = jj < 128 ? pn * 128 + jj : 1024 + pn * 128 + (jj - 128);
        d.src = p.in[16] + (size_t)e * DM * 2048 + (size_t)(tk * 128) * 2048 + sc; d.ldsrc = 2048; d.dst = (f16*)(ws + WS_WUP) + (size_t)e * 2048 * DM + tk * 128; d.K = DM; d.n0 = np; }
    else { const int q = t - T4, e = q / T_DN1, r = q % T_DN1, tn = r / 8, tk = r % 8;
        d.src = p.in[18] + (size_t)e * DM * DM + (size_t)(tk * 128) * DM + tn * 64; d.ldsrc = DM; d.dst = (f16*)(ws + WS_WDN) + (size_t)e * DM * DM + tk * 128; d.K = DM; d.n0 = tn * 64; }
    return d;
}
constexpr int PREP_NT = (INW / 64) * (DM / 128) + 2 * (DM / 64) * (512 / 128) + (DM / 64) * (DM / 128) + NEXP * ((2048 / 64) * (DM / 128) + (DM / 64) * (DM / 128));
constexpr int PREP_ND = (INW / 64) * (DM / 128) + 2 * (DM / 64) * (512 / 128) + (DM / 64) * (DM / 128);
#ifdef MOE_EARLY
constexpr int PREP_LIM = PREP_NT;
#else
constexpr int PREP_LIM = PREP_ND;
#endif
#ifndef MCB
#define MCB 4
#endif
constexpr size_t SM_PQ2 = SM_PQ + 4;
__device__ __forceinline__ bool moe_conv(const Params& p, LAS unsigned char* lds, int tid, int nbatch, LAS unsigned* pslot) {
    unsigned* pq2 = (unsigned*)(p.ws + WS_SMALL + SM_PQ2);
    LAS float* tile = (LAS float*)lds;
    LAS int* qslot = (LAS int*)(lds + 36864);
#pragma unroll 1
    for (int bb = 0; bb < nbatch; ++bb) {
        int t2 = tid; asm volatile("" : "+v"(t2));
        const int lk = t2 >> 4, ln4 = (t2 & 15) * 4;
        if (tid == 0) { qslot[0] = (int)*pslot; *pslot = __hip_atomic_fetch_add(pq2, (unsigned)MCB, __ATOMIC_RELAXED, __HIP_MEMORY_SCOPE_AGENT); }
        __syncthreads();
        const int t0 = __builtin_amdgcn_readfirstlane(PREP_ND + qslot[0]);
        if (t0 >= PREP_NT) { __syncthreads(); return false; }
        float4 v[MCB][4];
#pragma unroll
        for (int q = 0; q < MCB; ++q) { const PrepTile d_ = prep_desc(p, t0 + q);
#pragma unroll
            for (int j = 0; j < 4; ++j) { const f32x4 t_ = __builtin_nontemporal_load((const f32x4*)(d_.src + (size_t)(lk + 32 * j) * d_.ldsrc + ln4)); v[q][j] = make_float4(t_[0], t_[1], t_[2], t_[3]); } }
#pragma unroll
        for (int q = 0; q < MCB; ++q) {
            const PrepTile d = prep_desc(p, t0 + q);
#pragma unroll
            for (int j = 0; j < 4; ++j) { LAS float* r = tile + (lk + 32 * j) * 65 + (ln4 ^ (8 * j)); r[0] = v[q][j].x; r[1] = v[q][j].y; r[2] = v[q][j].z; r[3] = v[q][j].w; }
            __syncthreads();
            { const int nr = t2 >> 3, kc = (t2 & 7) * 16, n = nr ^ (8 * ((t2 & 7) >> 1)); u32x4 w0, w1;
              w0.x = pk2(tile[(kc + 0) * 65 + n], tile[(kc + 1) * 65 + n]); w0.y = pk2(tile[(kc + 2) * 65 + n], tile[(kc + 3) * 65 + n]);
              w0.z = pk2(tile[(kc + 4) * 65 + n], tile[(kc + 5) * 65 + n]); w0.w = pk2(tile[(kc + 6) * 65 + n], tile[(kc + 7) * 65 + n]);
              w1.x = pk2(tile[(kc + 8) * 65 + n], tile[(kc + 9) * 65 + n]); w1.y = pk2(tile[(kc + 10) * 65 + n], tile[(kc + 11) * 65 + n]);
              w1.z = pk2(tile[(kc + 12) * 65 + n], tile[(kc + 13) * 65 + n]); w1.w = pk2(tile[(kc + 14) * 65 + n], tile[(kc + 15) * 65 + n]);
              f16* o = d.dst + (size_t)(d.n0 + nr) * d.K + kc; *(u32x4*)o = w0; *(u32x4*)(o + 8) = w1; }
            __syncthreads();
        }
    }
    return true;
}
__device__ __forceinline__ void phase_prep(const Params& p, LAS unsigned char* lds, int wg, int nwg) {
    const int tid = get_tid(lds);
    unsigned char* ws = p.ws;
    {
        const float4* src = (const float4*)p.in[0]; u32x4* dst = (u32x4*)(ws + WS_XH);
        constexpr size_t n8 = (size_t)TOK * DM / 8;
        const size_t stride = (size_t)nwg * NTHR;
        for (size_t i = (size_t)wg * NTHR + tid; i < n8; i += 4 * stride) {
            float4 a[4], c[4];
#pragma unroll
            for (int u = 0; u < 4; ++u) { { const f32x4 t0_ = __builtin_nontemporal_load((const f32x4*)(src + 2 * (i + u * stride))), t1_ = __builtin_nontemporal_load((const f32x4*)(src + 2 * (i + u * stride) + 1)); a[u] = make_float4(t0_[0], t0_[1], t0_[2], t0_[3]); c[u] = make_float4(t1_[0], t1_[1], t1_[2], t1_[3]); } }
#pragma unroll
            for (int u = 0; u < 4; ++u) { u32x4 w; w.x = pk2(a[u].x, a[u].y); w.y = pk2(a[u].z, a[u].w); w.z = pk2(c[u].x, c[u].y); w.w = pk2(c[u].z, c[u].w); dst[i + u * stride] = w; }
        }
    }
    LAS float* tile = (LAS float*)lds;
    const int lk = tid >> 4, ln4 = (tid & 15) * 4;
    float4 va[4], vb[4];
#define PREP_LOAD(V, tt) do { if ((tt) < PREP_LIM) { const PrepTile d_ = prep_desc(p, (tt)); \
        _Pragma("unroll") for (int j = 0; j < 4; ++j) { const f32x4 t_ = __builtin_nontemporal_load((const f32x4*)(d_.src + (size_t)(lk + 32 * j) * d_.ldsrc + ln4)); V[j] = make_float4(t_[0], t_[1], t_[2], t_[3]); } } } while (0)
#define PREP_DO2(V, tt, tnext) do { if ((tt) < PREP_LIM) { const PrepTile d = prep_desc(p, (tt)); \
        _Pragma("unroll") for (int j = 0; j < 4; ++j) { LAS float* r = tile + (lk + 32 * j) * 65 + ln4; r[0] = V[j].x; r[1] = V[j].y; r[2] = V[j].z; r[3] = V[j].w; } \
        PREP_LOAD(V, (tnext)); \
        __syncthreads(); \
        { const int n = tid >> 3, kc = (tid & 7) * 16; u32x4 w0, w1; \
          w0.x = pk2(tile[(kc + 0) * 65 + n], tile[(kc + 1) * 65 + n]); w0.y = pk2(tile[(kc + 2) * 65 + n], tile[(kc + 3) * 65 + n]); \
          w0.z = pk2(tile[(kc + 4) * 65 + n], tile[(kc + 5) * 65 + n]); w0.w = pk2(tile[(kc + 6) * 65 + n], tile[(kc + 7) * 65 + n]); \
          w1.x = pk2(tile[(kc + 8) * 65 + n], tile[(kc + 9) * 65 + n]); w1.y = pk2(tile[(kc + 10) * 65 + n], tile[(kc + 11) * 65 + n]); \
          w1.z = pk2(tile[(kc + 12) * 65 + n], tile[(kc + 13) * 65 + n]); w1.w = pk2(tile[(kc + 14) * 65 + n], tile[(kc + 15) * 65 + n]); \
          f16* o = d.dst + (size_t)(d.n0 + n) * d.K + kc; *(u32x4*)o = w0; *(u32x4*)(o + 8) = w1; } \
        __syncthreads(); } } while (0)
    unsigned* pq = (unsigned*)(ws + WS_SMALL + SM_PQ);
    LAS int* qslot = (LAS int*)(lds + 36864);
#ifndef PQB
#define PQB 2
#endif
    int ta, tb, cur, pos = 0; unsigned pend = 0u;
    if (tid == 0) { qslot[0] = (int)__hip_atomic_fetch_add(pq, (unsigned)PQB, __ATOMIC_RELAXED, __HIP_MEMORY_SCOPE_AGENT); pend = __hip_atomic_fetch_add(pq, (unsigned)PQB, __ATOMIC_RELAXED, __HIP_MEMORY_SCOPE_AGENT); }
    __syncthreads();
    cur = qslot[0];
#define PREP_DRAW(tv) do { if (pos == PQB) { __syncthreads(); if (tid == 0) { qslot[0] = (int)pend; pend = __hip_atomic_fetch_add(pq, (unsigned)PQB, __ATOMIC_RELAXED, __HIP_MEMORY_SCOPE_AGENT); } __syncthreads(); cur = qslot[0]; pos = 0; } \
        tv = cur + pos; ++pos; } while (0)
    PREP_DRAW(ta); PREP_DRAW(tb);
    PREP_LOAD(va, ta); PREP_LOAD(vb, tb);
#pragma unroll 1
    for (;;) {
        if (ta >= PREP_LIM && tb >= PREP_LIM) break;
        int tn;
        if (ta < PREP_LIM) { PREP_DRAW(tn); PREP_DO2(va, ta, tn); ta = tn; }
        if (tb < PREP_LIM) { PREP_DRAW(tn); PREP_DO2(vb, tb, tn); tb = tn; }
    }
#undef PREP_DRAW
#undef PREP_LOAD
#undef PREP_DO2
}

struct EpiInProj {
    static constexpr bool PERM = true;
    f16* O; const float* bias; f16* GT; f16* KB;
    __device__ __forceinline__ void prefetch(const Unit& u, unsigned area, int wr, int wc, int lane) const {
        glds4_asm(bias + u.pn * BM + wc * 32 + (lane & 31) + (lane >> 5) * HALF, area + PF_BIAS);
    }
    __device__ __forceinline__ void operator()(const f32x4 (&acc)[2][2][4][2], const Unit& u, int wr, int wc, int fr, int fq, const LAS unsigned char* pfa) const {
        const int row0 = u.pm * BM + wr * 64 + fr, col0 = u.pn * BM + wc * 32 + 8 * fq;
        const int cls = u.pn;
        const float scl = (cls < 2 || cls == 6 || cls == 7) ? QSCALE : 1.0f;
        const bool sig = cls >= 12;
        f32x4 bv[2][2];
#pragma unroll
        for (int bj = 0; bj < 2; ++bj)
#pragma unroll
            for (int n = 0; n < 2; ++n) bv[bj][n] = *(const LAS f32x4*)(pfa + PF_BIAS + bj * 128 + (8 * fq + 4 * n) * 4);
#pragma unroll
        for (int ai = 0; ai < 2; ++ai)
#pragma unroll
            for (int m = 0; m < 4; ++m) {
                f16* rowp = O + (size_t)(row0 + ai * HALF + m * 16) * INW + col0;
#pragma unroll
                for (int bj = 0; bj < 2; ++bj) {
                    f32x4 v0 = acc[ai][bj][m][0] + bv[bj][0], v1 = acc[ai][bj][m][1] + bv[bj][1];
                    if (sig) {
#pragma unroll
                        for (int j = 0; j < 4; ++j) { v0[j] = __builtin_amdgcn_rcpf(1.0f + __expf(-v0[j])); v1[j] = __builtin_amdgcn_rcpf(1.0f + __expf(-v1[j])); }
                    } else { v0 *= scl; v1 *= scl; }
                    u32x4 w; w.x = pk2(v0[0], v0[1]); w.y = pk2(v0[2], v0[3]); w.z = pk2(v1[0], v1[1]); w.w = pk2(v1[2], v1[3]);
                    if (cls >= 8 && cls < 12) {
                        const int t = row0 + ai * HALF + m * 16, c = col0 + bj * HALF, isv = c >= C_VB ? 1 : 0, cc = c - C_KB - isv * 512;
                        *(u32x4*)(KB + ((size_t)((t >> 12) * 4 + (cc >> 7)) * SEQ + (t & (SEQ - 1))) * 256 + isv * 128 + (cc & 127)) = w;
                    } else if (sig) *(u32x4*)(GT + (((size_t)(u.pm * 8 + (cls - 12)) * BM + (wr * 64 + fr + ai * HALF + m * 16)) * BM + wc * 32 + 8 * fq + bj * HALF)) = w;
                    else *(u32x4*)(rowp + bj * HALF) = w;
                }
            }
    }
};
__device__ __forceinline__ void phase_inproj(const Params& p, LAS unsigned char* lds, int wg, int nwg) {
    DenseSched<DM> S; S.init(p.ws + WS_XH, p.ws + WS_WIN, TOK, INW, nwg, wg);
    EpiInProj E{(f16*)(p.ws + WS_PROJ), p.in[2], (f16*)(p.ws + WS_GATE), (f16*)(p.ws + WS_KVB)};
    gemm_phase(lds, S, E);
}
constexpr int RW_STR = 2064, RW_LO = 32 * RW_STR;
constexpr int RT_PART = 2 * RW_LO;
constexpr int RT_STAT = RT_PART + 16384;
constexpr int RT_C = RT_STAT + 1024;
constexpr int RT_HIST = RT_C + 256;
constexpr int RT_REC = RT_HIST + 256;
static_assert(RT_REC + 4096 <= LDS_PARAMS, "router LDS");
__device__ __forceinline__ void phase_router(const Params& p, LAS unsigned char* lds, int wg, int nwg) {
    const int tid = get_tid(lds);
    const int lane = tid & 63, wave = __builtin_amdgcn_readfirstlane(tid >> 6);
    const float* xin = p.in[0]; const f16* yh = (const f16*)(p.ws + WS_H1);
    f16* x1h = (f16*)(p.ws + WS_XH);
    const float* lng = p.in[12]; const float* lnb = p.in[13];
    const float* wr = p.in[14]; const float* br = p.in[15];
    int* cnt = (int*)(p.ws + WS_SMALL + SM_CNT);
    int* tk = (int*)(p.ws + WS_SMALL + SM_TK);
    int2* list = (int2*)(p.ws + WS_SMALL + SM_LIST);
    float* glog = (float*)(p.ws + WS_MERGED);
    LAS float* part = (LAS float*)(lds + RT_PART);
    LAS float* stat = (LAS float*)(lds + RT_STAT);
    LAS float* cc = (LAS float*)(lds + RT_C);
    LAS int* hist = (LAS int*)(lds + RT_HIST);
    LAS int* hbase = hist + 32;
    {
        const int E = tid & 31, pt = tid >> 5;
        float a1 = 0.f, a2 = 0.f;
#pragma unroll 16
        for (int kk = 0; kk < 64; ++kk) {
            const int k = pt * 64 + kk;
            const float w = wr[(size_t)k * NEXP + E], g = lng[k], bb = lnb[k];
            const float wp = g * w; a1 += wp; a2 = fmaf(bb, w, a2);
            const f16 whi = (f16)wp, wlo = (f16)(wp - (float)whi);
            *(LAS f16*)(lds + E * RW_STR + k * 2) = whi; *(LAS f16*)(lds + RW_LO + E * RW_STR + k * 2) = wlo;
        }
        part[pt * 64 + E] = a1; part[pt * 64 + 32 + E] = a2;
        if (tid < 32) hist[tid] = 0;
        __syncthreads();
        if (tid < 64) { float sm = 0.f;
#pragma unroll
            for (int j = 0; j < 16; ++j) sm += part[j * 64 + tid];
            if (tid >= 32) sm += br[tid - 32];
            cc[tid] = sm; }
        __syncthreads();
    }
    const int tpw = TOK / (nwg * 8);
    const int tokb = wg * (TOK / nwg);
    const int tok0 = tokb + wave * tpw;
    {
        const int i16 = lane & 15, q = lane >> 4;
        const int kw0 = wave * 128 + 8 * q;
        float gam[32], bet[32];
#pragma unroll
        for (int ks = 0; ks < 4; ++ks) {
            const f32x4 g0 = *(const f32x4*)(lng + kw0 + 32 * ks), g1 = *(const f32x4*)(lng + kw0 + 32 * ks + 4), b0 = *(const f32x4*)(lnb + kw0 + 32 * ks), b1 = *(const f32x4*)(lnb + kw0 + 32 * ks + 4);
#pragma unroll
            for (int j = 0; j < 4; ++j) { gam[8 * ks + j] = g0[j]; gam[8 * ks + 4 + j] = g1[j]; bet[8 * ks + j] = b0[j]; bet[8 * ks + 4 + j] = b1[j]; }
        }
        f32x4 xr[8]; u32x4 yr[4];
#define RT_LOAD(it_) do { const size_t ro_ = (size_t)(tokb + (it_) * 16 + i16) * DM + kw0; \
            _Pragma("unroll") for (int ks = 0; ks < 4; ++ks) { xr[2 * ks] = *(const f32x4*)(xin + ro_ + 32 * ks); xr[2 * ks + 1] = *(const f32x4*)(xin + ro_ + 32 * ks + 4); yr[ks] = *(const u32x4*)(yh + ro_ + 32 * ks); } } while (0)
        RT_LOAD(0);
#pragma unroll 1
        for (int it = 0; it < 8; ++it) {
            float h[32];
#pragma unroll
            for (int ks = 0; ks < 4; ++ks) { const f16x8 yv = __builtin_bit_cast(f16x8, yr[ks]);
#pragma unroll
                for (int j = 0; j < 4; ++j) { h[8 * ks + j] = fmaf(ALPHA, xr[2 * ks][j], (float)yv[j]); h[8 * ks + 4 + j] = fmaf(ALPHA, xr[2 * ks + 1][j], (float)yv[4 + j]); } }
            if (it + 1 < 8) RT_LOAD(it + 1);
            float s1 = 0.f, s2 = 0.f;
#pragma unroll
            for (int e = 0; e < 32; ++e) { s1 += h[e]; s2 = fmaf(h[e], h[e], s2); }
            s1 += shx(s1, 16, lane); s2 += shx(s2, 16, lane); s1 += shx(s1, 32, lane); s2 += shx(s2, 32, lane);
            f32x4 acc[2]; acc[0] = (f32x4){0.f, 0.f, 0.f, 0.f}; acc[1] = acc[0];
#pragma unroll
            for (int ks = 0; ks < 4; ++ks) {
                f16x8 ahi, alo;
#pragma unroll
                for (int j = 0; j < 8; ++j) { const f16 hh = (f16)h[8 * ks + j]; ahi[j] = hh; alo[j] = (f16)(h[8 * ks + j] - (float)hh); }
#pragma unroll
                for (int eb = 0; eb < 2; ++eb) {
                    const LAS unsigned char* bp = lds + (eb * 16 + i16) * RW_STR + (kw0 + 32 * ks) * 2;
                    const f16x8 bhi = *(const LAS f16x8*)bp, blo = *(const LAS f16x8*)(bp + RW_LO);
                    acc[eb] = __builtin_amdgcn_mfma_f32_16x16x32_f16(ahi, bhi, acc[eb], 0, 0, 0);
                    acc[eb] = __builtin_amdgcn_mfma_f32_16x16x32_f16(alo, bhi, acc[eb], 0, 0, 0);
                    acc[eb] = __builtin_amdgcn_mfma_f32_16x16x32_f16(ahi, blo, acc[eb], 0, 0, 0);
                }
            }
#pragma unroll
            for (int eb = 0; eb < 2; ++eb)
#pragma unroll
                for (int r = 0; r < 4; ++r) part[(wave * 16 + 4 * q + r) * 32 + eb * 16 + i16] = acc[eb][r];
            if (q == 0) { stat[(wave * 16 + i16) * 2] = s1; stat[(wave * 16 + i16) * 2 + 1] = s2; }
            __syncthreads();
            {
                const int tt = tid >> 5, ee = tid & 31;
                float T1 = 0.f, T2 = 0.f, L = 0.f;
#pragma unroll
                for (int w = 0; w < 8; ++w) { T1 += stat[(w * 16 + tt) * 2]; T2 += stat[(w * 16 + tt) * 2 + 1]; L += part[(w * 16 + tt) * 32 + ee]; }
                const float mu2 = T1 * (1.0f / DM), rs2 = rsqrtf(fmaxf(T2 * (1.0f / DM) - mu2 * mu2, 0.f) + 1e-5f);
                float v = rs2 * (L - mu2 * cc[ee]) + cc[32 + ee];
                float tv[4]; int te[4];
#pragma unroll
                for (int k = 0; k < 4; ++k) {
                    float mx = v;
                    mx = fmaxf(mx, __int_as_float(__builtin_amdgcn_update_dpp(0, __float_as_int(mx), 0xB1, 0xF, 0xF, true)));
                    mx = fmaxf(mx, __int_as_float(__builtin_amdgcn_update_dpp(0, __float_as_int(mx), 0x4E, 0xF, 0xF, true)));
                    mx = fmaxf(mx, __int_as_float(__builtin_amdgcn_update_dpp(0, __float_as_int(mx), 0x141, 0xF, 0xF, true)));
                    mx = fmaxf(mx, __int_as_float(__builtin_amdgcn_update_dpp(0, __float_as_int(mx), 0x140, 0xF, 0xF, true)));
                    mx = fmaxf(mx, shx(mx, 16, lane));
                    const unsigned long long bal = __builtin_amdgcn_ballot_w64(v == mx);
                    const unsigned hb = (unsigned)(bal >> (lane & 32));
                    const int win = __builtin_ctz(hb);
                    tv[k] = mx; te[k] = win;
                    v = (ee == win) ? -3.0e38f : v;
                }
                const float e1 = __expf(tv[1] - tv[0]), e2 = __expf(tv[2] - tv[0]), e3 = __expf(tv[3] - tv[0]);
                const float inv = 1.0f / (1.0f + e1 + e2 + e3);
                if (ee < 4) {
                    const int me = ee == 0 ? te[0] : ee == 1 ? te[1] : ee == 2 ? te[2] : te[3];
                    const float mg = ee == 0 ? inv : (ee == 1 ? e1 : ee == 2 ? e2 : e3) * inv;
                    const int loc = __hip_atomic_fetch_add(hist + me, 1, __ATOMIC_RELAXED, __HIP_MEMORY_SCOPE_WORKGROUP);
                    LAS int* rc_ = (LAS int*)(lds + RT_REC) + ((it * 16 + tt) * 4 + ee) * 2;
                    rc_[0] = me | (loc << 8); rc_[1] = __float_as_int(mg);
                }
            }
            {
                float S1 = 0.f, S2 = 0.f;
#pragma unroll
                for (int w = 0; w < 8; ++w) { S1 += stat[(w * 16 + i16) * 2]; S2 += stat[(w * 16 + i16) * 2 + 1]; }
                const float mu = S1 * (1.0f / DM), rs = rsqrtf(fmaxf(S2 * (1.0f / DM) - mu * mu, 0.f) + 1e-5f);
                f16* orow = x1h + (size_t)(tokb + it * 16 + i16) * DM + kw0;
#pragma unroll
                for (int ks = 0; ks < 4; ++ks) {
                    float v[8];
#pragma unroll
                    for (int j = 0; j < 8; ++j) v[j] = (h[8 * ks + j] - mu) * rs * gam[8 * ks + j] + bet[8 * ks + j];
                    u32x4 w4; w4.x = pk2(v[0], v[1]); w4.y = pk2(v[2], v[3]); w4.z = pk2(v[4], v[5]); w4.w = pk2(v[6], v[7]);
                    *(u32x4*)(orow + 32 * ks) = w4;
                }
            }
            __syncthreads();
        }
#undef RT_LOAD
    }
    __syncthreads();
    if (tid < 32) hbase[tid] = atomicAdd(&cnt[tid], hist[tid]);
    __syncthreads();
    {
        const LAS int* rc_ = (const LAS int*)(lds + RT_REC) + tid * 2;
        const int c0 = rc_[0], me = c0 & 255, slot = hbase[me] + (c0 >> 8), t = tokb + (tid >> 2);
        tk[t * 4 + (tid & 3)] = (me << 20) | slot;
        list[(size_t)me * LISTCAP + slot] = make_int2(t, rc_[1]);
    }
    __syncthreads();
}

__device__ __forceinline__ void phase_final(const Params& p, LAS unsigned char* lds, int wg, int nwg) {
    const int tid = get_tid(lds);
    const int lane = tid & 63, wave = tid >> 6;
    const f16* x1h = (const f16*)(p.ws + WS_XH);
    const f16* ys = (const f16*)(p.ws + WS_YS);
    const int* cnt = (const int*)(p.ws + WS_SMALL + SM_CNT);
    const int* tk = (const int*)(p.ws + WS_SMALL + SM_TK);
    const float* lng = p.in[20]; const float* lnb = p.in[21];
    LAS int* ps = (LAS int*)lds;
    if (tid == 0) { int a = 0; for (int e = 0; e < NEXP; ++e) { ps[e] = a; a += (cnt[e] + ROWPAD - 1) / ROWPAD * ROWPAD; } }
    __syncthreads();
    const int tpw = TOK / (nwg * 8);
    const int tok0 = wg * (TOK / nwg) + wave * tpw;
    float gm[16], bt[16];
#pragma unroll
    for (int hh = 0; hh < 2; ++hh) { const int c0 = hh * 512 + 8 * lane;
        const float4 g0 = *(const float4*)(lng + c0), g1 = *(const float4*)(lng + c0 + 4), b0 = *(const float4*)(lnb + c0), b1 = *(const float4*)(lnb + c0 + 4);
        gm[hh * 8 + 0] = g0.x; gm[hh * 8 + 1] = g0.y; gm[hh * 8 + 2] = g0.z; gm[hh * 8 + 3] = g0.w; gm[hh * 8 + 4] = g1.x; gm[hh * 8 + 5] = g1.y; gm[hh * 8 + 6] = g1.z; gm[hh * 8 + 7] = g1.w;
        bt[hh * 8 + 0] = b0.x; bt[hh * 8 + 1] = b0.y; bt[hh * 8 + 2] = b0.z; bt[hh * 8 + 3] = b0.w; bt[hh * 8 + 4] = b1.x; bt[hh * 8 + 5] = b1.y; bt[hh * 8 + 6] = b1.z; bt[hh * 8 + 7] = b1.w; }
    int rowv; { const int c_ = tk[tok0 * 4 + lane]; rowv = ps[c_ >> 20] + (c_ & 0xFFFFF); }
    f16x8 ra[5], rb[5];
#define FN_LOAD(t_) do { ra[0] = *(const f16x8*)(x1h + (size_t)(t_) * DM + 8 * lane); rb[0] = *(const f16x8*)(x1h + (size_t)(t_) * DM + 512 + 8 * lane); \
        _Pragma("unroll") for (int k = 0; k < 4; ++k) { const int row = __builtin_amdgcn_readlane(rowv, ((t_) - tok0) * 4 + k); \
            ra[1 + k] = __builtin_nontemporal_load((const f16x8*)(ys + (size_t)row * DM + 8 * lane)); rb[1 + k] = __builtin_nontemporal_load((const f16x8*)(ys + (size_t)row * DM + 512 + 8 * lane)); } } while (0)
    FN_LOAD(tok0);
#pragma unroll 1
    for (int j = 0; j < tpw; ++j) {
        const int t = tok0 + j;
        float v[16];
#pragma unroll
        for (int i = 0; i < 8; ++i) { v[i] = ALPHA * (float)ra[0][i]; v[8 + i] = ALPHA * (float)rb[0][i]; }
#pragma unroll
        for (int k = 1; k < 5; ++k)
#pragma unroll
            for (int i = 0; i < 8; ++i) { v[i] += (float)ra[k][i]; v[8 + i] += (float)rb[k][i]; }
        if (j + 1 < tpw) FN_LOAD(t + 1);
        float s = 0.f;
#pragma unroll
        for (int i = 0; i < 16; ++i) s += v[i];
        for (int o = 32; o >= 1; o >>= 1) s += shx(s, o, lane);
        const float mu = s * (1.0f / DM);
        float q = 0.f;
#pragma unroll
        for (int i = 0; i < 16; ++i) { const float d = v[i] - mu; q += d * d; }
        for (int o = 32; o >= 1; o >>= 1) q += shx(q, o, lane);
        const float rs = rsqrtf(q * (1.0f / DM) + 1e-5f);
        float* op = p.out + (size_t)t * DM;
#pragma unroll
        for (int hh = 0; hh < 2; ++hh) {
            const int c0 = hh * 512 + 8 * lane;
            float4 o0, o1;
            o0.x = (v[hh * 8 + 0] - mu) * rs * gm[hh * 8 + 0] + bt[hh * 8 + 0]; o0.y = (v[hh * 8 + 1] - mu) * rs * gm[hh * 8 + 1] + bt[hh * 8 + 1];
            o0.z = (v[hh * 8 + 2] - mu) * rs * gm[hh * 8 + 2] + bt[hh * 8 + 2]; o0.w = (v[hh * 8 + 3] - mu) * rs * gm[hh * 8 + 3] + bt[hh * 8 + 3];
            o1.x = (v[hh * 8 + 4] - mu) * rs * gm[hh * 8 + 4] + bt[hh * 8 + 4]; o1.y = (v[hh * 8 + 5] - mu) * rs * gm[hh * 8 + 5] + bt[hh * 8 + 5];
            o1.z = (v[hh * 8 + 6] - mu) * rs * gm[hh * 8 + 6] + bt[hh * 8 + 6]; o1.w = (v[hh * 8 + 7] - mu) * rs * gm[hh * 8 + 7] + bt[hh * 8 + 7];
            *(float4*)(op + c0) = o0; *(float4*)(op + c0 + 4) = o1;
        }
    }
#undef FN_LOAD
    __syncthreads();
}
struct MergeSched {
    static constexpr int K = 1024, LDB = 512, MID = 8;
    static constexpr bool PFIDX = false;
    __device__ __forceinline__ void idx_issue(const Unit&, const unsigned (&)[2], unsigned) const {}
    __device__ __forceinline__ void idx_finish(const Unit&, const unsigned (&)[2], const LAS unsigned char*, int, unsigned (&)[2]) const {}
    static constexpr unsigned OB_JUMP = (unsigned)(TOK * 512 * 2) - 1024u, WB_JUMP = (unsigned)(DM * 512 * 2) - 1024u;
    const char* A; const char* Bt; DenseSched<512> D;
    __device__ void init(const void* oa, const void* wpa_t, int G, int c) { A = (const char*)oa; Bt = (const char*)wpa_t; D.init(oa, wpa_t, TOK, DM, G, c); }
    __device__ __forceinline__ bool next(int i, Unit& u) const { return D.next(i, u); }
    static __device__ __forceinline__ unsigned ka(int kt) { return (unsigned)kt * 128u + (kt >= 8 ? OB_JUMP : 0u); }
    static __device__ __forceinline__ unsigned kb(int kt) { return (unsigned)kt * 128u + (kt >= 8 ? WB_JUMP : 0u); }
    static __device__ __forceinline__ unsigned make_rc(int R, int C) { return (unsigned)(R * 512 + C) * 2u; }
    __device__ __forceinline__ void a_desc(const Unit& u, const unsigned (&rc)[2], unsigned (&ad)[2]) const { const unsigned o = (unsigned)u.pm * (unsigned)(BM * 512 * 2); ad[0] = rc[0] + o; ad[1] = rc[1] + o; }
    static __device__ __forceinline__ unsigned aoff(unsigned ad, unsigned rc, int h) { return ad + (unsigned)h * (unsigned)(HALF * 512 * 2); }
    __device__ __forceinline__ const char* b_base(const Unit& u) const { return Bt + (size_t)u.pn * BM * 512 * 2; }
};
struct EpiMerge {
    __device__ __forceinline__ void prefetch(const Unit&, unsigned, int, int, int) const {}
    static constexpr bool PERM = true;
    const f16* gt; f16* merged;
    __device__ __forceinline__ void mid(f32x4 (&acc)[2][2][4][2], const Unit& u, int wr, int wc, int fr, int fq) const {
        asm volatile("" : "+v"(fr), "+v"(fq));
        const f16* ga_t = gt + ((size_t)(u.pm * 8 + u.pn) * BM + wr * 64 + fr) * BM + wc * 32 + 8 * fq;
#pragma unroll
        for (int ai = 0; ai < 2; ++ai) {
            f16x8 ga[4][2], gb[4][2];
#pragma unroll
            for (int m = 0; m < 4; ++m)
#pragma unroll
                for (int bj = 0; bj < 2; ++bj) {
                    const f16* gp = ga_t + (size_t)(ai * HALF + m * 16) * BM + bj * HALF;
                    ga[m][bj] = *(const f16x8*)gp; gb[m][bj] = *(const f16x8*)(gp + (size_t)4 * BM * BM);
                }
            asm volatile("" ::: "memory");
#pragma unroll
            for (int m = 0; m < 4; ++m)
#pragma unroll
                for (int bj = 0; bj < 2; ++bj)
#pragma unroll
                    for (int j = 0; j < 4; ++j) {
                        acc[ai][bj][m][0][j] *= (float)ga[m][bj][j] * __builtin_amdgcn_rcpf(fmaxf((float)gb[m][bj][j], 5.9604645e-8f));
                        acc[ai][bj][m][1][j] *= (float)ga[m][bj][4 + j] * __builtin_amdgcn_rcpf(fmaxf((float)gb[m][bj][4 + j], 5.9604645e-8f));
                    }
            asm volatile("" ::: "memory");
        }
    }
    __device__ __forceinline__ void operator()(const f32x4 (&acc)[2][2][4][2], const Unit& u, int wr, int wc, int fr, int fq, const LAS unsigned char* pfa) const {
        const int row0 = u.pm * BM + wr * 64 + fr, col0 = u.pn * BM + wc * 32 + 8 * fq;
        const f16* gb_t = gt + ((size_t)(u.pm * 8 + 4 + u.pn) * BM + wr * 64 + fr) * BM + wc * 32 + 8 * fq;
#pragma unroll
        for (int ai = 0; ai < 2; ++ai) {
            f16x8 gb[4][2];
#pragma unroll
            for (int m = 0; m < 4; ++m)
#pragma unroll
                for (int bj = 0; bj < 2; ++bj) gb[m][bj] = *(const f16x8*)(gb_t + (size_t)(ai * HALF + m * 16) * BM + bj * HALF);
            asm volatile("" ::: "memory");
#pragma unroll
            for (int m = 0; m < 4; ++m) {
                const size_t row = (size_t)(row0 + ai * HALF + m * 16);
#pragma unroll
                for (int bj = 0; bj < 2; ++bj) {
                    float v[8];
#pragma unroll
                    for (int j = 0; j < 4; ++j) { v[j] = fmaxf((float)gb[m][bj][j], 5.9604645e-8f) * acc[ai][bj][m][0][j]; v[4 + j] = fmaxf((float)gb[m][bj][4 + j], 5.9604645e-8f) * acc[ai][bj][m][1][j]; }
                    u32x4 w; w.x = pk2(v[0], v[1]); w.y = pk2(v[2], v[3]); w.z = pk2(v[4], v[5]); w.w = pk2(v[6], v[7]);
                    *(u32x4*)(merged + row * DM + col0 + bj * HALF) = w;
                }
            }
        }
    }
};
__device__ __forceinline__ void phase_merge(const Params& p, LAS unsigned char* lds, int wg, int nwg) {
    MergeSched S; S.init(p.ws + WS_OAB, p.ws + WS_WPA, nwg, wg);
    EpiMerge E{(const f16*)(p.ws + WS_GATE), (f16*)(p.ws + WS_MERGED)};
    gemm_phase(lds, S, E);
}
struct EpiOutProj {
    static constexpr bool PERM = true;
    const float* bias; f16* y;
    __device__ __forceinline__ void prefetch(const Unit& u, unsigned area, int wr, int wc, int lane) const {
        glds4_asm(bias + u.pn * BM + wc * 32 + (lane & 31) + (lane >> 5) * HALF, area + PF_BIAS);
    }
    __device__ __forceinline__ void operator()(const f32x4 (&acc)[2][2][4][2], const Unit& u, int wr, int wc, int fr, int fq, const LAS unsigned char* pfa) const {
        const int row0 = u.pm * BM + wr * 64 + fr, col0 = u.pn * BM + wc * 32 + 8 * fq;
        f32x4 bv[2][2];
#pragma unroll
        for (int bj = 0; bj < 2; ++bj)
#pragma unroll
            for (int n = 0; n < 2; ++n) bv[bj][n] = *(const LAS f32x4*)(pfa + PF_BIAS + bj * 128 + (8 * fq + 4 * n) * 4);
#pragma unroll
        for (int ai = 0; ai < 2; ++ai)
#pragma unroll
            for (int m = 0; m < 4; ++m) {
                f16* rowp = y + (size_t)(row0 + ai * HALF + m * 16) * DM + col0;
#pragma unroll
                for (int bj = 0; bj < 2; ++bj) {
                    const f32x4 v0 = acc[ai][bj][m][0] + bv[bj][0], v1 = acc[ai][bj][m][1] + bv[bj][1];
                    u32x4 w; w.x = pk2(v0[0], v0[1]); w.y = pk2(v0[2], v0[3]); w.z = pk2(v1[0], v1[1]); w.w = pk2(v1[2], v1[3]);
                    *(u32x4*)(rowp + bj * HALF) = w;
                }
            }
    }
};
__device__ __forceinline__ void phase_outproj(const Params& p, LAS unsigned char* lds, int wg, int nwg) {
    DenseSched<DM> S; S.init(p.ws + WS_MERGED, p.ws + WS_WOUT, TOK, DM, nwg, wg);
    EpiOutProj E{p.in[11], (f16*)(p.ws + WS_H1)};
    gemm_phase(lds, S, E);
}

constexpr int MOE_MISC = STAGE_BYTES;
__device__ __forceinline__ void moe_prefix(const Params& p, LAS unsigned char* lds) {
    LAS int* tpre = (LAS int*)(lds + MOE_MISC); LAS int* ecnt = tpre + 64;
    const int* cnt = (const int*)(p.ws + WS_SMALL + SM_CNT);
    if (get_tid(lds) == 0) { int a = 0; for (int e = 0; e < NEXP; ++e) { const int c = cnt[e]; ecnt[e] = c; tpre[e] = a; a += (c + ROWPAD - 1) / ROWPAD; } tpre[NEXP] = a; }
    __syncthreads();
}
template <int NPN, bool GATHER>
struct MoeSched {
    static constexpr int K = DM;
    const char* A; const char* Bt; const int2* list; LAS int* tpre; LAS int* ecnt; int c;
    __device__ __forceinline__ bool next(int i, Unit& u) const {
        constexpr int MPR = 256 / NPN, MPX = 32 / NPN;
        const int xcd = c & 7, j = c >> 3;
        const int M = i * MPR + xcd * MPX + j / NPN;
        if (M >= tpre[NEXP]) return false;
        int e = 0;
        for (int k = 1; k < NEXP; ++k) e += (tpre[k] <= M) ? 1 : 0;
        u.e = e; u.pm = M - tpre[e]; u.pn = j % NPN; u.row0 = M * ROWPAD; u.nrows = ecnt[e] - u.pm * ROWPAD;
        return true;
    }
    static constexpr int LDB = DM, MID = -1;
    static constexpr bool PFIDX = GATHER;
    __device__ __forceinline__ void idx_issue(const Unit& u, const unsigned (&rc)[2], unsigned area) const {
#pragma unroll
        for (int i = 0; i < 2; ++i) { const int2* lp = list + (size_t)u.e * LISTCAP + u.pm * ROWPAD + (int)(rc[i] & 0xFFu); glds4_asm(&lp[0].x, area + (2 * i) * 256); glds4_asm(&lp[HALF].x, area + (2 * i + 1) * 256); }
    }
    __device__ __forceinline__ void idx_finish(const Unit& u, const unsigned (&rc)[2], const LAS unsigned char* areap, int lane, unsigned (&ad)[2]) const {
#pragma unroll
        for (int i = 0; i < 2; ++i) {
            const int R = (int)(rc[i] & 0xFFu);
            int t0 = *(const LAS int*)(areap + (2 * i) * 256 + lane * 4), t1 = *(const LAS int*)(areap + (2 * i + 1) * 256 + lane * 4);
            t0 = R < u.nrows ? t0 : 0; t1 = (R + HALF) < u.nrows ? t1 : 0;
            ad[i] = (unsigned)t0 | ((unsigned)t1 << 16);
        }
    }
    static __device__ __forceinline__ unsigned ka(int kt) { return (unsigned)kt * 128u; }
    static __device__ __forceinline__ unsigned kb(int kt) { return (unsigned)kt * 128u; }
    static __device__ __forceinline__ unsigned make_rc(int R, int C) { return GATHER ? ((unsigned)R | ((unsigned)(2 * C) << 8)) : (unsigned)(R * K + C) * 2u; }
    __device__ __forceinline__ void a_desc(const Unit& u, const unsigned (&rc)[2], unsigned (&ad)[2]) const {
        if (GATHER) {
#pragma unroll
            for (int i = 0; i < 2; ++i) {
                const int R = (int)(rc[i] & 0xFFu);
                const int2* lp = list + (size_t)u.e * LISTCAP + u.pm * ROWPAD + R;
                int t0 = lp[0].x, t1 = lp[HALF].x;
                t0 = R < u.nrows ? t0 : 0; t1 = (R + HALF) < u.nrows ? t1 : 0;
                ad[i] = (unsigned)t0 | ((unsigned)t1 << 16);
            }
            asm volatile("" : "+v"(ad[0]), "+v"(ad[1]));
        } else { ad[0] = rc[0] + (unsigned)u.row0 * (unsigned)(K * 2); ad[1] = rc[1] + (unsigned)u.row0 * (unsigned)(K * 2); }
    }
    static __device__ __forceinline__ unsigned aoff(unsigned ad, unsigned rc, int h) {
        return GATHER ? (((ad >> (16 * h)) & 0xFFFFu) * (unsigned)(K * 2) + (rc >> 8)) : (ad + (unsigned)h * (unsigned)(HALF * K * 2)); }
    __device__ __forceinline__ const char* b_base(const Unit& u) const { return Bt + ((size_t)u.e * (NPN * BM) + (size_t)u.pn * BM) * K * 2; }
};
struct EpiUp {
    static constexpr bool PERM = true;
    const float* bup; f16* act;
    __device__ __forceinline__ void prefetch(const Unit& u, unsigned area, int wr, int wc, int lane) const {
        glds4_asm(bup + (size_t)u.e * 2048 + u.pn * HALF + wc * 32 + (lane & 31) + (lane >> 5) * 1024, area + PF_BIAS);
    }
    __device__ __forceinline__ void operator()(const f32x4 (&acc)[2][2][4][2], const Unit& u, int wr, int wc, int fr, int fq, const LAS unsigned char* pfa) const {
        const int col0 = u.pn * HALF + wc * 32 + 8 * fq;
        const LAS unsigned char* bl = pfa + PF_BIAS + 8 * fq * 4;
        const f32x4 bg0 = *(const LAS f32x4*)bl, bg1 = *(const LAS f32x4*)(bl + 16), bu0 = *(const LAS f32x4*)(bl + 128), bu1 = *(const LAS f32x4*)(bl + 144);
#pragma unroll
        for (int ai = 0; ai < 2; ++ai)
#pragma unroll
            for (int m = 0; m < 4; ++m) {
                const size_t row = (size_t)(u.row0 + ai * HALF + wr * 64 + m * 16 + fr);
                float v[8];
                typedef float e2 __attribute__((ext_vector_type(2)));
#pragma unroll
                for (int n = 0; n < 2; ++n)
#pragma unroll
                    for (int jp = 0; jp < 2; ++jp) {
                        const f32x4 ag = acc[ai][0][m][n], au = acc[ai][1][m][n], bgv = n == 0 ? bg0 : bg1, buv = n == 0 ? bu0 : bu1;
                        const e2 hg = (e2){ag[2 * jp], ag[2 * jp + 1]} + (e2){bgv[2 * jp], bgv[2 * jp + 1]};
                        const e2 hu = (e2){au[2 * jp], au[2 * jp + 1]} + (e2){buv[2 * jp], buv[2 * jp + 1]};
                        const e2 gate = (e2){fminf(hg[0], 7.0f), fminf(hg[1], 7.0f)};
                        const e2 up1 = (e2){__builtin_amdgcn_fmed3f(hu[0], -7.0f, 7.0f), __builtin_amdgcn_fmed3f(hu[1], -7.0f, 7.0f)} + (e2){1.0f, 1.0f};
                        const e2 z = gate * (e2){-1.702f * LOG2E, -1.702f * LOG2E};
                        const e2 den = (e2){__builtin_amdgcn_exp2f(z[0]), __builtin_amdgcn_exp2f(z[1])} + (e2){1.0f, 1.0f};
                        const e2 res = gate * (e2){__builtin_amdgcn_rcpf(den[0]), __builtin_amdgcn_rcpf(den[1])} * up1;
                        v[n * 4 + 2 * jp] = res[0]; v[n * 4 + 2 * jp + 1] = res[1];
                    }
                u32x4 w; w.x = pk2(v[0], v[1]); w.y = pk2(v[2], v[3]); w.z = pk2(v[4], v[5]); w.w = pk2(v[6], v[7]);
                *(u32x4*)(act + row * DM + col0) = w;
            }
    }
};
struct EpiDown {
    static constexpr bool PERM = true;
    const float* bdn; const int2* list; f16* ys;
    __device__ __forceinline__ void prefetch(const Unit& u, unsigned area, int wr, int wc, int lane) const {
        glds4_asm(bdn + (size_t)u.e * DM + u.pn * BM + wc * 32 + (lane & 31) + (lane >> 5) * HALF, area + PF_BIAS);
        const int2* lp = list + (size_t)u.e * LISTCAP + u.pm * ROWPAD + wr * 64 + lane;
        glds4_asm(&lp[0].y, area + PF_ROWW); glds4_asm(&lp[HALF].y, area + PF_ROWW + 256);
    }
    __device__ __forceinline__ void operator()(const f32x4 (&acc)[2][2][4][2], const Unit& u, int wr, int wc, int fr, int fq, const LAS unsigned char* pfa) const {
        const int col0 = u.pn * BM + wc * 32 + 8 * fq;
        f32x4 bv[2][2];
#pragma unroll
        for (int bj = 0; bj < 2; ++bj)
#pragma unroll
            for (int n = 0; n < 2; ++n) bv[bj][n] = *(const LAS f32x4*)(pfa + PF_BIAS + bj * 128 + (8 * fq + 4 * n) * 4);
#pragma unroll
        for (int ai = 0; ai < 2; ++ai)
#pragma unroll
            for (int m = 0; m < 4; ++m) {
                const int lr = ai * HALF + wr * 64 + m * 16 + fr;
                float wgt = *(const LAS float*)(pfa + PF_ROWW + ai * 256 + (m * 16 + fr) * 4); wgt = lr < u.nrows ? wgt : 0.f;
                f16* rowp = ys + (size_t)(u.row0 + lr) * DM + col0;
#pragma unroll
                for (int bj = 0; bj < 2; ++bj) {
                    const f32x4 v0 = (acc[ai][bj][m][0] + bv[bj][0]) * wgt, v1 = (acc[ai][bj][m][1] + bv[bj][1]) * wgt;
                    u32x4 w; w.x = pk2(v0[0], v0[1]); w.y = pk2(v0[2], v0[3]); w.z = pk2(v1[0], v1[1]); w.w = pk2(v1[2], v1[3]);
                    *(u32x4*)(rowp + bj * HALF) = w;
                }
            }
    }
};
__device__ __forceinline__ void phase_up(const Params& p, LAS unsigned char* lds, int wg, int nwg) {
    moe_prefix(p, lds);
    MoeSched<8, true> S{(const char*)(p.ws + WS_XH), (const char*)(p.ws + WS_WUP), (const int2*)(p.ws + WS_SMALL + SM_LIST), (LAS int*)(lds + MOE_MISC), (LAS int*)(lds + MOE_MISC) + 64, wg};
    EpiUp E{p.in[17], (f16*)(p.ws + WS_PROJ)};
    gemm_phase(lds, S, E);
}
__device__ __forceinline__ void phase_down(const Params& p, LAS unsigned char* lds, int wg, int nwg) {
    moe_prefix(p, lds);
    MoeSched<4, false> S{(const char*)(p.ws + WS_PROJ), (const char*)(p.ws + WS_WDN), (const int2*)(p.ws + WS_SMALL + SM_LIST), (LAS int*)(lds + MOE_MISC), (LAS int*)(lds + MOE_MISC) + 64, wg};
    EpiDown E{p.in[19], (const int2*)(p.ws + WS_SMALL + SM_LIST), (f16*)(p.ws + WS_YS)};
    gemm_phase(lds, S, E);
}
__device__ __forceinline__ float lambda_full(const float* lq1, const float* lk1, const float* lq2, const float* lk2, int lane) {
    float a = lq1[lane] * lk1[lane], c = lq2[lane] * lk2[lane];
    for (int o = 32; o >= 1; o >>= 1) { a += shx(a, o, lane); c += shx(c, o, lane); }
    return __expf(a) - __expf(c) + LAMBDA_INIT;
}
typedef short s16x4 __attribute__((ext_vector_type(4)));
__device__ __forceinline__ int crow(int r, int hi) { return (r & 3) + 8 * (r >> 2) + 4 * hi; }
__device__ __forceinline__ f16x4 vtr(const LAS unsigned char* p) { return __builtin_bit_cast(f16x4, __builtin_amdgcn_ds_read_tr16_b64_v4i16((LAS s16x4*)p)); }
#define MFMA32(a, b, c) __builtin_amdgcn_mfma_f32_32x32x16_f16(a, b, c, 0, 0, 0)
__device__ __forceinline__ float rowmax32(const f32x16& p0, const f32x16& p1) {
    float a = fmaxf(fmaxf(p0[0], p0[1]), p1[0]), b = fmaxf(fmaxf(p0[2], p0[3]), p1[1]); a = fmaxf(fmaxf(a, p1[2]), p1[3]);
#pragma unroll
    for (int r = 4; r < 16; r += 4) { a = fmaxf(fmaxf(a, p0[r]), p0[r + 1]); b = fmaxf(fmaxf(b, p0[r + 2]), p0[r + 3]); a = fmaxf(fmaxf(a, p1[r]), p1[r + 1]); b = fmaxf(fmaxf(b, p1[r + 2]), p1[r + 3]); }
    float m = fmaxf(a, b); auto rr = __builtin_amdgcn_permlane32_swap(__float_as_uint(m), __float_as_uint(m), false, false);
    return fmaxf(__uint_as_float(rr[0]), __uint_as_float(rr[1]));
}
__device__ __forceinline__ float half_sum(float v) { auto rr = __builtin_amdgcn_permlane32_swap(__float_as_uint(v), __float_as_uint(v), false, false); return __uint_as_float(rr[0]) + __uint_as_float(rr[1]); }

constexpr int AB_QSTR = 4160;
constexpr int AB_STG = 16384 + 4 * AB_QSTR;
constexpr int AB_STGS = 33280;
constexpr int AB_WSF = 131072;
constexpr float AB_THR = 8.0f;

constexpr int AA_HSTR = 2112;
constexpr int AA_BUF = 2 * AA_HSTR;
constexpr int AA_KBUF = 4096;
constexpr int AA_WAVE = 2 * AA_BUF + 2 * AA_KBUF + 128;
constexpr float AA_THR = 8.0f;
__device__ __forceinline__ float rowmax16(const f32x16& p0) {
    float a = fmaxf(fmaxf(p0[0], p0[1]), p0[2]), b = fmaxf(fmaxf(p0[3], p0[4]), p0[5]);
    a = fmaxf(fmaxf(a, p0[6]), p0[7]); b = fmaxf(fmaxf(b, p0[8]), p0[9]); a = fmaxf(fmaxf(a, p0[10]), p0[11]); b = fmaxf(fmaxf(b, p0[12]), p0[13]);
    a = fmaxf(fmaxf(a, p0[14]), p0[15]);
    float m = fmaxf(a, b); auto rr = __builtin_amdgcn_permlane32_swap(__float_as_uint(m), __float_as_uint(m), false, false);
    return fmaxf(__uint_as_float(rr[0]), __uint_as_float(rr[1]));
}
typedef float af32x2 __attribute__((ext_vector_type(2)));
constexpr int AS_SLOT = 4096 + 2 * AA_HSTR;
constexpr int AS_WSF = 16 * AS_SLOT;
__device__ __forceinline__ void dma1(const void* sbase, unsigned voff, unsigned ldsaddr) {
    unsigned keep;
    asm volatile("s_mov_b32 %0, m0\n\ts_mov_b32 m0, %3\n\ts_nop 0\n\tglobal_load_lds_dwordx4 %2, %1\n\ts_mov_b32 m0, %0" : "=&s"(keep) : "s"(sbase), "v"(voff), "s"(ldsaddr) : "memory");
}
struct AsLane { unsigned vK, cK, vV, cV; };
__device__ __forceinline__ void as_fetch(const f16* base, int h, const AsLane& L, int wave, unsigned lds0, int N, int KB0, int M1, int K1, int S2, int K2, int d, int SL0) {
    const int lg = d == 1 ? 0 : (d == 4 ? 2 : 4);
#pragma unroll 1
    for (int i = 0; i < N; ++i) {
        const int q = wave * N + i, j = q >> 3, pc = q & 7;
        const int kb = KB0 + (j & M1) * K1 + (j >> S2) * K2;
        if (kb + 31 * d < 0 || kb >= SEQ) continue;
        unsigned voff, ld; size_t so;
        if (pc < 4) { so = ((size_t)(kb + d * 8 * pc) * INW + C_KA + h * 64) * 2; voff = (L.vK << lg) + (L.cK ^ ((unsigned)(pc & 1) << 6)); ld = (unsigned)pc * 1024u; }
        else { const int p2 = pc - 4, dh = p2 >> 1; so = ((size_t)(kb + d * 16 * (p2 & 1)) * INW + C_VA + h * 64 + 32 * dh) * 2; voff = (L.vV << lg) + L.cV; ld = 4096u + (unsigned)(dh * AA_HSTR + (p2 & 1) * 1024); }
        dma1((const char*)base + so, voff, (unsigned)__builtin_amdgcn_readfirstlane(lds0 + (unsigned)((SL0 + j) & 15) * (unsigned)AS_SLOT + ld));
    }
}
#ifndef AAT
#define AAT 0
#endif
#define AATIME(n, ...) do { if (AAT == (n) && MODE == 0) { const long long t0_ = __builtin_readcyclecounter(); __VA_ARGS__; tacc += __builtin_readcyclecounter() - t0_; } else { __VA_ARGS__; } } while (0)
template <int MODE>
__device__ __forceinline__ void phase_attnA(const Params& p, LAS unsigned char* lds, int wg, int nwg, long long& tacc) {
    const int tid = get_tid(lds);
    const int lane = tid & 63, r32 = lane & 31, hi = lane >> 5;
    const int wave = __builtin_amdgcn_readfirstlane(tid >> 6);
    const f16* proj = (const f16*)(p.ws + WS_PROJ);
    f16* oa = (f16*)(p.ws + WS_OAB);
    float* so = (float*)(p.ws + WS_H1);
    float* sml = (float*)(p.ws + WS_H1 + 64 * MiB);
    const unsigned lds0 = (unsigned)(size_t)lds;
    const AsLane AL = {(unsigned)(lane >> 3) * (unsigned)(INW * 2), (unsigned)(((lane & 7) ^ (lane >> 4)) << 4), (unsigned)(lane >> 2) * (unsigned)(INW * 2), (unsigned)(lane & 3) * 16u};
    LAS float* wsf = (LAS float*)(lds + AS_WSF + wave * 128);
    const int kr0 = r32 * 128, kx = (hi ^ ((r32 >> 1) & 7)) << 4;
    const int vl = ((lane >> 4) & 1) * 32 + (lane & 3) * 8 + (4 * hi + ((lane & 15) >> 2)) * 64;
    const int g8 = wg & 7, jj8 = wg >> 3;
    const int bh = g8 * 8 + (jj8 >> 2), rg = jj8 & 3, b = bh >> 3, h = bh & 7;
    const int R0 = rg * 1024;
    const float sl2 = slope_of(h + (h >> 1)) * LOG2E;
    const f16* base = proj + (size_t)b * SEQ * INW;
    float* so_bh = so + (size_t)bh * SEQ * 64; float* sml_bh = sml + (size_t)bh * SEQ * 2;
    f32x16 o[2], on[2]; float m, l, mnx = 0.f, lnx = 0.f; f16x8 qr[4], qn[4];
    o[0] = (f32x16){0.f, 0.f, 0.f, 0.f, 0.f, 0.f, 0.f, 0.f, 0.f, 0.f, 0.f, 0.f, 0.f, 0.f, 0.f, 0.f}; o[1] = o[0]; on[0] = o[0]; on[1] = o[0]; m = -1.0e30f; l = 0.f;
    qr[0] = (f16x8){0, 0, 0, 0, 0, 0, 0, 0}; qr[1] = qr[0]; qr[2] = qr[0]; qr[3] = qr[0]; qn[0] = qr[0]; qn[1] = qr[0]; qn[2] = qr[0]; qn[3] = qr[0];
    const GAS f16* gbase = (const GAS f16*)base; GAS float* gso = (GAS float*)so_bh; GAS float* gml = (GAS float*)sml_bh; GAS f16* goa = (GAS f16*)oa;
#define AA_LOADQ(P0_, QS_) do { int lu = lane; asm volatile("" : "+v"(lu)); const int qpos = (P0_) + (QS_) * (lu & 31); \
            _Pragma("unroll") for (int d0 = 0; d0 < 4; ++d0) qn[d0] = *(const GAS f16x8*)(gbase + (size_t)qpos * INW + C_QA + h * 64 + 16 * d0 + 8 * (lu >> 5)); } while (0)
#define AA_LOADS(P0_) do { int lu = lane; asm volatile("" : "+v"(lu)); const int qpos = (P0_) + (lu & 31); \
            _Pragma("unroll") for (int d0 = 0; d0 < 4; ++d0) qn[d0] = *(const GAS f16x8*)(gbase + (size_t)qpos * INW + C_QA + h * 64 + 16 * d0 + 8 * (lu >> 5)); \
            const af32x2 ml = *(const GAS af32x2*)(gml + (size_t)qpos * 2); mnx = ml[0]; lnx = ml[1]; \
            _Pragma("unroll") for (int r = 0; r < 16; ++r) { const GAS float* ip = gso + (size_t)((P0_) + crow(r, lu >> 5)) * 64 + (lu & 31); on[0][r] = ip[0]; on[1][r] = ip[32]; } } while (0)
    const f32x16 z16 = (f32x16){0.f, 0.f, 0.f, 0.f, 0.f, 0.f, 0.f, 0.f, 0.f, 0.f, 0.f, 0.f, 0.f, 0.f, 0.f, 0.f};
#define AS_SYNC() do { if (MODE != 2) { AATIME(5, asm volatile("s_waitcnt vmcnt(0)" ::: "memory")); AATIME(6, asm volatile("s_barrier" ::: "memory")); } } while (0)
#define AS_FETCH(...) do { if (MODE != 2) as_fetch(__VA_ARGS__); } while (0)
#define AA_STEP(SLOT, D, KB, QS) do { \
            const LAS unsigned char* kbuf = lds + (SLOT) * AS_SLOT; \
            const LAS unsigned char* vbuf = kbuf + 4096; \
            const int d = (D), kb = (KB); \
            f32x16 s = z16; \
            _Pragma("unroll") for (int d0 = 0; d0 < 4; ++d0) { const f16x8 kf = *(const LAS f16x8*)(kbuf + kr0 + ((d0 << 5) ^ kx)); s = MFMA32(kf, qr[d0], s); } \
            const float df = (float)d, basef = (float)(kb - P0 + 4 * hi * d - (QS) * r32), lim = 64.0f * df; \
            const bool need_range = (kb < 0) || (kb + 31 * d >= SEQ); \
            const float kpf0 = (float)(kb + 4 * hi * d); \
            if (need_range) { \
                _Pragma("unroll") for (int r = 0; r < 16; ++r) { \
                    const float c = (float)((r & 3) + 8 * (r >> 2)); \
                    const float ad = __builtin_fabsf(__builtin_fmaf(df, c, basef)), kpf = __builtin_fmaf(df, c, kpf0); \
                    const bool valid = (ad <= lim) && (kpf >= 0.0f) && (kpf < (float)SEQ); \
                    s[r] = valid ? __builtin_fmaf(-sl2, ad, s[r]) : -INFINITY; } \
            } else { \
                _Pragma("unroll") for (int r = 0; r < 16; ++r) { \
                    const float c = (float)((r & 3) + 8 * (r >> 2)); \
                    const float ad = __builtin_fabsf(__builtin_fmaf(df, c, basef)); \
                    s[r] = (ad <= lim) ? __builtin_fmaf(-sl2, ad, s[r]) : -INFINITY; } \
            } \
            const float mx = rowmax16(s); \
            if (__any(mx > m + AA_THR)) { \
                const float mn = fmaxf(m, mx), al = __builtin_amdgcn_exp2f(m - mn); \
                l *= al; m = mn; \
                if (hi == 0) wsf[r32] = al; \
                _Pragma("unroll") for (int r = 0; r < 16; ++r) { const float f = wsf[crow(r, hi)]; o[0][r] *= f; o[1][r] *= f; } } \
            float ls = 0.f; \
            _Pragma("unroll") for (int r = 0; r < 16; ++r) { s[r] = __builtin_amdgcn_exp2f(s[r] - m); ls += s[r]; } \
            l += ls; \
            u32x4 pw[2]; \
            pw[0] = (u32x4){pk2(s[0], s[1]), pk2(s[2], s[3]), pk2(s[4], s[5]), pk2(s[6], s[7])}; \
            pw[1] = (u32x4){pk2(s[8], s[9]), pk2(s[10], s[11]), pk2(s[12], s[13]), pk2(s[14], s[15])}; \
            const LAS unsigned char* vb = vbuf + vl; \
            _Pragma("unroll") for (int ks = 0; ks < 2; ++ks) _Pragma("unroll") for (int dh = 0; dh < 2; ++dh) { \
                    const f16x4 lo = vtr(vb + dh * AA_HSTR + ks * 1024), hh = vtr(vb + dh * AA_HSTR + ks * 1024 + 512); \
                    const f16x8 vf = (f16x8){lo[0], lo[1], lo[2], lo[3], hh[0], hh[1], hh[2], hh[3]}; \
                    o[dh] = MFMA32(__builtin_bit_cast(f16x8, pw[ks]), vf, o[dh]); } \
        } while (0)
#define AA_STEP2(SLOTA, SLOTB, D, KBA, KBB, QS) do { \
            const LAS unsigned char* kbA = lds + (SLOTA) * AS_SLOT; const LAS unsigned char* kbB = lds + (SLOTB) * AS_SLOT; \
            const int d = (D); \
            f32x16 sa = z16, sb = z16; \
            _Pragma("unroll") for (int d0 = 0; d0 < 4; ++d0) { const f16x8 ka = *(const LAS f16x8*)(kbA + kr0 + ((d0 << 5) ^ kx)), kbq = *(const LAS f16x8*)(kbB + kr0 + ((d0 << 5) ^ kx)); \
                sa = MFMA32(ka, qr[d0], sa); sb = MFMA32(kbq, qr[d0], sb); } \
            const float df = (float)d, lim = 64.0f * df; \
            const float bfa = (float)((KBA) - P0 + 4 * hi * d - (QS) * r32), bfb = (float)((KBB) - P0 + 4 * hi * d - (QS) * r32); \
            _Pragma("unroll") for (int r = 0; r < 16; ++r) { \
                const float c = (float)((r & 3) + 8 * (r >> 2)); \
                const float ada = __builtin_fabsf(__builtin_fmaf(df, c, bfa)), adb = __builtin_fabsf(__builtin_fmaf(df, c, bfb)); \
                sa[r] = (ada <= lim) ? __builtin_fmaf(-sl2, ada, sa[r]) : -INFINITY; sb[r] = (adb <= lim) ? __builtin_fmaf(-sl2, adb, sb[r]) : -INFINITY; } \
            const float mx = rowmax32(sa, sb); \
            if (__any(mx > m + AA_THR)) { \
                const float mn = fmaxf(m, mx), al = __builtin_amdgcn_exp2f(m - mn); \
                l *= al; m = mn; \
                if (hi == 0) wsf[r32] = al; \
                _Pragma("unroll") for (int r = 0; r < 16; ++r) { const float f = wsf[crow(r, hi)]; o[0][r] *= f; o[1][r] *= f; } } \
            float ls = 0.f; \
            _Pragma("unroll") for (int r = 0; r < 16; ++r) { sa[r] = __builtin_amdgcn_exp2f(sa[r] - m); sb[r] = __builtin_amdgcn_exp2f(sb[r] - m); ls += sa[r] + sb[r]; } \
            l += ls; \
            u32x4 pa[2], pb[2]; \
            pa[0] = (u32x4){pk2(sa[0], sa[1]), pk2(sa[2], sa[3]), pk2(sa[4], sa[5]), pk2(sa[6], sa[7])}; \
            pa[1] = (u32x4){pk2(sa[8], sa[9]), pk2(sa[10], sa[11]), pk2(sa[12], sa[13]), pk2(sa[14], sa[15])}; \
            pb[0] = (u32x4){pk2(sb[0], sb[1]), pk2(sb[2], sb[3]), pk2(sb[4], sb[5]), pk2(sb[6], sb[7])}; \
            pb[1] = (u32x4){pk2(sb[8], sb[9]), pk2(sb[10], sb[11]), pk2(sb[12], sb[13]), pk2(sb[14], sb[15])}; \
            const LAS unsigned char* va_ = kbA + 4096 + vl; const LAS unsigned char* vb_ = kbB + 4096 + vl; \
            _Pragma("unroll") for (int ks = 0; ks < 2; ++ks) _Pragma("unroll") for (int dh = 0; dh < 2; ++dh) { \
                    const f16x4 lo = vtr(va_ + dh * AA_HSTR + ks * 1024), hh = vtr(va_ + dh * AA_HSTR + ks * 1024 + 512); \
                    const f16x8 vf = (f16x8){lo[0], lo[1], lo[2], lo[3], hh[0], hh[1], hh[2], hh[3]}; \
                    o[dh] = MFMA32(__builtin_bit_cast(f16x8, pa[ks]), vf, o[dh]); } \
            _Pragma("unroll") for (int ks = 0; ks < 2; ++ks) _Pragma("unroll") for (int dh = 0; dh < 2; ++dh) { \
                    const f16x4 lo = vtr(vb_ + dh * AA_HSTR + ks * 1024), hh = vtr(vb_ + dh * AA_HSTR + ks * 1024 + 512); \
                    const f16x8 vf = (f16x8){lo[0], lo[1], lo[2], lo[3], hh[0], hh[1], hh[2], hh[3]}; \
                    o[dh] = MFMA32(__builtin_bit_cast(f16x8, pb[ks]), vf, o[dh]); } \
        } while (0)
#define P1_LIST(R4, D, N, KB0, M1, K1, S2, K2, DD, NS, JW0, JWS) do { const int d_ = (D), a0_ = R0 + (R4) - 256, b0_ = R0 + (R4) - 1024; \
            if (d_ < 2)       { N = 2; KB0 = a0_ + 512 + 256 * d_; M1 = 1; K1 = 128; S2 = 1; K2 = 0; DD = 4; NS = 2; JW0 = 0; JWS = 1; } \
            else if (d_ < 4)  { N = 4; KB0 = a0_ + 256 * (d_ - 2); M1 = 1; K1 = 1024; S2 = 1; K2 = 128; DD = 4; NS = 2; JW0 = hf; JWS = 2; } \
            else if (d_ < 6)  { N = 8; KB0 = b0_ + 512 + 1024 * (d_ - 4); M1 = 3; K1 = 4; S2 = 2; K2 = 512; DD = 16; NS = 2; JW0 = k4; JWS = 4; } \
            else              { N = 8; KB0 = b0_; M1 = 3; K1 = 4; S2 = 2; K2 = 2560; DD = 16; NS = 1; JW0 = wave; JWS = 0; } } while (0)
    const int k4 = wave & 3, hf = wave >> 2;
    __syncthreads();
    { int N, KB0, M1, K1, S2, K2, DD, NS, JW0, JWS; P1_LIST(0, 0, N, KB0, M1, K1, S2, K2, DD, NS, JW0, JWS); AS_FETCH(base, h, AL, wave, lds0, N, KB0, M1, K1, S2, K2, DD, 0); }
    int gs = 0;
    if (MODE != 1) AA_LOADQ(R0 + 4 * k4 + 512 * hf, 16);
#pragma unroll 1
    for (int r4 = 0; r4 < 4; ++r4) {
        const int P0 = R0 + r4 + 4 * k4 + 512 * hf;
        qr[0] = qn[0]; qr[1] = qn[1]; qr[2] = qn[2]; qr[3] = qn[3]; m = -1.0e30f; l = 0.f; o[0] = z16; o[1] = z16;
#pragma unroll 1
        for (int s = 0; s < 7; ++s) {
            AATIME(1, AS_SYNC());
            if (s == 4 && r4 < 3 && MODE != 1) AA_LOADQ(P0 + 1, 16);
            { int ns = s + 1, nr = r4; if (ns == 7) { ns = 0; nr = r4 + 1; }
              if (nr < 4) { int N, KB0, M1, K1, S2, K2, DD, NS, JW0, JWS; P1_LIST(nr, ns, N, KB0, M1, K1, S2, K2, DD, NS, JW0, JWS); AS_FETCH(base, h, AL, wave, lds0, N, KB0, M1, K1, S2, K2, DD, 8 * ((gs + 1) & 1)); } }
            { int N, KB0, M1, K1, S2, K2, DD, NS, JW0, JWS; P1_LIST(r4, s, N, KB0, M1, K1, S2, K2, DD, NS, JW0, JWS);
              const int jw0 = JW0, jw1 = JW0 + JWS;
              const int kb0 = KB0 + (jw0 & M1) * K1 + (jw0 >> S2) * K2, kb1 = KB0 + (jw1 & M1) * K1 + (jw1 >> S2) * K2;
              const bool in0 = kb0 + 31 * DD >= 0 && kb0 < SEQ, in1 = NS == 2 && kb1 + 31 * DD >= 0 && kb1 < SEQ;
              if (MODE != 1) {
                  if (in0 && in1) AATIME(3, AA_STEP2(8 * (gs & 1) + jw0, 8 * (gs & 1) + jw1, DD, kb0, kb1, 16));
                  else if (in0 || in1) { const int jw = in0 ? jw0 : jw1, kbw = in0 ? kb0 : kb1; AATIME(3, AA_STEP(8 * (gs & 1) + jw, DD, kbw, 16)); }
              } }
            ++gs;
        }
        const float lt = half_sum(l);
        if (MODE != 0 && lt != -1.0f) continue;
        if (hi == 0) { af32x2 ml; ml[0] = m; ml[1] = lt; *(GAS af32x2*)(gml + (size_t)(P0 + 16 * r32) * 2) = ml; }
#pragma unroll
        for (int r = 0; r < 16; ++r) { GAS float* op = gso + (size_t)(P0 + 16 * crow(r, hi)) * 64 + r32; op[0] = o[0][r]; op[32] = o[1][r]; }
    }
    AS_SYNC();
    AS_FETCH(base, h, AL, wave, lds0, 8, R0 - 64, 7, 32, 3, 0, 1, 0);
    AS_FETCH(base, h, AL, wave, lds0, 1, R0 - 64 + 32 * 8, 7, 32, 3, 0, 1, 8);
    if (MODE != 1) AA_LOADS(R0 + 32 * wave);
#pragma unroll 1
    for (int c = 0; c < 4; ++c) {
        const int P0 = R0 + 256 * c + 32 * wave;
        qr[0] = qn[0]; qr[1] = qn[1]; qr[2] = qn[2]; qr[3] = qn[3]; m = mnx; l = hi == 0 ? lnx : 0.f; o[0] = on[0]; o[1] = on[1];
#pragma unroll 1
        for (int e = 0; e < 3; ++e) {
            AATIME(1, AS_SYNC());
            if (e == 0 && c < 3 && MODE != 1) AA_LOADS(P0 + 256);
            { const int tn = 8 * c + (e == 0 ? 9 : (e == 1 ? 11 : 12)), nn = e == 0 ? 2 : (e == 1 ? 1 : 5);
              if (e < 2 || c < 3) AS_FETCH(base, h, AL, wave, lds0, nn, R0 - 64 + 32 * tn, 7, 32, 3, 0, 1, tn & 15); }
            { const int tw0 = 8 * c + wave + 2 * e, tw1 = tw0 + 1, kb0 = R0 - 64 + 32 * tw0, kb1 = kb0 + 32;
              const bool in0 = kb0 + 31 >= 0 && kb0 < SEQ, in1 = e < 2 && kb1 + 31 >= 0 && kb1 < SEQ;
              if (MODE != 1) {
                  if (in0 && in1) AATIME(3, AA_STEP2(tw0 & 15, tw1 & 15, 1, kb0, kb1, 1));
                  else if (in0 || in1) { const int tw = in0 ? tw0 : tw1, kbw = in0 ? kb0 : kb1; AATIME(3, AA_STEP(tw & 15, 1, kbw, 1)); }
              } }
        }
        l = half_sum(l);
        if (MODE != 0 && l != -1.0f) continue;
        if (hi == 0) wsf[r32] = 1.0f / l;
#pragma unroll
        for (int r = 0; r < 16; ++r) {
            const float il = wsf[crow(r, hi)];
            GAS f16* op = goa + ((size_t)b * SEQ + P0 + crow(r, hi)) * 512 + h * 64 + r32;
            op[0] = (f16)(o[0][r] * il); op[32] = (f16)(o[1][r] * il);
        }
    }
#undef P1_LIST
#undef AA_STEP
#undef AA_STEP2
#undef AS_SYNC
#undef AS_FETCH
#undef AA_LOADQ
#undef AA_LOADS
    asm volatile("s_waitcnt vmcnt(0)" ::: "memory");
    __syncthreads();
}
constexpr int B2_STGS = 33280, B2_WSF = 4 * B2_STGS, B2_CMX = B2_WSF + 1024;
constexpr float B2_THR = 8.0f, B2_SKIP_T = 40.0f;
#ifndef MOE_Q
#define MOE_Q 2
#endif
constexpr size_t SM_KMAX = 15360, SM_KDONE = 15872, SM_AQ = 16000;

__device__ __forceinline__ void glds16_asm(const void* gsrc, unsigned lds_dst) {
    unsigned keep;
    asm volatile("s_mov_b32 %0, m0\n\ts_mov_b32 m0, %2\n\ts_nop 0\n\tglobal_load_lds_dwordx4 %1, off\n\ts_mov_b32 m0, %0" : "=&s"(keep) : "v"(gsrc), "s"(lds_dst) : "memory");
}
__device__ __forceinline__ void phase_knorm(const Params& p, LAS unsigned char* lds, int wg, int nwg) {
    const int tid = get_tid(lds);
    const int lane = tid & 63;
    const f16* proj = (const f16*)(p.ws + WS_PROJ);
    unsigned* kmax2 = (unsigned*)(p.ws + WS_SMALL + SM_KMAX);
    unsigned* kdone = (unsigned*)(p.ws + WS_SMALL + SM_KDONE);
    const int tpw = TOK / nwg;
    const int t = wg * tpw + (tid >> 2), part = tid & 3;
    float n2[2];
#pragma unroll
    for (int g = 0; g < 2; ++g) {
        const f16* kr = (const f16*)(p.ws + WS_KVB) + ((size_t)((t >> 12) * 4 + part) * SEQ + (t & (SEQ - 1))) * 256 + g * 64;
        float s = 0.f;
#pragma unroll
        for (int c = 0; c < 8; ++c) { const f16x8 v = *(const f16x8*)(kr + c * 8);
#pragma unroll
            for (int j = 0; j < 8; ++j) s = fmaf((float)v[j], (float)v[j], s); }
        n2[g] = s;
    }
#pragma unroll
    for (int g = 0; g < 2; ++g) { for (int o = 4; o <= 32; o <<= 1) n2[g] = fmaxf(n2[g], shx(n2[g], o, lane)); }
    if (lane < 4) {
        const int b = (wg * tpw) / SEQ;
#pragma unroll
        for (int g = 0; g < 2; ++g) { const int hm = part * 2 + g;
            __hip_atomic_fetch_max(kmax2 + b * 8 + hm, __float_as_uint(n2[g]), __ATOMIC_RELAXED, __HIP_MEMORY_SCOPE_AGENT); }
    }
    asm volatile("s_waitcnt vmcnt(0)" ::: "memory");
    __syncthreads();
    if (tid == 0) __hip_atomic_fetch_add(kdone, 1u, __ATOMIC_RELAXED, __HIP_MEMORY_SCOPE_AGENT);
}

__device__ __forceinline__ void dma8(const void* sbase, const unsigned (&vo)[8], unsigned ldk, unsigned ldv) {
    unsigned keep;
    asm volatile(
        "s_mov_b32 %0, m0\n\t"
        "s_mov_b32 m0, %10\n\ts_nop 0\n\tglobal_load_lds_dwordx4 %2, %1\n\t"
        "s_add_i32 m0, %10, 0x400\n\ts_nop 0\n\tglobal_load_lds_dwordx4 %3, %1\n\t"
        "s_add_i32 m0, %10, 0x4000\n\ts_nop 0\n\tglobal_load_lds_dwordx4 %4, %1\n\t"
        "s_add_i32 m0, %10, 0x4400\n\ts_nop 0\n\tglobal_load_lds_dwordx4 %5, %1\n\t"
        "s_mov_b32 m0, %11\n\ts_nop 0\n\tglobal_load_lds_dwordx4 %6, %1\n\t"
        "s_add_i32 m0, %11, 0x400\n\ts_nop 0\n\tglobal_load_lds_dwordx4 %7, %1\n\t"
        "s_add_i32 m0, %11, 0x800\n\ts_nop 0\n\tglobal_load_lds_dwordx4 %8, %1\n\t"
        "s_add_i32 m0, %11, 0xc00\n\ts_nop 0\n\tglobal_load_lds_dwordx4 %9, %1\n\t"
        "s_mov_b32 m0, %0"
        : "=&s"(keep)
        : "s"(sbase), "v"(vo[0]), "v"(vo[1]), "v"(vo[2]), "v"(vo[3]), "v"(vo[4]), "v"(vo[5]), "v"(vo[6]), "v"(vo[7]), "s"(ldk), "s"(ldv)
        : "memory", "scc");
}

typedef float b3f2 __attribute__((ext_vector_type(2)));
constexpr int B3_VQ = 8256;
constexpr int B3_STG = 32768 + 4 * B3_VQ;
constexpr int B3_WSF = 2 * B3_STG, B3_CMX = B3_WSF + 1024;
__device__ __forceinline__ void phase_attnB3(const Params& p, LAS unsigned char* lds, int wg, int nwg) {
    const int tid = get_tid(lds);
    const int lane = tid & 63, r32 = lane & 31, hi = lane >> 5;
    const int wave = __builtin_amdgcn_readfirstlane(tid >> 6), grp = wave >> 2, qsub = wave & 3;
    const f16* proj = (const f16*)(p.ws + WS_PROJ);
    f16* ob = (f16*)(p.ws + WS_OAB) + (size_t)TOK * 512;
    const float lam = lambda_full(p.in[3], p.in[4], p.in[5], p.in[6], lane);
    const float* subg = p.in[7];
    LAS float* wsf = (LAS float*)(lds + B3_WSF) + wave * 32;
    LAS float* cmx = (LAS float*)(lds + B3_CMX);
    if (tid == 0) { unsigned* kdone = (unsigned*)(p.ws + WS_SMALL + SM_KDONE); unsigned sp = 0;
        while (__hip_atomic_load(kdone, __ATOMIC_RELAXED, __HIP_MEMORY_SCOPE_AGENT) < (unsigned)nwg) { __builtin_amdgcn_s_sleep(2); if (++sp > (1u << 22)) break; } }
    __syncthreads();
    const unsigned* kmax2 = (const unsigned*)(p.ws + WS_SMALL + SM_KMAX);
    const int kx4 = (hi ^ ((r32 >> 1) & 7)) << 4, krow = r32 * 128;
#define KOFF(d0) (krow + (((d0) << 5) ^ kx4))
    const int vl = ((lane >> 4) & 1) * 32 + (lane & 3) * 8 + (4 * hi + ((lane & 15) >> 2)) * 64;
    const unsigned vo_k = (unsigned)((16 * wave + (lane >> 3)) * 256 + ((lane & 7) ^ (((16 * wave + (lane >> 3)) >> 1) & 7)) * 8) * 2u;
    const unsigned vo_v = (unsigned)((16 * ((4 * wave) & 7) + (lane >> 2)) * 256 + 128 + (wave >> 1) * 32 + (lane & 3) * 8) * 2u;
    const unsigned ldk_w = (unsigned)wave * 2048u, ldv_w = 32768u + (unsigned)(wave >> 1) * B3_VQ + (unsigned)(wave & 1) * 4096u;
#ifdef B3_PRIO
    if (grp) __builtin_amdgcn_s_setprio(1);
#endif
#ifndef TIMEQ
#define TIMEQ 0
#endif
    long long tacc = 0;
    const unsigned lds0 = (unsigned)(size_t)lds;
    const f32x16 z16 = (f32x16){0.f, 0.f, 0.f, 0.f, 0.f, 0.f, 0.f, 0.f, 0.f, 0.f, 0.f, 0.f, 0.f, 0.f, 0.f, 0.f};

    unsigned* aq = (unsigned*)(p.ws + WS_SMALL + SM_AQ) + (wg & 7);
    unsigned pend = 0u;
    if (tid == 0) pend = __hip_atomic_fetch_add(aq, 1u, __ATOMIC_RELAXED, __HIP_MEMORY_SCOPE_AGENT);
#ifndef MOE_EARLY
    LAS unsigned* mslot = (LAS unsigned*)(lds + B3_CMX) + 10;
    bool mconv = true;
    if (tid == 0) *mslot = __hip_atomic_fetch_add((unsigned*)(p.ws + WS_SMALL + SM_PQ2), (unsigned)MCB, __ATOMIC_RELAXED, __HIP_MEMORY_SCOPE_AGENT);
#endif
#pragma unroll 1
    for (;;) {
        if (tid == 0) { cmx[8] = __uint_as_float(pend); pend = __hip_atomic_fetch_add(aq, 1u, __ATOMIC_RELAXED, __HIP_MEMORY_SCOPE_AGENT); }
        __syncthreads();
        const int u = __builtin_amdgcn_readfirstlane((int)__float_as_uint(cmx[8]));
        if (u >= 128) break;
        const int g8 = wg & 7, h = 3 - (u >> 5), ui = (h - (g8 & 3)) & 3, qb = u & 31;
        const int b = 2 * ui + (g8 >> 2);
        const float sl2 = slope_of(3 * h + 2) * LOG2E;
        const f16* base = proj + (size_t)b * SEQ * INW;
        const f16* gk = (const f16*)(p.ws + WS_KVB) + (size_t)(b * 4 + h) * SEQ * 256;
#define B3_ISSUE_T(T2_, pp) do { const unsigned st_ = lds0 + (unsigned)((pp) & 1) * (unsigned)B3_STG; \
            const unsigned vo_[8] = {vo_k, (vo_k + 8u * 512u) ^ 64u, vo_k + 128u, ((vo_k + 8u * 512u) ^ 64u) + 128u,     \
                 vo_v, vo_v + 16u * 512u, vo_v + 32u * 512u, vo_v + 48u * 512u}; \
            dma8(gk + (size_t)(T2_) * 128 * 256, vo_, (unsigned)__builtin_amdgcn_readfirstlane(st_ + ldk_w), (unsigned)__builtin_amdgcn_readfirstlane(st_ + ldv_w)); } while (0)
        B3_ISSUE_T(qb, 0);
        const int dw = 2 * qb + (qsub >> 1);
        const int qrel = qsub * 32 + r32, qpos = qb * 128 + qrel;
        f16x8 qr[4], ks4[4];
        { int lu = lane; asm volatile("" : "+v"(lu));
          const unsigned qo = (unsigned)((qb * 128 + qsub * 32 + (lu & 31)) * INW + h * 128 + grp * 64 + 8 * (lu >> 5));
#pragma unroll
          for (int d0 = 0; d0 < 4; ++d0) { qr[d0] = *(const f16x8*)(base + qo + C_QB + 16 * d0); ks4[d0] = *(const f16x8*)(gk + (size_t)(qb * 128 + qsub * 32 + (lu & 31)) * 256 + grp * 64 + 8 * (lu >> 5) + 16 * d0); } }
        float qn2 = 0.f, sii = 0.f;
#pragma unroll
        for (int d0 = 0; d0 < 4; ++d0)
#pragma unroll
            for (int j = 0; j < 8; ++j) { const float qv = (float)qr[d0][j]; qn2 = fmaf(qv, qv, qn2); sii = fmaf(qv, (float)ks4[d0][j], sii); }
        qn2 = half_sum(qn2); sii = half_sum(sii);
        const float kmx = sqrtf(__uint_as_float(__hip_atomic_load(kmax2 + b * 8 + h * 2 + grp, __ATOMIC_RELAXED, __HIP_MEMORY_SCOPE_AGENT)));
        float cb = sqrtf(qn2) * kmx * 1.001f - sii;
        for (int of = 16; of >= 1; of >>= 1) cb = fmaxf(cb, shx(cb, of, lane));
        if (lane == 0) cmx[wave] = cb;
        const float a64 = 64.0f * sl2; const f16 aH = (f16)a64, aL = (f16)(a64 - (float)aH), bH = (f16)sl2, bL = (f16)(sl2 - (float)bH);
        const f16 zz = (f16)0.f;
        const unsigned qx01 = hi == 0 ? __builtin_bit_cast(unsigned, (f16x2){aH, aL}) : 0u, qx23 = hi == 0 ? __builtin_bit_cast(unsigned, (f16x2){bH, bL}) : 0u;
        asm volatile("s_waitcnt lgkmcnt(0)" ::: "memory"); __syncthreads();
        float cmax = cmx[0];
#pragma unroll
        for (int w = 1; w < 8; ++w) cmax = fmaxf(cmax, cmx[w]);
        const float Dm = (cmax + B2_SKIP_T + 1.0f) / sl2;
        int t_lo, t_hi;
        { const float lo = ((float)(qb * 128 - 127) - Dm) * (1.0f / 128.0f), hh = ((float)(qb * 128 + 127) + Dm) * (1.0f / 128.0f);
          t_lo = lo <= 0.f ? 0 : (int)lo; t_hi = hh >= 31.f ? 31 : (int)hh; if (t_lo > qb) t_lo = qb; if (t_hi < qb) t_hi = qb; }
        t_lo = __builtin_amdgcn_readfirstlane(t_lo); t_hi = __builtin_amdgcn_readfirstlane(t_hi);
        const int nL = qb - t_lo, U = 1 + nL + (t_hi - qb);
#define B3_SEQ(pp) ((pp) == 0 ? qb : ((pp) - 1 < nL ? qb - 1 - ((pp) - 1) : qb + 1 + ((pp) - 1 - nL)))
#define B3_ISSUE(pp) B3_ISSUE_T(B3_SEQ(pp), pp)
        f32x16 o[4]; o[0] = z16; o[1] = z16; o[2] = z16; o[3] = z16;
        float m = sii, l = 0.f;
        asm volatile("s_waitcnt vmcnt(0) lgkmcnt(0)\n\ts_barrier" ::: "memory");
#define SBAR() __builtin_amdgcn_sched_barrier(0)
#define PIN(x) asm volatile("" : "+v"(x))
#define B3_QK(S0, S1, T, JJ) do { \
            const LAS unsigned char* kbse = st + grp * 16384 + (JJ) * 8192; \
            const int side = (T) <= dw ? 0 : 1; \
            const float sq = sl2 * (float)qrel; \
            const float mr = side == 0 ? -(m + sq) : -(m - sq); \
            const f16 mH = (f16)mr, mL = (f16)(mr - (float)mH), one = (f16)1.0f; \
            const f16 trel = (f16)(float)((T) - 2 * qb), l0 = (f16)(float)r32, l1 = (f16)(float)(32 + r32); \
            const f16x8 kx0 = hi == 0 ? (f16x8){trel, trel, l0, l0, one, one, zz, zz} : (f16x8){zz, zz, zz, zz, zz, zz, zz, zz}; \
            const f16x8 kx1 = hi == 0 ? (f16x8){trel, trel, l1, l1, one, one, zz, zz} : (f16x8){zz, zz, zz, zz, zz, zz, zz, zz}; \
            u32x4 qxb = (u32x4){qx01, qx23, 0u, 0u}; if (side) { qxb.x ^= 0x80008000u; qxb.y ^= 0x80008000u; } \
            if (hi == 0) qxb.z = __builtin_bit_cast(unsigned, (f16x2){mH, mL}); \
            const f16x8 qx = __builtin_bit_cast(f16x8, qxb); \
            S0 = MFMA32(kx0, qx, z16); S1 = MFMA32(kx1, qx, z16); \
            _Pragma("unroll") for (int d0 = 0; d0 < 4; ++d0) { \
                const f16x8 a0 = *(const LAS f16x8*)(kbse + KOFF(d0)), a1 = *(const LAS f16x8*)(kbse + 4096 + KOFF(d0)); \
                S0 = MFMA32(a0, qr[d0], S0); S1 = MFMA32(a1, qr[d0], S1); } } while (0)
#define B3_FIX(S0, S1, T) do { if ((T) == dw) { const float dq0 = (float)(64 * ((T) - 2 * qb) + 4 * hi - qrel), m2 = -2.0f * sl2; \
            _Pragma("unroll") for (int r = 0; r < 16; ++r) { const float c = (float)((r & 3) + 8 * (r >> 2)); \
                S0[r] = __builtin_fmaf(m2, fmaxf(dq0 + c, 0.f), S0[r]); S1[r] = __builtin_fmaf(m2, fmaxf(dq0 + 32.0f + c, 0.f), S1[r]); } } } while (0)
#define B3_EXP(S0, S1, PW) do { float ls = 0.f; \
            _Pragma("unroll") for (int r = 0; r < 16; ++r) { S0[r] = __builtin_amdgcn_exp2f(S0[r]); S1[r] = __builtin_amdgcn_exp2f(S1[r]); ls += S0[r] + S1[r]; } \
            l += ls; \
            PW[0] = (u32x4){pk2(S0[0], S0[1]), pk2(S0[2], S0[3]), pk2(S0[4], S0[5]), pk2(S0[6], S0[7])}; \
            PW[1] = (u32x4){pk2(S0[8], S0[9]), pk2(S0[10], S0[11]), pk2(S0[12], S0[13]), pk2(S0[14], S0[15])}; \
            PW[2] = (u32x4){pk2(S1[0], S1[1]), pk2(S1[2], S1[3]), pk2(S1[4], S1[5]), pk2(S1[6], S1[7])}; \
            PW[3] = (u32x4){pk2(S1[8], S1[9]), pk2(S1[10], S1[11]), pk2(S1[12], S1[13]), pk2(S1[14], S1[15])}; } while (0)
#define B3_PV(PW, JJ) do { const LAS unsigned char* vb = st + 32768 + (JJ) * 4096 + vl; \
            _Pragma("unroll") for (int ks = 0; ks < 4; ++ks) { _Pragma("unroll") for (int dq = 0; dq < 4; ++dq) { \
                const f16x4 lo = vtr(vb + dq * B3_VQ + ks * 1024), hh = vtr(vb + dq * B3_VQ + ks * 1024 + 512); \
                const f16x8 vf = (f16x8){lo[0], lo[1], lo[2], lo[3], hh[0], hh[1], hh[2], hh[3]}; \
                o[dq] = MFMA32(__builtin_bit_cast(f16x8, PW[ks]), vf, o[dq]); } } } while (0)
#pragma unroll 1
        for (int pp = 0; pp < U; ++pp) {
            if (pp + 1 < U) B3_ISSUE(pp + 1);
#ifdef B3_SKEW
            if (grp) __builtin_amdgcn_s_sleep(B3_SKEW);
#endif
            const LAS unsigned char* st = lds + (pp & 1) * B3_STG;
            const int T2 = B3_SEQ(pp), TA = 2 * T2, TB = 2 * T2 + 1;
            f32x16 a0s, a1s, b0s, b1s; u32x4 pwA[4], pwB[4];
            B3_QK(a0s, a1s, TA, 0);
            __builtin_amdgcn_sched_group_barrier(0x100, 4, 0); __builtin_amdgcn_sched_group_barrier(0x8, 2, 0);
            __builtin_amdgcn_sched_group_barrier(0x8, 2, 0); __builtin_amdgcn_sched_group_barrier(0x100, 2, 0);
            __builtin_amdgcn_sched_group_barrier(0x8, 2, 0); __builtin_amdgcn_sched_group_barrier(0x100, 2, 0);
            __builtin_amdgcn_sched_group_barrier(0x8, 4, 0);
            B3_FIX(a0s, a1s, TA);
            { const float mx = rowmax32(a0s, a1s);
              if (__any(mx > B2_THR)) {
                const float dl = fmaxf(mx, 0.f), al = __builtin_amdgcn_exp2f(-dl);
                m += dl; l *= al;
                if (hi == 0) wsf[r32] = al;
#pragma unroll
                for (int r = 0; r < 16; ++r) { const float f = wsf[crow(r, hi)];
#pragma unroll
                    for (int i = 0; i < 4; ++i) o[i][r] *= f;
                    a0s[r] -= dl; a1s[r] -= dl; }
              } }
            {
                const LAS unsigned char* kbse = st + grp * 16384 + 8192;
                const int side = TB <= dw ? 0 : 1;
                const float sq = sl2 * (float)qrel;
                const float mr = side == 0 ? -(m + sq) : -(m - sq);
                const f16 mH = (f16)mr, mL = (f16)(mr - (float)mH), one = (f16)1.0f;
                const f16 trel = (f16)(float)(TB - 2 * qb), l0 = (f16)(float)r32, l1 = (f16)(float)(32 + r32);
                const f16x8 kx0 = hi == 0 ? (f16x8){trel, trel, l0, l0, one, one, zz, zz} : (f16x8){zz, zz, zz, zz, zz, zz, zz, zz};
                const f16x8 kx1 = hi == 0 ? (f16x8){trel, trel, l1, l1, one, one, zz, zz} : (f16x8){zz, zz, zz, zz, zz, zz, zz, zz};
                u32x4 qxb = (u32x4){qx01, qx23, 0u, 0u}; if (side) { qxb.x ^= 0x80008000u; qxb.y ^= 0x80008000u; }
                if (hi == 0) qxb.z = __builtin_bit_cast(unsigned, (f16x2){mH, mL});
                const f16x8 qx = __builtin_bit_cast(f16x8, qxb);
                f16x8 kf0 = *(const LAS f16x8*)(kbse + KOFF(0)), kf1 = *(const LAS f16x8*)(kbse + 4096 + KOFF(0));
                f16x8 kf2 = *(const LAS f16x8*)(kbse + KOFF(1)), kf3 = *(const LAS f16x8*)(kbse + 4096 + KOFF(1));
                float ls = 0.f;
                SBAR();
#define EX3(S, i0) do { S[i0] = __builtin_amdgcn_exp2f(S[i0]); S[i0 + 1] = __builtin_amdgcn_exp2f(S[i0 + 1]); S[i0 + 2] = __builtin_amdgcn_exp2f(S[i0 + 2]); ls += S[i0]; ls += S[i0 + 1]; ls += S[i0 + 2]; PIN(ls); } while (0)
#define EX4(S, i0) do { S[i0] = __builtin_amdgcn_exp2f(S[i0]); S[i0 + 1] = __builtin_amdgcn_exp2f(S[i0 + 1]); S[i0 + 2] = __builtin_amdgcn_exp2f(S[i0 + 2]); S[i0 + 3] = __builtin_amdgcn_exp2f(S[i0 + 3]); ls += S[i0]; ls += S[i0 + 1]; ls += S[i0 + 2]; ls += S[i0 + 3]; PIN(ls); } while (0)
                b0s = MFMA32(kx0, qx, z16); EX3(a0s, 0); SBAR();
                b1s = MFMA32(kx1, qx, z16); EX3(a0s, 3); SBAR();
                b0s = MFMA32(kf0, qr[0], b0s); kf0 = *(const LAS f16x8*)(kbse + KOFF(2)); EX3(a0s, 6); SBAR();
                b1s = MFMA32(kf1, qr[0], b1s); kf1 = *(const LAS f16x8*)(kbse + 4096 + KOFF(2)); EX3(a0s, 9); SBAR();
                b0s = MFMA32(kf2, qr[1], b0s); kf2 = *(const LAS f16x8*)(kbse + KOFF(3)); EX4(a0s, 12); SBAR();
                b1s = MFMA32(kf3, qr[1], b1s); kf3 = *(const LAS f16x8*)(kbse + 4096 + KOFF(3)); EX4(a1s, 0); SBAR();
                b0s = MFMA32(kf0, qr[2], b0s); EX4(a1s, 4); SBAR();
                b1s = MFMA32(kf1, qr[2], b1s); EX4(a1s, 8); SBAR();
                b0s = MFMA32(kf2, qr[3], b0s); EX4(a1s, 12);
                pwA[0] = (u32x4){pk2(a0s[0], a0s[1]), pk2(a0s[2], a0s[3]), pk2(a0s[4], a0s[5]), pk2(a0s[6], a0s[7])};
                pwA[1] = (u32x4){pk2(a0s[8], a0s[9]), pk2(a0s[10], a0s[11]), pk2(a0s[12], a0s[13]), pk2(a0s[14], a0s[15])};
                SBAR();
                b1s = MFMA32(kf3, qr[3], b1s);
                pwA[2] = (u32x4){pk2(a1s[0], a1s[1]), pk2(a1s[2], a1s[3]), pk2(a1s[4], a1s[5]), pk2(a1s[6], a1s[7])};
                pwA[3] = (u32x4){pk2(a1s[8], a1s[9]), pk2(a1s[10], a1s[11]), pk2(a1s[12], a1s[13]), pk2(a1s[14], a1s[15])};
                SBAR();
                l += ls;
            }
            B3_FIX(b0s, b1s, TB);
            { const float mx = rowmax32(b0s, b1s);
              if (__any(mx > B2_THR)) {
                const float dl = fmaxf(mx, 0.f), al = __builtin_amdgcn_exp2f(-dl);
                m += dl; l *= al;
                if (hi == 0) wsf[r32] = al;
#pragma unroll
                for (int r = 0; r < 16; ++r) { const float f = wsf[crow(r, hi)];
#pragma unroll
                    for (int i = 0; i < 4; ++i) o[i][r] *= f;
                    b0s[r] -= dl; b1s[r] -= dl; a0s[r] *= al; a1s[r] *= al; }
                pwA[0] = (u32x4){pk2(a0s[0], a0s[1]), pk2(a0s[2], a0s[3]), pk2(a0s[4], a0s[5]), pk2(a0s[6], a0s[7])};
                pwA[1] = (u32x4){pk2(a0s[8], a0s[9]), pk2(a0s[10], a0s[11]), pk2(a0s[12], a0s[13]), pk2(a0s[14], a0s[15])};
                pwA[2] = (u32x4){pk2(a1s[0], a1s[1]), pk2(a1s[2], a1s[3]), pk2(a1s[4], a1s[5]), pk2(a1s[6], a1s[7])};
                pwA[3] = (u32x4){pk2(a1s[8], a1s[9]), pk2(a1s[10], a1s[11]), pk2(a1s[12], a1s[13]), pk2(a1s[14], a1s[15])};
              } }
            {
                const LAS unsigned char* vb = st + 32768 + vl;
                float ls = 0.f;
#define VFR_(ks, dq) do { const f16x4 lo_ = vtr(vb + (dq) * B3_VQ + (ks) * 1024), hh_ = vtr(vb + (dq) * B3_VQ + (ks) * 1024 + 512); vnx = (f16x8){lo_[0], lo_[1], lo_[2], lo_[3], hh_[0], hh_[1], hh_[2], hh_[3]}; } while (0)
#define EX2(S, i0) do { S[i0] = __builtin_amdgcn_exp2f(S[i0]); S[i0 + 1] = __builtin_amdgcn_exp2f(S[i0 + 1]); ls += S[i0]; ls += S[i0 + 1]; PIN(ls); } while (0)
                f16x8 vcu, vn1, vnx;
                VFR_(0, 0); vcu = vnx; VFR_(0, 1); vn1 = vnx; SBAR();
#define PVG(ks, dq, nks, ndq, S, i0) do { VFR_(nks, ndq); o[dq] = MFMA32(__builtin_bit_cast(f16x8, pwA[ks]), vcu, o[dq]); EX2(S, i0); vcu = vn1; vn1 = vnx; SBAR(); } while (0)
                PVG(0, 0, 0, 2, b0s, 0);  PVG(0, 1, 0, 3, b0s, 2);  PVG(0, 2, 1, 0, b0s, 4);  PVG(0, 3, 1, 1, b0s, 6);
                PVG(1, 0, 1, 2, b0s, 8);  PVG(1, 1, 1, 3, b0s, 10); PVG(1, 2, 2, 0, b0s, 12); PVG(1, 3, 2, 1, b0s, 14);
                PVG(2, 0, 2, 2, b1s, 0);  PVG(2, 1, 2, 3, b1s, 2);  PVG(2, 2, 3, 0, b1s, 4);  PVG(2, 3, 3, 1, b1s, 6);
                PVG(3, 0, 3, 2, b1s, 8);  PVG(3, 1, 3, 3, b1s, 10);
                o[2] = MFMA32(__builtin_bit_cast(f16x8, pwA[3]), vcu, o[2]); EX2(b1s, 12); vcu = vn1; SBAR();
                o[3] = MFMA32(__builtin_bit_cast(f16x8, pwA[3]), vcu, o[3]); EX2(b1s, 14); SBAR();
#undef PVG
#undef VFR_
                l += ls;
                pwB[0] = (u32x4){pk2(b0s[0], b0s[1]), pk2(b0s[2], b0s[3]), pk2(b0s[4], b0s[5]), pk2(b0s[6], b0s[7])};
                pwB[1] = (u32x4){pk2(b0s[8], b0s[9]), pk2(b0s[10], b0s[11]), pk2(b0s[12], b0s[13]), pk2(b0s[14], b0s[15])};
                pwB[2] = (u32x4){pk2(b1s[0], b1s[1]), pk2(b1s[2], b1s[3]), pk2(b1s[4], b1s[5]), pk2(b1s[6], b1s[7])};
                pwB[3] = (u32x4){pk2(b1s[8], b1s[9]), pk2(b1s[10], b1s[11]), pk2(b1s[12], b1s[13]), pk2(b1s[14], b1s[15])};
            }
            B3_PV(pwB, 1);
            __builtin_amdgcn_sched_group_barrier(0x100, 4, 3);
#pragma unroll
            for (int i = 0; i < 14; ++i) { __builtin_amdgcn_sched_group_barrier(0x8, 1, 3); __builtin_amdgcn_sched_group_barrier(0x100, 2, 3); }
            __builtin_amdgcn_sched_group_barrier(0x8, 2, 3);
#if TIMEQ == 1
            { const long long tq0 = __builtin_readcyclecounter(); asm volatile("s_waitcnt vmcnt(0)" ::: "memory"); tacc += __builtin_readcyclecounter() - tq0; }
#endif
#if TIMEQ == 2
            asm volatile("s_waitcnt vmcnt(0)" ::: "memory");
            const long long tq0 = __builtin_readcyclecounter();
#endif
            asm volatile("s_waitcnt vmcnt(0) lgkmcnt(0)\n\ts_barrier" ::: "memory");
#if TIMEQ == 2
            tacc += __builtin_readcyclecounter() - tq0;
#endif
        }
#undef B3_QK
#undef SBAR
#undef PIN
#undef EX2
#undef EX3
#undef EX4
#undef B3_FIX
#undef B3_EXP
#undef B3_PV
#undef B3_ISSUE
#undef B3_ISSUE_T
#undef B3_SEQ
        l = half_sum(l);
        if (hi == 0) wsf[r32] = 1.0f / l;
        LAS float* ost = (LAS float*)lds + (size_t)grp * 128 * 128;
#pragma unroll
        for (int r = 0; r < 16; ++r) { const float il = wsf[crow(r, hi)]; const int row = qsub * 32 + crow(r, hi);
#pragma unroll
            for (int i = 0; i < 4; ++i) ost[row * 128 + i * 32 + r32] = o[i][r] * il; }
        __syncthreads();
        {
            const LAS float* o1 = (const LAS float*)lds; const LAS float* o2 = o1 + 128 * 128;
            int l2 = lane; asm volatile("" : "+v"(l2));
            const float g0s = subg[2 * l2], g1s = subg[2 * l2 + 1];
            float v0[16], v1[16], ss[16];
#pragma unroll
            for (int rr = 0; rr < 16; ++rr) {
                const int row = wave * 16 + rr;
                const b3f2 a1 = *(const LAS b3f2*)(o1 + row * 128 + 2 * l2), a2 = *(const LAS b3f2*)(o2 + row * 128 + 2 * l2);
                v0[rr] = a1[0] - lam * a2[0]; v1[rr] = a1[1] - lam * a2[1];
                ss[rr] = v0[rr] * v0[rr] + v1[rr] * v1[rr];
            }
#pragma unroll
            for (int of = 32; of >= 1; of >>= 1) {
#pragma unroll
                for (int rr = 0; rr < 16; ++rr) ss[rr] += shx(ss[rr], of, lane);
            }
#pragma unroll
            for (int rr = 0; rr < 16; ++rr) {
                const int row = wave * 16 + rr;
                const float rs = rsqrtf(ss[rr] * (1.0f / 128.0f) + 1e-5f) * (1.0f - LAMBDA_INIT);
                f16* op = ob + ((size_t)b * SEQ + qb * 128 + row) * 512 + h * 128;
                *(unsigned*)(op + 2 * l2) = pk2(v0[rr] * rs * g0s, v1[rr] * rs * g1s);
            }
        }
        __syncthreads();
#ifndef MOE_EARLY
        if (mconv) mconv = moe_conv(p, lds, tid, MOE_Q, mslot);
#endif
    }
#ifndef MOE_EARLY
    while (mconv) mconv = moe_conv(p, lds, tid, 2, mslot);
    __syncthreads();
#endif
#if TIMEQ
    { const long long t0 = __builtin_readcyclecounter(); while (__builtin_readcyclecounter() - t0 < tacc) __builtin_amdgcn_s_sleep(1); }
    __syncthreads();
#endif
#ifdef B3_PRIO
    __builtin_amdgcn_s_setprio(0);
#endif
#undef KOFF
}
#define XB_TMO      128
#define XB_XCNT(j)  (256  + 64 * (j))
#define XB_XSUB(j)  (1280 + 64 * (j))
#define XB_XGEN(j)  (2304 + 64 * (j))
#define XB_TOP      3328
#define XB_TOPGEN   3392
#define XCD_BAR_WORDS 3456
#define XB_SPIN_CAP (1u << 20)
__device__ __forceinline__ unsigned xb_ld(unsigned* p)              { return __hip_atomic_load(p, __ATOMIC_RELAXED, __HIP_MEMORY_SCOPE_AGENT); }
__device__ __forceinline__ unsigned xb_add(unsigned* p, unsigned v) { return __hip_atomic_fetch_add(p, v, __ATOMIC_RELAXED, __HIP_MEMORY_SCOPE_AGENT); }
__device__ __forceinline__ unsigned xb_xcc_id() { return (unsigned)__builtin_amdgcn_s_getreg((3 << 11) | 20) & 0xFu; }
#define XB_SPIN(cond, bar) do { unsigned _sp = 0; while (cond) { __builtin_amdgcn_s_sleep(1); \
    if ((++_sp & 255u) == 0u) { if (xb_ld(&(bar)[XB_TMO])) break; if (_sp > XB_SPIN_CAP) { atomicAdd(&(bar)[XB_TMO], 1u); break; } } } } while (0)
__device__ __forceinline__ void xcd_barrier_post(unsigned* bar, int tid) { if (tid == 0) (void)xb_add(&bar[XB_XCNT(xb_xcc_id())], 1u); }
__device__ __forceinline__ void xcd_barrier_complete(unsigned* bar, unsigned x, unsigned& nloc, unsigned& nx) {
    const unsigned G = gridDim.x;
    unsigned sum, cnt, mine, sp = 0u;
    for (;;) {
        sum = 0u; cnt = 0u; mine = 0u;
#pragma unroll
        for (unsigned j = 0; j < 16; ++j) { const unsigned c = xb_ld(&bar[XB_XCNT(j)]); sum += c; cnt += (c > 0u) ? 1u : 0u; mine = (j == x) ? c : mine; }
        if (sum == G) break;
        __builtin_amdgcn_s_sleep(1);
        if ((++sp & 255u) == 0u) { if (xb_ld(&bar[XB_TMO])) break; if (sp > XB_SPIN_CAP) { atomicAdd(&bar[XB_TMO], 1u); break; } }
    }
    nloc = mine > 0u ? mine : 1u; nx = cnt > 0u ? cnt : 1u;
}
__device__ __forceinline__ void xcd_barrier(unsigned* bar, volatile LAS unsigned* st, LAS unsigned char* lds) {
    const int tid = get_tid(lds);
    asm volatile("s_waitcnt vmcnt(0)" ::: "memory");
    __syncthreads();
    if (tid == 0) {
        const unsigned x = xb_xcc_id();
        __builtin_amdgcn_s_waitcnt(0);
        unsigned nloc = st[0], nx = st[1];
        if (nloc == 0u) { xcd_barrier_complete(bar, x, nloc, nx); st[0] = nloc; st[1] = nx; }
        const unsigned old = xb_add(&bar[XB_XSUB(x)], 1u);
        const unsigned gen = old / nloc;
        if (old + 1u == (gen + 1u) * nloc) {
            __builtin_amdgcn_fence(__ATOMIC_RELEASE, "agent");
            asm volatile("s_waitcnt vmcnt(0)" ::: "memory");
            const unsigned og = xb_add(&bar[XB_TOP], 1u);
            const unsigned tg = og / nx;
            if (og + 1u == (tg + 1u) * nx) xb_add(&bar[XB_TOPGEN], 1u);
            else XB_SPIN(xb_ld(&bar[XB_TOPGEN]) == tg, bar);
            __builtin_amdgcn_fence(__ATOMIC_ACQUIRE, "agent");
            xb_add(&bar[XB_XGEN(x)], 1u);
            asm volatile("s_waitcnt vmcnt(0)" ::: "memory");
        } else {
            XB_SPIN(xb_ld(&bar[XB_XGEN(x)]) == gen, bar);
            __builtin_amdgcn_fence(__ATOMIC_ACQUIRE, "agent");
            asm volatile("s_waitcnt vmcnt(0)" ::: "memory");
        }
    }
    __syncthreads();
}
constexpr int LDS_BARST = LDS_TOTAL - 16;
constexpr size_t SM_BAR = 1024;
__global__ void __launch_bounds__(NTHR, 2) k_mega(Params p) {
    extern __shared__ __attribute__((aligned(16))) unsigned char smem[];
    LAS unsigned char* lds = (LAS unsigned char*)smem;
    const int wg = blockIdx.x, nwg = gridDim.x;
    volatile LAS unsigned* st = (volatile LAS unsigned*)(lds + LDS_BARST);
    { const unsigned hw = (unsigned)__builtin_amdgcn_s_getreg((5 << 11) | 4) & 63u; if ((threadIdx.x & 63) == 0) ((LAS int*)(lds + LDS_WTAB))[hw] = (int)(threadIdx.x >> 6); }
    if (threadIdx.x == 0) { st[0] = 0u; st[1] = 0u; put_params(p, lds); }
    __syncthreads();
    xcd_barrier_post((unsigned*)(get_params(lds).ws + WS_SMALL + SM_BAR), get_tid(lds));
#define GRID_SYNC() xcd_barrier((unsigned*)(get_params(lds).ws + WS_SMALL + SM_BAR), st, lds)
#ifndef TIMEPH
#define TIMEPH 0
#endif
    long long tph = 0;
#define TPH2(n, call) do { if (TIMEPH == (n) || TIMEPH == 11) { const long long t0_ = __builtin_readcyclecounter(); call; tph += __builtin_readcyclecounter() - t0_; } else { call; } } while (0)
#define TPH(n, call) do { if (TIMEPH == (n)) { const long long t0_ = __builtin_readcyclecounter(); call; tph += __builtin_readcyclecounter() - t0_; } else { call; } } while (0)
    TPH(1, phase_prep(get_params(lds), lds, wg, nwg));      TPH2(21, GRID_SYNC());
    TPH(2, phase_inproj(get_params(lds), lds, wg, nwg));    TPH2(22, GRID_SYNC());
    TPH(10, phase_knorm(get_params(lds), lds, wg, nwg));
    TPH(3, phase_attnA<0>(get_params(lds), lds, wg, nwg, tph));
#ifdef AAPROBE
    phase_attnA<AAPROBE>(get_params(lds), lds, wg, nwg, tph);
#endif
    TPH(4, phase_attnB3(get_params(lds), lds, wg, nwg));
    TPH2(23, GRID_SYNC());
#ifdef EXTRA_SYNC
    GRID_SYNC(); GRID_SYNC(); GRID_SYNC(); GRID_SYNC();
#endif
    TPH(5, phase_merge(get_params(lds), lds, wg, nwg));     TPH2(24, GRID_SYNC());
    TPH(6, phase_outproj(get_params(lds), lds, wg, nwg));   TPH2(25, GRID_SYNC());
    TPH(12, phase_router(get_params(lds), lds, wg, nwg));   TPH2(26, GRID_SYNC());
    TPH(7, phase_up(get_params(lds), lds, wg, nwg));        TPH2(27, GRID_SYNC());
    TPH(8, phase_down(get_params(lds), lds, wg, nwg));      TPH2(28, GRID_SYNC());
    TPH(9, phase_final(get_params(lds), lds, wg, nwg));
    if (TIMEPH) { const long long t0_ = __builtin_readcyclecounter(); while (__builtin_readcyclecounter() - t0_ < tph) __builtin_amdgcn_s_sleep(1); }
#undef TPH
#undef GRID_SYNC
}
}

extern "C" void kernel_launch(void* const* d_in, const int* in_sizes, int n_in, void* d_out, int out_size, void* d_ws, size_t ws_size,
                              hipStream_t stream) {
    static int grid_blocks = 0;
    if (grid_blocks == 0) {
        int dev = 0, cus = 0, per_cu = 0;
        if (hipGetDevice(&dev) != hipSuccess || hipDeviceGetAttribute(&cus, hipDeviceAttributeMultiprocessorCount, dev) != hipSuccess) { fprintf(stderr, "kernel_launch: device query failed\n"); grid_blocks = -1; return; }
        if (hipFuncSetAttribute((const void*)k_mega, hipFuncAttributeMaxDynamicSharedMemorySize, LDS_TOTAL) != hipSuccess) { fprintf(stderr, "kernel_launch: hipFuncSetAttribute failed\n"); grid_blocks = -1; return; }
        if (hipOccupancyMaxActiveBlocksPerMultiprocessor(&per_cu, (const void*)k_mega, NTHR, LDS_TOTAL) != hipSuccess || per_cu < 1) { fprintf(stderr, "kernel_launch: occupancy query says %d blocks/CU\n", per_cu); grid_blocks = -1; return; }
        grid_blocks = cus * per_cu;
        if (grid_blocks > NWG) grid_blocks = NWG;
        if (grid_blocks != NWG) { fprintf(stderr, "kernel_launch: need %d co-resident workgroups, device offers %d\n", NWG, grid_blocks); grid_blocks = -1; return; }
        if (ws_size < WS_TOTAL) { fprintf(stderr, "kernel_launch: workspace too small (%zu < %zu)\n", ws_size, (size_t)WS_TOTAL); grid_blocks = -1; return; }
    }
    if (grid_blocks < 0) return;
    Params p{};
    for (int i = 0; i < 22; ++i) p.in[i] = (const float*)d_in[i];
    p.out = (float*)d_out; p.ws = (unsigned char*)d_ws;
    if (hipMemsetAsync((char*)d_ws + WS_SMALL, 0, 16384, stream) != hipSuccess) { fprintf(stderr, "kernel_launch: memset failed\n"); return; }
    void* args[] = {&p};
    hipError_t e = hipLaunchCooperativeKernel((const void*)k_mega, dim3(grid_blocks), dim3(NTHR), args, LDS_TOTAL, stream);
    if (e != hipSuccess) fprintf(stderr, "kernel_launch: cooperative launch failed: %s (grid %d)\n", hipGetErrorString(e), grid_blocks);
}
```
